# Optimizing an MI355X kernel written in HIP

```python
import math
import jax, jax.numpy as jnp
from jax import lax
import numpy as np

D_MODEL = 1024
BATCH = 32
SEQ = 256
DEPTH = 2
DEC_BATCH = 8
DEC_SEQ = 2048
PAST_LEN = 256

GRID_W = 64
N_HEADS = 8
KV_HEADS = 2
HEAD_DIM = 64
Q_PER_KV = N_HEADS // KV_HEADS
ATTN_W = N_HEADS * HEAD_DIM
KV_W = KV_HEADS * HEAD_DIM
CONV_W = D_MODEL // 4
HYENA_W = D_MODEL // 4
MIX_W = ATTN_W + CONV_W + HYENA_W
IN_W = ATTN_W + 2 * KV_W + 2 * CONV_W + 3 * HYENA_W
WINDOW = 128
BLOCK = 128
CONV_K = 31
SHORT_K = 3
HYENA_ORDER = 2
HYENA_EMB = 33
HYENA_BANDS = (HYENA_EMB - 1) // 2
HYENA_HID = 64
D_FF = 2816
N_MOD = 9
ROPE_BASE = 10000.0
EPS = 1e-6
NEG_INF = -1e30

kernel_name = 'hybrid_prefix_diffusion_step'

F32 = jnp.float32


def rmsnorm(x, g):
    xf = x.astype(F32)
    y = xf * lax.rsqrt(jnp.mean(xf * xf, axis=-1, keepdims=True) + EPS)
    return (y * g.astype(F32)).astype(x.dtype)


def layernorm(x, g, b):
    xf = x.astype(F32)
    mu = jnp.mean(xf, axis=-1, keepdims=True)
    var = jnp.mean(jnp.square(xf - mu), axis=-1, keepdims=True)
    y = (xf - mu) * lax.rsqrt(var + EPS)
    return (y * g.astype(F32) + b.astype(F32)).astype(x.dtype)


def swiglu(h, wg, wu, wd):
    return (jax.nn.silu(h @ wg) * (h @ wu)) @ wd


def depthwise_conv(x, w, b):
    k = w.shape[0]
    y = lax.conv_general_dilated(x, w[:, None, :].astype(x.dtype), (1,), ((k // 2, k // 2),),
                                 dimension_numbers=('NWC', 'WIO', 'NWC'),
                                 feature_group_count=x.shape[-1])
    return y + b


def rope_2d(x):
    L = x.shape[1]
    rows = L // GRID_W
    row = jnp.repeat(jnp.arange(rows), GRID_W)
    col = jnp.arange(rows * GRID_W) % GRID_W
    nf = HEAD_DIM // 4
    inv = ROPE_BASE ** (-jnp.arange(nf, dtype=F32) / nf)
    xf = x.astype(F32)

    def rot(xp, pos):
        ang = pos.astype(F32)[:, None] * inv[None, :]
        cos = jnp.cos(ang)[None, :, None, :]
        sin = jnp.sin(ang)[None, :, None, :]
        a, b = xp[..., :nf], xp[..., nf:]
        return jnp.concatenate([a * cos - b * sin, b * cos + a * sin], axis=-1)

    half = HEAD_DIM // 2
    out = jnp.concatenate([rot(xf[..., :half], row), rot(xf[..., half:], col)], axis=-1)
    return out.astype(x.dtype)


def context_attention(q, k, v, sink):
    B, L = q.shape[0], q.shape[1]
    nb = L // BLOCK
    qb = q.reshape(B, nb, BLOCK, KV_HEADS, Q_PER_KV, HEAD_DIM).swapaxes(0, 1)
    sk = jnp.broadcast_to(sink.astype(F32).reshape(1, KV_HEADS, Q_PER_KV, 1, 1),
                          (B, KV_HEADS, Q_PER_KV, BLOCK, 1))
    scale = HEAD_DIM ** -0.5

    def one(qblk):
        s = jnp.einsum('bqgrd,bkgd->bgrqk', qblk, k).astype(F32) * scale
        p = jax.nn.softmax(jnp.concatenate([s, sk], axis=-1), axis=-1)[..., :-1]
        return jnp.einsum('bgrqk,bkgd->bqgrd', p.astype(v.dtype), v)

    o = lax.map(one, qb)
    return o.swapaxes(0, 1).reshape(B, L, ATTN_W)


def latent_attention(q, k, v, kc, vc, sink):
    B, L = q.shape[0], q.shape[1]
    nb = L // BLOCK
    nloc = 3 * BLOCK
    qb = q.reshape(B, nb, BLOCK, KV_HEADS, Q_PER_KV, HEAD_DIM).swapaxes(0, 1)
    pad = ((0, 0), (BLOCK, BLOCK), (0, 0), (0, 0))
    kp = jnp.pad(k, pad)
    vp = jnp.pad(v, pad)
    qi = jnp.arange(BLOCK)
    kj = jnp.arange(nloc)
    band = jnp.abs(kj[None, :] - BLOCK - qi[:, None]) <= WINDOW
    sk = jnp.broadcast_to(sink.astype(F32).reshape(1, KV_HEADS, Q_PER_KV, 1, 1),
                          (B, KV_HEADS, Q_PER_KV, BLOCK, 1))
    scale = HEAD_DIM ** -0.5

    def one(args):
        qblk, b = args
        kw = lax.dynamic_slice_in_dim(kp, b * BLOCK, nloc, axis=1)
        vw = lax.dynamic_slice_in_dim(vp, b * BLOCK, nloc, axis=1)
        j = (b - 1) * BLOCK + kj
        valid = band & ((j >= 0) & (j < L))[None, :]
        s_loc = jnp.einsum('bqgrd,bkgd->bgrqk', qblk, kw).astype(F32) * scale
        s_loc = jnp.where(valid, s_loc, NEG_INF)
        s_ctx = jnp.einsum('bqgrd,bcgd->bgrqc', qblk, kc).astype(F32) * scale
        p = jax.nn.softmax(jnp.concatenate([s_loc, s_ctx, sk], axis=-1), axis=-1)
        o = jnp.einsum('bgrqk,bkgd->bqgrd', p[..., :nloc].astype(v.dtype), vw)
        o = o + jnp.einsum('bgrqc,bcgd->bqgrd', p[..., nloc:-1].astype(vc.dtype), vc)
        return o

    o = lax.map(one, (qb, jnp.arange(nb)))
    return o.swapaxes(0, 1).reshape(B, L, ATTN_W)


def conformer_conv(u, dw, dwb, lng, lnb, pw):
    a, g = jnp.split(u, 2, axis=-1)
    y = a * jax.nn.sigmoid(g)
    y = depthwise_conv(y, dw, dwb)
    y = jax.nn.silu(layernorm(y, lng, lnb))
    return y @ pw


def hyena_filters(L, w1, b1, f1, w2, b2, f2, w3, log_decay):
    t = jnp.arange(L, dtype=F32)
    tn = t / (L - 1)
    bands = jnp.linspace(1e-4, HYENA_BANDS - 1, HYENA_BANDS, dtype=F32)
    ang = 2.0 * math.pi * t[:, None] * bands[None, :] / L
    z = jnp.concatenate([tn[:, None], jnp.cos(ang), -jnp.sin(ang)], axis=-1)
    h = jnp.sin(f1.astype(F32) * (z @ w1.astype(F32) + b1.astype(F32)))
    h = jnp.sin(f2.astype(F32) * (h @ w2.astype(F32) + b2.astype(F32)))
    h = (h @ w3.astype(F32)).reshape(L, HYENA_ORDER, 2, HYENA_W)
    decay = jnp.exp(log_decay.astype(F32)).reshape(HYENA_ORDER, 2, HYENA_W)
    h = h * jnp.exp(-tn[:, None, None, None] * decay[None])
    h = h * lax.rsqrt(jnp.sum(h * h, axis=(0, 2), keepdims=True) + EPS)
    return h


def bidir_longconv(u, hf, hb):
    L, C = u.shape[1], u.shape[2]
    hc = jnp.concatenate([hf, jnp.zeros((1, C), F32), hb[1:][::-1]], axis=0)
    U = jnp.fft.rfft(u.astype(F32), n=2 * L, axis=1)
    H = jnp.fft.rfft(hc, axis=0)
    y = jnp.fft.irfft(U * H[None], n=2 * L, axis=1)[:, :L]
    return y.astype(u.dtype)


def hyena_mixer(u, sw, sb, w1, b1, f1, w2, b2, f2, w3, log_decay, bias):
    L = u.shape[1]
    u = depthwise_conv(u, sw, sb)
    vv, x1, x2 = jnp.split(u, 3, axis=-1)
    h = hyena_filters(L, w1, b1, f1, w2, b2, f2, w3, log_decay)
    y = x1 * (bidir_longconv(vv, h[:, 0, 0], h[:, 0, 1]) + bias[0] * vv)
    y = x2 * (bidir_longconv(y, h[:, 1, 0], h[:, 1, 1]) + bias[1] * y)
    return y


def token_mix(h, l, P, cache):
    B, L = h.shape[0], h.shape[1]
    z = h @ P['w_in'][l]
    o1 = ATTN_W
    o2 = o1 + KV_W
    o3 = o2 + KV_W
    o4 = o3 + 2 * CONV_W
    q = z[..., :o1].reshape(B, L, N_HEADS, HEAD_DIM)
    k = z[..., o1:o2].reshape(B, L, KV_HEADS, HEAD_DIM)
    v = z[..., o2:o3].reshape(B, L, KV_HEADS, HEAD_DIM)
    if cache is None:
        att = context_attention(q, k, v, P['attn_sink'][l])
        kv_out = (k, v)
    else:
        att = latent_attention(rope_2d(q), rope_2d(k), v, cache[0], cache[1], P['attn_sink'][l])
        kv_out = None
    conv = conformer_conv(z[..., o3:o4], P['conv_dw'][l], P['conv_dw_b'][l],
                          P['conv_ln_g'][l], P['conv_ln_b'][l], P['conv_pw'][l])
    hy = hyena_mixer(z[..., o4:], P['hy_short_w'][l], P['hy_short_b'][l],
                     P['hy_w1'][l], P['hy_b1'][l], P['hy_f1'][l],
                     P['hy_w2'][l], P['hy_b2'][l], P['hy_f2'][l],
                     P['hy_w3'][l], P['hy_log_decay'][l], P['hy_bias'][l])
    out = jnp.concatenate([att, conv, hy], axis=-1) @ P['w_out'][l]
    return out, kv_out


def trunk_layer(x, cond, l, P, cache):
    mod = (jax.nn.silu(cond) @ P['w_mod'][l] + P['b_mod'][l])[:, None, :]
    sh1, sc1, g1, sh2, sc2, g2, sh3, sc3, g3 = jnp.split(mod, N_MOD, axis=-1)
    h = rmsnorm(x, P['g_ffn1'][l]) * (1 + sc1) + sh1
    x = x + 0.5 * g1 * swiglu(h, P['w1_gate'][l], P['w1_up'][l], P['w1_down'][l])
    h = rmsnorm(x, P['g_mix'][l]) * (1 + sc2) + sh2
    m, kv = token_mix(h, l, P, cache)
    x = x + g2 * m
    h = rmsnorm(x, P['g_ffn2'][l]) * (1 + sc3) + sh3
    x = x + 0.5 * g3 * swiglu(h, P['w2_gate'][l], P['w2_up'][l], P['w2_down'][l])
    return x, kv


def setup_inputs(seed: int = 0) -> dict:
    key = jax.random.key(seed)
    keys = iter(jax.random.split(key, 48))

    def nrm(shape, std):
        return std * jax.random.normal(next(keys), shape, F32)

    def gain(shape):
        return 1.0 + nrm(shape, 0.05)

    D = D_MODEL
    cache_shape = (DEC_BATCH, DEPTH, PAST_LEN, KV_HEADS, HEAD_DIM)
    return {
        'x_prompt': nrm((BATCH, SEQ, D), 1.0),
        'x_sample': nrm((DEC_BATCH, DEC_SEQ, D), 1.0),
        'c': nrm((DEC_BATCH, D), 1.0),
        'cache_k': nrm(cache_shape, 1.0),
        'cache_v': nrm(cache_shape, 1.0),
        'c_ctx': nrm((D,), 1.0),
        'w_mod': nrm((DEPTH, D, N_MOD * D), 0.5 * D ** -0.5),
        'b_mod': nrm((DEPTH, N_MOD * D), 0.02),
        'g_ffn1': gain((DEPTH, D)),
        'g_mix': gain((DEPTH, D)),
        'g_ffn2': gain((DEPTH, D)),
        'g_final': gain((D,)),
        'w1_gate': nrm((DEPTH, D, D_FF), D ** -0.5),
        'w1_up': nrm((DEPTH, D, D_FF), D ** -0.5),
        'w1_down': nrm((DEPTH, D_FF, D), D_FF ** -0.5),
        'w2_gate': nrm((DEPTH, D, D_FF), D ** -0.5),
        'w2_up': nrm((DEPTH, D, D_FF), D ** -0.5),
        'w2_down': nrm((DEPTH, D_FF, D), D_FF ** -0.5),
        'w_in': nrm((DEPTH, D, IN_W), D ** -0.5),
        'w_out': nrm((DEPTH, MIX_W, D), MIX_W ** -0.5),
        'attn_sink': nrm((DEPTH, N_HEADS), 0.5),
        'conv_dw': nrm((DEPTH, CONV_K, CONV_W), CONV_K ** -0.5),
        'conv_dw_b': nrm((DEPTH, CONV_W), 0.02),
        'conv_ln_g': gain((DEPTH, CONV_W)),
        'conv_ln_b': nrm((DEPTH, CONV_W), 0.02),
        'conv_pw': nrm((DEPTH, CONV_W, CONV_W), CONV_W ** -0.5),
        'hy_short_w': nrm((DEPTH, SHORT_K, 3 * HYENA_W), SHORT_K ** -0.5),
        'hy_short_b': nrm((DEPTH, 3 * HYENA_W), 0.02),
        'hy_w1': nrm((DEPTH, HYENA_EMB, HYENA_HID), HYENA_EMB ** -0.5),
        'hy_b1': nrm((DEPTH, HYENA_HID), 0.1),
        'hy_f1': gain((DEPTH, HYENA_HID)),
        'hy_w2': nrm((DEPTH, HYENA_HID, HYENA_HID), HYENA_HID ** -0.5),
        'hy_b2': nrm((DEPTH, HYENA_HID), 0.1),
        'hy_f2': gain((DEPTH, HYENA_HID)),
        'hy_w3': nrm((DEPTH, HYENA_HID, HYENA_ORDER * 2 * HYENA_W), HYENA_HID ** -0.5),
        'hy_log_decay': jax.random.uniform(next(keys), (DEPTH, HYENA_ORDER * 2 * HYENA_W), F32,
                                           math.log(3.0), math.log(15.0)),
        'hy_bias': nrm((DEPTH, HYENA_ORDER, HYENA_W), 0.5),
    }


def reference(x_prompt, x_sample, c, cache_k, cache_v, c_ctx, w_mod, b_mod, g_ffn1, g_mix, g_ffn2,
              g_final, w1_gate, w1_up, w1_down, w2_gate, w2_up, w2_down, w_in, w_out, attn_sink,
              conv_dw, conv_dw_b, conv_ln_g, conv_ln_b, conv_pw, hy_short_w, hy_short_b,
              hy_w1, hy_b1, hy_f1, hy_w2, hy_b2, hy_f2, hy_w3, hy_log_decay, hy_bias):
    P = dict(w_mod=w_mod, b_mod=b_mod, g_ffn1=g_ffn1, g_mix=g_mix, g_ffn2=g_ffn2,
             w1_gate=w1_gate, w1_up=w1_up, w1_down=w1_down,
             w2_gate=w2_gate, w2_up=w2_up, w2_down=w2_down,
             w_in=w_in, w_out=w_out, attn_sink=attn_sink,
             conv_dw=conv_dw, conv_dw_b=conv_dw_b, conv_ln_g=conv_ln_g, conv_ln_b=conv_ln_b,
             conv_pw=conv_pw, hy_short_w=hy_short_w, hy_short_b=hy_short_b,
             hy_w1=hy_w1, hy_b1=hy_b1, hy_f1=hy_f1, hy_w2=hy_w2, hy_b2=hy_b2, hy_f2=hy_f2,
             hy_w3=hy_w3, hy_log_decay=hy_log_decay, hy_bias=hy_bias)

    xp = x_prompt
    cond_ctx = c_ctx[None, :]
    ks = []
    vs = []
    for l in range(DEPTH):
        xp, kv = trunk_layer(xp, cond_ctx, l, P, None)
        ks.append(kv[0])
        vs.append(kv[1])

    xs = x_sample
    for l in range(DEPTH):
        xs, _ = trunk_layer(xs, c, l, P, (cache_k[:, l], cache_v[:, l]))

    y_prompt = rmsnorm(xp, g_final)
    y_sample = rmsnorm(xs, g_final)
    new_k = jnp.stack(ks, axis=1)
    new_v = jnp.stack(vs, axis=1)
    return (y_prompt, y_sample, new_k, new_v)
```

```cpp
#include <hip/hip_runtime.h>
#include <hip/hip_cooperative_groups.h>
#include <cstdio>
#include <cstdint>
namespace cg = cooperative_groups;

#ifndef MK_SINGLE
#define MK_SINGLE 1
#endif

constexpr int D = 1024, DFF = 2816, INW = 2048;
constexpr int MCTX = 8192, MLAT = 16384, M = MCTX + MLAT;
constexpr int LCTX = 256, LLAT = 2048;
constexpr int NCOND = 9, MODW = 9 * 1024;
constexpr int ZW = 1280;
constexpr int HYC = 768;
constexpr float EPS = 1e-6f;
constexpr float LOG2E = 1.4426950408889634f;
constexpr float QSCALE = 0.125f * LOG2E;

enum { I_XP = 0, I_XS, I_C, I_CK, I_CV, I_CCTX, I_WMOD, I_BMOD, I_GF1, I_GMIX, I_GF2, I_GFIN, I_W1G, I_W1U, I_W1D, I_W2G, I_W2U, I_W2D, I_WIN, I_WOUT, I_SINK,
       I_CDW, I_CDWB, I_CLNG, I_CLNB, I_CPW, I_HSW, I_HSB, I_HW1, I_HB1, I_HF1, I_HW2, I_HB2, I_HF2, I_HW3, I_HLD, I_HBIAS, N_IN };

constexpr size_t MiB = 1u << 20;
constexpr size_t WS_CTL = 0, CTL_ZERO_BYTES = 2 * MiB;
constexpr size_t WS_SUMSQ = 64 * 1024;
constexpr size_t WS_MOD = 128 * 1024;
constexpr size_t WS_SS = 1 * MiB;
constexpr size_t WS_ROPE = 3 * MiB;
constexpr size_t WS_BIAS = 3 * MiB + 64 * 1024;
constexpr size_t WS_WGU = 4 * MiB;
constexpr size_t WS_WD = 48 * MiB;
constexpr size_t WS_WIN = 70 * MiB;
constexpr size_t WS_WOUT = 78 * MiB;
constexpr size_t WS_CKB = 82 * MiB;
constexpr size_t WS_CVT = 83 * MiB;
constexpr size_t WS_HYH = 84 * MiB;
constexpr size_t WS_HYRAW = 86 * MiB;
constexpr size_t WS_H = 96 * MiB;
constexpr size_t WS_BIG = 144 * MiB;
constexpr size_t WS_Z = WS_BIG;
constexpr size_t WS_ZT = 204 * MiB;
constexpr size_t WS_CAT = 276 * MiB;
constexpr size_t WS_END = 324 * MiB;
static_assert(WS_MOD + 2 * 9 * 9216 * 4 <= WS_SS && WS_SS + 7 * (size_t)M * 4 <= CTL_ZERO_BYTES && WS_BIAS + 2 * 9 * 13312 * 4 <= WS_WGU, "ctl");
static_assert(WS_BIG + (size_t)M * DFF * 2 <= WS_END && WS_Z + (size_t)M * ZW * 2 <= WS_ZT && WS_ZT + (size_t)896 * M * 2 <= WS_END, "ws map");
constexpr int CW_BAR = 4096;

constexpr int RING_BYTES = 131072;
constexpr int LDSCTL_OFF = 133120, MISC_OFF = LDSCTL_OFF + 320;
constexpr int LDS_BYTES = 135168;
constexpr int NWAVES = 8, NTHREADS = 512;

namespace pg8 {
#define PG8_LAS __attribute__((address_space(3)))
typedef unsigned short bf16_t;
typedef short bf16x8 __attribute__((ext_vector_type(8)));
typedef float f32x4 __attribute__((ext_vector_type(4)));
typedef unsigned u32x4 __attribute__((ext_vector_type(4)));
constexpr int BM = 256, BK = 64, HALF = 128, HTB = HALF * BK * 2  , STAGE_BYTES = 8 * HTB, NXCD = 8, WGM = 8;

__host__ __device__ __forceinline__ int lds_byte(int r, int c) { const int st = (r >> 4) * 2 + (c >> 5), rr = r & 15, cc = c & 31, ob = rr * 64 + cc * 2; return st * 1024 + (ob ^ (((ob >> 9) & 1) << 5)); }
__host__ __device__ __forceinline__ void stage_rc(int b, int& R, int& C) { const int st = b / 1024, sb = b % 1024, swz = sb ^ (((sb >> 9) & 1) << 5); R = (st >> 1) * 16 + swz / 64; C = (st & 1) * 32 + (swz % 64) / 2; }
__host__ __device__ __forceinline__ int perm32(int rho) { const int n = rho >> 4, i = rho & 15; return 8 * (i >> 2) + 4 * n + (i & 3); }

struct Unit { int pm, pn; };
struct Gemm { const bf16_t* A; const bf16_t* Bt; int M, N, K; };

struct StaticOrder {
    int nM, nN, nwg, G, c;
    __host__ __device__ void init(int M, int N, int G_, int c_) { nM = M / BM; nN = N / BM; nwg = nM * nN; G = G_; c = c_; }
    __host__ __device__ bool next(int i, Unit& u) const {
        const long L = (long)i * G + c; if (L >= nwg) return false;
        int wgid = (int)L; { const int q = nwg / NXCD, r = nwg % NXCD, xcd = wgid % NXCD, off = wgid / NXCD; wgid = (xcd < r ? xcd * (q + 1) : r * (q + 1) + (xcd - r) * q) + off; }
        const int nig = WGM * nN, gid = wgid / nig, fm = gid * WGM, gsz = (nM - fm) < WGM ? (nM - fm) : WGM;
        u.pm = fm + ((wgid % nig) % gsz); u.pn = (wgid % nig) / gsz; return true;
    }
    __device__ __forceinline__ void a_ready(const Unit&) const {}
    __device__ __forceinline__ void done(const Unit&) const {}
};


__device__ __forceinline__ unsigned cvt_pk_bf16(float lo, float hi) { unsigned r; asm volatile("v_cvt_pk_bf16_f32 %0, %1, %2" : "=v"(r) : "v"(lo), "v"(hi)); return r; }
__device__ __forceinline__ float silu_f(float x) { return x * __builtin_amdgcn_rcpf(1.0f + __builtin_amdgcn_exp2f(-1.4426950408889634f * x)); }
__device__ __forceinline__ int cond_of_tile(int pm) { return pm < 32 ? 0 : 1 + ((pm - 32) >> 3); }

struct EpiGU {
    static constexpr bool PERM = true, AFTER_DRAIN = false;
    bf16_t* O;
    const float* ss; const float* bias;
    __device__ __forceinline__ void operator()(const f32x4 (&acc)[2][2][4][2], const Unit& u, int wr, int wc, int fr, int fq) const {
        const int row0 = u.pm * BM + wr * 64 + fr, col0 = u.pn * HALF + wc * 32 + 8 * fq;
        const float* bp = bias + cond_of_tile(u.pm) * 5632 + u.pn * BM + wc * 32 + 8 * fq;
        const f32x4 bg0 = *(const f32x4*)bp, bg1 = *(const f32x4*)(bp + 4), bu0 = *(const f32x4*)(bp + HALF), bu1 = *(const f32x4*)(bp + HALF + 4);
        float rsv[2][4];
#pragma unroll
        for (int ai = 0; ai < 2; ++ai)
#pragma unroll
            for (int m = 0; m < 4; ++m) rsv[ai][m] = ss[row0 + ai * HALF + m * 16];
#pragma unroll
        for (int ai = 0; ai < 2; ++ai)
#pragma unroll
            for (int m = 0; m < 4; ++m) { const int row = row0 + ai * HALF + m * 16; bf16_t* rowp = O + (size_t)row * 2816 + col0;
                const float rs = __builtin_amdgcn_rsqf(rsv[ai][m] * (1.0f / 1024.0f) + 1e-6f);
                const f32x4 g0 = acc[ai][0][m][0] * rs + bg0, g1 = acc[ai][0][m][1] * rs + bg1, u0 = acc[ai][1][m][0] * rs + bu0, u1 = acc[ai][1][m][1] * rs + bu1;
                u32x4 w;
                w.x = cvt_pk_bf16(silu_f(g0[0]) * u0[0], silu_f(g0[1]) * u0[1]); w.y = cvt_pk_bf16(silu_f(g0[2]) * u0[2], silu_f(g0[3]) * u0[3]);
                w.z = cvt_pk_bf16(silu_f(g1[0]) * u1[0], silu_f(g1[1]) * u1[1]); w.w = cvt_pk_bf16(silu_f(g1[2]) * u1[2], silu_f(g1[3]) * u1[3]);
                *(u32x4*)rowp = w; }
    }
};
struct EpiRes {
    static constexpr bool PERM = false, AFTER_DRAIN = false;
    const float* in0; const float* in1; float* X; const float* gate;
    bf16_t* Hn; const float* gn; const float* scn; float* ssn; float scale;
    __device__ __forceinline__ void operator()(const f32x4 (&acc)[2][2][4][2], const Unit& u, int wr, int wc, int fr, int fq) const {
        const int cond = cond_of_tile(u.pm); const float* gp = gate + cond * 9216;
        const int col0 = u.pn * BM + wc * 32 + 4 * fq;
        f32x4 gv[2][2], gc[2][2];
        const bool ctx = u.pm < 32; const float* src = ctx ? in0 : in1; const int rbase = u.pm * BM - (ctx ? 0 : 8192);
        typedef unsigned u32x2 __attribute__((ext_vector_type(2)));
        { f32x4 nraw[2][2], sraw[2][2];
#pragma unroll
          for (int bj = 0; bj < 2; ++bj)
#pragma unroll
              for (int n = 0; n < 2; ++n) { gv[bj][n] = *(const f32x4*)(gp + col0 + bj * HALF + n * 16);
                  if (Hn) { nraw[bj][n] = *(const f32x4*)(gn + col0 + bj * HALF + n * 16); sraw[bj][n] = *(const f32x4*)(scn + cond * 9216 + col0 + bj * HALF + n * 16); } }
#pragma unroll
          for (int bj = 0; bj < 2; ++bj)
#pragma unroll
              for (int n = 0; n < 2; ++n) { gv[bj][n] = gv[bj][n] * scale; if (Hn) gc[bj][n] = nraw[bj][n] * (sraw[bj][n] + 1.0f); else gc[bj][n] = (f32x4){0.f, 0.f, 0.f, 0.f}; } }
        f32x4 xo[1][2][2][2];
#define EPIRES_LOAD(buf_, ag_) do { _Pragma("unroll") for (int mm = 0; mm < 2; ++mm) { const float* sp = src + (size_t)(rbase + ((ag_) >> 1) * HALF + wr * 64 + (((ag_) & 1) * 2 + mm) * 16 + fr) * 1024 + col0; \
            _Pragma("unroll") for (int bj = 0; bj < 2; ++bj) _Pragma("unroll") for (int n = 0; n < 2; ++n) xo[buf_][mm][bj][n] = *(const f32x4*)(sp + bj * HALF + n * 16); } } while (0)
#pragma unroll
        for (int ag = 0; ag < 4; ++ag) { const int ai = ag >> 1, m0 = (ag & 1) * 2;
            EPIRES_LOAD(0, ag);
#pragma unroll
            for (int mm = 0; mm < 2; ++mm) { const int m = m0 + mm; const int rl = ai * HALF + wr * 64 + m * 16 + fr;
                float* xp = X + (size_t)(u.pm * BM + rl) * 1024 + col0;
                float sq = 0.f;
#pragma unroll
                for (int bj = 0; bj < 2; ++bj)
#pragma unroll
                    for (int n = 0; n < 2; ++n) { const f32x4 xn = xo[0][mm][bj][n] + gv[bj][n] * acc[ai][bj][m][n];
                        *(f32x4*)(xp + bj * HALF + n * 16) = xn; sq += (xn[0] * xn[0] + xn[1] * xn[1]) + (xn[2] * xn[2] + xn[3] * xn[3]);
                        if (Hn) { const f32x4 hv = xn * gc[bj][n]; u32x2 w; w.x = cvt_pk_bf16(hv[0], hv[1]); w.y = cvt_pk_bf16(hv[2], hv[3]); *(u32x2*)(Hn + (size_t)(u.pm * BM + rl) * 1024 + col0 + bj * HALF + n * 16) = w; } }
                sq += __shfl_xor(sq, 16); sq += __shfl_xor(sq, 32);
                if (fq == 0) atomicAdd(ssn + u.pm * BM + rl, sq); }
        }
#undef EPIRES_LOAD
    }
};
struct EpiIN {
    static constexpr bool PERM = false, AFTER_DRAIN = false;
    bf16_t* Z; bf16_t* ZT; float* newk; float* newv; const float* rope; const float* ss; const float* bias; int layer; float qscale;
    __device__ __forceinline__ void operator()(const f32x4 (&acc)[2][2][4][2], const Unit& u, int wr, int wc, int fr, int fq) const {
        const bool lat = u.pm >= 32;
        const int colb = u.pn * BM + wc * 32 + 4 * fq;
        const float* bp = bias + cond_of_tile(u.pm) * 2048 + colb;
        f32x4 bv[2][2];
#pragma unroll
        for (int bj = 0; bj < 2; ++bj)
#pragma unroll
            for (int n = 0; n < 2; ++n) bv[bj][n] = *(const f32x4*)(bp + bj * HALF + n * 16);
        const bool roped = lat && u.pn < 3;
        float rsv[2][4];
#pragma unroll
        for (int ai = 0; ai < 2; ++ai)
#pragma unroll
            for (int m = 0; m < 4; ++m) rsv[ai][m] = ss[u.pm * BM + ai * HALF + wr * 64 + m * 16 + fr];
#pragma unroll
        for (int ai = 0; ai < 2; ++ai) {
            f32x4 rc0[4], rc1[4];
#pragma unroll
            for (int m = 0; m < 4; ++m) { rc0[m] = (f32x4){1.f, 0.f, 1.f, 0.f}; rc1[m] = rc0[m];
                if (roped) { const int pos = (u.pm * BM + ai * HALF + wr * 64 + m * 16 + fr - 8192) & 2047; const int p = (wc & 1) ? (pos & 63) : (pos >> 6);
                    const f32x4* rp = (const f32x4*)(rope + (size_t)(p * 16 + 4 * fq) * 2); rc0[m] = rp[0]; rc1[m] = rp[1]; } }
#pragma unroll
            for (int m = 0; m < 4; ++m) { const int row = u.pm * BM + ai * HALF + wr * 64 + m * 16 + fr;
                const float rs = __builtin_amdgcn_rsqf(rsv[ai][m] * (1.0f / 1024.0f) + 1e-6f);
#pragma unroll
                for (int bj = 0; bj < 2; ++bj) { const int col = colb + bj * HALF;
                    f32x4 v0 = acc[ai][bj][m][0] * rs + bv[bj][0], v1 = acc[ai][bj][m][1] * rs + bv[bj][1];
                    if (u.pn < 5) {
                        const int cb = u.pn * BM + bj * HALF;
                        if (lat && cb < 640) {
                            const f32x4 cs0 = rc0[m], cs1 = rc1[m];
                            const float c0 = cs0[0], s0 = cs0[1], c1 = cs0[2], s1 = cs0[3], c2 = cs1[0], s2 = cs1[1], c3 = cs1[2], s3 = cs1[3];
                            const f32x4 a = v0, b = v1;
                            v0[0] = a[0] * c0 - b[0] * s0; v1[0] = b[0] * c0 + a[0] * s0;
                            v0[1] = a[1] * c1 - b[1] * s1; v1[1] = b[1] * c1 + a[1] * s1;
                            v0[2] = a[2] * c2 - b[2] * s2; v1[2] = b[2] * c2 + a[2] * s2;
                            v0[3] = a[3] * c3 - b[3] * s3; v1[3] = b[3] * c3 + a[3] * s3;
                        }
                        if (!lat && cb >= 512 && cb < 768) {
                            const int b = row >> 8, s = row & 255; float* dst = (cb < 640 ? newk : newv) + ((size_t)(b * 2 + layer) * 256 + s) * 128 + (col - cb);
                            *(f32x4*)dst = v0; *(f32x4*)(dst + 16) = v1;
                        }
                        if (cb < 512) { v0 = v0 * qscale; v1 = v1 * qscale; }
                        if (cb == 640) {
                            const int ch = 768 + col - 640;
#pragma unroll
                            for (int j = 0; j < 4; ++j) { ZT[(size_t)(ch + j) * 24576 + row] = (bf16_t)(cvt_pk_bf16(v0[j], 0.f) & 0xffffu); ZT[(size_t)(ch + 16 + j) * 24576 + row] = (bf16_t)(cvt_pk_bf16(v1[j], 0.f) & 0xffffu); }
                        } else {
                        bf16_t* zp = Z + (size_t)row * 1280 + col;
                        typedef unsigned u32x2 __attribute__((ext_vector_type(2)));
                        u32x2 w0, w1; w0.x = cvt_pk_bf16(v0[0], v0[1]); w0.y = cvt_pk_bf16(v0[2], v0[3]); w1.x = cvt_pk_bf16(v1[0], v1[1]); w1.y = cvt_pk_bf16(v1[2], v1[3]);
                        *(u32x2*)zp = w0; *(u32x2*)(zp + 16) = w1; }
                    } else {
                        const int ch = col - 1280;
#pragma unroll
                        for (int j = 0; j < 4; ++j) { ZT[(size_t)(ch + j) * 24576 + row] = (bf16_t)(cvt_pk_bf16(v0[j], 0.f) & 0xffffu); ZT[(size_t)(ch + 16 + j) * 24576 + row] = (bf16_t)(cvt_pk_bf16(v1[j], 0.f) & 0xffffu); }
                    }
                } }
        }
    }
};

template <class Epi, class Sched, bool ALIGN_EPI = false, bool SP2 = false>
__device__ __forceinline__ void gemm_phase(PG8_LAS unsigned char* lds, const Gemm g, const Sched S, const Epi E) {
    const int tid = threadIdx.x, wid = __builtin_amdgcn_readfirstlane(tid >> 6), lane = tid & 63, wr = wid >> 2, wc = wid & 3, fr = lane & 15, fq = lane >> 4;
    const int K = g.K, nt = K / BK;
    unsigned voffA[2], voffB[2];
#pragma unroll
    for (int i = 0; i < 2; ++i) { int R, C; stage_rc(tid * 16 + i * 8192, R, C); const int Rb = Epi::PERM ? ((R & ~31) + perm32(R & 31)) : R;
        voffA[i] = (unsigned)(R * K + C) * 2u; voffB[i] = (unsigned)(Rb * K + C) * 2u; }
    const size_t kstep = (size_t)(BK * 2);
    const size_t hstep = (size_t)HALF * K * 2;
    const size_t tstep = 2 * hstep;
    const unsigned ldsw = (unsigned)wid * 1024u;
    const int aoff = lds_byte(wr * 64 + fr, fq * 8), boff = lds_byte(wc * 32 + fr, fq * 8);
#define PG8_SA(b, h) (((b) * 2 + (h)) * HTB)
#define PG8_SB(b, h) ((4 + (b) * 2 + (h)) * HTB)
#define PG8_STAGE(bufoff, gbase, voff) do { _Pragma("unroll") for (int _i = 0; _i < 2; ++_i) \
        __builtin_amdgcn_global_load_lds((const unsigned*)((const char*)(gbase) + (voff)[_i]), (PG8_LAS unsigned*)(lds + (bufoff) + ldsw + _i * 8192), 16, 0, 0); } while (0)
#define PG8_LDA(dst, b, h) do { _Pragma("unroll") for (int m = 0; m < 4; ++m) _Pragma("unroll") for (int k = 0; k < 2; ++k) dst[m][k] = *(const PG8_LAS bf16x8*)(lds + PG8_SA(b, h) + aoff + m * 2048 + k * 1024); } while (0)
#define PG8_LDB(dst, b, h) do { _Pragma("unroll") for (int n = 0; n < 2; ++n) _Pragma("unroll") for (int k = 0; k < 2; ++k) dst[n][k] = *(const PG8_LAS bf16x8*)(lds + PG8_SB(b, h) + boff + n * 2048 + k * 1024); } while (0)
#define PG8_MMA(ai, bj, At, Bt) do { __builtin_amdgcn_s_setprio(1); _Pragma("unroll") for (int m = 0; m < 4; ++m) _Pragma("unroll") for (int n = 0; n < 2; ++n) _Pragma("unroll") for (int k = 0; k < 2; ++k) \
        acc[ai][bj][m][n] = __builtin_amdgcn_mfma_f32_16x16x32_bf16(Bt[n][k], At[m][k], acc[ai][bj][m][n], 0, 0, 0); __builtin_amdgcn_s_setprio(0); } while (0)
#define PG8_WAIT_V(n) asm volatile("s_waitcnt vmcnt(" #n ")" ::: "memory")
#define PG8_WAIT_L(n) asm volatile("s_waitcnt lgkmcnt(" #n ")" ::: "memory")
#define PG8_BAR __builtin_amdgcn_s_barrier()
#define PG8_SCHED __builtin_amdgcn_sched_barrier(0)
    Unit cur, nxt; int ui = 0;
    if (!S.next(0, cur)) return;
    f32x4 acc[2][2][4][2];
#pragma unroll
    for (int a = 0; a < 2; ++a)
#pragma unroll
        for (int b = 0; b < 2; ++b)
#pragma unroll
            for (int m = 0; m < 4; ++m)
#pragma unroll
                for (int n = 0; n < 2; ++n) acc[a][b][m][n] = (f32x4){0.f, 0.f, 0.f, 0.f};
    bf16x8 At[4][2], B0[2][2], B1[2][2];
    const char* cA = (const char*)g.A + (size_t)cur.pm * tstep; const char* cB = (const char*)g.Bt + (size_t)cur.pn * tstep;
    S.a_ready(cur);
    if constexpr (SP2) {
        PG8_STAGE(PG8_SB(0, 0), cB, voffB); PG8_STAGE(PG8_SB(0, 1), cB + hstep, voffB); PG8_STAGE(PG8_SA(0, 0), cA, voffA); PG8_STAGE(PG8_SA(0, 1), cA + hstep, voffA);
        if (wr == 1) PG8_BAR;
        PG8_WAIT_V(2); PG8_BAR;
        PG8_STAGE(PG8_SB(1, 0), cB + kstep, voffB); PG8_STAGE(PG8_SA(1, 0), cA + kstep, voffA); PG8_STAGE(PG8_SB(1, 1), cB + hstep + kstep, voffB);
        PG8_WAIT_V(6); PG8_BAR;
    } else {
        PG8_STAGE(PG8_SB(0, 0), cB, voffB); PG8_STAGE(PG8_SA(0, 0), cA, voffA); PG8_STAGE(PG8_SB(0, 1), cB + hstep, voffB); PG8_STAGE(PG8_SA(0, 1), cA + hstep, voffA);
        if (wr == 1) PG8_BAR;
        PG8_WAIT_V(4); PG8_BAR;
        PG8_STAGE(PG8_SB(1, 0), cB + kstep, voffB); PG8_STAGE(PG8_SA(1, 0), cA + kstep, voffA); PG8_STAGE(PG8_SB(1, 1), cB + hstep + kstep, voffB);
        PG8_WAIT_V(6); PG8_BAR;
    }
    for (;;) {
        const bool has_next = S.next(ui + 1, nxt);
        const char* nA = has_next ? (const char*)g.A + (size_t)nxt.pm * tstep : cA; const char* nB = has_next ? (const char*)g.Bt + (size_t)nxt.pn * tstep : cB;
        for (int t = 0; t < nt; t += 2) {
            const bool last = (t == nt - 2);
            const char* a1 = cA + (size_t)(t + 1) * kstep;
            const char* a2 = last ? nA : cA + (size_t)(t + 2) * kstep; const char* b2 = last ? nB : cB + (size_t)(t + 2) * kstep;
            const char* a3 = a2 + kstep; const char* b3 = b2 + kstep;
            if (last && has_next) S.a_ready(nxt);
            if constexpr (SP2) {
            PG8_LDB(B0, 0, 0); PG8_LDB(B1, 0, 1); PG8_SCHED; PG8_LDA(At, 0, 0); PG8_STAGE(PG8_SA(1, 1), a1 + hstep, voffA);
            PG8_WAIT_V(8); PG8_WAIT_L(0); PG8_BAR; PG8_MMA(0, 0, At, B0); PG8_MMA(0, 1, At, B1); PG8_BAR; PG8_SCHED;
            PG8_LDA(At, 0, 1); PG8_STAGE(PG8_SB(0, 0), b2, voffB); PG8_STAGE(PG8_SB(0, 1), b2 + hstep, voffB); PG8_STAGE(PG8_SA(0, 0), a2, voffA);
            PG8_WAIT_V(8); PG8_WAIT_L(0); PG8_BAR; PG8_MMA(1, 0, At, B0); PG8_MMA(1, 1, At, B1); PG8_BAR; PG8_SCHED;
            PG8_LDB(B0, 1, 0); PG8_LDB(B1, 1, 1); PG8_SCHED; PG8_LDA(At, 1, 0); PG8_STAGE(PG8_SA(0, 1), a2 + hstep, voffA);
            PG8_WAIT_V(8); PG8_WAIT_L(0); PG8_BAR; PG8_MMA(0, 0, At, B0); PG8_MMA(0, 1, At, B1); PG8_BAR; PG8_SCHED;
            PG8_LDA(At, 1, 1); PG8_STAGE(PG8_SB(1, 0), b3, voffB); PG8_STAGE(PG8_SB(1, 1), b3 + hstep, voffB); PG8_STAGE(PG8_SA(1, 0), a3, voffA);
            PG8_WAIT_V(8); PG8_WAIT_L(0); PG8_BAR; PG8_MMA(1, 0, At, B0); PG8_MMA(1, 1, At, B1); PG8_BAR; PG8_SCHED;
            } else {
            PG8_LDB(B0, 0, 0); PG8_SCHED; PG8_LDA(At, 0, 0); PG8_STAGE(PG8_SA(1, 1), a1 + hstep, voffA);
            PG8_WAIT_L(8); PG8_BAR; PG8_WAIT_L(0); PG8_MMA(0, 0, At, B0); PG8_BAR; PG8_SCHED;
            PG8_LDB(B1, 0, 1); PG8_STAGE(PG8_SB(0, 0), b2, voffB);
            PG8_BAR; PG8_WAIT_L(0); PG8_MMA(0, 1, At, B1); PG8_BAR;
            PG8_LDA(At, 0, 1); PG8_STAGE(PG8_SA(0, 0), a2, voffA);
            PG8_BAR; PG8_WAIT_L(0); PG8_MMA(1, 0, At, B0); PG8_BAR; PG8_SCHED;
            PG8_STAGE(PG8_SB(0, 1), b2 + hstep, voffB);
            PG8_WAIT_V(6); PG8_BAR; PG8_MMA(1, 1, At, B1); PG8_BAR;
            PG8_LDB(B0, 1, 0); PG8_SCHED; PG8_LDA(At, 1, 0); PG8_STAGE(PG8_SA(0, 1), a2 + hstep, voffA);
            PG8_WAIT_L(8); PG8_BAR; PG8_WAIT_L(0); PG8_MMA(0, 0, At, B0); PG8_BAR; PG8_SCHED;
            PG8_LDB(B1, 1, 1); PG8_STAGE(PG8_SB(1, 0), b3, voffB);
            PG8_BAR; PG8_WAIT_L(0); PG8_MMA(0, 1, At, B1); PG8_BAR;
            PG8_LDA(At, 1, 1); PG8_STAGE(PG8_SA(1, 0), a3, voffA);
            PG8_BAR; PG8_WAIT_L(0); PG8_MMA(1, 0, At, B0); PG8_BAR; PG8_SCHED;
            PG8_STAGE(PG8_SB(1, 1), b3 + hstep, voffB);
            PG8_WAIT_V(6); PG8_BAR; PG8_MMA(1, 1, At, B1); PG8_BAR;
            }
        }
        if constexpr (ALIGN_EPI) { if (wr == 0) PG8_BAR; }
        if constexpr (!Epi::AFTER_DRAIN) { E(acc, cur, wr, wc, fr, fq); S.done(cur); }
        if (!has_next) break;
#pragma unroll
        for (int a = 0; a < 2; ++a)
#pragma unroll
            for (int b = 0; b < 2; ++b)
#pragma unroll
                for (int m = 0; m < 4; ++m)
#pragma unroll
                    for (int n = 0; n < 2; ++n) acc[a][b][m][n] = (f32x4){0.f, 0.f, 0.f, 0.f};
        cur = nxt; cA = nA; cB = nB; ++ui;
        if constexpr (ALIGN_EPI) { if (wr == 1) PG8_BAR; }
    }
    PG8_WAIT_V(0);
    if constexpr (!ALIGN_EPI) { if (wr == 0) PG8_BAR; }
    PG8_BAR;
    if constexpr (Epi::AFTER_DRAIN) { E.fused(acc, cur, wr, wc, fr, fq, lds, wid, lane); S.done(cur); }
#undef PG8_SA
#undef PG8_SB
#undef PG8_STAGE
#undef PG8_LDA
#undef PG8_LDB
#undef PG8_MMA
#undef PG8_WAIT_V
#undef PG8_WAIT_L
#undef PG8_BAR
#undef PG8_SCHED
}
}

#define GAS __attribute__((address_space(1)))
#define LAS __attribute__((address_space(3)))
typedef unsigned short bf16;
typedef unsigned v4u __attribute__((ext_vector_type(4)));
typedef unsigned v2u __attribute__((ext_vector_type(2)));
typedef float f32x4 __attribute__((ext_vector_type(4)));
typedef short bf16x8 __attribute__((ext_vector_type(8)));
typedef GAS unsigned gu32;
#define RLX_AGENT __ATOMIC_RELAXED, __HIP_MEMORY_SCOPE_AGENT
#define LDS_WAIT() asm volatile("s_waitcnt lgkmcnt(0)" ::: "memory")
#define VM_WAIT() asm volatile("s_waitcnt vmcnt(0)" ::: "memory")
__device__ __forceinline__ unsigned f2bf(float f) { unsigned u = __builtin_bit_cast(unsigned, f); return (u + 0x7fffu + ((u >> 16) & 1u)) >> 16; }
__device__ __forceinline__ unsigned pk2(float lo, float hi) { return f2bf(lo) | (f2bf(hi) << 16); }
__device__ __forceinline__ float bf2f(unsigned h) { return __builtin_bit_cast(float, h << 16); }
__device__ __forceinline__ float bflo(unsigned w) { return __builtin_bit_cast(float, w << 16); }
__device__ __forceinline__ float bfhi(unsigned w) { return __builtin_bit_cast(float, w & 0xffff0000u); }
__device__ __forceinline__ float wave_sum(float v) {
#pragma unroll
    for (int o = 1; o < 64; o <<= 1) v += __shfl_xor(v, o);
    return v;
}
__device__ __forceinline__ float silu_acc(float x) { return x / (1.0f + __expf(-x)); }

#define XB_TMO      128
#define XB_XCNT(j)  (256  + 64 * (j))
#define XB_XSUB(j)  (1280 + 64 * (j))
#define XB_XGEN(j)  (2304 + 64 * (j))
#define XB_TOP      3328
#define XB_TOPGEN   3392
#define XCD_BAR_WORDS 3456
#define XB_SPIN_CAP (1u << 18)
__device__ __forceinline__ unsigned xb_ld(unsigned* p)              { return __hip_atomic_load(p, __ATOMIC_RELAXED, __HIP_MEMORY_SCOPE_AGENT); }
__device__ __forceinline__ unsigned xb_add(unsigned* p, unsigned v) { return __hip_atomic_fetch_add(p, v, __ATOMIC_RELAXED, __HIP_MEMORY_SCOPE_AGENT); }
__device__ __forceinline__ unsigned xb_xcc_id() { return (unsigned)__builtin_amdgcn_s_getreg((3 << 11) | 20) & 0xFu; }
#define XB_SPIN(cond, bar) do { unsigned _sp = 0; while (cond) { __builtin_amdgcn_s_sleep(1); \
    if ((++_sp & 255u) == 0u) { if (xb_ld(&(bar)[XB_TMO])) break; if (_sp > XB_SPIN_CAP) { atomicAdd(&(bar)[XB_TMO], 1u); break; } } } } while (0)
struct XcdBarrier { unsigned* bar; unsigned x; volatile LAS unsigned* st; };
__device__ __forceinline__ XcdBarrier xcd_barrier_post(unsigned* bar, volatile LAS unsigned* st) {
    XcdBarrier b; b.bar = bar; b.x = xb_xcc_id(); b.st = st;
    if (threadIdx.x == 0) (void)xb_add(&bar[XB_XCNT(b.x)], 1u);
    return b;
}
__device__ __forceinline__ void xcd_barrier_complete(unsigned* bar, unsigned x, unsigned& nloc, unsigned& nx) {
    const unsigned G = gridDim.x * gridDim.y * gridDim.z;
    unsigned sum, cnt, mine, sp = 0u;
    for (;;) {
        sum = 0u; cnt = 0u; mine = 0u;
#pragma unroll
        for (unsigned j = 0; j < 16; ++j) { const unsigned c = xb_ld(&bar[XB_XCNT(j)]); sum += c; cnt += (c > 0u) ? 1u : 0u; mine = (j == x) ? c : mine; }
        if (sum == G) break;
        __builtin_amdgcn_s_sleep(1);
        if ((++sp & 255u) == 0u) { if (xb_ld(&bar[XB_TMO])) break; if (sp > XB_SPIN_CAP) { atomicAdd(&bar[XB_TMO], 1u); break; } }
    }
    nloc = mine > 0u ? mine : 1u; nx = cnt > 0u ? cnt : 1u;
}
__device__ __forceinline__ void xcd_barrier(const XcdBarrier& b) {
    asm volatile("s_waitcnt vmcnt(0)" ::: "memory");
    __syncthreads();
    if (threadIdx.x == 0) {
        unsigned* bar = b.bar;
        __builtin_amdgcn_s_waitcnt(0);
        unsigned nloc = b.st[0], nx = b.st[1];
        if (nloc == 0u) { xcd_barrier_complete(bar, b.x, nloc, nx); b.st[0] = nloc; b.st[1] = nx; }
        const unsigned old = xb_add(&bar[XB_XSUB(b.x)], 1u);
        const unsigned gen = old / nloc;
        if (old + 1u == (gen + 1u) * nloc) {
            __builtin_amdgcn_fence(__ATOMIC_RELEASE, "agent");
            asm volatile("s_waitcnt vmcnt(0)" ::: "memory");
            const unsigned og = xb_add(&bar[XB_TOP], 1u);
            const unsigned tg = og / nx;
            if (og + 1u == (tg + 1u) * nx) xb_add(&bar[XB_TOPGEN], 1u);
            else XB_SPIN(xb_ld(&bar[XB_TOPGEN]) == tg, bar);
            __builtin_amdgcn_fence(__ATOMIC_ACQUIRE, "agent");
            xb_add(&bar[XB_XGEN(b.x)], 1u);
            asm volatile("s_waitcnt vmcnt(0)" ::: "memory");
        } else {
            XB_SPIN(xb_ld(&bar[XB_XGEN(b.x)]) == gen, bar);
            __builtin_amdgcn_fence(__ATOMIC_ACQUIRE, "agent");
            asm volatile("s_waitcnt vmcnt(0)" ::: "memory");
        }
    }
    __syncthreads();
}

struct Args { const float* in[N_IN]; float* out; unsigned char* ws; int ph_lo, ph_hi; };

__device__ __forceinline__ void transpose_item(const float* W, int N, bf16* WT, int Kd, int kb, int nb, int mode, LAS float* scr, int lane) {
    const int k0 = 64 * kb, n0 = 32 * nb;
    float tv[32];
#pragma unroll
    for (int i = 0; i < 32; ++i) tv[i] = W[(size_t)(k0 + 2 * i + (lane >> 5)) * N + n0 + (lane & 31)];
#pragma unroll
    for (int i = 0; i < 32; ++i) scr[(2 * i + (lane >> 5)) * 33 + (lane & 31)] = tv[i];
    LDS_WAIT(); asm volatile("" ::: "memory");
    const int c = lane & 7;
    const int drow0 = mode == 0 ? n0 : ((n0 >> 7) * 256 + (n0 & 127) + (mode == 2 ? 128 : 0));
#pragma unroll
    for (int j = 0; j < 4; ++j) { const int n = (lane >> 3) + 8 * j; const LAS float* s = scr + (8 * c) * 33 + n;
        v4u o; o.x = pk2(s[0 * 33], s[1 * 33]); o.y = pk2(s[2 * 33], s[3 * 33]); o.z = pk2(s[4 * 33], s[5 * 33]); o.w = pk2(s[6 * 33], s[7 * 33]);
        *(v4u*)(WT + (size_t)(drow0 + n) * Kd + k0 + 8 * c) = o; }
    LDS_WAIT(); asm volatile("" ::: "memory");
}

__device__ __forceinline__ void p0_prologue(const Args& a, LAS unsigned char* lds, int gw, int NGW, int wave, int lane, const bool with_j3) {
    unsigned char* ws = a.ws;
    LAS float* scr = (LAS float*)(lds + wave * 16384);
    constexpr int I_G = 16 * 88, I_D = 44 * 32, I_FF = 3 * I_G, I_IN = 16 * 64, I_OUT = 12 * 32, I_L = 2 * I_FF + I_IN + I_OUT;
    static_assert(I_G == I_D, "items");
    for (int it = gw; it < 2 * I_L; it += NGW) {
        const int l = it / I_L; int r = it % I_L;
        if (r < 2 * I_FF) {
            const int f = r / I_FF; r %= I_FF; const int part = r / I_G; r %= I_G;
            const size_t lo = (size_t)l * 1024 * 2816;
            if (part == 0)      transpose_item(a.in[f ? I_W2G : I_W1G] + lo, 2816, (bf16*)(ws + WS_WGU) + (size_t)(l * 2 + f) * 5632 * 1024, 1024, r / 88, r % 88, 1, scr, lane);
            else if (part == 1) transpose_item(a.in[f ? I_W2U : I_W1U] + lo, 2816, (bf16*)(ws + WS_WGU) + (size_t)(l * 2 + f) * 5632 * 1024, 1024, r / 88, r % 88, 2, scr, lane);
            else                transpose_item(a.in[f ? I_W2D : I_W1D] + lo, 1024, (bf16*)(ws + WS_WD) + (size_t)(l * 2 + f) * 1024 * 2816, 2816, r / 32, r % 32, 0, scr, lane);
        } else { r -= 2 * I_FF;
            if (r < I_IN) transpose_item(a.in[I_WIN] + (size_t)l * 1024 * 2048, 2048, (bf16*)(ws + WS_WIN) + (size_t)l * 2048 * 1024, 1024, r / 64, r % 64, 0, scr, lane);
            else { r -= I_IN; int kb = r / 32; if (kb >= 8) kb += 4;
                transpose_item(a.in[I_WOUT] + (size_t)l * 1024 * 1024, 1024, (bf16*)(ws + WS_WOUT) + (size_t)l * 1024 * 1024, 1024, kb, r % 32, 0, scr, lane); }
        }
    }
    for (int it = gw; it < 2 * 256 * 4; it += NGW) {
        const int l = it >> 10, kp = (it >> 2) & 255, nc = it & 3;
        const float* pw = a.in[I_CPW] + (size_t)l * 65536 + kp * 256;
        const float* wo = a.in[I_WOUT] + (size_t)l * 1048576 + (size_t)512 * 1024 + nc * 256 + lane * 4;
        f32x4 acc = {0.f, 0.f, 0.f, 0.f};
#pragma unroll 8
        for (int j = 0; j < 256; ++j) acc += pw[j] * *(const f32x4*)(wo + (size_t)j * 1024);
        bf16* dst = (bf16*)(ws + WS_WOUT) + (size_t)l * 1048576 + (size_t)(nc * 256 + lane * 4) * 1024 + 512 + kp;
        dst[0] = (bf16)f2bf(acc[0]); dst[1024] = (bf16)f2bf(acc[1]); dst[2048] = (bf16)f2bf(acc[2]); dst[3072] = (bf16)f2bf(acc[3]);
    }
    if (with_j3) {
        LAS float* sl = (LAS float*)(lds + wave * 16384);
        for (int it = gw; it < 2 * 36 * 16; it += NGW) {
            const int l = it / 576, r = it % 576, nch = r >> 4, ks = r & 15;
            const int n = nch * 256 + lane * 4;
            const float* wm = a.in[I_WMOD] + (size_t)l * 1024 * 9216 + (size_t)(ks * 64) * 9216 + n;
            sl[lane] = silu_acc(a.in[I_CCTX][ks * 64 + lane]);
#pragma unroll
            for (int c = 1; c < 9; ++c) sl[c * 64 + lane] = silu_acc(a.in[I_C][(c - 1) * 1024 + ks * 64 + lane]);
            LDS_WAIT(); asm volatile("" ::: "memory");
            f32x4 acc[9];
#pragma unroll
            for (int c = 0; c < 9; ++c) acc[c] = (f32x4){0.f, 0.f, 0.f, 0.f};
#pragma unroll 1
            for (int kb = 0; kb < 4; ++kb) {
                f32x4 w[16];
#pragma unroll
                for (int k = 0; k < 16; ++k) w[k] = *(const f32x4*)(wm + (size_t)(kb * 16 + k) * 9216);
#pragma unroll
                for (int k = 0; k < 16; ++k)
#pragma unroll
                    for (int c = 0; c < 9; ++c) acc[c] += sl[c * 64 + kb * 16 + k] * w[k];
            }
            float* mod = (float*)(ws + WS_MOD) + (size_t)l * 9 * 9216 + n;
            f32x4 bm = {0.f, 0.f, 0.f, 0.f}; if (ks == 0) bm = *(const f32x4*)(a.in[I_BMOD] + l * 9216 + n);
#pragma unroll
            for (int c = 0; c < 9; ++c)
#pragma unroll
                for (int j = 0; j < 4; ++j) atomicAdd(mod + c * 9216 + j, acc[c][j] + bm[j]);
            LDS_WAIT(); asm volatile("" ::: "memory");
        }
    }
    {
        const int gt = gw * 64 + lane, NGT = NGW * 64;
        for (int e = gt; e < 2 * 8 * 256 * 128; e += NGT) {
            const int gd = e & 127, p = (e >> 7) & 255, b = (e >> 15) & 7, l = e >> 18;
            const size_t src = (((size_t)b * 2 + l) * 256 + p) * 128 + gd;
            const float kv = a.in[I_CK][src], vv = a.in[I_CV][src];
            ((bf16*)(ws + WS_CKB))[e] = (bf16)f2bf(kv);
            ((bf16*)(ws + WS_CVT))[(((size_t)l * 8 + b) * 128 + gd) * 256 + p] = (bf16)f2bf(vv);
        }
        for (int e = gt; e < 1024; e += NGT) { const int p = e >> 4, i = e & 15; const float inv = powf(10000.0f, -(float)i / 16.0f); const float ang = (float)p * inv;
            ((float*)(ws + WS_ROPE))[2 * e] = cosf(ang); ((float*)(ws + WS_ROPE))[2 * e + 1] = sinf(ang); }
    }
    for (int it = gw; it < 2 * 2304; it += NGW) {
        const int l = it / 2304, tt = it % 2304; const int L = tt < 2048 ? 2048 : 256, t = tt < 2048 ? tt : tt - 2048;
        const float tf = (float)t, tn = tf / (float)(L - 1);
        const float* w1 = a.in[I_HW1] + l * 33 * 64; const float* w2 = a.in[I_HW2] + l * 64 * 64;
        float s1 = tn * w1[lane];
#pragma unroll 4
        for (int i = 0; i < 16; ++i) { const float band = 1e-4f + (float)i * ((15.0f - 1e-4f) / 15.0f); const float ang = (6.283185307179586f * tf) * band / (float)L;
            s1 += cosf(ang) * w1[(1 + i) * 64 + lane] - sinf(ang) * w1[(17 + i) * 64 + lane]; }
        const float h1 = sinf(a.in[I_HF1][l * 64 + lane] * (s1 + a.in[I_HB1][l * 64 + lane]));
        float s2 = 0.f;
#pragma unroll 8
        for (int k = 0; k < 64; ++k) s2 += __shfl(h1, k) * w2[k * 64 + lane];
        const float h2 = sinf(a.in[I_HF2][l * 64 + lane] * (s2 + a.in[I_HB2][l * 64 + lane]));
        ((float*)(ws + WS_HYH))[(size_t)it * 64 + lane] = h2;
    }
}

__device__ __forceinline__ void prep_phase(const float* src0, const float* src1, const float* g, const float* mod, int sc_chunk, bf16* H, float* ss, int gw, int NGW, int lane) {
    for (int r = gw; r < M; r += NGW) {
        const float* xr = r < MCTX ? src0 + (size_t)r * D : src1 + (size_t)(r - MCTX) * D;
        const int cond = r < MCTX ? 0 : 1 + ((r - MCTX) >> 11);
        const float* sc = mod + cond * 9216 + sc_chunk * 1024;
        f32x4 v[4]; float s = 0.f;
#pragma unroll
        for (int j = 0; j < 4; ++j) { v[j] = ((const f32x4*)xr)[lane + 64 * j]; s += (v[j][0] * v[j][0] + v[j][1] * v[j][1]) + (v[j][2] * v[j][2] + v[j][3] * v[j][3]); }
        s = wave_sum(s); if (lane == 0) ss[r] = s;
#pragma unroll
        for (int j = 0; j < 4; ++j) { const int col = 4 * (lane + 64 * j);
            const f32x4 o = v[j] * *(const f32x4*)(g + col) * (*(const f32x4*)(sc + col) + 1.0f);
            v2u w; w.x = pk2(o[0], o[1]); w.y = pk2(o[2], o[3]); *(v2u*)(H + (size_t)r * D + col) = w; }
    }
}
__device__ __forceinline__ void bias_phase(const Args& a, int gw, int NGW, int lane) {
    unsigned char* ws = a.ws;
    for (int it = gw; it < 2 * 832; it += NGW) {
        const int l = it / 832; int r = it % 832; int which, n0;
        if (r < 352) { which = 0; n0 = r * 16; } else if (r < 480) { which = 1; n0 = (r - 352) * 16; } else { which = 2; n0 = (r - 480) * 16; }
        const bf16* Wt = which == 1 ? (const bf16*)(ws + WS_WIN) + (size_t)l * 2048 * 1024 : (const bf16*)(ws + WS_WGU) + (size_t)(l * 2 + (which == 2 ? 1 : 0)) * 5632 * 1024;
        const int shc = which == 0 ? 0 : (which == 1 ? 3 : 6), off = which == 0 ? 0 : (which == 1 ? 50688 : 69120), bst = which == 1 ? 2048 : 5632;
        const float* mod = (const float*)(ws + WS_MOD) + (size_t)l * 9 * 9216 + shc * 1024 + lane * 16;
        float sh[9][16];
#pragma unroll
        for (int c = 0; c < 9; ++c)
#pragma unroll
            for (int k4 = 0; k4 < 4; ++k4) { const f32x4 q = *(const f32x4*)(mod + c * 9216 + 4 * k4); sh[c][4 * k4] = q[0]; sh[c][4 * k4 + 1] = q[1]; sh[c][4 * k4 + 2] = q[2]; sh[c][4 * k4 + 3] = q[3]; }
        float* bo = (float*)(ws + WS_BIAS) + (size_t)l * 119808 + off;
        for (int nn = 0; nn < 16; ++nn) {
            const v4u w0 = *(const v4u*)(Wt + (size_t)(n0 + nn) * 1024 + lane * 16), w1 = *(const v4u*)(Wt + (size_t)(n0 + nn) * 1024 + lane * 16 + 8);
            const float wf[16] = {bflo(w0.x), bfhi(w0.x), bflo(w0.y), bfhi(w0.y), bflo(w0.z), bfhi(w0.z), bflo(w0.w), bfhi(w0.w), bflo(w1.x), bfhi(w1.x), bflo(w1.y), bfhi(w1.y), bflo(w1.z), bfhi(w1.z), bflo(w1.w), bfhi(w1.w)};
#pragma unroll
            for (int c = 0; c < 9; ++c) { float d = 0.f;
#pragma unroll
                for (int k = 0; k < 16; ++k) d += sh[c][k] * wf[k];
                d = wave_sum(d); if (lane == 0) bo[c * bst + n0 + nn] = d; }
        }
    }
}
__device__ __forceinline__ void final_norm_phase(float* X, const float* g, const float* ss, int gw, int NGW, int lane) {
    for (int r = gw; r < M; r += NGW) {
        float* xr = X + (size_t)r * D;
        const float rstd = 1.0f / sqrtf(ss[r] * (1.0f / D) + EPS);
#pragma unroll
        for (int j = 0; j < 4; ++j) { const int col = 4 * (lane + 64 * j); ((f32x4*)xr)[lane + 64 * j] = (((const f32x4*)xr)[lane + 64 * j] * rstd) * *(const f32x4*)(g + col); }
    }
}

__device__ __forceinline__ void hyena_filter_phase(const Args& a, int gw, int NGW, int lane) {
    unsigned char* ws = a.ws;
    for (int it = gw; it < 2 * 36 * 16; it += NGW) {
        const int l = it / 576, r = it % 576, tc = r >> 4, ng = r & 15;
        const int stream = tc < 32 ? 0 : 1; const int L = stream ? 256 : 2048; const int t = (stream ? tc - 32 : tc) * 64 + lane; const int soff = stream ? 4096 : 0;
        const float tn = (float)t / (float)(L - 1);
        const float* hrow = (const float*)(ws + WS_HYH) + ((size_t)l * 2304 + (stream ? 2048 : 0) + t) * 64;
        float h2[64];
#pragma unroll
        for (int k4 = 0; k4 < 16; ++k4) { const f32x4 q = ((const f32x4*)hrow)[k4]; h2[4 * k4] = q[0]; h2[4 * k4 + 1] = q[1]; h2[4 * k4 + 2] = q[2]; h2[4 * k4 + 3] = q[3]; }
        const float* w3 = a.in[I_HW3] + (size_t)l * 64 * 1024;
        for (int nn = 0; nn < 64; ++nn) {
            const int n = ng * 64 + nn, o = n >> 9, dir = (n >> 8) & 1, c = n & 255;
            float dot = 0.f;
#pragma unroll
            for (int k = 0; k < 64; ++k) dot += h2[k] * w3[k * 1024 + n];
            const float decay = __expf(a.in[I_HLD][l * 1024 + n]);
            const float val = dot * __expf(-tn * decay);
            const float ss = wave_sum(val * val);
            if (lane == 0) atomicAdd((float*)(ws + WS_SUMSQ) + ((l * 2 + stream) * 2 + o) * 256 + c, ss);
            bf16* dst = (bf16*)(ws + WS_HYRAW) + ((size_t)(l * 2 + o) * 256 + c) * 4608 + soff;
            if (dir == 0) dst[L - 1 - t] = (bf16)f2bf(val);
            else if (t > 0) dst[L - 1 + t] = (bf16)f2bf(val);
            else dst[2 * L - 1] = 0;
        }
    }
}

__device__ __forceinline__ void conv_phase(const Args& a, int l, const bf16* Z, bf16* CAT, LAS unsigned char* lds, int tid) {
    LAS float* ybuf = (LAS float*)lds;
    LAS float* cbuf = (LAS float*)(lds + 65536);
    const float* dw = a.in[I_CDW] + l * 31 * 256; const float* dwb = a.in[I_CDWB] + l * 256; const float* lng = a.in[I_CLNG] + l * 256; const float* lnb = a.in[I_CLNB] + l * 256;
    const int lane = tid & 63, wave = tid >> 6;
    for (int u = blockIdx.x; u < M / 32; u += gridDim.x) {
        const int r0 = u * 32;
        const int seq0 = r0 < MCTX ? (r0 & ~255) : MCTX + ((r0 - MCTX) & ~2047); const int seq1 = seq0 + (r0 < MCTX ? 256 : 2048);
        for (int e = tid; e < 62 * 32; e += NTHREADS) {
            const int rr = e >> 5, ch = e & 31; const int row = r0 - 15 + rr;
            float y[8];
            if (row >= seq0 && row < seq1) {
                const v4u av = *(const v4u*)(Z + (size_t)row * ZW + 768 + ch * 8), gv = *(const v4u*)(Z + (size_t)row * ZW + 1024 + ch * 8);
                const float af[8] = {bflo(av.x), bfhi(av.x), bflo(av.y), bfhi(av.y), bflo(av.z), bfhi(av.z), bflo(av.w), bfhi(av.w)};
                const float gf[8] = {bflo(gv.x), bfhi(gv.x), bflo(gv.y), bfhi(gv.y), bflo(gv.z), bfhi(gv.z), bflo(gv.w), bfhi(gv.w)};
#pragma unroll
                for (int j = 0; j < 8; ++j) y[j] = af[j] / (1.0f + __expf(-gf[j]));
            } else {
#pragma unroll
                for (int j = 0; j < 8; ++j) y[j] = 0.f;
            }
            *(LAS f32x4*)(ybuf + rr * 256 + ch * 8) = (f32x4){y[0], y[1], y[2], y[3]}; *(LAS f32x4*)(ybuf + rr * 256 + ch * 8 + 4) = (f32x4){y[4], y[5], y[6], y[7]};
        }
        __syncthreads();
        { const int c = tid & 255, half = tid >> 8;
          float w[31];
#pragma unroll
          for (int k = 0; k < 31; ++k) w[k] = dw[k * 256 + c];
          const float bias = dwb[c];
          float yv[46];
#pragma unroll
          for (int i = 0; i < 46; ++i) yv[i] = ybuf[(half * 16 + i) * 256 + c];
#pragma unroll
          for (int t = 0; t < 16; ++t) { float s = bias;
#pragma unroll
              for (int k = 0; k < 31; ++k) s += w[k] * yv[t + k];
              cbuf[(half * 16 + t) * 256 + c] = s; } }
        __syncthreads();
        for (int rr = wave * 4; rr < wave * 4 + 4; ++rr) {
            const f32x4 x = *(const LAS f32x4*)(cbuf + rr * 256 + lane * 4);
            const float mu = wave_sum((x[0] + x[1]) + (x[2] + x[3])) * (1.0f / 256.0f);
            const f32x4 dx = x - mu;
            const float var = wave_sum((dx[0] * dx[0] + dx[1] * dx[1]) + (dx[2] * dx[2] + dx[3] * dx[3])) * (1.0f / 256.0f);
            const float rstd = 1.0f / sqrtf(var + EPS);
            const f32x4 yv = dx * rstd * *(const f32x4*)(lng + lane * 4) + *(const f32x4*)(lnb + lane * 4);
            v2u wv; wv.x = pk2(silu_acc(yv[0]), silu_acc(yv[1])); wv.y = pk2(silu_acc(yv[2]), silu_acc(yv[3]));
            *(v2u*)(CAT + (size_t)(r0 + rr) * 1024 + 512 + lane * 4) = wv;
        }
        __syncthreads();
    }
}


typedef unsigned long long u64;
typedef u64 u64x2 __attribute__((ext_vector_type(2)));
template <int L> struct HyGeo {
    static constexpr int R = L / 128, NSTEP = L / 32, CS = 4 * L + 64, US = 2 * L + 32, OFF_U = 8 * CS;
};
template <int L>
__device__ __forceinline__ void hy_build_copies(LAS unsigned char* lds, const bf16* raw, int tid) {
    constexpr int CS = HyGeo<L>::CS;
    for (int p = tid; p < L / 4; p += NTHREADS) {
        const v4u a = *(const v4u*)(raw + 8 * p), b = *(const v4u*)(raw + 8 * p + 8);
        const unsigned w[8] = {a.x, a.y, a.z, a.w, b.x, b.y, b.z, b.w};
#pragma unroll
        for (int sg = 0; sg < 8; ++sg) { v4u o;
            if ((sg & 1) == 0) { o.x = w[sg / 2]; o.y = w[sg / 2 + 1]; o.z = w[sg / 2 + 2]; o.w = w[sg / 2 + 3]; }
            else { const int h = sg / 2; o.x = (w[h] >> 16) | (w[h + 1] << 16); o.y = (w[h + 1] >> 16) | (w[h + 2] << 16); o.z = (w[h + 2] >> 16) | (w[h + 3] << 16); o.w = (w[h + 3] >> 16) | (w[h + 4] << 16); }
            *(LAS v4u*)(lds + sg * CS + 16 * p) = o; }
    }
}
template <int L, int NB>
__device__ __forceinline__ void hy_toeplitz(LAS unsigned char* lds, int boff, f32x4 (&acc)[HyGeo<L>::R][NB > 8 ? 2 : 1], int wave, int lane) {
    constexpr int R = HyGeo<L>::R, NT = NB > 8 ? 2 : 1, NSTEP = HyGeo<L>::NSTEP, CS = HyGeo<L>::CS, US = HyGeo<L>::US;
    const int i = lane & 15, q = lane >> 4;
    const int abase = (7 - (i & 7)) * CS + 16 * ((L / 8 - 1) - (i >> 3) + q - 2 * R * wave);
    int bb[NT];
#pragma unroll
    for (int nt = 0; nt < NT; ++nt) bb[nt] = boff + ((NB > 8 ? nt * 16 + i : (i & 7))) * US + 16 * q;
    bf16x8 F[R];
#pragma unroll
    for (int e = 0; e < R; ++e) F[e] = *(const LAS bf16x8*)(lds + abase - 32 * e);
#pragma unroll
    for (int r = 0; r < R; ++r)
#pragma unroll
        for (int nt = 0; nt < NT; ++nt) acc[r][nt] = (f32x4){0.f, 0.f, 0.f, 0.f};
    bf16x8 B[2][NT];
#pragma unroll
    for (int nt = 0; nt < NT; ++nt) B[0][nt] = *(const LAS bf16x8*)(lds + bb[nt]);
#pragma unroll 1
    for (int jo = 0; jo < NSTEP; jo += 8) {
#pragma unroll
        for (int ji = 0; ji < 8; ++ji) {
            const int j = jo + ji; constexpr int dummy = 0; (void)dummy;
#pragma unroll
            for (int r = R - 2; r < R; ++r) { const int slot = (((r - 2 * ji) % R) + R) % R;
#pragma unroll
                for (int nt = 0; nt < NT; ++nt) acc[r][nt] = __builtin_amdgcn_mfma_f32_16x16x32_bf16(F[slot], B[ji & 1][nt], acc[r][nt], 0, 0, 0); }
            __builtin_amdgcn_sched_barrier(0);
            if (j + 1 < NSTEP) {
#pragma unroll
                for (int nt = 0; nt < NT; ++nt) B[(ji + 1) & 1][nt] = *(const LAS bf16x8*)(lds + bb[nt] + 64 * (j + 1));
#pragma unroll
                for (int rr = 0; rr < 2; ++rr) { const int slot = (((rr - 2 * (ji + 1)) % R) + R) % R; F[slot] = *(const LAS bf16x8*)(lds + abase + 64 * (j + 1) - 32 * rr); }
            }
            __builtin_amdgcn_sched_barrier(0);
#pragma unroll
            for (int r = 0; r < R - 2; ++r) { const int slot = (((r - 2 * ji) % R) + R) % R;
#pragma unroll
                for (int nt = 0; nt < NT; ++nt) acc[r][nt] = __builtin_amdgcn_mfma_f32_16x16x32_bf16(F[slot], B[ji & 1][nt], acc[r][nt], 0, 0, 0); }
            __builtin_amdgcn_sched_barrier(0);
        }
    }
}
struct XRaw { v2u z; unsigned zl, zr; };
__device__ __forceinline__ XRaw xraw_load(const bf16* zrow, int t, int L) { XRaw x; x.z = *(const v2u*)zrow; x.zl = t > 0 ? (unsigned)zrow[-1] : 0u; x.zr = t + 4 < L ? (unsigned)zrow[4] : 0u; return x; }
__device__ __forceinline__ void sconv4x(const XRaw& x, float w0, float w1, float w2, float sb, float (&out)[4]) {
    const float zl = bf2f(x.zl), zr = bf2f(x.zr), z0 = bflo(x.z.x), z1 = bfhi(x.z.x), z2 = bflo(x.z.y), z3 = bfhi(x.z.y);
    out[0] = sb + w0 * zl + w1 * z0 + w2 * z1; out[1] = sb + w0 * z0 + w1 * z1 + w2 * z2; out[2] = sb + w0 * z1 + w1 * z2 + w2 * z3; out[3] = sb + w0 * z2 + w1 * z3 + w2 * zr;
}
__device__ __forceinline__ void sconv4(const bf16* zrow, int t, int L, float w0, float w1, float w2, float sb, float (&out)[4]) { const XRaw x = xraw_load(zrow, t, L); sconv4x(x, w0, w1, w2, sb, out); }
template <int L>
__device__ __forceinline__ void hy_store_copies(LAS unsigned char* lds, const v4u a, const v4u b, int p) {
    constexpr int CS = HyGeo<L>::CS;
    const unsigned w[8] = {a.x, a.y, a.z, a.w, b.x, b.y, b.z, b.w};
#pragma unroll
    for (int sg = 0; sg < 8; ++sg) { v4u o;
        if ((sg & 1) == 0) { o.x = w[sg / 2]; o.y = w[sg / 2 + 1]; o.z = w[sg / 2 + 2]; o.w = w[sg / 2 + 3]; }
        else { const int h = sg / 2; o.x = (w[h] >> 16) | (w[h + 1] << 16); o.y = (w[h + 1] >> 16) | (w[h + 2] << 16); o.z = (w[h + 2] >> 16) | (w[h + 3] << 16); o.w = (w[h + 3] >> 16) | (w[h + 4] << 16); }
        *(LAS v4u*)(lds + sg * CS + 16 * p) = o; }
}
template <int L, int NB, bool DUP = false>
__device__ __forceinline__ void hyena_channel(const Args& a, int l, int c, const bf16* ZT, bf16* CAT, LAS unsigned char* lds, int tid, int wave, int lane) {
    constexpr int R = HyGeo<L>::R, NT = NB > 8 ? 2 : 1, US = HyGeo<L>::US, OFF_U = HyGeo<L>::OFF_U, OFF_Y = OFF_U + NB * US;
    constexpr bool LAT = (L == 2048); constexpr int stream = LAT ? 0 : 1; constexpr int rowbase = LAT ? MCTX : 0;
    static_assert(L / 4 <= NTHREADS, "one copy slot per thread");
    unsigned char* ws = a.ws;
    const float* sw = a.in[I_HSW] + l * 3 * 768; const float* sb = a.in[I_HSB] + l * 768;
    const bf16* raw0 = (const bf16*)(ws + WS_HYRAW) + ((size_t)(l * 2 + 0) * 256 + c) * 4608 + (LAT ? 0 : 4096);
    const bf16* raw1 = (const bf16*)(ws + WS_HYRAW) + ((size_t)(l * 2 + 1) * 256 + c) * 4608 + (LAT ? 0 : 4096);
    const int i = lane & 15;
    const bool cp = tid < L / 4;
    v4u f0a = {0u, 0u, 0u, 0u}, f0b = f0a, f1a = f0a, f1b = f0a;
    if (cp) { f0a = *(const v4u*)(raw0 + 8 * tid); f0b = *(const v4u*)(raw0 + 8 * tid + 8); f1a = *(const v4u*)(raw1 + 8 * tid); f1b = *(const v4u*)(raw1 + 8 * tid + 8); }
    __syncthreads();
    if (cp) hy_store_copies<L>(lds, f0a, f0b, tid);
    { const float w0 = sw[c], w1 = sw[768 + c], w2 = sw[1536 + c], b0 = sb[c];
      for (int idx = tid; idx < NB * (L / 8); idx += NTHREADS) {
          const int b = idx / (L / 8), s0 = (idx % (L / 8)) * 8; const bf16* zrow = ZT + (size_t)c * M + rowbase + b * L + s0;
          float o0[4], o1[4]; sconv4(zrow, s0, L, w0, w1, w2, b0, o0); sconv4(zrow + 4, s0 + 4, L, w0, w1, w2, b0, o1);
          v4u w; w.x = pk2(o0[0], o0[1]); w.y = pk2(o0[2], o0[3]); w.z = pk2(o1[0], o1[1]); w.w = pk2(o1[2], o1[3]);
          *(LAS v4u*)(lds + OFF_U + b * US + 2 * s0) = w; } }
    __syncthreads();
    f32x4 acc[R][NT];
    hy_toeplitz<L, NB>(lds, OFF_U, acc, wave, lane);
    if constexpr (DUP) { { _Pragma("unroll") for (int r_ = 0; r_ < R; ++r_) _Pragma("unroll") for (int n_ = 0; n_ < NT; ++n_) asm volatile("" : "+v"(acc[r_][n_])); } hy_toeplitz<L, NB>(lds, OFF_U, acc, wave, lane); }
    { const float scale = 1.0f / sqrtf(((const float*)(ws + WS_SUMSQ))[((l * 2 + stream) * 2 + 0) * 256 + c] + EPS), bias = a.in[I_HBIAS][(l * 2 + 0) * 256 + c];
      const float w0 = sw[256 + c], w1 = sw[768 + 256 + c], w2 = sw[1536 + 256 + c], b0 = sb[256 + c];
      int q = lane >> 4; asm volatile("" : "+v"(q));
#pragma unroll
      for (int nt = 0; nt < NT; ++nt) { const int b = nt * 16 + i;
          if (b < NB) {
#pragma unroll
              for (int r = 0; r < R; ++r) { const int t = 16 * (R * wave + r) + 4 * q;
                  float x1[4]; sconv4(ZT + (size_t)(256 + c) * M + rowbase + b * L + t, t, L, w0, w1, w2, b0, x1);
                  const v2u uv = *(const LAS v2u*)(lds + OFF_U + b * US + 2 * t);
                  const float y0 = x1[0] * (scale * acc[r][nt][0] + bias * bflo(uv.x)), y1 = x1[1] * (scale * acc[r][nt][1] + bias * bfhi(uv.x));
                  const float y2 = x1[2] * (scale * acc[r][nt][2] + bias * bflo(uv.y)), y3 = x1[3] * (scale * acc[r][nt][3] + bias * bfhi(uv.y));
                  v2u w; w.x = pk2(y0, y1); w.y = pk2(y2, y3); *(LAS v2u*)(lds + OFF_Y + b * US + 2 * t) = w; } } } }
    __syncthreads();
    if (cp) hy_store_copies<L>(lds, f1a, f1b, tid);
    __syncthreads();
    hy_toeplitz<L, NB>(lds, OFF_Y, acc, wave, lane);
    if constexpr (DUP) { { _Pragma("unroll") for (int r_ = 0; r_ < R; ++r_) _Pragma("unroll") for (int n_ = 0; n_ < NT; ++n_) asm volatile("" : "+v"(acc[r_][n_])); } hy_toeplitz<L, NB>(lds, OFF_Y, acc, wave, lane); }
    { const float scale = 1.0f / sqrtf(((const float*)(ws + WS_SUMSQ))[((l * 2 + stream) * 2 + 1) * 256 + c] + EPS), bias = a.in[I_HBIAS][(l * 2 + 1) * 256 + c];
      const float w0 = sw[512 + c], w1 = sw[768 + 512 + c], w2 = sw[1536 + 512 + c], b0 = sb[512 + c];
      int q = lane >> 4; asm volatile("" : "+v"(q));
#pragma unroll
      for (int nt = 0; nt < NT; ++nt) { const int b = nt * 16 + i;
          if (b < NB) {
#pragma unroll
              for (int r = 0; r < R; ++r) { const int t = 16 * (R * wave + r) + 4 * q;
                  float x2[4]; sconv4(ZT + (size_t)(512 + c) * M + rowbase + b * L + t, t, L, w0, w1, w2, b0, x2);
                  const v2u yv = *(const LAS v2u*)(lds + OFF_Y + b * US + 2 * t);
                  bf16* dst = CAT + (size_t)(rowbase + b * L + t) * 1024 + 768 + c;
                  dst[0]    = (bf16)f2bf(x2[0] * (scale * acc[r][nt][0] + bias * bflo(yv.x)));
                  dst[1024] = (bf16)f2bf(x2[1] * (scale * acc[r][nt][1] + bias * bfhi(yv.x)));
                  dst[2048] = (bf16)f2bf(x2[2] * (scale * acc[r][nt][2] + bias * bflo(yv.y)));
                  dst[3072] = (bf16)f2bf(x2[3] * (scale * acc[r][nt][3] + bias * bfhi(yv.y))); } } } }
    __syncthreads();
}

typedef float f32x16 __attribute__((ext_vector_type(16)));
constexpr int ATT_KP = 144, ATT_VP = 80, ATT_KB = 32 * ATT_KP, ATT_BUF = ATT_KB + 64 * ATT_VP;
__device__ __forceinline__ void attn_phase(const Args& a, int l, const bf16* Z, const bf16* ZT, bf16* CAT, LAS unsigned char* lds, int tid, int wave, int lane) {
    const bf16* CKB = (const bf16*)(a.ws + WS_CKB) + (size_t)l * 8 * 256 * 128; const bf16* CVT = (const bf16*)(a.ws + WS_CVT) + (size_t)l * 8 * 128 * 256;
    const int r = lane & 31, hh = lane >> 5;
    for (int it = blockIdx.x; it < 768; it += gridDim.x) {
        bool lat; int b, g, qb;
        if (it < 512) { lat = true; b = it >> 6; g = (it >> 5) & 1; qb = it & 31; }
        else { const int rr = it - 512; lat = false; b = rr >> 3; g = (rr >> 2) & 1; qb = rr & 3; }
        const int h = g * 4 + (wave & 3), q0 = qb * 64 + 32 * (wave >> 2);
        const int L = lat ? 2048 : 256, seq0 = lat ? MCTX + b * 2048 : b * 256;
        const int kt_lo = lat ? (qb * 64 - 128 < 0 ? 0 : qb * 64 - 128) : 0, kt_hi = lat ? (qb * 64 + 192 > L ? L : qb * 64 + 192) : 256;
        const int n_local = (kt_hi - kt_lo) >> 5, n_total = n_local + (lat ? 8 : 0);
        const bool isk = tid < 256; const int t2 = tid & 255;
        const bf16* src_loc = isk ? Z + (size_t)(seq0 + kt_lo + (t2 >> 3)) * ZW + 512 + g * 64 + (t2 & 7) * 8 : ZT + (size_t)(768 + g * 64 + (t2 >> 2)) * M + seq0 + kt_lo + (t2 & 3) * 8;
        const bf16* src_ctx = isk ? CKB + ((size_t)b * 256 + (t2 >> 3)) * 128 + g * 64 + (t2 & 7) * 8 : CVT + ((size_t)b * 128 + g * 64 + (t2 >> 2)) * 256 + (t2 & 3) * 8;
        const size_t step_loc = isk ? (size_t)32 * ZW : 32, step_ctx = isk ? (size_t)32 * 128 : 32;
        const int dst = isk ? (t2 >> 3) * ATT_KP + (t2 & 7) * 16 : ATT_KB + (t2 >> 2) * ATT_VP + ((t2 & 3) >> 1) * 32 + ((t2 & 3) & 1) * 8;
#define ATT_GLOAD(ti_) (*(const v4u*)((ti_) < n_local ? src_loc + (size_t)(ti_) * step_loc : src_ctx + (size_t)((ti_) - n_local) * step_ctx))
#define ATT_LSTORE(buf_, v_) do { LAS unsigned char* p_ = lds + (buf_) * ATT_BUF + dst; if (isk) *(LAS v4u*)p_ = (v_); else { v2u lo_, hi_; lo_.x = (v_).x; lo_.y = (v_).y; hi_.x = (v_).z; hi_.y = (v_).w; *(LAS v2u*)p_ = lo_; *(LAS v2u*)(p_ + 16) = hi_; } } while (0)
        bf16x8 qf[4];
        { const bf16* qp = Z + (size_t)(seq0 + q0 + r) * ZW + h * 64 + 8 * hh;
#pragma unroll
          for (int s = 0; s < 4; ++s) qf[s] = *(const bf16x8*)(qp + 16 * s); }
        f32x16 o0, o1;
#pragma unroll
        for (int e = 0; e < 16; ++e) { o0[e] = 0.f; o1[e] = 0.f; }
        float mrun = a.in[I_SINK][l * 8 + h] * LOG2E, lsum = 1.0f;
        __syncthreads();
        { const v4u g0 = ATT_GLOAD(0); ATT_LSTORE(0, g0); }
        __syncthreads();
        for (int ti = 0; ti < n_total; ++ti) {
            v4u gn = {0u, 0u, 0u, 0u};
            if (ti + 1 < n_total) gn = ATT_GLOAD(ti + 1);
            const int kt = kt_lo + 32 * ti;
            const bool active = !lat || ti >= n_local || (kt >= q0 - 128 && kt <= q0 + 128);
            if (active) {
                const LAS unsigned char* kb = lds + (ti & 1) * ATT_BUF + r * ATT_KP + 16 * hh;
                const LAS unsigned char* vb = lds + (ti & 1) * ATT_BUF + ATT_KB + r * ATT_VP + 16 * hh;
                f32x16 st;
#pragma unroll
                for (int e = 0; e < 16; ++e) st[e] = 0.f;
#pragma unroll
                for (int s = 0; s < 4; ++s) st = __builtin_amdgcn_mfma_f32_32x32x16_bf16(*(const LAS bf16x8*)(kb + 32 * s), qf[s], st, 0, 0, 0);
                const bf16x8 v00 = *(const LAS bf16x8*)(vb), v01 = *(const LAS bf16x8*)(vb + 32), v10 = *(const LAS bf16x8*)(vb + 32 * ATT_VP), v11 = *(const LAS bf16x8*)(vb + 32 * ATT_VP + 32);
                if (lat && ti < n_local) {
                    if (kt == q0 - 128) {
#pragma unroll
                        for (int e = 0; e < 16; ++e) { const int jj = (e & 3) + 8 * (e >> 2) + 4 * hh; if (jj < r) st[e] = -1e30f; }
                    } else if (kt == q0 + 128) {
#pragma unroll
                        for (int e = 0; e < 16; ++e) { const int jj = (e & 3) + 8 * (e >> 2) + 4 * hh; if (jj > r) st[e] = -1e30f; }
                    }
                }
                float mx = fmaxf(fmaxf(st[0], st[1]), fmaxf(st[2], st[3]));
#pragma unroll
                for (int e = 4; e < 16; e += 4) mx = fmaxf(mx, fmaxf(fmaxf(st[e], st[e + 1]), fmaxf(st[e + 2], st[e + 3])));
                mx = fmaxf(mx, __shfl_xor(mx, 32));
                const float mn = fmaxf(mrun, mx), alpha = __builtin_amdgcn_exp2f(mrun - mn); mrun = mn;
                float ps = 0.f;
#pragma unroll
                for (int e = 0; e < 16; ++e) { st[e] = __builtin_amdgcn_exp2f(st[e] - mn); ps += st[e]; }
                ps += __shfl_xor(ps, 32);
                lsum = lsum * alpha + ps;
#pragma unroll
                for (int e = 0; e < 16; ++e) { o0[e] *= alpha; o1[e] *= alpha; }
                v4u pa, pb;
                pa.x = pk2(st[0], st[1]); pa.y = pk2(st[2], st[3]); pa.z = pk2(st[4], st[5]); pa.w = pk2(st[6], st[7]);
                pb.x = pk2(st[8], st[9]); pb.y = pk2(st[10], st[11]); pb.z = pk2(st[12], st[13]); pb.w = pk2(st[14], st[15]);
                const bf16x8 p0 = __builtin_bit_cast(bf16x8, pa), p1 = __builtin_bit_cast(bf16x8, pb);
                o0 = __builtin_amdgcn_mfma_f32_32x32x16_bf16(v00, p0, o0, 0, 0, 0);
                o0 = __builtin_amdgcn_mfma_f32_32x32x16_bf16(v01, p1, o0, 0, 0, 0);
                o1 = __builtin_amdgcn_mfma_f32_32x32x16_bf16(v10, p0, o1, 0, 0, 0);
                o1 = __builtin_amdgcn_mfma_f32_32x32x16_bf16(v11, p1, o1, 0, 0, 0);
            }
            if (ti + 1 < n_total) ATT_LSTORE((ti + 1) & 1, gn);
            __syncthreads();
        }
#undef ATT_GLOAD
#undef ATT_LSTORE
        const float inv = 1.0f / lsum;
        bf16* op = CAT + (size_t)(seq0 + q0 + r) * 1024 + h * 64 + 4 * hh;
#pragma unroll
        for (int g4 = 0; g4 < 4; ++g4) {
            v2u w; w.x = pk2(o0[4 * g4] * inv, o0[4 * g4 + 1] * inv); w.y = pk2(o0[4 * g4 + 2] * inv, o0[4 * g4 + 3] * inv); *(v2u*)(op + 8 * g4) = w;
            v2u x; x.x = pk2(o1[4 * g4] * inv, o1[4 * g4 + 1] * inv); x.y = pk2(o1[4 * g4 + 2] * inv, o1[4 * g4 + 3] * inv); *(v2u*)(op + 32 + 8 * g4) = x; }
    }
}

constexpr int PH_PER_LAYER = 7, PH_FINAL = 2 + 2 * PH_PER_LAYER, N_PHASES = PH_FINAL + 1;
struct Ctx { LAS unsigned char* lds; int tid, lane, wave, G, gw, NGW, lo, hi; };
#if MK_SINGLE
#define SEAM(k) do { if (lo <= (k) && (k) + 1 < hi) xcd_barrier(bar); } while (0)
#else
#define SEAM(k) do { } while (0)
#endif
#define IN(k) (lo <= (k) && (k) < hi)
#ifndef PROBE_PH
#define PROBE_PH -1
#endif
#define RUN(k, f) do { f(); if constexpr ((k) == PROBE_PH) f(); } while (0)
template <int L>
__device__ __forceinline__ void layer_phases(const Args& a, const Ctx& c, const XcdBarrier& bar) {
    constexpr int P = 2 + L * PH_PER_LAYER;
    const int lo = c.lo, hi = c.hi, G = c.G, lane = c.lane, tid = c.tid;
    LAS unsigned char* lds = c.lds;
    unsigned char* ws = a.ws;
    float* X = a.out;
    float* newk = a.out + (size_t)M * D; float* newv = newk + 32 * 2 * 256 * 128;
    bf16* H = (bf16*)(ws + WS_H); bf16* ACT = (bf16*)(ws + WS_BIG); bf16* Z = (bf16*)(ws + WS_Z); bf16* ZT = (bf16*)(ws + WS_ZT); bf16* CAT = (bf16*)(ws + WS_CAT);
    const float* modl = (const float*)(ws + WS_MOD) + (size_t)L * 9 * 9216;
    float* SS = (float*)(ws + WS_SS); const float* BIAS = (const float*)(ws + WS_BIAS) + (size_t)L * 119808;
    { auto f_ = [&]() __attribute__((always_inline)) { if (IN(P + 0)) {
        pg8::Gemm g{H, (const bf16*)(ws + WS_WGU) + (size_t)(L * 2 + 0) * 5632 * 1024, M, 5632, 1024}; pg8::StaticOrder S; S.init(M, 5632, G, (int)blockIdx.x);
        pg8::EpiGU E{ACT, SS + (size_t)(3 * L) * M, BIAS};
        pg8::gemm_phase<pg8::EpiGU, pg8::StaticOrder, true, true>(lds, g, S, E);
    } }; RUN(P + 0, f_); }
    SEAM(P + 0);
    { auto f_ = [&]() __attribute__((always_inline)) { if (IN(P + 1)) {
        pg8::Gemm g{ACT, (const bf16*)(ws + WS_WD) + (size_t)(L * 2 + 0) * 1024 * 2816, M, 1024, 2816}; pg8::StaticOrder S; S.init(M, 1024, G, (int)blockIdx.x);
        pg8::EpiRes E{L == 0 ? a.in[I_XP] : X, L == 0 ? a.in[I_XS] : X + (size_t)MCTX * D, X, modl + 2 * 1024, H, a.in[I_GMIX] + L * 1024, modl + 4 * 1024, SS + (size_t)(3 * L + 1) * M, 0.5f};
        pg8::gemm_phase<pg8::EpiRes, pg8::StaticOrder, true, true>(lds, g, S, E);
    } }; RUN(P + 1, f_); }
    SEAM(P + 1);
    { auto f_ = [&]() __attribute__((always_inline)) { if (IN(P + 2)) {
        pg8::Gemm g{H, (const bf16*)(ws + WS_WIN) + (size_t)L * 2048 * 1024, M, 2048, 1024}; pg8::StaticOrder S; S.init(M, 2048, G, (int)blockIdx.x);
        pg8::EpiIN E{Z, ZT, newk, newv, (const float*)(ws + WS_ROPE), SS + (size_t)(3 * L + 1) * M, BIAS + 50688, L, QSCALE};
        pg8::gemm_phase<pg8::EpiIN, pg8::StaticOrder, true, true>(lds, g, S, E);
    } }; RUN(P + 2, f_); }
    SEAM(P + 2);
    { auto f_ = [&]() __attribute__((always_inline)) { if (IN(P + 3)) {
#define HY_CH(w) ((((w) & 7) << 5) | (((w) >> 3) & 31))
        for (int w = blockIdx.x; w < 256; w += G) hyena_channel<2048, 8, (PROBE_PH == 105 && L == 0)>(a, L, HY_CH(w), ZT, CAT, lds, tid, c.wave, lane);
        if constexpr (PROBE_PH == 101 && L == 0) { for (int w = blockIdx.x; w < 256; w += G) hyena_channel<2048, 8>(a, L, HY_CH(w), ZT, CAT, lds, tid, c.wave, lane); }
        for (int w = blockIdx.x; w < 256; w += G) hyena_channel<256, 32>(a, L, HY_CH(w), ZT, CAT, lds, tid, c.wave, lane);
        if constexpr (PROBE_PH == 102 && L == 0) { for (int w = blockIdx.x; w < 256; w += G) hyena_channel<256, 32>(a, L, HY_CH(w), ZT, CAT, lds, tid, c.wave, lane); }
#undef HY_CH
        attn_phase(a, L, Z, ZT, CAT, lds, tid, c.wave, lane);
        if constexpr (PROBE_PH == 103 && L == 0) attn_phase(a, L, Z, ZT, CAT, lds, tid, c.wave, lane);
        __syncthreads();
        conv_phase(a, L, Z, CAT, lds, tid);
        if constexpr (PROBE_PH == 104 && L == 0) conv_phase(a, L, Z, CAT, lds, tid);
    } }; RUN(P + 3, f_); }
    SEAM(P + 3);
    { auto f_ = [&]() __attribute__((always_inline)) { if (IN(P + 4)) {
        pg8::Gemm g{CAT, (const bf16*)(ws + WS_WOUT) + (size_t)L * 1024 * 1024, M, 1024, 1024}; pg8::StaticOrder S; S.init(M, 1024, G, (int)blockIdx.x);
        pg8::EpiRes E{X, X + (size_t)MCTX * D, X, modl + 5 * 1024, H, a.in[I_GF2] + L * 1024, modl + 7 * 1024, SS + (size_t)(3 * L + 2) * M, 1.0f};
        pg8::gemm_phase<pg8::EpiRes, pg8::StaticOrder, true, true>(lds, g, S, E);
    } }; RUN(P + 4, f_); }
    SEAM(P + 4);
    { auto f_ = [&]() __attribute__((always_inline)) { if (IN(P + 5)) {
        pg8::Gemm g{H, (const bf16*)(ws + WS_WGU) + (size_t)(L * 2 + 1) * 5632 * 1024, M, 5632, 1024}; pg8::StaticOrder S; S.init(M, 5632, G, (int)blockIdx.x);
        pg8::EpiGU E{ACT, SS + (size_t)(3 * L + 2) * M, BIAS + 69120};
        pg8::gemm_phase<pg8::EpiGU, pg8::StaticOrder, true, true>(lds, g, S, E);
    } }; RUN(P + 5, f_); }
    SEAM(P + 5);
    { auto f_ = [&]() __attribute__((always_inline)) { if (IN(P + 6)) {
        pg8::Gemm g{ACT, (const bf16*)(ws + WS_WD) + (size_t)(L * 2 + 1) * 1024 * 2816, M, 1024, 2816}; pg8::StaticOrder S; S.init(M, 1024, G, (int)blockIdx.x);
        pg8::EpiRes E{X, X + (size_t)MCTX * D, X, modl + 8 * 1024, L == 0 ? H : (bf16*)nullptr, a.in[I_GF1] + 1024, (const float*)(ws + WS_MOD) + 9 * 9216 + 1024, SS + (size_t)(3 * L + 3) * M, 0.5f};
        pg8::gemm_phase<pg8::EpiRes, pg8::StaticOrder, true, true>(lds, g, S, E);
    } }; RUN(P + 6, f_); }
    SEAM(P + 6);
}

__global__ void __launch_bounds__(NTHREADS, 2) mega_fwd(Args a) {
    extern __shared__ __attribute__((aligned(16))) unsigned char lds_raw[];
    Ctx c;
    c.lds = (LAS unsigned char*)lds_raw;
    c.tid = threadIdx.x; c.lane = c.tid & 63; c.wave = __builtin_amdgcn_readfirstlane(c.tid >> 6);
    c.G = gridDim.x; c.gw = blockIdx.x * NWAVES + c.wave; c.NGW = c.G * NWAVES; c.lo = a.ph_lo; c.hi = a.ph_hi;
    const int lo = c.lo, hi = c.hi;
    XcdBarrier bar; bar.bar = nullptr; bar.x = 0; bar.st = nullptr;
#if MK_SINGLE
    for (int u = c.tid; u < (LDS_BYTES - LDSCTL_OFF) / 4; u += NTHREADS) ((LAS unsigned*)(c.lds + LDSCTL_OFF))[u] = 0u;
    __syncthreads();
    bar = xcd_barrier_post((unsigned*)(a.ws + WS_CTL) + CW_BAR, (volatile LAS unsigned*)(c.lds + MISC_OFF) + 8);
    cg::grid_group grid = cg::this_grid();
#endif
    if (IN(0)) { p0_prologue(a, c.lds, c.gw, c.NGW, c.wave, c.lane, true); if constexpr (PROBE_PH == 200) p0_prologue(a, c.lds, c.gw, c.NGW, c.wave, c.lane, false); }
#if MK_SINGLE
    if (lo <= 0 && 1 < hi) grid.sync();
#endif
    if (IN(1)) {
        prep_phase(a.in[I_XP], a.in[I_XS], a.in[I_GF1], (const float*)(a.ws + WS_MOD), 1, (bf16*)(a.ws + WS_H), (float*)(a.ws + WS_SS), c.gw, c.NGW, c.lane);
        bias_phase(a, c.gw, c.NGW, c.lane);
        if constexpr (PROBE_PH == 201) { prep_phase(a.in[I_XP], a.in[I_XS], a.in[I_GF1], (const float*)(a.ws + WS_MOD), 1, (bf16*)(a.ws + WS_H), (float*)(a.ws + WS_SS), c.gw, c.NGW, c.lane); bias_phase(a, c.gw, c.NGW, c.lane); }
        hyena_filter_phase(a, c.gw, c.NGW, c.lane);
    }
    SEAM(1);
    layer_phases<0>(a, c, bar);
    layer_phases<1>(a, c, bar);
    if (IN(PH_FINAL)) final_norm_phase(a.out, a.in[I_GFIN], (const float*)(a.ws + WS_SS) + (size_t)6 * M, c.gw, c.NGW, c.lane);
}
#undef IN
#undef SEAM

extern "C" void kernel_launch(void* const* d_in, const int* in_sizes, int n_in, void* d_out, int out_size, void* d_ws, size_t ws_size, hipStream_t stream) {
    static int grid = 0;
    if (grid == 0) {
        if (n_in != N_IN || ws_size < WS_END || out_size != M * D + 2 * 32 * 2 * 256 * 128) { fprintf(stderr, "kernel_launch: unexpected shapes (n_in %d, ws %zu, out %d)\n", n_in, ws_size, out_size); grid = -1; return; }
        int dev = 0, cus = 0, per_cu = 0;
        if (hipGetDevice(&dev) != hipSuccess || hipDeviceGetAttribute(&cus, hipDeviceAttributeMultiprocessorCount, dev) != hipSuccess) { grid = -1; return; }
        if (hipFuncSetAttribute((const void*)mega_fwd, hipFuncAttributeMaxDynamicSharedMemorySize, LDS_BYTES) != hipSuccess) { fprintf(stderr, "kernel_launch: hipFuncSetAttribute failed\n"); grid = -1; return; }
        if (hipOccupancyMaxActiveBlocksPerMultiprocessor(&per_cu, (const void*)mega_fwd, NTHREADS, LDS_BYTES) != hipSuccess || per_cu < 1) { fprintf(stderr, "kernel_launch: occupancy query says %d\n", per_cu); per_cu = 1; }
        (void)hipGetLastError();
        grid = cus;
    }
    if (grid < 0) return;
    (void)hipMemsetAsync((char*)d_ws + WS_CTL, 0, CTL_ZERO_BYTES, stream);
    Args a{};
    for (int i = 0; i < N_IN; ++i) a.in[i] = (const float*)d_in[i];
    a.out = (float*)d_out; a.ws = (unsigned char*)d_ws;
#if MK_SINGLE
    a.ph_lo = 0; a.ph_hi = N_PHASES;
    void* args[] = {&a};
    hipError_t e = hipLaunchCooperativeKernel((const void*)mega_fwd, dim3(grid), dim3(NTHREADS), args, LDS_BYTES, stream);
    if (e != hipSuccess) fprintf(stderr, "cooperative launch failed: %s (grid %d)\n", hipGetErrorString(e), grid);
#else
    for (int ph = 0; ph < N_PHASES; ++ph) {
        a.ph_lo = ph; a.ph_hi = ph + 1;
        hipLaunchKernelGGL(mega_fwd, dim3(grid), dim3(NTHREADS), LDS_BYTES, stream, a);
    }
#endif
}
```

```cpp
#include <hip/hip_runtime.h>
#include <hip/hip_cooperative_groups.h>
#include <cstdio>
#include <cstdint>
namespace cg = cooperative_groups;

constexpr int D = 1024, DFF = 2816, INW = 2048;
constexpr int MCTX = 8192, MLAT = 16384, M = MCTX + MLAT;
constexpr int LCTX = 256, LLAT = 2048;
constexpr int NCOND = 9, MODW = 9 * 1024;
constexpr int ZW = 1280;
constexpr int HYC = 768;
constexpr float EPS = 1e-6f;
constexpr float LOG2E = 1.4426950408889634f;
constexpr float QSCALE = 0.125f * LOG2E;

enum { I_XP = 0, I_XS, I_C, I_CK, I_CV, I_CCTX, I_WMOD, I_BMOD, I_GF1, I_GMIX, I_GF2, I_GFIN, I_W1G, I_W1U, I_W1D, I_W2G, I_W2U, I_W2D, I_WIN, I_WOUT, I_SINK,
       I_CDW, I_CDWB, I_CLNG, I_CLNB, I_CPW, I_HSW, I_HSB, I_HW1, I_HB1, I_HF1, I_HW2, I_HB2, I_HF2, I_HW3, I_HLD, I_HBIAS, N_IN };

constexpr size_t MiB = 1u << 20;
constexpr size_t WS_CTL = 0, CTL_ZERO_BYTES = 2 * MiB;
constexpr size_t WS_SUMSQ = 64 * 1024;
constexpr size_t WS_MOD = 128 * 1024;
constexpr size_t WS_SS = 1 * MiB;
constexpr size_t WS_ROPE = 3 * MiB;
constexpr size_t WS_BIAS = 3 * MiB + 64 * 1024;
constexpr size_t WS_WGU = 4 * MiB;
constexpr size_t WS_WD = 48 * MiB;
constexpr size_t WS_WIN = 70 * MiB;
constexpr size_t WS_WOUT = 78 * MiB;
constexpr size_t WS_CKB = 82 * MiB;
constexpr size_t WS_CVT = 83 * MiB;
constexpr size_t WS_HYH = 84 * MiB;
constexpr size_t WS_HYRAW = 86 * MiB;
constexpr size_t WS_H = 96 * MiB;
constexpr size_t WS_BIG = 144 * MiB;
constexpr size_t WS_Z = WS_BIG;
constexpr size_t WS_ZT = 204 * MiB;
constexpr size_t WS_CAT = 276 * MiB;
constexpr size_t WS_END = 324 * MiB;
static_assert(WS_MOD + 2 * 9 * 9216 * 4 <= WS_SS && WS_SS + 7 * (size_t)M * 4 <= CTL_ZERO_BYTES && WS_BIAS + 2 * 9 * 13312 * 4 <= WS_WGU, "ctl");
static_assert(WS_BIG + (size_t)M * DFF * 2 <= WS_END && WS_Z + (size_t)M * ZW * 2 <= WS_ZT && WS_ZT + (size_t)896 * M * 2 <= WS_END, "ws map");
constexpr int CW_BAR = 4096;

constexpr int RING_BYTES = 131072;
constexpr int LDSCTL_OFF = 133120, MISC_OFF = LDSCTL_OFF + 320;
constexpr int LDS_BYTES = 135168;
constexpr int NWAVES = 8, NTHREADS = 512;

namespace pg8 {
#define PG8_LAS __attribute__((address_space(3)))
typedef unsigned short bf16_t;
typedef short bf16x8 __attribute__((ext_vector_type(8)));
typedef float f32x4 __attribute__((ext_vector_type(4)));
typedef unsigned u32x4 __attribute__((ext_vector_type(4)));
constexpr int BM = 256, BK = 64, HALF = 128, HTB = HALF * BK * 2  , STAGE_BYTES = 8 * HTB, NXCD = 8, WGM = 8;

__host__ __device__ __forceinline__ int lds_byte(int r, int c) { const int st = (r >> 4) * 2 + (c >> 5), rr = r & 15, cc = c & 31, ob = rr * 64 + cc * 2; return st * 1024 + (ob ^ (((ob >> 9) & 1) << 5)); }
__host__ __device__ __forceinline__ void stage_rc(int b, int& R, int& C) { const int st = b / 1024, sb = b % 1024, swz = sb ^ (((sb >> 9) & 1) << 5); R = (st >> 1) * 16 + swz / 64; C = (st & 1) * 32 + (swz % 64) / 2; }
__host__ __device__ __forceinline__ int perm32(int rho) { const int n = rho >> 4, i = rho & 15; return 8 * (i >> 2) + 4 * n + (i & 3); }

struct Unit { int pm, pn; };
struct Gemm { const bf16_t* A; const bf16_t* Bt; int M, N, K; };

struct StaticOrder {
    int nM, nN, nwg, G, c;
    __host__ __device__ void init(int M, int N, int G_, int c_) { nM = M / BM; nN = N / BM; nwg = nM * nN; G = G_; c = c_; }
    __host__ __device__ bool next(int i, Unit& u) const {
        const long L = (long)i * G + c; if (L >= nwg) return false;
        int wgid = (int)L; { const int q = nwg / NXCD, r = nwg % NXCD, xcd = wgid % NXCD, off = wgid / NXCD; wgid = (xcd < r ? xcd * (q + 1) : r * (q + 1) + (xcd - r) * q) + off; }
        const int nig = WGM * nN, gid = wgid / nig, fm = gid * WGM, gsz = (nM - fm) < WGM ? (nM - fm) : WGM;
        u.pm = fm + ((wgid % nig) % gsz); u.pn = (wgid % nig) / gsz; return true;
    }
    __device__ __forceinline__ void a_ready(const Unit&) const {}
    __device__ __forceinline__ void done(const Unit&) const {}
};


__device__ __forceinline__ unsigned cvt_pk_bf16(float lo, float hi) { unsigned r; asm volatile("v_cvt_pk_bf16_f32 %0, %1, %2" : "=v"(r) : "v"(lo), "v"(hi)); return r; }
__device__ __forceinline__ float silu_f(float x) { return x * __builtin_amdgcn_rcpf(1.0f + __builtin_amdgcn_exp2f(-1.4426950408889634f * x)); }
__device__ __forceinline__ int cond_of_tile(int pm) { return pm < 32 ? 0 : 1 + ((pm - 32) >> 3); }

__device__ __forceinline__ void st16_wt(void* p, u32x4 v) { asm volatile("global_store_dwordx4 %0, %1, off sc1\n\ts_nop 1" :: "v"(p), "v"(v) : "memory"); }
__device__ __forceinline__ void st16_wt(void* p, f32x4 v) { asm volatile("global_store_dwordx4 %0, %1, off sc1\n\ts_nop 1" :: "v"(p), "v"(v) : "memory"); }
__device__ __forceinline__ void st8_wt(void* p, unsigned lo, unsigned hi) { __hip_atomic_store((unsigned long long*)p, ((unsigned long long)hi << 32) | lo, __ATOMIC_RELAXED, __HIP_MEMORY_SCOPE_AGENT); }
struct EpiGU {
    static constexpr bool PERM = true, AFTER_DRAIN = false;
    bf16_t* O;
    const float* ss; const float* bias;
    __device__ __forceinline__ void operator()(const f32x4 (&acc)[2][2][4][2], const Unit& u, int wr, int wc, int fr, int fq) const {
        const int row0 = u.pm * BM + wr * 64 + fr, col0 = u.pn * HALF + wc * 32 + 8 * fq;
        const float* bp = bias + cond_of_tile(u.pm) * 5632 + u.pn * BM + wc * 32 + 8 * fq;
        const f32x4 bg0 = *(const f32x4*)bp, bg1 = *(const f32x4*)(bp + 4), bu0 = *(const f32x4*)(bp + HALF), bu1 = *(const f32x4*)(bp + HALF + 4);
        float rsv[2][4];
#pragma unroll
        for (int ai = 0; ai < 2; ++ai)
#pragma unroll
            for (int m = 0; m < 4; ++m) rsv[ai][m] = ss[row0 + ai * HALF + m * 16];
#pragma unroll
        for (int ai = 0; ai < 2; ++ai)
#pragma unroll
            for (int m = 0; m < 4; ++m) { const int row = row0 + ai * HALF + m * 16; bf16_t* rowp = O + (size_t)row * 2816 + col0;
                const float rs = __builtin_amdgcn_rsqf(rsv[ai][m] * (1.0f / 1024.0f) + 1e-6f);
                const f32x4 g0 = acc[ai][0][m][0] * rs + bg0, g1 = acc[ai][0][m][1] * rs + bg1, u0 = acc[ai][1][m][0] * rs + bu0, u1 = acc[ai][1][m][1] * rs + bu1;
                u32x4 w;
                w.x = cvt_pk_bf16(silu_f(g0[0]) * u0[0], silu_f(g0[1]) * u0[1]); w.y = cvt_pk_bf16(silu_f(g0[2]) * u0[2], silu_f(g0[3]) * u0[3]);
                w.z = cvt_pk_bf16(silu_f(g1[0]) * u1[0], silu_f(g1[1]) * u1[1]); w.w = cvt_pk_bf16(silu_f(g1[2]) * u1[2], silu_f(g1[3]) * u1[3]);
                st16_wt(rowp, w); }
    }
};
struct EpiRes {
    static constexpr bool PERM = false, AFTER_DRAIN = false;
    const float* in0; const float* in1; float* X; const float* gate;
    bf16_t* Hn; const float* gn; const float* scn; float* ssn; float scale;
    __device__ __forceinline__ void operator()(const f32x4 (&acc)[2][2][4][2], const Unit& u, int wr, int wc, int fr, int fq) const {
        const int cond = cond_of_tile(u.pm); const float* gp = gate + cond * 9216;
        const int col0 = u.pn * BM + wc * 32 + 4 * fq;
        f32x4 gv[2][2], gc[2][2];
        const bool ctx = u.pm < 32; const float* src = ctx ? in0 : in1; const int rbase = u.pm * BM - (ctx ? 0 : 8192);
        typedef unsigned u32x2 __attribute__((ext_vector_type(2)));
        { f32x4 nraw[2][2], sraw[2][2];
#pragma unroll
          for (int bj = 0; bj < 2; ++bj)
#pragma unroll
              for (int n = 0; n < 2; ++n) { gv[bj][n] = *(const f32x4*)(gp + col0 + bj * HALF + n * 16);
                  if (Hn) { nraw[bj][n] = *(const f32x4*)(gn + col0 + bj * HALF + n * 16); sraw[bj][n] = *(const f32x4*)(scn + cond * 9216 + col0 + bj * HALF + n * 16); } }
#pragma unroll
          for (int bj = 0; bj < 2; ++bj)
#pragma unroll
              for (int n = 0; n < 2; ++n) { gv[bj][n] = gv[bj][n] * scale; if (Hn) gc[bj][n] = nraw[bj][n] * (sraw[bj][n] + 1.0f); else gc[bj][n] = (f32x4){0.f, 0.f, 0.f, 0.f}; } }
        f32x4 xo[1][2][2][2];
#define EPIRES_LOAD(buf_, ag_) do { _Pragma("unroll") for (int mm = 0; mm < 2; ++mm) { const float* sp = src + (size_t)(rbase + ((ag_) >> 1) * HALF + wr * 64 + (((ag_) & 1) * 2 + mm) * 16 + fr) * 1024 + col0; \
            _Pragma("unroll") for (int bj = 0; bj < 2; ++bj) _Pragma("unroll") for (int n = 0; n < 2; ++n) xo[buf_][mm][bj][n] = *(const f32x4*)(sp + bj * HALF + n * 16); } } while (0)
#pragma unroll
        for (int ag = 0; ag < 4; ++ag) { const int ai = ag >> 1, m0 = (ag & 1) * 2;
            EPIRES_LOAD(0, ag);
#pragma unroll
            for (int mm = 0; mm < 2; ++mm) { const int m = m0 + mm; const int rl = ai * HALF + wr * 64 + m * 16 + fr;
                float* xp = X + (size_t)(u.pm * BM + rl) * 1024 + col0;
                float sq = 0.f;
#pragma unroll
                for (int bj = 0; bj < 2; ++bj)
#pragma unroll
                    for (int n = 0; n < 2; ++n) { const f32x4 xn = xo[0][mm][bj][n] + gv[bj][n] * acc[ai][bj][m][n];
                        st16_wt(xp + bj * HALF + n * 16, xn); sq += (xn[0] * xn[0] + xn[1] * xn[1]) + (xn[2] * xn[2] + xn[3] * xn[3]);
                        if (Hn) { const f32x4 hv = xn * gc[bj][n]; st8_wt(Hn + (size_t)(u.pm * BM + rl) * 1024 + col0 + bj * HALF + n * 16, cvt_pk_bf16(hv[0], hv[1]), cvt_pk_bf16(hv[2], hv[3])); } }
                sq += __shfl_xor(sq, 16); sq += __shfl_xor(sq, 32);
                if (fq == 0) atomicAdd(ssn + u.pm * BM + rl, sq); }
        }
#undef EPIRES_LOAD
    }
};
struct EpiIN {
    static constexpr bool PERM = false, AFTER_DRAIN = false;
    bf16_t* Z; bf16_t* ZT; float* newk; float* newv; const float* rope; const float* ss; const float* bias; int layer; float qscale;
    __device__ __forceinline__ void operator()(const f32x4 (&acc)[2][2][4][2], const Unit& u, int wr, int wc, int fr, int fq) const {
        const bool lat = u.pm >= 32;
        const int colb = u.pn * BM + wc * 32 + 4 * fq;
        const float* bp = bias + cond_of_tile(u.pm) * 2048 + colb;
        f32x4 bv[2][2];
#pragma unroll
        for (int bj = 0; bj < 2; ++bj)
#pragma unroll
            for (int n = 0; n < 2; ++n) bv[bj][n] = *(const f32x4*)(bp + bj * HALF + n * 16);
        const bool roped = lat && u.pn < 3;
        float rsv[2][4];
#pragma unroll
        for (int ai = 0; ai < 2; ++ai)
#pragma unroll
            for (int m = 0; m < 4; ++m) rsv[ai][m] = ss[u.pm * BM + ai * HALF + wr * 64 + m * 16 + fr];
#pragma unroll
        for (int ai = 0; ai < 2; ++ai) {
            f32x4 rc0[4], rc1[4];
#pragma unroll
            for (int m = 0; m < 4; ++m) { rc0[m] = (f32x4){1.f, 0.f, 1.f, 0.f}; rc1[m] = rc0[m];
                if (roped) { const int pos = (u.pm * BM + ai * HALF + wr * 64 + m * 16 + fr - 8192) & 2047; const int p = (wc & 1) ? (pos & 63) : (pos >> 6);
                    const f32x4* rp = (const f32x4*)(rope + (size_t)(p * 16 + 4 * fq) * 2); rc0[m] = rp[0]; rc1[m] = rp[1]; } }
#pragma unroll
            for (int m = 0; m < 4; ++m) { const int row = u.pm * BM + ai * HALF + wr * 64 + m * 16 + fr;
                const float rs = __builtin_amdgcn_rsqf(rsv[ai][m] * (1.0f / 1024.0f) + 1e-6f);
#pragma unroll
                for (int bj = 0; bj < 2; ++bj) { const int col = colb + bj * HALF;
                    f32x4 v0 = acc[ai][bj][m][0] * rs + bv[bj][0], v1 = acc[ai][bj][m][1] * rs + bv[bj][1];
                    if (u.pn < 5) {
                        const int cb = u.pn * BM + bj * HALF;
                        if (lat && cb < 640) {
                            const f32x4 cs0 = rc0[m], cs1 = rc1[m];
                            const float c0 = cs0[0], s0 = cs0[1], c1 = cs0[2], s1 = cs0[3], c2 = cs1[0], s2 = cs1[1], c3 = cs1[2], s3 = cs1[3];
                            const f32x4 a = v0, b = v1;
                            v0[0] = a[0] * c0 - b[0] * s0; v1[0] = b[0] * c0 + a[0] * s0;
                            v0[1] = a[1] * c1 - b[1] * s1; v1[1] = b[1] * c1 + a[1] * s1;
                            v0[2] = a[2] * c2 - b[2] * s2; v1[2] = b[2] * c2 + a[2] * s2;
                            v0[3] = a[3] * c3 - b[3] * s3; v1[3] = b[3] * c3 + a[3] * s3;
                        }
                        if (!lat && cb >= 512 && cb < 768) {
                            const int b = row >> 8, s = row & 255; float* dst = (cb < 640 ? newk : newv) + ((size_t)(b * 2 + layer) * 256 + s) * 128 + (col - cb);
                            *(f32x4*)dst = v0; *(f32x4*)(dst + 16) = v1;
                        }
                        if (cb < 512) { v0 = v0 * qscale; v1 = v1 * qscale; }
                        if (cb == 640) {
                            const int ch = 768 + col - 640;
#pragma unroll
                            for (int j = 0; j < 4; ++j) { ZT[(size_t)(ch + j) * 24576 + row] = (bf16_t)(cvt_pk_bf16(v0[j], 0.f) & 0xffffu); ZT[(size_t)(ch + 16 + j) * 24576 + row] = (bf16_t)(cvt_pk_bf16(v1[j], 0.f) & 0xffffu); }
                        } else {
                        bf16_t* zp = Z + (size_t)row * 1280 + col;
                        typedef unsigned u32x2 __attribute__((ext_vector_type(2)));
                        u32x2 w0, w1; w0.x = cvt_pk_bf16(v0[0], v0[1]); w0.y = cvt_pk_bf16(v0[2], v0[3]); w1.x = cvt_pk_bf16(v1[0], v1[1]); w1.y = cvt_pk_bf16(v1[2], v1[3]);
                        *(u32x2*)zp = w0; *(u32x2*)(zp + 16) = w1; }
                    } else {
                        const int ch = col - 1280;
#pragma unroll
                        for (int j = 0; j < 4; ++j) { ZT[(size_t)(ch + j) * 24576 + row] = (bf16_t)(cvt_pk_bf16(v0[j], 0.f) & 0xffffu); ZT[(size_t)(ch + 16 + j) * 24576 + row] = (bf16_t)(cvt_pk_bf16(v1[j], 0.f) & 0xffffu); }
                    }
                } }
        }
    }
};

template <class Epi, class Sched, bool ALIGN_EPI = false, bool SP2 = false>
__device__ __forceinline__ void gemm_phase(PG8_LAS unsigned char* lds, const Gemm g, const Sched S, const Epi E) {
    int tid_ = threadIdx.x; asm volatile("" : "+v"(tid_));
    const int tid = tid_, wid = __builtin_amdgcn_readfirstlane(tid >> 6), lane = tid & 63, wr = wid >> 2, wc = wid & 3, fr = lane & 15, fq = lane >> 4;
    const int K = g.K, nt = K / BK;
    unsigned voffA[2], voffB[2];
#pragma unroll
    for (int i = 0; i < 2; ++i) { int R, C; stage_rc(tid * 16 + i * 8192, R, C); const int Rb = Epi::PERM ? ((R & ~31) + perm32(R & 31)) : R;
        voffA[i] = (unsigned)(R * K + C) * 2u; voffB[i] = (unsigned)(Rb * K + C) * 2u; }
    const size_t kstep = (size_t)(BK * 2);
    const size_t hstep = (size_t)HALF * K * 2;
    const size_t tstep = 2 * hstep;
    const unsigned ldsw = (unsigned)wid * 1024u;
    const int aoff = lds_byte(wr * 64 + fr, fq * 8), boff = lds_byte(wc * 32 + fr, fq * 8);
#define PG8_SA(b, h) (((b) * 2 + (h)) * HTB)
#define PG8_SB(b, h) ((4 + (b) * 2 + (h)) * HTB)
#define PG8_STAGE(bufoff, gbase, voff) do { _Pragma("unroll") for (int _i = 0; _i < 2; ++_i) \
        __builtin_amdgcn_global_load_lds((const unsigned*)((const char*)(gbase) + (voff)[_i]), (PG8_LAS unsigned*)(lds + (bufoff) + ldsw + _i * 8192), 16, 0, 0); } while (0)
#define PG8_LDA(dst, b, h) do { _Pragma("unroll") for (int m = 0; m < 4; ++m) _Pragma("unroll") for (int k = 0; k < 2; ++k) dst[m][k] = *(const PG8_LAS bf16x8*)(lds + PG8_SA(b, h) + aoff + m * 2048 + k * 1024); } while (0)
#define PG8_LDB(dst, b, h) do { _Pragma("unroll") for (int n = 0; n < 2; ++n) _Pragma("unroll") for (int k = 0; k < 2; ++k) dst[n][k] = *(const PG8_LAS bf16x8*)(lds + PG8_SB(b, h) + boff + n * 2048 + k * 1024); } while (0)
#define PG8_MMA(ai, bj, At, Bt) do { __builtin_amdgcn_s_setprio(1); _Pragma("unroll") for (int m = 0; m < 4; ++m) _Pragma("unroll") for (int n = 0; n < 2; ++n) _Pragma("unroll") for (int k = 0; k < 2; ++k) \
        acc[ai][bj][m][n] = __builtin_amdgcn_mfma_f32_16x16x32_bf16(Bt[n][k], At[m][k], acc[ai][bj][m][n], 0, 0, 0); __builtin_amdgcn_s_setprio(0); } while (0)
#define PG8_WAIT_V(n) asm volatile("s_waitcnt vmcnt(" #n ")" ::: "memory")
#define PG8_WAIT_L(n) asm volatile("s_waitcnt lgkmcnt(" #n ")" ::: "memory")
#define PG8_BAR __builtin_amdgcn_s_barrier()
#define PG8_SCHED __builtin_amdgcn_sched_barrier(0)
    Unit cur, nxt; int ui = 0;
    if (!S.next(0, cur)) return;
    f32x4 acc[2][2][4][2];
#pragma unroll
    for (int a = 0; a < 2; ++a)
#pragma unroll
        for (int b = 0; b < 2; ++b)
#pragma unroll
            for (int m = 0; m < 4; ++m)
#pragma unroll
                for (int n = 0; n < 2; ++n) acc[a][b][m][n] = (f32x4){0.f, 0.f, 0.f, 0.f};
    bf16x8 At[4][2], B0[2][2], B1[2][2];
    const char* cA = (const char*)g.A + (size_t)cur.pm * tstep; const char* cB = (const char*)g.Bt + (size_t)cur.pn * tstep;
    S.a_ready(cur);
    if constexpr (SP2) {
        PG8_STAGE(PG8_SB(0, 0), cB, voffB); PG8_STAGE(PG8_SB(0, 1), cB + hstep, voffB); PG8_STAGE(PG8_SA(0, 0), cA, voffA); PG8_STAGE(PG8_SA(0, 1), cA + hstep, voffA);
        if (wr == 1) PG8_BAR;
        PG8_WAIT_V(2); PG8_BAR;
        PG8_STAGE(PG8_SB(1, 0), cB + kstep, voffB); PG8_STAGE(PG8_SA(1, 0), cA + kstep, voffA); PG8_STAGE(PG8_SB(1, 1), cB + hstep + kstep, voffB);
        PG8_WAIT_V(6); PG8_BAR;
    } else {
        PG8_STAGE(PG8_SB(0, 0), cB, voffB); PG8_STAGE(PG8_SA(0, 0), cA, voffA); PG8_STAGE(PG8_SB(0, 1), cB + hstep, voffB); PG8_STAGE(PG8_SA(0, 1), cA + hstep, voffA);
        if (wr == 1) PG8_BAR;
        PG8_WAIT_V(4); PG8_BAR;
        PG8_STAGE(PG8_SB(1, 0), cB + kstep, voffB); PG8_STAGE(PG8_SA(1, 0), cA + kstep, voffA); PG8_STAGE(PG8_SB(1, 1), cB + hstep + kstep, voffB);
        PG8_WAIT_V(6); PG8_BAR;
    }
    for (;;) {
        const bool has_next = S.next(ui + 1, nxt);
        const char* nA = has_next ? (const char*)g.A + (size_t)nxt.pm * tstep : cA; const char* nB = has_next ? (const char*)g.Bt + (size_t)nxt.pn * tstep : cB;
        for (int t = 0; t < nt; t += 2) {
            const bool last = (t == nt - 2);
            const char* a1 = cA + (size_t)(t + 1) * kstep;
            const char* a2 = last ? nA : cA + (size_t)(t + 2) * kstep; const char* b2 = last ? nB : cB + (size_t)(t + 2) * kstep;
            const char* a3 = a2 + kstep; const char* b3 = b2 + kstep;
            if (last && has_next) S.a_ready(nxt);
            if constexpr (SP2) {
            PG8_LDB(B0, 0, 0); PG8_LDB(B1, 0, 1); PG8_SCHED; PG8_LDA(At, 0, 0); PG8_STAGE(PG8_SA(1, 1), a1 + hstep, voffA);
            PG8_WAIT_V(8); PG8_WAIT_L(0); PG8_BAR; PG8_MMA(0, 0, At, B0); PG8_MMA(0, 1, At, B1); PG8_BAR; PG8_SCHED;
            PG8_LDA(At, 0, 1); PG8_STAGE(PG8_SB(0, 0), b2, voffB); PG8_STAGE(PG8_SB(0, 1), b2 + hstep, voffB); PG8_STAGE(PG8_SA(0, 0), a2, voffA);
            PG8_WAIT_V(8); PG8_WAIT_L(0); PG8_BAR; PG8_MMA(1, 0, At, B0); PG8_MMA(1, 1, At, B1); PG8_BAR; PG8_SCHED;
            PG8_LDB(B0, 1, 0); PG8_LDB(B1, 1, 1); PG8_SCHED; PG8_LDA(At, 1, 0); PG8_STAGE(PG8_SA(0, 1), a2 + hstep, voffA);
            PG8_WAIT_V(8); PG8_WAIT_L(0); PG8_BAR; PG8_MMA(0, 0, At, B0); PG8_MMA(0, 1, At, B1); PG8_BAR; PG8_SCHED;
            PG8_LDA(At, 1, 1); PG8_STAGE(PG8_SB(1, 0), b3, voffB); PG8_STAGE(PG8_SB(1, 1), b3 + hstep, voffB); PG8_STAGE(PG8_SA(1, 0), a3, voffA);
            PG8_WAIT_V(8); PG8_WAIT_L(0); PG8_BAR; PG8_MMA(1, 0, At, B0); PG8_MMA(1, 1, At, B1); PG8_BAR; PG8_SCHED;
            } else {
            PG8_LDB(B0, 0, 0); PG8_SCHED; PG8_LDA(At, 0, 0); PG8_STAGE(PG8_SA(1, 1), a1 + hstep, voffA);
            PG8_WAIT_L(8); PG8_BAR; PG8_WAIT_L(0); PG8_MMA(0, 0, At, B0); PG8_BAR; PG8_SCHED;
            PG8_LDB(B1, 0, 1); PG8_STAGE(PG8_SB(0, 0), b2, voffB);
            PG8_BAR; PG8_WAIT_L(0); PG8_MMA(0, 1, At, B1); PG8_BAR;
            PG8_LDA(At, 0, 1); PG8_STAGE(PG8_SA(0, 0), a2, voffA);
            PG8_BAR; PG8_WAIT_L(0); PG8_MMA(1, 0, At, B0); PG8_BAR; PG8_SCHED;
            PG8_STAGE(PG8_SB(0, 1), b2 + hstep, voffB);
            PG8_WAIT_V(6); PG8_BAR; PG8_MMA(1, 1, At, B1); PG8_BAR;
            PG8_LDB(B0, 1, 0); PG8_SCHED; PG8_LDA(At, 1, 0); PG8_STAGE(PG8_SA(0, 1), a2 + hstep, voffA);
            PG8_WAIT_L(8); PG8_BAR; PG8_WAIT_L(0); PG8_MMA(0, 0, At, B0); PG8_BAR; PG8_SCHED;
            PG8_LDB(B1, 1, 1); PG8_STAGE(PG8_SB(1, 0), b3, voffB);
            PG8_BAR; PG8_WAIT_L(0); PG8_MMA(0, 1, At, B1); PG8_BAR;
            PG8_LDA(At, 1, 1); PG8_STAGE(PG8_SA(1, 0), a3, voffA);
            PG8_BAR; PG8_WAIT_L(0); PG8_MMA(1, 0, At, B0); PG8_BAR; PG8_SCHED;
            PG8_STAGE(PG8_SB(1, 1), b3 + hstep, voffB);
            PG8_WAIT_V(6); PG8_BAR; PG8_MMA(1, 1, At, B1); PG8_BAR;
            }
        }
        if constexpr (ALIGN_EPI) { if (wr == 0) PG8_BAR; }
        if constexpr (!Epi::AFTER_DRAIN) { E(acc, cur, wr, wc, fr, fq); S.done(cur); }
        if (!has_next) break;
#pragma unroll
        for (int a = 0; a < 2; ++a)
#pragma unroll
            for (int b = 0; b < 2; ++b)
#pragma unroll
                for (int m = 0; m < 4; ++m)
#pragma unroll
                    for (int n = 0; n < 2; ++n) acc[a][b][m][n] = (f32x4){0.f, 0.f, 0.f, 0.f};
        cur = nxt; cA = nA; cB = nB; ++ui;
        if constexpr (ALIGN_EPI) { if (wr == 1) PG8_BAR; }
    }
    PG8_WAIT_V(0);
    if constexpr (!ALIGN_EPI) { if (wr == 0) PG8_BAR; }
    PG8_BAR;
    if constexpr (Epi::AFTER_DRAIN) { E.fused(acc, cur, wr, wc, fr, fq, lds, wid, lane); S.done(cur); }
#undef PG8_SA
#undef PG8_SB
#undef PG8_STAGE
#undef PG8_LDA
#undef PG8_LDB
#undef PG8_MMA
#undef PG8_WAIT_V
#undef PG8_WAIT_L
#undef PG8_BAR
#undef PG8_SCHED
}
}

#define GAS __attribute__((address_space(1)))
#define LAS __attribute__((address_space(3)))
typedef unsigned short bf16;
typedef unsigned v4u __attribute__((ext_vector_type(4)));
typedef unsigned v2u __attribute__((ext_vector_type(2)));
typedef float f32x4 __attribute__((ext_vector_type(4)));
typedef short bf16x8 __attribute__((ext_vector_type(8)));
typedef GAS unsigned gu32;
#define RLX_AGENT __ATOMIC_RELAXED, __HIP_MEMORY_SCOPE_AGENT
#define LDS_WAIT() asm volatile("s_waitcnt lgkmcnt(0)" ::: "memory")
#define VM_WAIT() asm volatile("s_waitcnt vmcnt(0)" ::: "memory")
__device__ __forceinline__ unsigned f2bf(float f) { unsigned u = __builtin_bit_cast(unsigned, f); return (u + 0x7fffu + ((u >> 16) & 1u)) >> 16; }
__device__ __forceinline__ unsigned pk2(float lo, float hi) { return f2bf(lo) | (f2bf(hi) << 16); }
__device__ __forceinline__ float bf2f(unsigned h) { return __builtin_bit_cast(float, h << 16); }
__device__ __forceinline__ float bflo(unsigned w) { return __builtin_bit_cast(float, w << 16); }
__device__ __forceinline__ float bfhi(unsigned w) { return __builtin_bit_cast(float, w & 0xffff0000u); }
__device__ __forceinline__ float wave_sum(float v) {
#define WS_DPP(ctrl, rmask) v += __builtin_bit_cast(float, __builtin_amdgcn_update_dpp(0, __builtin_bit_cast(int, v), ctrl, rmask, 0xf, false))
    WS_DPP(0xB1, 0xf); WS_DPP(0x4E, 0xf); WS_DPP(0x141, 0xf); WS_DPP(0x140, 0xf); WS_DPP(0x142, 0xa); WS_DPP(0x143, 0xc);
#undef WS_DPP
    return __builtin_bit_cast(float, __builtin_amdgcn_readlane(__builtin_bit_cast(int, v), 63));
}
__device__ __forceinline__ float silu_acc(float x) { return x / (1.0f + __expf(-x)); }

#define XB_TMO      128
#define XB_XCNT(j)  (256  + 64 * (j))
#define XB_XSUB(j)  (1280 + 64 * (j))
#define XB_XGEN(j)  (2304 + 64 * (j))
#define XB_TOP      3328
#define XB_TOPGEN   3392
#define XCD_BAR_WORDS 3456
#define XB_SPIN_CAP (1u << 18)
__device__ __forceinline__ unsigned xb_ld(unsigned* p)              { return __hip_atomic_load(p, __ATOMIC_RELAXED, __HIP_MEMORY_SCOPE_AGENT); }
__device__ __forceinline__ unsigned xb_add(unsigned* p, unsigned v) { return __hip_atomic_fetch_add(p, v, __ATOMIC_RELAXED, __HIP_MEMORY_SCOPE_AGENT); }
__device__ __forceinline__ unsigned xb_xcc_id() { return (unsigned)__builtin_amdgcn_s_getreg((3 << 11) | 20) & 0xFu; }
#define XB_SPIN(cond, bar) do { unsigned _sp = 0; while (cond) { __builtin_amdgcn_s_sleep(1); \
    if ((++_sp & 255u) == 0u) { if (xb_ld(&(bar)[XB_TMO])) break; if (_sp > XB_SPIN_CAP) { atomicAdd(&(bar)[XB_TMO], 1u); break; } } } } while (0)
struct XcdBarrier { unsigned* bar; unsigned x; volatile LAS unsigned* st; };
__device__ __forceinline__ XcdBarrier xcd_barrier_post(unsigned* bar, volatile LAS unsigned* st) {
    XcdBarrier b; b.bar = bar; b.x = xb_xcc_id(); b.st = st;
    if (threadIdx.x == 0) (void)xb_add(&bar[XB_XCNT(b.x)], 1u);
    return b;
}
__device__ __forceinline__ void xcd_barrier_complete(unsigned* bar, unsigned x, unsigned& nloc, unsigned& nx) {
    const unsigned G = gridDim.x * gridDim.y * gridDim.z;
    unsigned sum, cnt, mine, sp = 0u;
    for (;;) {
        sum = 0u; cnt = 0u; mine = 0u;
#pragma unroll
        for (unsigned j = 0; j < 16; ++j) { const unsigned c = xb_ld(&bar[XB_XCNT(j)]); sum += c; cnt += (c > 0u) ? 1u : 0u; mine = (j == x) ? c : mine; }
        if (sum == G) break;
        __builtin_amdgcn_s_sleep(1);
        if ((++sp & 255u) == 0u) { if (xb_ld(&bar[XB_TMO])) break; if (sp > XB_SPIN_CAP) { atomicAdd(&bar[XB_TMO], 1u); break; } }
    }
    nloc = mine > 0u ? mine : 1u; nx = cnt > 0u ? cnt : 1u;
}
__device__ __forceinline__ void xcd_barrier(const XcdBarrier& b) {
    asm volatile("s_waitcnt vmcnt(0)" ::: "memory");
    __syncthreads();
    if (threadIdx.x == 0) {
        unsigned* bar = b.bar;
        __builtin_amdgcn_s_waitcnt(0);
        unsigned nloc = b.st[0], nx = b.st[1];
        if (nloc == 0u) { xcd_barrier_complete(bar, b.x, nloc, nx); b.st[0] = nloc; b.st[1] = nx; }
        const unsigned old = xb_add(&bar[XB_XSUB(b.x)], 1u);
        const unsigned gen = old / nloc;
        if (old + 1u == (gen + 1u) * nloc) {
            __builtin_amdgcn_fence(__ATOMIC_RELEASE, "agent");
            asm volatile("s_waitcnt vmcnt(0)" ::: "memory");
            const unsigned og = xb_add(&bar[XB_TOP], 1u);
            const unsigned tg = og / nx;
            if (og + 1u == (tg + 1u) * nx) xb_add(&bar[XB_TOPGEN], 1u);
            else XB_SPIN(xb_ld(&bar[XB_TOPGEN]) == tg, bar);
            __builtin_amdgcn_fence(__ATOMIC_ACQUIRE, "agent");
            xb_add(&bar[XB_XGEN(b.x)], 1u);
            asm volatile("s_waitcnt vmcnt(0)" ::: "memory");
        } else {
            XB_SPIN(xb_ld(&bar[XB_XGEN(b.x)]) == gen, bar);
            __builtin_amdgcn_fence(__ATOMIC_ACQUIRE, "agent");
            asm volatile("s_waitcnt vmcnt(0)" ::: "memory");
        }
    }
    __syncthreads();
}

struct Args { const float* in[N_IN]; float* out; unsigned char* ws; int ph_lo, ph_hi; };

struct TrItem { const float* src; bf16* dst; int N, Kd; };
__device__ __forceinline__ TrItem tr_make(const float* W, int N, bf16* WT, int Kd, int kb, int nb, int mode) {
    const int k0 = 64 * kb, n0 = 32 * nb; const int drow0 = mode == 0 ? n0 : ((n0 >> 7) * 256 + (n0 & 127) + (mode == 2 ? 128 : 0));
    TrItem t; t.src = W + (size_t)k0 * N + n0; t.dst = WT + (size_t)drow0 * Kd + k0; t.N = N; t.Kd = Kd; return t;
}
__device__ __forceinline__ void tr_load(const TrItem& t, float (&tv)[32], int lane) {
#pragma unroll
    for (int i = 0; i < 32; ++i) tv[i] = t.src[(size_t)(2 * i + (lane >> 5)) * t.N + (lane & 31)];
}
__device__ __forceinline__ void tr_finish(const TrItem& t, const float (&tv)[32], LAS float* scr, int lane) {
#pragma unroll
    for (int i = 0; i < 32; ++i) scr[(2 * i + (lane >> 5)) * 33 + (lane & 31)] = tv[i];
    LDS_WAIT(); asm volatile("" ::: "memory");
    const int c = lane & 7;
#pragma unroll
    for (int j = 0; j < 4; ++j) { const int n = (lane >> 3) + 8 * j; const LAS float* s = scr + (8 * c) * 33 + n;
        v4u o; o.x = pk2(s[0 * 33], s[1 * 33]); o.y = pk2(s[2 * 33], s[3 * 33]); o.z = pk2(s[4 * 33], s[5 * 33]); o.w = pk2(s[6 * 33], s[7 * 33]);
        *(v4u*)(t.dst + (size_t)n * t.Kd + 8 * c) = o; }
    LDS_WAIT(); asm volatile("" ::: "memory");
}

__device__ __forceinline__ void p0_prologue(const Args& a, LAS unsigned char* lds, int gw, int NGW, int wave, int lane, const bool with_j3) {
    unsigned char* ws = a.ws;
    LAS float* scr = (LAS float*)(lds + wave * 16384);
    constexpr int I_G = 16 * 88, I_D = 44 * 32, I_FF = 3 * I_G, I_IN = 16 * 64, I_OUT = 12 * 32, I_L = 2 * I_FF + I_IN + I_OUT;
    static_assert(I_G == I_D, "items");
    auto j1_item = [&](int it) __attribute__((always_inline)) -> TrItem {
        const int l = it / I_L; int r = it % I_L;
        if (r < 2 * I_FF) {
            const int f = r / I_FF; r %= I_FF; const int part = r / I_G; r %= I_G;
            const size_t lo = (size_t)l * 1024 * 2816;
            if (part == 0)      return tr_make(a.in[f ? I_W2G : I_W1G] + lo, 2816, (bf16*)(ws + WS_WGU) + (size_t)(l * 2 + f) * 5632 * 1024, 1024, r / 88, r % 88, 1);
            else if (part == 1) return tr_make(a.in[f ? I_W2U : I_W1U] + lo, 2816, (bf16*)(ws + WS_WGU) + (size_t)(l * 2 + f) * 5632 * 1024, 1024, r / 88, r % 88, 2);
            else                return tr_make(a.in[f ? I_W2D : I_W1D] + lo, 1024, (bf16*)(ws + WS_WD) + (size_t)(l * 2 + f) * 1024 * 2816, 2816, r / 32, r % 32, 0);
        }
        r -= 2 * I_FF;
        if (r < I_IN) return tr_make(a.in[I_WIN] + (size_t)l * 1024 * 2048, 2048, (bf16*)(ws + WS_WIN) + (size_t)l * 2048 * 1024, 1024, r / 64, r % 64, 0);
        r -= I_IN; int kb = r / 32; if (kb >= 8) kb += 4;
        return tr_make(a.in[I_WOUT] + (size_t)l * 1024 * 1024, 1024, (bf16*)(ws + WS_WOUT) + (size_t)l * 1024 * 1024, 1024, kb, r % 32, 0);
    };
    if (gw < 2 * I_L) {
        TrItem cur = j1_item(gw); float tv[32]; tr_load(cur, tv, lane);
        for (int it = gw; it < 2 * I_L; it += NGW) {
            const bool more = it + NGW < 2 * I_L;
            TrItem nxt = cur; float tn[32];
            if (more) { nxt = j1_item(it + NGW); tr_load(nxt, tn, lane); }
            tr_finish(cur, tv, scr, lane);
            if (more) { cur = nxt;
#pragma unroll
                for (int i = 0; i < 32; ++i) tv[i] = tn[i]; }
        }
    }
    for (int it = gw; it < 2 * 256 * 4; it += NGW) {
        const int l = it >> 10, kp = (it >> 2) & 255, nc = it & 3;
        const float* pw = a.in[I_CPW] + (size_t)l * 65536 + kp * 256;
        const float* wo = a.in[I_WOUT] + (size_t)l * 1048576 + (size_t)512 * 1024 + nc * 256 + lane * 4;
        f32x4 acc = {0.f, 0.f, 0.f, 0.f};
#pragma unroll 8
        for (int j = 0; j < 256; ++j) acc += pw[j] * *(const f32x4*)(wo + (size_t)j * 1024);
        bf16* dst = (bf16*)(ws + WS_WOUT) + (size_t)l * 1048576 + (size_t)(nc * 256 + lane * 4) * 1024 + 512 + kp;
        dst[0] = (bf16)f2bf(acc[0]); dst[1024] = (bf16)f2bf(acc[1]); dst[2048] = (bf16)f2bf(acc[2]); dst[3072] = (bf16)f2bf(acc[3]);
    }
    if (with_j3) {
        LAS float* sl = (LAS float*)(lds + wave * 16384);
        for (int it = gw; it < 2 * 36 * 16; it += NGW) {
            const int l = it / 576, r = it % 576, nch = r >> 4, ks = r & 15;
            const int n = nch * 256 + lane * 4;
            const float* wm = a.in[I_WMOD] + (size_t)l * 1024 * 9216 + (size_t)(ks * 64) * 9216 + n;
            sl[lane] = silu_acc(a.in[I_CCTX][ks * 64 + lane]);
#pragma unroll
            for (int c = 1; c < 9; ++c) sl[c * 64 + lane] = silu_acc(a.in[I_C][(c - 1) * 1024 + ks * 64 + lane]);
            LDS_WAIT(); asm volatile("" ::: "memory");
            f32x4 acc[9];
#pragma unroll
            for (int c = 0; c < 9; ++c) acc[c] = (f32x4){0.f, 0.f, 0.f, 0.f};
#pragma unroll 1
            for (int kb = 0; kb < 4; ++kb) {
                f32x4 w[16];
#pragma unroll
                for (int k = 0; k < 16; ++k) w[k] = *(const f32x4*)(wm + (size_t)(kb * 16 + k) * 9216);
#pragma unroll
                for (int k = 0; k < 16; ++k)
#pragma unroll
                    for (int c = 0; c < 9; ++c) acc[c] += sl[c * 64 + kb * 16 + k] * w[k];
            }
            float* mod = (float*)(ws + WS_MOD) + (size_t)l * 9 * 9216 + n;
            f32x4 bm = {0.f, 0.f, 0.f, 0.f}; if (ks == 0) bm = *(const f32x4*)(a.in[I_BMOD] + l * 9216 + n);
#pragma unroll
            for (int c = 0; c < 9; ++c)
#pragma unroll
                for (int j = 0; j < 4; ++j) atomicAdd(mod + c * 9216 + j, acc[c][j] + bm[j]);
            LDS_WAIT(); asm volatile("" ::: "memory");
        }
    }
    {
        const int gt = gw * 64 + lane, NGT = NGW * 64;
        for (int e = gt; e < 2 * 8 * 256 * 128; e += NGT) {
            const int gd = e & 127, p = (e >> 7) & 255, b = (e >> 15) & 7, l = e >> 18;
            const size_t src = (((size_t)b * 2 + l) * 256 + p) * 128 + gd;
            const float kv = a.in[I_CK][src], vv = a.in[I_CV][src];
            ((bf16*)(ws + WS_CKB))[e] = (bf16)f2bf(kv);
            ((bf16*)(ws + WS_CVT))[(((size_t)l * 8 + b) * 128 + gd) * 256 + p] = (bf16)f2bf(vv);
        }
        for (int e = gt; e < 1024; e += NGT) { const int p = e >> 4, i = e & 15; const float inv = powf(10000.0f, -(float)i / 16.0f); const float ang = (float)p * inv;
            ((float*)(ws + WS_ROPE))[2 * e] = cosf(ang); ((float*)(ws + WS_ROPE))[2 * e + 1] = sinf(ang); }
    }
    for (int it = gw; it < 2 * 2304; it += NGW) {
        const int l = it / 2304, tt = it % 2304; const int L = tt < 2048 ? 2048 : 256, t = tt < 2048 ? tt : tt - 2048;
        const float tf = (float)t, tn = tf / (float)(L - 1);
        const float* w1 = a.in[I_HW1] + l * 33 * 64; const float* w2 = a.in[I_HW2] + l * 64 * 64;
        float s1 = tn * w1[lane];
#pragma unroll 4
        for (int i = 0; i < 16; ++i) { const float band = 1e-4f + (float)i * ((15.0f - 1e-4f) / 15.0f); const float ang = (6.283185307179586f * tf) * band / (float)L;
            s1 += cosf(ang) * w1[(1 + i) * 64 + lane] - sinf(ang) * w1[(17 + i) * 64 + lane]; }
        const float h1 = sinf(a.in[I_HF1][l * 64 + lane] * (s1 + a.in[I_HB1][l * 64 + lane]));
        float s2 = 0.f;
#pragma unroll 8
        for (int k = 0; k < 64; ++k) s2 += __shfl(h1, k) * w2[k * 64 + lane];
        const float h2 = sinf(a.in[I_HF2][l * 64 + lane] * (s2 + a.in[I_HB2][l * 64 + lane]));
        ((float*)(ws + WS_HYH))[(size_t)it * 64 + lane] = h2;
    }
}

__device__ __forceinline__ void prep_phase(const float* src0, const float* src1, const float* g, const float* mod, int sc_chunk, bf16* H, float* ss, int r_lo, int r_hi, int gw, int NGW, int lane) {
    const int per = (r_hi - r_lo + NGW - 1) / NGW; int r = r_lo + gw * per; r_hi = (r + per < r_hi) ? r + per : r_hi; NGW = 1;
    if (r >= r_hi) return;
    f32x4 v[4], v1[4], v2[4];
#define PREP_LOAD(dst, row) do { const int rr_ = (row); if (rr_ < r_hi) { const float* xr_ = rr_ < MCTX ? src0 + (size_t)rr_ * D : src1 + (size_t)(rr_ - MCTX) * D; \
        _Pragma("unroll") for (int j = 0; j < 4; ++j) dst[j] = ((const f32x4*)xr_)[lane + 64 * j]; } } while (0)
    PREP_LOAD(v, r); PREP_LOAD(v1, r + NGW);
    for (; r < r_hi; r += NGW) {
        PREP_LOAD(v2, r + 2 * NGW);
        const int cond = r < MCTX ? 0 : 1 + ((r - MCTX) >> 11);
        const float* sc = mod + cond * 9216 + sc_chunk * 1024;
        float s = 0.f;
#pragma unroll
        for (int j = 0; j < 4; ++j) s += (v[j][0] * v[j][0] + v[j][1] * v[j][1]) + (v[j][2] * v[j][2] + v[j][3] * v[j][3]);
        s = wave_sum(s); if (lane == 0) ss[r] = s;
#pragma unroll
        for (int j = 0; j < 4; ++j) { const int col = 4 * (lane + 64 * j);
            const f32x4 o = v[j] * *(const f32x4*)(g + col) * (*(const f32x4*)(sc + col) + 1.0f);
            v2u w; w.x = pk2(o[0], o[1]); w.y = pk2(o[2], o[3]); *(v2u*)(H + (size_t)r * D + col) = w; }
#pragma unroll
        for (int j = 0; j < 4; ++j) { v[j] = v1[j]; v1[j] = v2[j]; }
    }
#undef PREP_LOAD
}
__device__ __forceinline__ void bias_phase(const Args& a, int it_lo, int it_hi, int gw, int NGW, int lane) {
    unsigned char* ws = a.ws;
    const int i = lane & 15, q = lane >> 4;
    for (int it = it_lo + gw; it < it_hi; it += NGW) {
        const int l = it / 832; int r = it % 832; int which, n0;
        if (r < 352) { which = 0; n0 = r * 16; } else if (r < 480) { which = 1; n0 = (r - 352) * 16; } else { which = 2; n0 = (r - 480) * 16; }
        const bf16* Wt = which == 1 ? (const bf16*)(ws + WS_WIN) + (size_t)l * 2048 * 1024 : (const bf16*)(ws + WS_WGU) + (size_t)(l * 2 + (which == 2 ? 1 : 0)) * 5632 * 1024;
        const int shc = which == 0 ? 0 : (which == 1 ? 3 : 6), off = which == 0 ? 0 : (which == 1 ? 50688 : 69120), bst = which == 1 ? 2048 : 5632;
        const float* shp = (const float*)(ws + WS_MOD) + (size_t)l * 9 * 9216 + (size_t)(i < 9 ? i : 0) * 9216 + shc * 1024 + 8 * q;
        const bf16* wp = Wt + (size_t)(n0 + i) * 1024 + 8 * q;
        f32x4 acc = {0.f, 0.f, 0.f, 0.f};
#pragma unroll 8
        for (int st = 0; st < 32; ++st) {
            const f32x4 s0 = *(const f32x4*)(shp + 32 * st), s1 = *(const f32x4*)(shp + 32 * st + 4);
            const v4u wv = *(const v4u*)(wp + 32 * st);
            v4u av; av.x = pk2(s0[0], s0[1]); av.y = pk2(s0[2], s0[3]); av.z = pk2(s1[0], s1[1]); av.w = pk2(s1[2], s1[3]);
            if (i >= 9) av = (v4u){0u, 0u, 0u, 0u};
            acc = __builtin_amdgcn_mfma_f32_16x16x32_bf16(__builtin_bit_cast(bf16x8, av), __builtin_bit_cast(bf16x8, wv), acc, 0, 0, 0);
        }
        float* bo = (float*)(ws + WS_BIAS) + (size_t)l * 119808 + off + n0 + i;
#pragma unroll
        for (int rg = 0; rg < 4; ++rg) { const int cond = 4 * q + rg; if (cond < 9) bo[(size_t)cond * bst] = acc[rg]; }
    }
}
__device__ __forceinline__ void final_norm_phase(float* X, const float* g, const float* ss, int gw, int NGW, int lane) {
    for (int r = gw; r < M; r += NGW) {
        float* xr = X + (size_t)r * D;
        const float rstd = 1.0f / sqrtf(ss[r] * (1.0f / D) + EPS);
#pragma unroll
        for (int j = 0; j < 4; ++j) { const int col = 4 * (lane + 64 * j); ((f32x4*)xr)[lane + 64 * j] = (((const f32x4*)xr)[lane + 64 * j] * rstd) * *(const f32x4*)(g + col); }
    }
}

__device__ __forceinline__ void hyena_filter_phase(const Args& a, LAS unsigned char* lds, int gw, int NGW, int wave, int lane) {
    unsigned char* ws = a.ws;
    LAS float* hs = (LAS float*)(lds + wave * 16384);
    for (int it = gw; it < 2 * 36 * 16; it += NGW) {
        const int l = it / 576, r = it % 576, tc = r >> 4, ng = r & 15;
        const int stream = tc < 32 ? 0 : 1; const int L = stream ? 256 : 2048; const int t0 = (stream ? tc - 32 : tc) * 64; const int soff = stream ? 4096 : 0;
        const int n = ng * 64 + lane, o = n >> 9, dir = (n >> 8) & 1, c = n & 255;
        const float* hrow = (const float*)(ws + WS_HYH) + ((size_t)l * 2304 + (stream ? 2048 : 0) + t0) * 64;
        f32x4 hv[16];
#pragma unroll
        for (int i = 0; i < 16; ++i) hv[i] = ((const f32x4*)hrow)[i * 64 + lane];
        const float* w3 = a.in[I_HW3] + (size_t)l * 64 * 1024 + n;
        float w[64];
#pragma unroll
        for (int k = 0; k < 64; ++k) w[k] = w3[k * 1024];
        const float ndecay = -__expf(a.in[I_HLD][l * 1024 + n]) / (float)(L - 1);
#pragma unroll
        for (int i = 0; i < 16; ++i) *(LAS f32x4*)(hs + (i * 64 + lane) * 4) = hv[i];
        LDS_WAIT(); asm volatile("" ::: "memory");
        bf16* dst = (bf16*)(ws + WS_HYRAW) + ((size_t)(l * 2 + o) * 256 + c) * 4608 + soff;
        float sq = 0.f;
        for (int tt = 0; tt < 64; ++tt) {
            const int t = t0 + tt; float dot = 0.f;
#pragma unroll
            for (int k4 = 0; k4 < 16; ++k4) { const f32x4 h = *(const LAS f32x4*)(hs + tt * 64 + k4 * 4); dot += (h[0] * w[4 * k4] + h[1] * w[4 * k4 + 1]) + (h[2] * w[4 * k4 + 2] + h[3] * w[4 * k4 + 3]); }
            const float val = dot * __expf((float)t * ndecay);
            sq += val * val;
            if (dir == 0) dst[L - 1 - t] = (bf16)f2bf(val);
            else if (t > 0) dst[L - 1 + t] = (bf16)f2bf(val);
            else dst[2 * L - 1] = 0;
        }
        atomicAdd((float*)(ws + WS_SUMSQ) + ((l * 2 + stream) * 2 + o) * 256 + c, sq);
        LDS_WAIT(); asm volatile("" ::: "memory");
    }
}

__device__ __forceinline__ void conv_phase(const Args& a, int l, const bf16* Z, bf16* CAT, LAS unsigned char* lds, int tid) {
    LAS float* ybuf = (LAS float*)lds;
    LAS float* cbuf = (LAS float*)(lds + 65536);
    const float* dw = a.in[I_CDW] + l * 31 * 256; const float* dwb = a.in[I_CDWB] + l * 256; const float* lng = a.in[I_CLNG] + l * 256; const float* lnb = a.in[I_CLNB] + l * 256;
    const int lane = tid & 63, wave = tid >> 6;
    for (int u = blockIdx.x; u < M / 32; u += gridDim.x) {
        const int r0 = u * 32;
        const int seq0 = r0 < MCTX ? (r0 & ~255) : MCTX + ((r0 - MCTX) & ~2047); const int seq1 = seq0 + (r0 < MCTX ? 256 : 2048);
        for (int e = tid; e < 62 * 32; e += NTHREADS) {
            const int rr = e >> 5, ch = e & 31; const int row = r0 - 15 + rr;
            float y[8];
            if (row >= seq0 && row < seq1) {
                const v4u av = *(const v4u*)(Z + (size_t)row * ZW + 768 + ch * 8), gv = *(const v4u*)(Z + (size_t)row * ZW + 1024 + ch * 8);
                const float af[8] = {bflo(av.x), bfhi(av.x), bflo(av.y), bfhi(av.y), bflo(av.z), bfhi(av.z), bflo(av.w), bfhi(av.w)};
                const float gf[8] = {bflo(gv.x), bfhi(gv.x), bflo(gv.y), bfhi(gv.y), bflo(gv.z), bfhi(gv.z), bflo(gv.w), bfhi(gv.w)};
#pragma unroll
                for (int j = 0; j < 8; ++j) y[j] = af[j] / (1.0f + __expf(-gf[j]));
            } else {
#pragma unroll
                for (int j = 0; j < 8; ++j) y[j] = 0.f;
            }
            *(LAS f32x4*)(ybuf + rr * 256 + ch * 8) = (f32x4){y[0], y[1], y[2], y[3]}; *(LAS f32x4*)(ybuf + rr * 256 + ch * 8 + 4) = (f32x4){y[4], y[5], y[6], y[7]};
        }
        __syncthreads();
        { const int c = tid & 255, half = tid >> 8;
          float w[31];
#pragma unroll
          for (int k = 0; k < 31; ++k) w[k] = dw[k * 256 + c];
          const float bias = dwb[c];
          float yv[46];
#pragma unroll
          for (int i = 0; i < 46; ++i) yv[i] = ybuf[(half * 16 + i) * 256 + c];
#pragma unroll
          for (int t = 0; t < 16; ++t) { float s = bias;
#pragma unroll
              for (int k = 0; k < 31; ++k) s += w[k] * yv[t + k];
              cbuf[(half * 16 + t) * 256 + c] = s; } }
        __syncthreads();
        for (int rr = wave * 4; rr < wave * 4 + 4; ++rr) {
            const f32x4 x = *(const LAS f32x4*)(cbuf + rr * 256 + lane * 4);
            const float mu = wave_sum((x[0] + x[1]) + (x[2] + x[3])) * (1.0f / 256.0f);
            const f32x4 dx = x - mu;
            const float var = wave_sum((dx[0] * dx[0] + dx[1] * dx[1]) + (dx[2] * dx[2] + dx[3] * dx[3])) * (1.0f / 256.0f);
            const float rstd = 1.0f / sqrtf(var + EPS);
            const f32x4 yv = dx * rstd * *(const f32x4*)(lng + lane * 4) + *(const f32x4*)(lnb + lane * 4);
            v2u wv; wv.x = pk2(silu_acc(yv[0]), silu_acc(yv[1])); wv.y = pk2(silu_acc(yv[2]), silu_acc(yv[3]));
            *(v2u*)(CAT + (size_t)(r0 + rr) * 1024 + 512 + lane * 4) = wv;
        }
        __syncthreads();
    }
}


typedef unsigned long long u64;
typedef u64 u64x2 __attribute__((ext_vector_type(2)));
template <int L> struct HyGeo {
    static constexpr int R = L / 128, NSTEP = L / 32, CS = 4 * L + 64, US = 2 * L + 32, OFF_U = 8 * CS;
};
template <int L>
__device__ __forceinline__ void hy_build_copies(LAS unsigned char* lds, const bf16* raw, int tid) {
    constexpr int CS = HyGeo<L>::CS;
    for (int p = tid; p < L / 4; p += NTHREADS) {
        const v4u a = *(const v4u*)(raw + 8 * p), b = *(const v4u*)(raw + 8 * p + 8);
        const unsigned w[8] = {a.x, a.y, a.z, a.w, b.x, b.y, b.z, b.w};
#pragma unroll
        for (int sg = 0; sg < 8; ++sg) { v4u o;
            if ((sg & 1) == 0) { o.x = w[sg / 2]; o.y = w[sg / 2 + 1]; o.z = w[sg / 2 + 2]; o.w = w[sg / 2 + 3]; }
            else { const int h = sg / 2; o.x = (w[h] >> 16) | (w[h + 1] << 16); o.y = (w[h + 1] >> 16) | (w[h + 2] << 16); o.z = (w[h + 2] >> 16) | (w[h + 3] << 16); o.w = (w[h + 3] >> 16) | (w[h + 4] << 16); }
            *(LAS v4u*)(lds + sg * CS + 16 * p) = o; }
    }
}
template <int L, int NB>
__device__ __forceinline__ void hy_toeplitz(LAS unsigned char* lds, int boff, f32x4 (&acc)[HyGeo<L>::R][NB > 8 ? 2 : 1], int wave, int lane) {
    constexpr int R = HyGeo<L>::R, NT = NB > 8 ? 2 : 1, NSTEP = HyGeo<L>::NSTEP, CS = HyGeo<L>::CS, US = HyGeo<L>::US;
    const int i = lane & 15, q = lane >> 4;
    const int abase = (7 - (i & 7)) * CS + 16 * ((L / 8 - 1) - (i >> 3) + q - 2 * R * wave);
    int bb[NT];
#pragma unroll
    for (int nt = 0; nt < NT; ++nt) bb[nt] = boff + ((NB > 8 ? nt * 16 + i : (i & 7))) * US + 16 * q;
    bf16x8 F[R];
#pragma unroll
    for (int e = 0; e < R; ++e) F[e] = *(const LAS bf16x8*)(lds + abase - 32 * e);
#pragma unroll
    for (int r = 0; r < R; ++r)
#pragma unroll
        for (int nt = 0; nt < NT; ++nt) acc[r][nt] = (f32x4){0.f, 0.f, 0.f, 0.f};
    bf16x8 B[2][NT];
#pragma unroll
    for (int nt = 0; nt < NT; ++nt) B[0][nt] = *(const LAS bf16x8*)(lds + bb[nt]);
#pragma unroll 1
    for (int jo = 0; jo < NSTEP; jo += 8) {
#pragma unroll
        for (int ji = 0; ji < 8; ++ji) {
            const int j = jo + ji; constexpr int dummy = 0; (void)dummy;
#pragma unroll
            for (int r = R - 2; r < R; ++r) { const int slot = (((r - 2 * ji) % R) + R) % R;
#pragma unroll
                for (int nt = 0; nt < NT; ++nt) acc[r][nt] = __builtin_amdgcn_mfma_f32_16x16x32_bf16(F[slot], B[ji & 1][nt], acc[r][nt], 0, 0, 0); }
            __builtin_amdgcn_sched_barrier(0);
            if (j + 1 < NSTEP) {
#pragma unroll
                for (int nt = 0; nt < NT; ++nt) B[(ji + 1) & 1][nt] = *(const LAS bf16x8*)(lds + bb[nt] + 64 * (j + 1));
#pragma unroll
                for (int rr = 0; rr < 2; ++rr) { const int slot = (((rr - 2 * (ji + 1)) % R) + R) % R; F[slot] = *(const LAS bf16x8*)(lds + abase + 64 * (j + 1) - 32 * rr); }
            }
            __builtin_amdgcn_sched_barrier(0);
#pragma unroll
            for (int r = 0; r < R - 2; ++r) { const int slot = (((r - 2 * ji) % R) + R) % R;
#pragma unroll
                for (int nt = 0; nt < NT; ++nt) acc[r][nt] = __builtin_amdgcn_mfma_f32_16x16x32_bf16(F[slot], B[ji & 1][nt], acc[r][nt], 0, 0, 0); }
            __builtin_amdgcn_sched_barrier(0);
        }
    }
}
struct XRaw { v2u z; unsigned zl, zr; };
__device__ __forceinline__ XRaw xraw_load(const bf16* zrow, int t, int L) { XRaw x; x.z = *(const v2u*)zrow; x.zl = t > 0 ? (unsigned)zrow[-1] : 0u; x.zr = t + 4 < L ? (unsigned)zrow[4] : 0u; return x; }
__device__ __forceinline__ void sconv4x(const XRaw& x, float w0, float w1, float w2, float sb, float (&out)[4]) {
    const float zl = bf2f(x.zl), zr = bf2f(x.zr), z0 = bflo(x.z.x), z1 = bfhi(x.z.x), z2 = bflo(x.z.y), z3 = bfhi(x.z.y);
    out[0] = sb + w0 * zl + w1 * z0 + w2 * z1; out[1] = sb + w0 * z0 + w1 * z1 + w2 * z2; out[2] = sb + w0 * z1 + w1 * z2 + w2 * z3; out[3] = sb + w0 * z2 + w1 * z3 + w2 * zr;
}
__device__ __forceinline__ void sconv4(const bf16* zrow, int t, int L, float w0, float w1, float w2, float sb, float (&out)[4]) { const XRaw x = xraw_load(zrow, t, L); sconv4x(x, w0, w1, w2, sb, out); }
template <int L>
__device__ __forceinline__ void hy_store_copies(LAS unsigned char* lds, const v4u a, const v4u b, int p) {
    constexpr int CS = HyGeo<L>::CS;
    const unsigned w[8] = {a.x, a.y, a.z, a.w, b.x, b.y, b.z, b.w};
#pragma unroll
    for (int sg = 0; sg < 8; ++sg) { v4u o;
        if ((sg & 1) == 0) { o.x = w[sg / 2]; o.y = w[sg / 2 + 1]; o.z = w[sg / 2 + 2]; o.w = w[sg / 2 + 3]; }
        else { const int h = sg / 2; o.x = (w[h] >> 16) | (w[h + 1] << 16); o.y = (w[h + 1] >> 16) | (w[h + 2] << 16); o.z = (w[h + 2] >> 16) | (w[h + 3] << 16); o.w = (w[h + 3] >> 16) | (w[h + 4] << 16); }
        *(LAS v4u*)(lds + sg * CS + 16 * p) = o; }
}
template <int L, int NB, bool DUP = false>
__device__ __forceinline__ void hyena_channel(const Args& a, int l, int c, const bf16* ZT, bf16* CAT, LAS unsigned char* lds, int tid, int wave, int lane) {
    constexpr int R = HyGeo<L>::R, NT = NB > 8 ? 2 : 1, US = HyGeo<L>::US, OFF_U = HyGeo<L>::OFF_U, OFF_Y = OFF_U + NB * US;
    constexpr bool LAT = (L == 2048); constexpr int stream = LAT ? 0 : 1; constexpr int rowbase = LAT ? MCTX : 0;
    static_assert(L / 4 <= NTHREADS, "one copy slot per thread");
    unsigned char* ws = a.ws;
    const float* sw = a.in[I_HSW] + l * 3 * 768; const float* sb = a.in[I_HSB] + l * 768;
    const bf16* raw0 = (const bf16*)(ws + WS_HYRAW) + ((size_t)(l * 2 + 0) * 256 + c) * 4608 + (LAT ? 0 : 4096);
    const bf16* raw1 = (const bf16*)(ws + WS_HYRAW) + ((size_t)(l * 2 + 1) * 256 + c) * 4608 + (LAT ? 0 : 4096);
    const int i = lane & 15;
    const bool cp = tid < L / 4;
    v4u f0a = {0u, 0u, 0u, 0u}, f0b = f0a, f1a = f0a, f1b = f0a;
    if (cp) { f0a = *(const v4u*)(raw0 + 8 * tid); f0b = *(const v4u*)(raw0 + 8 * tid + 8); f1a = *(const v4u*)(raw1 + 8 * tid); f1b = *(const v4u*)(raw1 + 8 * tid + 8); }
    __syncthreads();
    if (cp) hy_store_copies<L>(lds, f0a, f0b, tid);
    { const float w0 = sw[c], w1 = sw[768 + c], w2 = sw[1536 + c], b0 = sb[c];
      for (int idx = tid; idx < NB * (L / 8); idx += NTHREADS) {
          const int b = idx / (L / 8), s0 = (idx % (L / 8)) * 8; const bf16* zrow = ZT + (size_t)c * M + rowbase + b * L + s0;
          float o0[4], o1[4]; sconv4(zrow, s0, L, w0, w1, w2, b0, o0); sconv4(zrow + 4, s0 + 4, L, w0, w1, w2, b0, o1);
          v4u w; w.x = pk2(o0[0], o0[1]); w.y = pk2(o0[2], o0[3]); w.z = pk2(o1[0], o1[1]); w.w = pk2(o1[2], o1[3]);
          *(LAS v4u*)(lds + OFF_U + b * US + 2 * s0) = w; } }
    __syncthreads();
    f32x4 acc[R][NT];
    hy_toeplitz<L, NB>(lds, OFF_U, acc, wave, lane);
    if constexpr (DUP) { { _Pragma("unroll") for (int r_ = 0; r_ < R; ++r_) _Pragma("unroll") for (int n_ = 0; n_ < NT; ++n_) asm volatile("" : "+v"(acc[r_][n_])); } hy_toeplitz<L, NB>(lds, OFF_U, acc, wave, lane); }
    { const float scale = 1.0f / sqrtf(((const float*)(ws + WS_SUMSQ))[((l * 2 + stream) * 2 + 0) * 256 + c] + EPS), bias = a.in[I_HBIAS][(l * 2 + 0) * 256 + c];
      const float w0 = sw[256 + c], w1 = sw[768 + 256 + c], w2 = sw[1536 + 256 + c], b0 = sb[256 + c];
      int q = lane >> 4; asm volatile("" : "+v"(q));
#pragma unroll
      for (int nt = 0; nt < NT; ++nt) { const int b = nt * 16 + i;
          if (b < NB) {
#pragma unroll
              for (int r = 0; r < R; ++r) { const int t = 16 * (R * wave + r) + 4 * q;
                  float x1[4]; sconv4(ZT + (size_t)(256 + c) * M + rowbase + b * L + t, t, L, w0, w1, w2, b0, x1);
                  const v2u uv = *(const LAS v2u*)(lds + OFF_U + b * US + 2 * t);
                  const float y0 = x1[0] * (scale * acc[r][nt][0] + bias * bflo(uv.x)), y1 = x1[1] * (scale * acc[r][nt][1] + bias * bfhi(uv.x));
                  const float y2 = x1[2] * (scale * acc[r][nt][2] + bias * bflo(uv.y)), y3 = x1[3] * (scale * acc[r][nt][3] + bias * bfhi(uv.y));
                  v2u w; w.x = pk2(y0, y1); w.y = pk2(y2, y3); *(LAS v2u*)(lds + OFF_Y + b * US + 2 * t) = w; } } } }
    __syncthreads();
    if (cp) hy_store_copies<L>(lds, f1a, f1b, tid);
    __syncthreads();
    hy_toeplitz<L, NB>(lds, OFF_Y, acc, wave, lane);
    if constexpr (DUP) { { _Pragma("unroll") for (int r_ = 0; r_ < R; ++r_) _Pragma("unroll") for (int n_ = 0; n_ < NT; ++n_) asm volatile("" : "+v"(acc[r_][n_])); } hy_toeplitz<L, NB>(lds, OFF_Y, acc, wave, lane); }
    { const float scale = 1.0f / sqrtf(((const float*)(ws + WS_SUMSQ))[((l * 2 + stream) * 2 + 1) * 256 + c] + EPS), bias = a.in[I_HBIAS][(l * 2 + 1) * 256 + c];
      const float w0 = sw[512 + c], w1 = sw[768 + 512 + c], w2 = sw[1536 + 512 + c], b0 = sb[512 + c];
      int q = lane >> 4; asm volatile("" : "+v"(q));
#pragma unroll
      for (int nt = 0; nt < NT; ++nt) { const int b = nt * 16 + i;
          if (b < NB) {
#pragma unroll
              for (int r = 0; r < R; ++r) { const int t = 16 * (R * wave + r) + 4 * q;
                  float x2[4]; sconv4(ZT + (size_t)(512 + c) * M + rowbase + b * L + t, t, L, w0, w1, w2, b0, x2);
                  const v2u yv = *(const LAS v2u*)(lds + OFF_Y + b * US + 2 * t);
                  bf16* dst = CAT + (size_t)(rowbase + b * L + t) * 1024 + 768 + c;
                  dst[0]    = (bf16)f2bf(x2[0] * (scale * acc[r][nt][0] + bias * bflo(yv.x)));
                  dst[1024] = (bf16)f2bf(x2[1] * (scale * acc[r][nt][1] + bias * bfhi(yv.x)));
                  dst[2048] = (bf16)f2bf(x2[2] * (scale * acc[r][nt][2] + bias * bflo(yv.y)));
                  dst[3072] = (bf16)f2bf(x2[3] * (scale * acc[r][nt][3] + bias * bfhi(yv.y))); } } } }
    __syncthreads();
}

typedef float f32x16 __attribute__((ext_vector_type(16)));
constexpr int ATT_KP = 144, ATT_VP = 80, ATT_KB = 32 * ATT_KP, ATT_BUF = ATT_KB + 64 * ATT_VP;
__device__ __forceinline__ void attn_phase(const Args& a, int l, const bf16* Z, const bf16* ZT, bf16* CAT, LAS unsigned char* lds, int tid, int wave, int lane) {
    const bf16* CKB = (const bf16*)(a.ws + WS_CKB) + (size_t)l * 8 * 256 * 128; const bf16* CVT = (const bf16*)(a.ws + WS_CVT) + (size_t)l * 8 * 128 * 256;
    const int r = lane & 31, hh = lane >> 5;
    for (int it = blockIdx.x; it < 768; it += gridDim.x) {
        bool lat; int b, g, qb;
        if (it < 512) { lat = true; b = it >> 6; g = (it >> 5) & 1; qb = it & 31; }
        else { const int rr = it - 512; lat = false; b = rr >> 3; g = (rr >> 2) & 1; qb = rr & 3; }
        const int h = g * 4 + (wave & 3), q0 = qb * 64 + 32 * (wave >> 2);
        const int L = lat ? 2048 : 256, seq0 = lat ? MCTX + b * 2048 : b * 256;
        const int kt_lo = lat ? (qb * 64 - 128 < 0 ? 0 : qb * 64 - 128) : 0, kt_hi = lat ? (qb * 64 + 192 > L ? L : qb * 64 + 192) : 256;
        const int n_local = (kt_hi - kt_lo) >> 5, n_total = n_local + (lat ? 8 : 0);
        const bool isk = tid < 256; const int t2 = tid & 255;
        const bf16* src_loc = isk ? Z + (size_t)(seq0 + kt_lo + (t2 >> 3)) * ZW + 512 + g * 64 + (t2 & 7) * 8 : ZT + (size_t)(768 + g * 64 + (t2 >> 2)) * M + seq0 + kt_lo + (t2 & 3) * 8;
        const bf16* src_ctx = isk ? CKB + ((size_t)b * 256 + (t2 >> 3)) * 128 + g * 64 + (t2 & 7) * 8 : CVT + ((size_t)b * 128 + g * 64 + (t2 >> 2)) * 256 + (t2 & 3) * 8;
        const size_t step_loc = isk ? (size_t)32 * ZW : 32, step_ctx = isk ? (size_t)32 * 128 : 32;
        const int dst = isk ? (t2 >> 3) * ATT_KP + (t2 & 7) * 16 : ATT_KB + (t2 >> 2) * ATT_VP + ((t2 & 3) >> 1) * 32 + ((t2 & 3) & 1) * 8;
#define ATT_GLOAD(ti_) (*(const v4u*)((ti_) < n_local ? src_loc + (size_t)(ti_) * step_loc : src_ctx + (size_t)((ti_) - n_local) * step_ctx))
#define ATT_LSTORE(buf_, v_) do { LAS unsigned char* p_ = lds + (buf_) * ATT_BUF + dst; if (isk) *(LAS v4u*)p_ = (v_); else { v2u lo_, hi_; lo_.x = (v_).x; lo_.y = (v_).y; hi_.x = (v_).z; hi_.y = (v_).w; *(LAS v2u*)p_ = lo_; *(LAS v2u*)(p_ + 16) = hi_; } } while (0)
        bf16x8 qf[4];
        { const bf16* qp = Z + (size_t)(seq0 + q0 + r) * ZW + h * 64 + 8 * hh;
#pragma unroll
          for (int s = 0; s < 4; ++s) qf[s] = *(const bf16x8*)(qp + 16 * s); }
        f32x16 o0, o1;
#pragma unroll
        for (int e = 0; e < 16; ++e) { o0[e] = 0.f; o1[e] = 0.f; }
        float mrun = a.in[I_SINK][l * 8 + h] * LOG2E, lsum = 1.0f;
        __syncthreads();
        v4u g1 = {0u, 0u, 0u, 0u}, g2 = g1;
        { const v4u g0 = ATT_GLOAD(0); if (n_total > 1) g1 = ATT_GLOAD(1); if (n_total > 2) g2 = ATT_GLOAD(2); ATT_LSTORE(0, g0); }
        __syncthreads();
        for (int ti = 0; ti < n_total; ++ti) {
            v4u gn = {0u, 0u, 0u, 0u};
            if (ti + 3 < n_total) gn = ATT_GLOAD(ti + 3);
            const int kt = kt_lo + 32 * ti;
            const bool active = !lat || ti >= n_local || (kt >= q0 - 128 && kt <= q0 + 128);
            if (active) {
                const LAS unsigned char* kb = lds + (ti & 1) * ATT_BUF + r * ATT_KP + 16 * hh;
                const LAS unsigned char* vb = lds + (ti & 1) * ATT_BUF + ATT_KB + r * ATT_VP + 16 * hh;
                f32x16 st;
#pragma unroll
                for (int e = 0; e < 16; ++e) st[e] = 0.f;
#pragma unroll
                for (int s = 0; s < 4; ++s) st = __builtin_amdgcn_mfma_f32_32x32x16_bf16(*(const LAS bf16x8*)(kb + 32 * s), qf[s], st, 0, 0, 0);
                const bf16x8 v00 = *(const LAS bf16x8*)(vb), v01 = *(const LAS bf16x8*)(vb + 32), v10 = *(const LAS bf16x8*)(vb + 32 * ATT_VP), v11 = *(const LAS bf16x8*)(vb + 32 * ATT_VP + 32);
                if (lat && ti < n_local) {
                    if (kt == q0 - 128) {
#pragma unroll
                        for (int e = 0; e < 16; ++e) { const int jj = (e & 3) + 8 * (e >> 2) + 4 * hh; if (jj < r) st[e] = -1e30f; }
                    } else if (kt == q0 + 128) {
#pragma unroll
                        for (int e = 0; e < 16; ++e) { const int jj = (e & 3) + 8 * (e >> 2) + 4 * hh; if (jj > r) st[e] = -1e30f; }
                    }
                }
                float mx = fmaxf(fmaxf(st[0], st[1]), fmaxf(st[2], st[3]));
#pragma unroll
                for (int e = 4; e < 16; e += 4) mx = fmaxf(mx, fmaxf(fmaxf(st[e], st[e + 1]), fmaxf(st[e + 2], st[e + 3])));
                mx = fmaxf(mx, __shfl_xor(mx, 32));
                const float mn = fmaxf(mrun, mx); const bool grew = __any(mn > mrun);
                const float alpha = grew ? __builtin_amdgcn_exp2f(mrun - mn) : 1.0f; mrun = mn;
                float ps = 0.f;
#pragma unroll
                for (int e = 0; e < 16; ++e) { st[e] = __builtin_amdgcn_exp2f(st[e] - mn); ps += st[e]; }
                ps += __shfl_xor(ps, 32);
                lsum = lsum * alpha + ps;
                if (grew) {
#pragma unroll
                    for (int e = 0; e < 16; ++e) { o0[e] *= alpha; o1[e] *= alpha; } }
                v4u pa, pb;
                pa.x = pk2(st[0], st[1]); pa.y = pk2(st[2], st[3]); pa.z = pk2(st[4], st[5]); pa.w = pk2(st[6], st[7]);
                pb.x = pk2(st[8], st[9]); pb.y = pk2(st[10], st[11]); pb.z = pk2(st[12], st[13]); pb.w = pk2(st[14], st[15]);
                const bf16x8 p0 = __builtin_bit_cast(bf16x8, pa), p1 = __builtin_bit_cast(bf16x8, pb);
                o0 = __builtin_amdgcn_mfma_f32_32x32x16_bf16(v00, p0, o0, 0, 0, 0);
                o0 = __builtin_amdgcn_mfma_f32_32x32x16_bf16(v01, p1, o0, 0, 0, 0);
                o1 = __builtin_amdgcn_mfma_f32_32x32x16_bf16(v10, p0, o1, 0, 0, 0);
                o1 = __builtin_amdgcn_mfma_f32_32x32x16_bf16(v11, p1, o1, 0, 0, 0);
            }
            if (ti + 1 < n_total) ATT_LSTORE((ti + 1) & 1, g1);
            g1 = g2; g2 = gn;
            __syncthreads();
        }
#undef ATT_GLOAD
#undef ATT_LSTORE
        const float inv = 1.0f / lsum;
        bf16* op = CAT + (size_t)(seq0 + q0 + r) * 1024 + h * 64 + 4 * hh;
#pragma unroll
        for (int g4 = 0; g4 < 4; ++g4) {
            v2u w; w.x = pk2(o0[4 * g4] * inv, o0[4 * g4 + 1] * inv); w.y = pk2(o0[4 * g4 + 2] * inv, o0[4 * g4 + 3] * inv); *(v2u*)(op + 8 * g4) = w;
            v2u x; x.x = pk2(o1[4 * g4] * inv, o1[4 * g4 + 1] * inv); x.y = pk2(o1[4 * g4 + 2] * inv, o1[4 * g4 + 3] * inv); *(v2u*)(op + 32 + 8 * g4) = x; }
    }
}

#ifndef PROBE_PH
#define PROBE_PH -1
#endif
#ifndef PROBE_TS
#define PROBE_TS -1
#endif
#ifndef PROBE_BLK
#define PROBE_BLK 0
#endif
#define TS_BEGIN(k) do { if constexpr ((k) == PROBE_TS) { if (blockIdx.x == PROBE_BLK && threadIdx.x == 0) *((volatile LAS unsigned long long*)(c.lds + MISC_OFF + 64)) = __builtin_amdgcn_s_memrealtime(); } } while (0)
#define TS_END(k) do { if constexpr ((k) == PROBE_TS) { if (blockIdx.x == PROBE_BLK && threadIdx.x == 0) *((volatile LAS unsigned long long*)(c.lds + MISC_OFF + 72)) = __builtin_amdgcn_s_memrealtime(); } } while (0)
struct Ctx { LAS unsigned char* lds; int tid, lane, wave, G, gw, NGW; };
constexpr int CW_SPLIT = 8192;

__device__ __forceinline__ void sb_arrive(unsigned* ctl, int id) {
    asm volatile("s_waitcnt vmcnt(0)" ::: "memory");
    __syncthreads();
    if (threadIdx.x == 0) __hip_atomic_fetch_add(ctl + CW_SPLIT + 64 * id, 1u, __ATOMIC_RELAXED, __HIP_MEMORY_SCOPE_AGENT);
}
__device__ __forceinline__ void sb_wait(unsigned* ctl, int id, unsigned G) {
    if (threadIdx.x == 0) {
        unsigned sp = 0;
        while (__hip_atomic_load(ctl + CW_SPLIT + 64 * id, __ATOMIC_RELAXED, __HIP_MEMORY_SCOPE_AGENT) < G) {
            __builtin_amdgcn_s_sleep(2);
            if (++sp > (1u << 22)) { atomicAdd(ctl + CW_BAR + XB_TMO, 1u); break; }
        }
        __builtin_amdgcn_fence(__ATOMIC_ACQUIRE, "agent");
        asm volatile("s_waitcnt vmcnt(0)" ::: "memory");
    }
    __syncthreads();
}
struct HalfOrder {
    pg8::StaticOrder S; int pm0;
    __device__ __forceinline__ void init(int N, int G, int c, int pm0_, int off) { const int rot = (G == 256) ? off : 0; S.init(48 * 256, N, G, (c + G - rot) % G); pm0 = pm0_; }
    __device__ __forceinline__ bool next(int i, pg8::Unit& u) const { if (!S.next(i, u)) return false; u.pm += pm0; return true; }
    __device__ __forceinline__ void a_ready(const pg8::Unit&) const {}
    __device__ __forceinline__ void done(const pg8::Unit&) const {}
};

template <int L, int f, int h> __device__ __forceinline__ void stage_G(const Args& a, const Ctx& c, int off) {
    unsigned char* ws = a.ws;
    pg8::Gemm g{(const bf16*)(ws + WS_H), (const bf16*)(ws + WS_WGU) + (size_t)(L * 2 + f) * 5632 * 1024, M, 5632, 1024};
    HalfOrder S; S.init(5632, c.G, (int)blockIdx.x, 48 * h, off);
    pg8::EpiGU E{(bf16*)(ws + WS_BIG), (const float*)(ws + WS_SS) + (size_t)(3 * L + 2 * f) * M, (const float*)(ws + WS_BIAS) + (size_t)L * 119808 + (f ? 69120 : 0)};
    pg8::gemm_phase<pg8::EpiGU, HalfOrder, true, true>(c.lds, g, S, E);
}
template <int L, int f, int h> __device__ __forceinline__ void stage_D(const Args& a, const Ctx& c, int off) {
    unsigned char* ws = a.ws; float* X = a.out; float* SS = (float*)(ws + WS_SS);
    const float* modl = (const float*)(ws + WS_MOD) + (size_t)L * 9 * 9216;
    pg8::Gemm g{(const bf16*)(ws + WS_BIG), (const bf16*)(ws + WS_WD) + (size_t)(L * 2 + f) * 1024 * 2816, M, 1024, 2816};
    HalfOrder S; S.init(1024, c.G, (int)blockIdx.x, 48 * h, off);
    const bool first = (L == 0) && f == 0;
    const float* gn = f == 0 ? a.in[I_GMIX] + L * 1024 : a.in[I_GF1] + 1024;
    const float* scn = f == 0 ? modl + 4 * 1024 : (const float*)(ws + WS_MOD) + 9 * 9216 + 1024;
    bf16* Hn = (f == 1 && L == 1) ? (bf16*)nullptr : (bf16*)(ws + WS_H);
    pg8::EpiRes E{first ? a.in[I_XP] : X, first ? a.in[I_XS] : X + (size_t)MCTX * D, X, modl + (f ? 8 : 2) * 1024, Hn, gn, scn, SS + (size_t)(3 * L + 1 + 2 * f) * M, 0.5f};
    pg8::gemm_phase<pg8::EpiRes, HalfOrder, true, true>(c.lds, g, S, E);
}
template <int L, int h> __device__ __forceinline__ void stage_IN(const Args& a, const Ctx& c, int off) {
    unsigned char* ws = a.ws; float* newk = a.out + (size_t)M * D; float* newv = newk + 32 * 2 * 256 * 128;
    pg8::Gemm g{(const bf16*)(ws + WS_H), (const bf16*)(ws + WS_WIN) + (size_t)L * 2048 * 1024, M, 2048, 1024};
    HalfOrder S; S.init(2048, c.G, (int)blockIdx.x, 48 * h, off);
    pg8::EpiIN E{(bf16*)(ws + WS_Z), (bf16*)(ws + WS_ZT), newk, newv, (const float*)(ws + WS_ROPE), (const float*)(ws + WS_SS) + (size_t)(3 * L + 1) * M, (const float*)(ws + WS_BIAS) + (size_t)L * 119808 + 50688, L, QSCALE};
    pg8::gemm_phase<pg8::EpiIN, HalfOrder, true, true>(c.lds, g, S, E);
}
template <int L, int h> __device__ __forceinline__ void stage_OUT(const Args& a, const Ctx& c, int off) {
    unsigned char* ws = a.ws; float* X = a.out; const float* modl = (const float*)(ws + WS_MOD) + (size_t)L * 9 * 9216;
    pg8::Gemm g{(const bf16*)(ws + WS_CAT), (const bf16*)(ws + WS_WOUT) + (size_t)L * 1024 * 1024, M, 1024, 1024};
    HalfOrder S; S.init(1024, c.G, (int)blockIdx.x, 48 * h, off);
    pg8::EpiRes E{X, X + (size_t)MCTX * D, X, modl + 5 * 1024, (bf16*)(ws + WS_H), a.in[I_GF2] + L * 1024, modl + 7 * 1024, (float*)(ws + WS_SS) + (size_t)(3 * L + 2) * M, 1.0f};
    pg8::gemm_phase<pg8::EpiRes, HalfOrder, true, true>(c.lds, g, S, E);
}
template <int L> __device__ __forceinline__ void mix_stage(const Args& a, const Ctx& c) {
    unsigned char* ws = a.ws; const bf16* Z = (const bf16*)(ws + WS_Z); const bf16* ZT = (const bf16*)(ws + WS_ZT); bf16* CAT = (bf16*)(ws + WS_CAT);
    int tid_ = c.tid; asm volatile("" : "+v"(tid_));
    const int G = c.G, tid = tid_, lane = tid_ & 63; LAS unsigned char* lds = c.lds;
#define HY_CH(w) ((((w) & 7) << 5) | (((w) >> 3) & 31))
    if constexpr (L == 0) TS_BEGIN(301);
    for (int w = blockIdx.x; w < 256; w += G) hyena_channel<2048, 8>(a, L, HY_CH(w), ZT, CAT, lds, tid, c.wave, lane);
    if constexpr (L == 0) { TS_END(301); TS_BEGIN(302); }
    for (int w = blockIdx.x; w < 256; w += G) hyena_channel<256, 32>(a, L, HY_CH(w), ZT, CAT, lds, tid, c.wave, lane);
#undef HY_CH
    if constexpr (L == 0) { TS_END(302); TS_BEGIN(303); }
    attn_phase(a, L, Z, ZT, CAT, lds, tid, c.wave, lane);
    __syncthreads();
    if constexpr (L == 0) { TS_END(303); TS_BEGIN(304); }
    conv_phase(a, L, Z, CAT, lds, tid);
    if constexpr (L == 0) TS_END(304);
}
__device__ __forceinline__ void final_half(const Args& a, const Ctx& c, int h) {
    float* X = a.out; const float* ss = (const float*)(a.ws + WS_SS) + (size_t)6 * M; const float* g = a.in[I_GFIN];
    for (int r = h * 12288 + c.gw; r < (h + 1) * 12288; r += c.NGW) {
        float* xr = X + (size_t)r * D;
        const float rstd = 1.0f / sqrtf(ss[r] * (1.0f / D) + EPS);
#pragma unroll
        for (int j = 0; j < 4; ++j) { const int col = 4 * (c.lane + 64 * j); ((f32x4*)xr)[c.lane + 64 * j] = (((const f32x4*)xr)[c.lane + 64 * j] * rstd) * *(const f32x4*)(g + col); }
    }
}

__global__ void __launch_bounds__(NTHREADS, 2) mega_fwd(Args a) {
    extern __shared__ __attribute__((aligned(16))) unsigned char lds_raw[];
    Ctx c;
    c.lds = (LAS unsigned char*)lds_raw;
    c.tid = threadIdx.x; c.lane = c.tid & 63; c.wave = __builtin_amdgcn_readfirstlane(c.tid >> 6);
    c.G = gridDim.x; c.gw = blockIdx.x * NWAVES + c.wave; c.NGW = c.G * NWAVES;
    unsigned* ctl = (unsigned*)(a.ws + WS_CTL);
    for (int u = c.tid; u < (LDS_BYTES - LDSCTL_OFF) / 4; u += NTHREADS) ((LAS unsigned*)(c.lds + LDSCTL_OFF))[u] = 0u;
    __syncthreads();
    XcdBarrier bar = xcd_barrier_post(ctl + CW_BAR, (volatile LAS unsigned*)(c.lds + MISC_OFF) + 8);
    cg::grid_group grid = cg::this_grid();
    const unsigned G = (unsigned)c.G;
    TS_BEGIN(0);
    p0_prologue(a, c.lds, c.gw, c.NGW, c.wave, c.lane, true);
    if (a.ph_hi > 100000) grid.sync(); else xcd_barrier(bar);
    TS_END(0); TS_BEGIN(1);
    prep_phase(a.in[I_XP], a.in[I_XS], a.in[I_GF1], (const float*)(a.ws + WS_MOD), 1, (bf16*)(a.ws + WS_H), (float*)(a.ws + WS_SS), 0, M, c.gw, c.NGW, c.lane);
    bias_phase(a, 0, 2 * 832, c.gw, c.NGW, c.lane);
    xcd_barrier(bar);
    TS_END(1); TS_BEGIN(2);
    { stage_G<0, 0, 0>(a, c, 0); sb_arrive(ctl, 0); }
    { stage_G<0, 0, 1>(a, c, 32); sb_arrive(ctl, 1); }
    { sb_wait(ctl, 0, G); stage_D<0, 0, 0>(a, c, 64); sb_arrive(ctl, 2); }
    { sb_wait(ctl, 1, G); stage_D<0, 0, 1>(a, c, 0); sb_arrive(ctl, 3); }
    { const int b = (int)blockIdx.x;
      if (b < 64 || b >= 192) hyena_filter_phase(a, c.lds, (b < 64 ? b : b - 128) * NWAVES + c.wave, 128 * NWAVES, c.wave, c.lane); }
    sb_wait(ctl, 2, G); sb_wait(ctl, 3, G);
    stage_IN<0, 0>(a, c, 0);
    stage_IN<0, 1>(a, c, 128);
    xcd_barrier(bar);
    TS_END(2); TS_BEGIN(3);
    mix_stage<0>(a, c);
    xcd_barrier(bar);
    TS_END(3); TS_BEGIN(4);
    { stage_OUT<0, 0>(a, c, 128); sb_arrive(ctl, 4); }
    { stage_OUT<0, 1>(a, c, 64); sb_arrive(ctl, 5); }
    { sb_wait(ctl, 4, G); stage_G<0, 1, 0>(a, c, 0); sb_arrive(ctl, 6); }
    { sb_wait(ctl, 5, G); stage_G<0, 1, 1>(a, c, 32); sb_arrive(ctl, 7); }
    { sb_wait(ctl, 6, G); stage_D<0, 1, 0>(a, c, 0); sb_arrive(ctl, 8); }
    { sb_wait(ctl, 7, G); stage_D<0, 1, 1>(a, c, 192); sb_arrive(ctl, 9); }
    { sb_wait(ctl, 8, G); stage_G<1, 0, 0>(a, c, 64); sb_arrive(ctl, 10); }
    { sb_wait(ctl, 9, G); stage_G<1, 0, 1>(a, c, 96); sb_arrive(ctl, 11); }
    { sb_wait(ctl, 10, G); stage_D<1, 0, 0>(a, c, 128); sb_arrive(ctl, 12); }
    { sb_wait(ctl, 11, G); stage_D<1, 0, 1>(a, c, 64); sb_arrive(ctl, 13); }
    sb_wait(ctl, 12, G); sb_wait(ctl, 13, G);
    stage_IN<1, 0>(a, c, 0);
    stage_IN<1, 1>(a, c, 128);
    xcd_barrier(bar);
    TS_END(4); TS_BEGIN(5);
    mix_stage<1>(a, c);
    xcd_barrier(bar);
    TS_END(5); TS_BEGIN(6);
    { stage_OUT<1, 0>(a, c, 128); sb_arrive(ctl, 14); }
    { stage_OUT<1, 1>(a, c, 64); sb_arrive(ctl, 15); }
    { sb_wait(ctl, 14, G); stage_G<1, 1, 0>(a, c, 128); sb_arrive(ctl, 16); }
    { sb_wait(ctl, 15, G); stage_G<1, 1, 1>(a, c, 160); sb_arrive(ctl, 17); }
    { sb_wait(ctl, 16, G); stage_D<1, 1, 0>(a, c, 0); sb_arrive(ctl, 18); }
    { sb_wait(ctl, 17, G); stage_D<1, 1, 1>(a, c, 192); sb_arrive(ctl, 19); }
    { sb_wait(ctl, 18, G); final_half(a, c, 0); }
    { sb_wait(ctl, 19, G); final_half(a, c, 1); }
    TS_END(6);
    if constexpr (PROBE_TS >= 0) { if (blockIdx.x == PROBE_BLK && threadIdx.x == 0) { const unsigned long long t0 = *((volatile LAS unsigned long long*)(c.lds + MISC_OFF + 64)), t1 = *((volatile LAS unsigned long long*)(c.lds + MISC_OFF + 72)); const unsigned long long now = __builtin_amdgcn_s_memrealtime(); while (__builtin_amdgcn_s_memrealtime() - now < 9ull * (t1 - t0)) __builtin_amdgcn_s_sleep(8); } __syncthreads(); }
}

extern "C" void kernel_launch(void* const* d_in, const int* in_sizes, int n_in, void* d_out, int out_size, void* d_ws, size_t ws_size, hipStream_t stream) {
    static int grid = 0;
    if (grid == 0) {
        if (n_in != N_IN || ws_size < WS_END || out_size != M * D + 2 * 32 * 2 * 256 * 128) { fprintf(stderr, "kernel_launch: unexpected shapes (n_in %d, ws %zu, out %d)\n", n_in, ws_size, out_size); grid = -1; return; }
        int dev = 0, cus = 0, per_cu = 0;
        if (hipGetDevice(&dev) != hipSuccess || hipDeviceGetAttribute(&cus, hipDeviceAttributeMultiprocessorCount, dev) != hipSuccess) { grid = -1; return; }
        if (hipFuncSetAttribute((const void*)mega_fwd, hipFuncAttributeMaxDynamicSharedMemorySize, LDS_BYTES) != hipSuccess) { fprintf(stderr, "kernel_launch: hipFuncSetAttribute failed\n"); grid = -1; return; }
        if (hipOccupancyMaxActiveBlocksPerMultiprocessor(&per_cu, (const void*)mega_fwd, NTHREADS, LDS_BYTES) != hipSuccess || per_cu < 1) { fprintf(stderr, "kernel_launch: occupancy query says %d\n", per_cu); per_cu = 1; }
        (void)hipGetLastError();
        if (cus < 256) { fprintf(stderr, "kernel_launch: built for a 256-CU device (got %d)\n", cus); grid = -1; return; }
        grid = 256;
    }
    if (grid < 0) return;
    (void)hipMemsetAsync((char*)d_ws + WS_CTL, 0, CTL_ZERO_BYTES, stream);
    Args a{};
    for (int i = 0; i < N_IN; ++i) a.in[i] = (const float*)d_in[i];
    a.out = (float*)d_out; a.ws = (unsigned char*)d_ws; a.ph_lo = 0; a.ph_hi = 1;
    void* args[] = {&a};
    hipError_t e = hipLaunchCooperativeKernel((const void*)mega_fwd, dim3(grid), dim3(NTHREADS), args, LDS_BYTES, stream);
    if (e != hipSuccess) fprintf(stderr, "cooperative launch failed: %s (grid %d)\n", hipGetErrorString(e), grid);
}
```

```cpp
#include <hip/hip_runtime.h>
#include <hip/hip_cooperative_groups.h>
#include <cstdio>
#include <cstdint>
namespace cg = cooperative_groups;

constexpr int D = 1024, DFF = 2816, INW = 2048;
constexpr int MCTX = 8192, MLAT = 16384, M = MCTX + MLAT;
constexpr int LCTX = 256, LLAT = 2048;
constexpr int NCOND = 9, MODW = 9 * 1024;
constexpr int ZW = 1280;
constexpr int HYC = 768;
constexpr float EPS = 1e-6f;
constexpr float LOG2E = 1.4426950408889634f;
constexpr float QSCALE = 0.125f * LOG2E;

enum { I_XP = 0, I_XS, I_C, I_CK, I_CV, I_CCTX, I_WMOD, I_BMOD, I_GF1, I_GMIX, I_GF2, I_GFIN, I_W1G, I_W1U, I_W1D, I_W2G, I_W2U, I_W2D, I_WIN, I_WOUT, I_SINK,
       I_CDW, I_CDWB, I_CLNG, I_CLNB, I_CPW, I_HSW, I_HSB, I_HW1, I_HB1, I_HF1, I_HW2, I_HB2, I_HF2, I_HW3, I_HLD, I_HBIAS, N_IN };

constexpr size_t MiB = 1u << 20;
constexpr size_t WS_CTL = 0, CTL_ZERO_BYTES = 2 * MiB;
constexpr size_t WS_SUMSQ = 64 * 1024;
constexpr size_t WS_MOD = 128 * 1024;
constexpr size_t WS_SS = 1 * MiB;
constexpr size_t WS_ROPE = 3 * MiB;
constexpr size_t WS_BIAS = 3 * MiB + 64 * 1024;
constexpr size_t WS_WGU = 4 * MiB;
constexpr size_t WS_WD = 48 * MiB;
constexpr size_t WS_WIN = 70 * MiB;
constexpr size_t WS_WOUT = 78 * MiB;
constexpr size_t WS_CKB = 82 * MiB;
constexpr size_t WS_CVT = 83 * MiB;
constexpr size_t WS_HYH = 84 * MiB;
constexpr size_t WS_HYRAW = 86 * MiB;
constexpr size_t WS_H = 96 * MiB;
constexpr size_t WS_BIG = 144 * MiB;
constexpr size_t WS_Z = WS_BIG;
constexpr size_t WS_ZT = 204 * MiB;
constexpr size_t WS_CAT = 276 * MiB;
constexpr size_t WS_END = 324 * MiB;
static_assert(WS_MOD + 2 * 9 * 9216 * 4 <= WS_SS && WS_SS + 7 * (size_t)M * 4 <= CTL_ZERO_BYTES && WS_BIAS + 2 * 9 * 13312 * 4 <= WS_WGU, "ctl");
static_assert(WS_BIG + (size_t)M * DFF * 2 <= WS_END && WS_Z + (size_t)M * ZW * 2 <= WS_ZT && WS_ZT + (size_t)896 * M * 2 <= WS_END, "ws map");
constexpr int CW_BAR = 4096;

constexpr int RING_BYTES = 131072;
constexpr int LDSCTL_OFF = 133120, MISC_OFF = LDSCTL_OFF + 320;
constexpr int LDS_BYTES = 135168;
constexpr int NWAVES = 8, NTHREADS = 512;

namespace pg8 {
#define PG8_LAS __attribute__((address_space(3)))
typedef unsigned short bf16_t;
typedef short bf16x8 __attribute__((ext_vector_type(8)));
typedef float f32x4 __attribute__((ext_vector_type(4)));
typedef unsigned u32x4 __attribute__((ext_vector_type(4)));
constexpr int BM = 256, BK = 64, HALF = 128, HTB = HALF * BK * 2  , STAGE_BYTES = 8 * HTB, NXCD = 8, WGM = 8;

__host__ __device__ __forceinline__ int lds_byte(int r, int c) { const int st = (r >> 4) * 2 + (c >> 5), rr = r & 15, cc = c & 31, ob = rr * 64 + cc * 2; return st * 1024 + (ob ^ (((ob >> 9) & 1) << 5)); }
__host__ __device__ __forceinline__ void stage_rc(int b, int& R, int& C) { const int st = b / 1024, sb = b % 1024, swz = sb ^ (((sb >> 9) & 1) << 5); R = (st >> 1) * 16 + swz / 64; C = (st & 1) * 32 + (swz % 64) / 2; }
__host__ __device__ __forceinline__ int perm32(int rho) { const int n = rho >> 4, i = rho & 15; return 8 * (i >> 2) + 4 * n + (i & 3); }

struct Unit { int pm, pn; };
struct Gemm { const bf16_t* A; const bf16_t* Bt; int M, N, K; };

struct StaticOrder {
    int nM, nN, nwg, G, c;
    __host__ __device__ void init(int M, int N, int G_, int c_) { nM = M / BM; nN = N / BM; nwg = nM * nN; G = G_; c = c_; }
    __host__ __device__ bool next(int i, Unit& u) const {
        const long L = (long)i * G + c; if (L >= nwg) return false;
        int wgid = (int)L; { const int q = nwg / NXCD, r = nwg % NXCD, xcd = wgid % NXCD, off = wgid / NXCD; wgid = (xcd < r ? xcd * (q + 1) : r * (q + 1) + (xcd - r) * q) + off; }
        const int nig = WGM * nN, gid = wgid / nig, fm = gid * WGM, gsz = (nM - fm) < WGM ? (nM - fm) : WGM;
        u.pm = fm + ((wgid % nig) % gsz); u.pn = (wgid % nig) / gsz; return true;
    }
    __device__ __forceinline__ void a_ready(const Unit&) const {}
    __device__ __forceinline__ void done(const Unit&) const {}
};


__device__ __forceinline__ unsigned cvt_pk_bf16(float lo, float hi) { unsigned r; asm volatile("v_cvt_pk_bf16_f32 %0, %1, %2" : "=v"(r) : "v"(lo), "v"(hi)); return r; }
__device__ __forceinline__ float silu_f(float x) { return x * __builtin_amdgcn_rcpf(1.0f + __builtin_amdgcn_exp2f(-1.4426950408889634f * x)); }
__device__ __forceinline__ int cond_of_tile(int pm) { return pm < 32 ? 0 : 1 + ((pm - 32) >> 3); }

__device__ __forceinline__ void st16_wt(void* p, u32x4 v) { asm volatile("global_store_dwordx4 %0, %1, off sc1\n\ts_nop 1" :: "v"(p), "v"(v) : "memory"); }
__device__ __forceinline__ void st16_wt(void* p, f32x4 v) { asm volatile("global_store_dwordx4 %0, %1, off sc1\n\ts_nop 1" :: "v"(p), "v"(v) : "memory"); }
__device__ __forceinline__ void st8_wt(void* p, unsigned lo, unsigned hi) { __hip_atomic_store((unsigned long long*)p, ((unsigned long long)hi << 32) | lo, __ATOMIC_RELAXED, __HIP_MEMORY_SCOPE_AGENT); }
struct EpiGU {
    static constexpr bool PERM = true, AFTER_DRAIN = false;
    bf16_t* O;
    const float* ss; const float* bias;
    __device__ __forceinline__ void operator()(const f32x4 (&acc)[2][2][4][2], const Unit& u, int wr, int wc, int fr, int fq) const {
        const int row0 = u.pm * BM + wr * 64 + fr, col0 = u.pn * HALF + wc * 32 + 8 * fq;
        const float* bp = bias + cond_of_tile(u.pm) * 5632 + u.pn * BM + wc * 32 + 8 * fq;
        const f32x4 bg0 = *(const f32x4*)bp, bg1 = *(const f32x4*)(bp + 4), bu0 = *(const f32x4*)(bp + HALF), bu1 = *(const f32x4*)(bp + HALF + 4);
        float rsv[2][4];
#pragma unroll
        for (int ai = 0; ai < 2; ++ai)
#pragma unroll
            for (int m = 0; m < 4; ++m) rsv[ai][m] = ss[row0 + ai * HALF + m * 16];
#pragma unroll
        for (int ai = 0; ai < 2; ++ai)
#pragma unroll
            for (int m = 0; m < 4; ++m) { const int row = row0 + ai * HALF + m * 16; bf16_t* rowp = O + (size_t)row * 2816 + col0;
                const float rs = __builtin_amdgcn_rsqf(rsv[ai][m] * (1.0f / 1024.0f) + 1e-6f);
                const f32x4 g0 = acc[ai][0][m][0] * rs + bg0, g1 = acc[ai][0][m][1] * rs + bg1, u0 = acc[ai][1][m][0] * rs + bu0, u1 = acc[ai][1][m][1] * rs + bu1;
                u32x4 w;
                w.x = cvt_pk_bf16(silu_f(g0[0]) * u0[0], silu_f(g0[1]) * u0[1]); w.y = cvt_pk_bf16(silu_f(g0[2]) * u0[2], silu_f(g0[3]) * u0[3]);
                w.z = cvt_pk_bf16(silu_f(g1[0]) * u1[0], silu_f(g1[1]) * u1[1]); w.w = cvt_pk_bf16(silu_f(g1[2]) * u1[2], silu_f(g1[3]) * u1[3]);
                st16_wt(rowp, w); }
    }
};
struct EpiRes {
    static constexpr bool PERM = false, AFTER_DRAIN = false;
    const float* in0; const float* in1; float* X; const float* gate;
    bf16_t* Hn; const float* gn; const float* scn; float* ssn; float scale;
    __device__ __forceinline__ void operator()(const f32x4 (&acc)[2][2][4][2], const Unit& u, int wr, int wc, int fr, int fq) const {
        const int cond = cond_of_tile(u.pm); const float* gp = gate + cond * 9216;
        const int col0 = u.pn * BM + wc * 32 + 4 * fq;
        f32x4 gv[2][2], gc[2][2];
        const bool ctx = u.pm < 32; const float* src = ctx ? in0 : in1; const int rbase = u.pm * BM - (ctx ? 0 : 8192);
        typedef unsigned u32x2 __attribute__((ext_vector_type(2)));
        { f32x4 nraw[2][2], sraw[2][2];
#pragma unroll
          for (int bj = 0; bj < 2; ++bj)
#pragma unroll
              for (int n = 0; n < 2; ++n) { gv[bj][n] = *(const f32x4*)(gp + col0 + bj * HALF + n * 16);
                  if (Hn) { nraw[bj][n] = *(const f32x4*)(gn + col0 + bj * HALF + n * 16); sraw[bj][n] = *(const f32x4*)(scn + cond * 9216 + col0 + bj * HALF + n * 16); } }
#pragma unroll
          for (int bj = 0; bj < 2; ++bj)
#pragma unroll
              for (int n = 0; n < 2; ++n) { gv[bj][n] = gv[bj][n] * scale; if (Hn) gc[bj][n] = nraw[bj][n] * (sraw[bj][n] + 1.0f); else gc[bj][n] = (f32x4){0.f, 0.f, 0.f, 0.f}; } }
        f32x4 xo[1][2][2][2];
#define EPIRES_LOAD(buf_, ag_) do { _Pragma("unroll") for (int mm = 0; mm < 2; ++mm) { const float* sp = src + (size_t)(rbase + ((ag_) >> 1) * HALF + wr * 64 + (((ag_) & 1) * 2 + mm) * 16 + fr) * 1024 + col0; \
            _Pragma("unroll") for (int bj = 0; bj < 2; ++bj) _Pragma("unroll") for (int n = 0; n < 2; ++n) xo[buf_][mm][bj][n] = *(const f32x4*)(sp + bj * HALF + n * 16); } } while (0)
#pragma unroll
        for (int ag = 0; ag < 4; ++ag) { const int ai = ag >> 1, m0 = (ag & 1) * 2;
            EPIRES_LOAD(0, ag);
#pragma unroll
            for (int mm = 0; mm < 2; ++mm) { const int m = m0 + mm; const int rl = ai * HALF + wr * 64 + m * 16 + fr;
                float* xp = X + (size_t)(u.pm * BM + rl) * 1024 + col0;
                float sq = 0.f;
#pragma unroll
                for (int bj = 0; bj < 2; ++bj)
#pragma unroll
                    for (int n = 0; n < 2; ++n) { const f32x4 xn = xo[0][mm][bj][n] + gv[bj][n] * acc[ai][bj][m][n];
                        st16_wt(xp + bj * HALF + n * 16, xn); sq += (xn[0] * xn[0] + xn[1] * xn[1]) + (xn[2] * xn[2] + xn[3] * xn[3]);
                        if (Hn) { const f32x4 hv = xn * gc[bj][n]; st8_wt(Hn + (size_t)(u.pm * BM + rl) * 1024 + col0 + bj * HALF + n * 16, cvt_pk_bf16(hv[0], hv[1]), cvt_pk_bf16(hv[2], hv[3])); } }
                sq += __shfl_xor(sq, 16); sq += __shfl_xor(sq, 32);
                if (fq == 0) atomicAdd(ssn + u.pm * BM + rl, sq); }
        }
#undef EPIRES_LOAD
    }
};
struct EpiIN {
    static constexpr bool PERM = false, AFTER_DRAIN = false;
    bf16_t* Z; bf16_t* ZT; float* newk; float* newv; const float* rope; const float* ss; const float* bias; int layer; float qscale;
    __device__ __forceinline__ void operator()(const f32x4 (&acc)[2][2][4][2], const Unit& u, int wr, int wc, int fr, int fq) const {
        const bool lat = u.pm >= 32;
        const int colb = u.pn * BM + wc * 32 + 4 * fq;
        const float* bp = bias + cond_of_tile(u.pm) * 2048 + colb;
        f32x4 bv[2][2];
#pragma unroll
        for (int bj = 0; bj < 2; ++bj)
#pragma unroll
            for (int n = 0; n < 2; ++n) bv[bj][n] = *(const f32x4*)(bp + bj * HALF + n * 16);
        const bool roped = lat && u.pn < 3;
        float rsv[2][4];
#pragma unroll
        for (int ai = 0; ai < 2; ++ai)
#pragma unroll
            for (int m = 0; m < 4; ++m) rsv[ai][m] = ss[u.pm * BM + ai * HALF + wr * 64 + m * 16 + fr];
#pragma unroll
        for (int ai = 0; ai < 2; ++ai) {
            f32x4 rc0[4], rc1[4];
#pragma unroll
            for (int m = 0; m < 4; ++m) { rc0[m] = (f32x4){1.f, 0.f, 1.f, 0.f}; rc1[m] = rc0[m];
                if (roped) { const int pos = (u.pm * BM + ai * HALF + wr * 64 + m * 16 + fr - 8192) & 2047; const int p = (wc & 1) ? (pos & 63) : (pos >> 6);
                    const f32x4* rp = (const f32x4*)(rope + (size_t)(p * 16 + 4 * fq) * 2); rc0[m] = rp[0]; rc1[m] = rp[1]; } }
#pragma unroll
            for (int m = 0; m < 4; ++m) { const int row = u.pm * BM + ai * HALF + wr * 64 + m * 16 + fr;
                const float rs = __builtin_amdgcn_rsqf(rsv[ai][m] * (1.0f / 1024.0f) + 1e-6f);
#pragma unroll
                for (int bj = 0; bj < 2; ++bj) { const int col = colb + bj * HALF;
                    f32x4 v0 = acc[ai][bj][m][0] * rs + bv[bj][0], v1 = acc[ai][bj][m][1] * rs + bv[bj][1];
                    if (u.pn < 5) {
                        const int cb = u.pn * BM + bj * HALF;
                        if (lat && cb < 640) {
                            const f32x4 cs0 = rc0[m], cs1 = rc1[m];
                            const float c0 = cs0[0], s0 = cs0[1], c1 = cs0[2], s1 = cs0[3], c2 = cs1[0], s2 = cs1[1], c3 = cs1[2], s3 = cs1[3];
                            const f32x4 a = v0, b = v1;
                            v0[0] = a[0] * c0 - b[0] * s0; v1[0] = b[0] * c0 + a[0] * s0;
                            v0[1] = a[1] * c1 - b[1] * s1; v1[1] = b[1] * c1 + a[1] * s1;
                            v0[2] = a[2] * c2 - b[2] * s2; v1[2] = b[2] * c2 + a[2] * s2;
                            v0[3] = a[3] * c3 - b[3] * s3; v1[3] = b[3] * c3 + a[3] * s3;
                        }
                        if (!lat && cb >= 512 && cb < 768) {
                            const int b = row >> 8, s = row & 255; float* dst = (cb < 640 ? newk : newv) + ((size_t)(b * 2 + layer) * 256 + s) * 128 + (col - cb);
                            *(f32x4*)dst = v0; *(f32x4*)(dst + 16) = v1;
                        }
                        if (cb < 512) { v0 = v0 * qscale; v1 = v1 * qscale; }
                        if (cb == 640) {
                            const int ch = 768 + col - 640;
#pragma unroll
                            for (int j = 0; j < 4; ++j) { ZT[(size_t)(ch + j) * 24576 + row] = (bf16_t)(cvt_pk_bf16(v0[j], 0.f) & 0xffffu); ZT[(size_t)(ch + 16 + j) * 24576 + row] = (bf16_t)(cvt_pk_bf16(v1[j], 0.f) & 0xffffu); }
                        } else {
                        bf16_t* zp = Z + (size_t)row * 1280 + col;
                        typedef unsigned u32x2 __attribute__((ext_vector_type(2)));
                        u32x2 w0, w1; w0.x = cvt_pk_bf16(v0[0], v0[1]); w0.y = cvt_pk_bf16(v0[2], v0[3]); w1.x = cvt_pk_bf16(v1[0], v1[1]); w1.y = cvt_pk_bf16(v1[2], v1[3]);
                        *(u32x2*)zp = w0; *(u32x2*)(zp + 16) = w1; }
                    } else {
                        const int ch = col - 1280;
#pragma unroll
                        for (int j = 0; j < 4; ++j) { ZT[(size_t)(ch + j) * 24576 + row] = (bf16_t)(cvt_pk_bf16(v0[j], 0.f) & 0xffffu); ZT[(size_t)(ch + 16 + j) * 24576 + row] = (bf16_t)(cvt_pk_bf16(v1[j], 0.f) & 0xffffu); }
                    }
                } }
        }
    }
};

template <class Epi, class Sched, bool ALIGN_EPI = false, bool SP2 = false>
__device__ __forceinline__ void gemm_phase(PG8_LAS unsigned char* lds, const Gemm g, const Sched S, const Epi E) {
    int tid_ = threadIdx.x; asm volatile("" : "+v"(tid_));
    const int tid = tid_, wid = __builtin_amdgcn_readfirstlane(tid >> 6), lane = tid & 63, wr = wid >> 2, wc = wid & 3, fr = lane & 15, fq = lane >> 4;
    const int K = g.K, nt = K / BK;
    unsigned voffA[2], voffB[2];
#pragma unroll
    for (int i = 0; i < 2; ++i) { int R, C; stage_rc(tid * 16 + i * 8192, R, C); const int Rb = Epi::PERM ? ((R & ~31) + perm32(R & 31)) : R;
        voffA[i] = (unsigned)(R * K + C) * 2u; voffB[i] = (unsigned)(Rb * K + C) * 2u; }
    const size_t kstep = (size_t)(BK * 2);
    const size_t hstep = (size_t)HALF * K * 2;
    const size_t tstep = 2 * hstep;
    const unsigned ldsw = (unsigned)wid * 1024u;
    const int aoff = lds_byte(wr * 64 + fr, fq * 8), boff = lds_byte(wc * 32 + fr, fq * 8);
#define PG8_SA(b, h) (((b) * 2 + (h)) * HTB)
#define PG8_SB(b, h) ((4 + (b) * 2 + (h)) * HTB)
#define PG8_STAGE(bufoff, gbase, voff) do { _Pragma("unroll") for (int _i = 0; _i < 2; ++_i) \
        __builtin_amdgcn_global_load_lds((const unsigned*)((const char*)(gbase) + (voff)[_i]), (PG8_LAS unsigned*)(lds + (bufoff) + ldsw + _i * 8192), 16, 0, 0); } while (0)
#define PG8_LDA(dst, b, h) do { _Pragma("unroll") for (int m = 0; m < 4; ++m) _Pragma("unroll") for (int k = 0; k < 2; ++k) dst[m][k] = *(const PG8_LAS bf16x8*)(lds + PG8_SA(b, h) + aoff + m * 2048 + k * 1024); } while (0)
#define PG8_LDB(dst, b, h) do { _Pragma("unroll") for (int n = 0; n < 2; ++n) _Pragma("unroll") for (int k = 0; k < 2; ++k) dst[n][k] = *(const PG8_LAS bf16x8*)(lds + PG8_SB(b, h) + boff + n * 2048 + k * 1024); } while (0)
#define PG8_MMA(ai, bj, At, Bt) do { __builtin_amdgcn_s_setprio(1); _Pragma("unroll") for (int m = 0; m < 4; ++m) _Pragma("unroll") for (int n = 0; n < 2; ++n) _Pragma("unroll") for (int k = 0; k < 2; ++k) \
        acc[ai][bj][m][n] = __builtin_amdgcn_mfma_f32_16x16x32_bf16(Bt[n][k], At[m][k], acc[ai][bj][m][n], 0, 0, 0); __builtin_amdgcn_s_setprio(0); } while (0)
#define PG8_WAIT_V(n) asm volatile("s_waitcnt vmcnt(" #n ")" ::: "memory")
#define PG8_WAIT_L(n) asm volatile("s_waitcnt lgkmcnt(" #n ")" ::: "memory")
#define PG8_BAR __builtin_amdgcn_s_barrier()
#define PG8_SCHED __builtin_amdgcn_sched_barrier(0)
    Unit cur, nxt; int ui = 0;
    if (!S.next(0, cur)) return;
    f32x4 acc[2][2][4][2];
#pragma unroll
    for (int a = 0; a < 2; ++a)
#pragma unroll
        for (int b = 0; b < 2; ++b)
#pragma unroll
            for (int m = 0; m < 4; ++m)
#pragma unroll
                for (int n = 0; n < 2; ++n) acc[a][b][m][n] = (f32x4){0.f, 0.f, 0.f, 0.f};
    bf16x8 At[4][2], B0[2][2], B1[2][2];
    const char* cA = (const char*)g.A + (size_t)cur.pm * tstep; const char* cB = (const char*)g.Bt + (size_t)cur.pn * tstep;
    S.a_ready(cur);
    if constexpr (SP2) {
        PG8_STAGE(PG8_SB(0, 0), cB, voffB); PG8_STAGE(PG8_SB(0, 1), cB + hstep, voffB); PG8_STAGE(PG8_SA(0, 0), cA, voffA); PG8_STAGE(PG8_SA(0, 1), cA + hstep, voffA);
        if (wr == 1) PG8_BAR;
        PG8_WAIT_V(2); PG8_BAR;
        PG8_STAGE(PG8_SB(1, 0), cB + kstep, voffB); PG8_STAGE(PG8_SA(1, 0), cA + kstep, voffA); PG8_STAGE(PG8_SB(1, 1), cB + hstep + kstep, voffB);
        PG8_WAIT_V(6); PG8_BAR;
    } else {
        PG8_STAGE(PG8_SB(0, 0), cB, voffB); PG8_STAGE(PG8_SA(0, 0), cA, voffA); PG8_STAGE(PG8_SB(0, 1), cB + hstep, voffB); PG8_STAGE(PG8_SA(0, 1), cA + hstep, voffA);
        if (wr == 1) PG8_BAR;
        PG8_WAIT_V(4); PG8_BAR;
        PG8_STAGE(PG8_SB(1, 0), cB + kstep, voffB); PG8_STAGE(PG8_SA(1, 0), cA + kstep, voffA); PG8_STAGE(PG8_SB(1, 1), cB + hstep + kstep, voffB);
        PG8_WAIT_V(6); PG8_BAR;
    }
    for (;;) {
        const bool has_next = S.next(ui + 1, nxt);
        const char* nA = has_next ? (const char*)g.A + (size_t)nxt.pm * tstep : cA; const char* nB = has_next ? (const char*)g.Bt + (size_t)nxt.pn * tstep : cB;
        for (int t = 0; t < nt; t += 2) {
            const bool last = (t == nt - 2);
            const char* a1 = cA + (size_t)(t + 1) * kstep;
            const char* a2 = last ? nA : cA + (size_t)(t + 2) * kstep; const char* b2 = last ? nB : cB + (size_t)(t + 2) * kstep;
            const char* a3 = a2 + kstep; const char* b3 = b2 + kstep;
            if (last && has_next) S.a_ready(nxt);
            if constexpr (SP2) {
            PG8_LDB(B0, 0, 0); PG8_LDB(B1, 0, 1); PG8_SCHED; PG8_LDA(At, 0, 0); PG8_STAGE(PG8_SA(1, 1), a1 + hstep, voffA);
            PG8_WAIT_V(8); PG8_WAIT_L(0); PG8_BAR; PG8_MMA(0, 0, At, B0); PG8_MMA(0, 1, At, B1); PG8_BAR; PG8_SCHED;
            PG8_LDA(At, 0, 1); PG8_STAGE(PG8_SB(0, 0), b2, voffB); PG8_STAGE(PG8_SB(0, 1), b2 + hstep, voffB); PG8_STAGE(PG8_SA(0, 0), a2, voffA);
            PG8_WAIT_V(8); PG8_WAIT_L(0); PG8_BAR; PG8_MMA(1, 0, At, B0); PG8_MMA(1, 1, At, B1); PG8_BAR; PG8_SCHED;
            PG8_LDB(B0, 1, 0); PG8_LDB(B1, 1, 1); PG8_SCHED; PG8_LDA(At, 1, 0); PG8_STAGE(PG8_SA(0, 1), a2 + hstep, voffA);
            PG8_WAIT_V(8); PG8_WAIT_L(0); PG8_BAR; PG8_MMA(0, 0, At, B0); PG8_MMA(0, 1, At, B1); PG8_BAR; PG8_SCHED;
            PG8_LDA(At, 1, 1); PG8_STAGE(PG8_SB(1, 0), b3, voffB); PG8_STAGE(PG8_SB(1, 1), b3 + hstep, voffB); PG8_STAGE(PG8_SA(1, 0), a3, voffA);
            PG8_WAIT_V(8); PG8_WAIT_L(0); PG8_BAR; PG8_MMA(1, 0, At, B0); PG8_MMA(1, 1, At, B1); PG8_BAR; PG8_SCHED;
            } else {
            PG8_LDB(B0, 0, 0); PG8_SCHED; PG8_LDA(At, 0, 0); PG8_STAGE(PG8_SA(1, 1), a1 + hstep, voffA);
            PG8_WAIT_L(8); PG8_BAR; PG8_WAIT_L(0); PG8_MMA(0, 0, At, B0); PG8_BAR; PG8_SCHED;
            PG8_LDB(B1, 0, 1); PG8_STAGE(PG8_SB(0, 0), b2, voffB);
            PG8_BAR; PG8_WAIT_L(0); PG8_MMA(0, 1, At, B1); PG8_BAR;
            PG8_LDA(At, 0, 1); PG8_STAGE(PG8_SA(0, 0), a2, voffA);
            PG8_BAR; PG8_WAIT_L(0); PG8_MMA(1, 0, At, B0); PG8_BAR; PG8_SCHED;
            PG8_STAGE(PG8_SB(0, 1), b2 + hstep, voffB);
            PG8_WAIT_V(6); PG8_BAR; PG8_MMA(1, 1, At, B1); PG8_BAR;
            PG8_LDB(B0, 1, 0); PG8_SCHED; PG8_LDA(At, 1, 0); PG8_STAGE(PG8_SA(0, 1), a2 + hstep, voffA);
            PG8_WAIT_L(8); PG8_BAR; PG8_WAIT_L(0); PG8_MMA(0, 0, At, B0); PG8_BAR; PG8_SCHED;
            PG8_LDB(B1, 1, 1); PG8_STAGE(PG8_SB(1, 0), b3, voffB);
            PG8_BAR; PG8_WAIT_L(0); PG8_MMA(0, 1, At, B1); PG8_BAR;
            PG8_LDA(At, 1, 1); PG8_STAGE(PG8_SA(1, 0), a3, voffA);
            PG8_BAR; PG8_WAIT_L(0); PG8_MMA(1, 0, At, B0); PG8_BAR; PG8_SCHED;
            PG8_STAGE(PG8_SB(1, 1), b3 + hstep, voffB);
            PG8_WAIT_V(6); PG8_BAR; PG8_MMA(1, 1, At, B1); PG8_BAR;
            }
        }
        if constexpr (ALIGN_EPI) { if (wr == 0) PG8_BAR; }
        if constexpr (!Epi::AFTER_DRAIN) { E(acc, cur, wr, wc, fr, fq); S.done(cur); }
        if (!has_next) break;
#pragma unroll
        for (int a = 0; a < 2; ++a)
#pragma unroll
            for (int b = 0; b < 2; ++b)
#pragma unroll
                for (int m = 0; m < 4; ++m)
#pragma unroll
                    for (int n = 0; n < 2; ++n) acc[a][b][m][n] = (f32x4){0.f, 0.f, 0.f, 0.f};
        cur = nxt; cA = nA; cB = nB; ++ui;
        if constexpr (ALIGN_EPI) { if (wr == 1) PG8_BAR; }
    }
    PG8_WAIT_V(0);
    if constexpr (!ALIGN_EPI) { if (wr == 0) PG8_BAR; }
    PG8_BAR;
    if constexpr (Epi::AFTER_DRAIN) { E.fused(acc, cur, wr, wc, fr, fq, lds, wid, lane); S.done(cur); }
#undef PG8_SA
#undef PG8_SB
#undef PG8_STAGE
#undef PG8_LDA
#undef PG8_LDB
#undef PG8_MMA
#undef PG8_WAIT_V
#undef PG8_WAIT_L
#undef PG8_BAR
#undef PG8_SCHED
}
}

#define GAS __attribute__((address_space(1)))
#define LAS __attribute__((address_space(3)))
typedef unsigned short bf16;
typedef unsigned v4u __attribute__((ext_vector_type(4)));
typedef unsigned v2u __attribute__((ext_vector_type(2)));
typedef float f32x4 __attribute__((ext_vector_type(4)));
typedef short bf16x8 __attribute__((ext_vector_type(8)));
typedef GAS unsigned gu32;
#define RLX_AGENT __ATOMIC_RELAXED, __HIP_MEMORY_SCOPE_AGENT
#define LDS_WAIT() asm volatile("s_waitcnt lgkmcnt(0)" ::: "memory")
#define VM_WAIT() asm volatile("s_waitcnt vmcnt(0)" ::: "memory")
__device__ __forceinline__ unsigned f2bf(float f) { unsigned u = __builtin_bit_cast(unsigned, f); return (u + 0x7fffu + ((u >> 16) & 1u)) >> 16; }
__device__ __forceinline__ unsigned pk2(float lo, float hi) { return f2bf(lo) | (f2bf(hi) << 16); }
__device__ __forceinline__ float bf2f(unsigned h) { return __builtin_bit_cast(float, h << 16); }
__device__ __forceinline__ float bflo(unsigned w) { return __builtin_bit_cast(float, w << 16); }
__device__ __forceinline__ float bfhi(unsigned w) { return __builtin_bit_cast(float, w & 0xffff0000u); }
__device__ __forceinline__ float wave_sum(float v) {
#define WS_DPP(ctrl, rmask) v += __builtin_bit_cast(float, __builtin_amdgcn_update_dpp(0, __builtin_bit_cast(int, v), ctrl, rmask, 0xf, false))
    WS_DPP(0xB1, 0xf); WS_DPP(0x4E, 0xf); WS_DPP(0x141, 0xf); WS_DPP(0x140, 0xf); WS_DPP(0x142, 0xa); WS_DPP(0x143, 0xc);
#undef WS_DPP
    return __builtin_bit_cast(float, __builtin_amdgcn_readlane(__builtin_bit_cast(int, v), 63));
}
__device__ __forceinline__ float silu_acc(float x) { return x / (1.0f + __expf(-x)); }

#define XB_TMO      128
#define XB_XCNT(j)  (256  + 64 * (j))
#define XB_XSUB(j)  (1280 + 64 * (j))
#define XB_XGEN(j)  (2304 + 64 * (j))
#define XB_TOP      3328
#define XB_TOPGEN   3392
#define XCD_BAR_WORDS 3456
#define XB_SPIN_CAP (1u << 18)
__device__ __forceinline__ unsigned xb_ld(unsigned* p)              { return __hip_atomic_load(p, __ATOMIC_RELAXED, __HIP_MEMORY_SCOPE_AGENT); }
__device__ __forceinline__ unsigned xb_add(unsigned* p, unsigned v) { return __hip_atomic_fetch_add(p, v, __ATOMIC_RELAXED, __HIP_MEMORY_SCOPE_AGENT); }
__device__ __forceinline__ unsigned xb_xcc_id() { return (unsigned)__builtin_amdgcn_s_getreg((3 << 11) | 20) & 0xFu; }
#define XB_SPIN(cond, bar) do { unsigned _sp = 0; while (cond) { __builtin_amdgcn_s_sleep(1); \
    if ((++_sp & 255u) == 0u) { if (xb_ld(&(bar)[XB_TMO])) break; if (_sp > XB_SPIN_CAP) { atomicAdd(&(bar)[XB_TMO], 1u); break; } } } } while (0)
struct XcdBarrier { unsigned* bar; unsigned x; volatile LAS unsigned* st; };
__device__ __forceinline__ XcdBarrier xcd_barrier_post(unsigned* bar, volatile LAS unsigned* st) {
    XcdBarrier b; b.bar = bar; b.x = xb_xcc_id(); b.st = st;
    if (threadIdx.x == 0) (void)xb_add(&bar[XB_XCNT(b.x)], 1u);
    return b;
}
__device__ __forceinline__ void xcd_barrier_complete(unsigned* bar, unsigned x, unsigned& nloc, unsigned& nx) {
    const unsigned G = gridDim.x * gridDim.y * gridDim.z;
    unsigned sum, cnt, mine, sp = 0u;
    for (;;) {
        sum = 0u; cnt = 0u; mine = 0u;
#pragma unroll
        for (unsigned j = 0; j < 16; ++j) { const unsigned c = xb_ld(&bar[XB_XCNT(j)]); sum += c; cnt += (c > 0u) ? 1u : 0u; mine = (j == x) ? c : mine; }
        if (sum == G) break;
        __builtin_amdgcn_s_sleep(1);
        if ((++sp & 255u) == 0u) { if (xb_ld(&bar[XB_TMO])) break; if (sp > XB_SPIN_CAP) { atomicAdd(&bar[XB_TMO], 1u); break; } }
    }
    nloc = mine > 0u ? mine : 1u; nx = cnt > 0u ? cnt : 1u;
}
__device__ __forceinline__ void xcd_barrier(const XcdBarrier& b) {
    asm volatile("s_waitcnt vmcnt(0)" ::: "memory");
    __syncthreads();
    if (threadIdx.x == 0) {
        unsigned* bar = b.bar;
        __builtin_amdgcn_s_waitcnt(0);
        unsigned nloc = b.st[0], nx = b.st[1];
        if (nloc == 0u) { xcd_barrier_complete(bar, b.x, nloc, nx); b.st[0] = nloc; b.st[1] = nx; }
        const unsigned old = xb_add(&bar[XB_XSUB(b.x)], 1u);
        const unsigned gen = old / nloc;
        if (old + 1u == (gen + 1u) * nloc) {
            __builtin_amdgcn_fence(__ATOMIC_RELEASE, "agent");
            asm volatile("s_waitcnt vmcnt(0)" ::: "memory");
            const unsigned og = xb_add(&bar[XB_TOP], 1u);
            const unsigned tg = og / nx;
            if (og + 1u == (tg + 1u) * nx) xb_add(&bar[XB_TOPGEN], 1u);
            else XB_SPIN(xb_ld(&bar[XB_TOPGEN]) == tg, bar);
            __builtin_amdgcn_fence(__ATOMIC_ACQUIRE, "agent");
            xb_add(&bar[XB_XGEN(b.x)], 1u);
            asm volatile("s_waitcnt vmcnt(0)" ::: "memory");
        } else {
            XB_SPIN(xb_ld(&bar[XB_XGEN(b.x)]) == gen, bar);
            __builtin_amdgcn_fence(__ATOMIC_ACQUIRE, "agent");
            asm volatile("s_waitcnt vmcnt(0)" ::: "memory");
        }
    }
    __syncthreads();
}

struct Args { const float* in[N_IN]; float* out; unsigned char* ws; int ph_lo, ph_hi; };

struct TrItem { const float* src; bf16* dst; int N, Kd; };
__device__ __forceinline__ TrItem tr_make(const float* W, int N, bf16* WT, int Kd, int kb, int nb, int mode) {
    const int k0 = 64 * kb, n0 = 32 * nb; const int drow0 = mode == 0 ? n0 : ((n0 >> 7) * 256 + (n0 & 127) + (mode == 2 ? 128 : 0));
    TrItem t; t.src = W + (size_t)k0 * N + n0; t.dst = WT + (size_t)drow0 * Kd + k0; t.N = N; t.Kd = Kd; return t;
}
__device__ __forceinline__ void tr_load(const TrItem& t, float (&tv)[32], int lane) {
#pragma unroll
    for (int i = 0; i < 32; ++i) tv[i] = t.src[(size_t)(2 * i + (lane >> 5)) * t.N + (lane & 31)];
}
__device__ __forceinline__ void tr_finish(const TrItem& t, const float (&tv)[32], LAS float* scr, int lane) {
#pragma unroll
    for (int i = 0; i < 32; ++i) scr[(2 * i + (lane >> 5)) * 33 + (lane & 31)] = tv[i];
    LDS_WAIT(); asm volatile("" ::: "memory");
    const int c = lane & 7;
#pragma unroll
    for (int j = 0; j < 4; ++j) { const int n = (lane >> 3) + 8 * j; const LAS float* s = scr + (8 * c) * 33 + n;
        v4u o; o.x = pk2(s[0 * 33], s[1 * 33]); o.y = pk2(s[2 * 33], s[3 * 33]); o.z = pk2(s[4 * 33], s[5 * 33]); o.w = pk2(s[6 * 33], s[7 * 33]);
        *(v4u*)(t.dst + (size_t)n * t.Kd + 8 * c) = o; }
    LDS_WAIT(); asm volatile("" ::: "memory");
}

__device__ __forceinline__ void p0_prologue(const Args& a, LAS unsigned char* lds, int gw, int NGW, int wave, int lane, const bool with_j3) {
    unsigned char* ws = a.ws;
    LAS float* scr = (LAS float*)(lds + wave * 16384);
    constexpr int I_G = 16 * 88, I_D = 44 * 32, I_FF = 3 * I_G, I_IN = 16 * 64, I_OUT = 12 * 32, I_L = 2 * I_FF + I_IN + I_OUT;
    static_assert(I_G == I_D, "items");
    auto j1_item = [&](int it) __attribute__((always_inline)) -> TrItem {
        const int l = it / I_L; int r = it % I_L;
        if (r < 2 * I_FF) {
            const int f = r / I_FF; r %= I_FF; const int part = r / I_G; r %= I_G;
            const size_t lo = (size_t)l * 1024 * 2816;
            if (part == 0)      return tr_make(a.in[f ? I_W2G : I_W1G] + lo, 2816, (bf16*)(ws + WS_WGU) + (size_t)(l * 2 + f) * 5632 * 1024, 1024, r / 88, r % 88, 1);
            else if (part == 1) return tr_make(a.in[f ? I_W2U : I_W1U] + lo, 2816, (bf16*)(ws + WS_WGU) + (size_t)(l * 2 + f) * 5632 * 1024, 1024, r / 88, r % 88, 2);
            else                return tr_make(a.in[f ? I_W2D : I_W1D] + lo, 1024, (bf16*)(ws + WS_WD) + (size_t)(l * 2 + f) * 1024 * 2816, 2816, r / 32, r % 32, 0);
        }
        r -= 2 * I_FF;
        if (r < I_IN) return tr_make(a.in[I_WIN] + (size_t)l * 1024 * 2048, 2048, (bf16*)(ws + WS_WIN) + (size_t)l * 2048 * 1024, 1024, r / 64, r % 64, 0);
        r -= I_IN; int kb = r / 32; if (kb >= 8) kb += 4;
        return tr_make(a.in[I_WOUT] + (size_t)l * 1024 * 1024, 1024, (bf16*)(ws + WS_WOUT) + (size_t)l * 1024 * 1024, 1024, kb, r % 32, 0);
    };
    const bool lowv = (NGW == 2048) && gw < 1152; const bool split = (NGW == 2048);
    const int j_lo = split ? (lowv ? 0 : 9216) : 0, j_hi = split ? (lowv ? 9216 : 2 * I_L) : 2 * I_L, j_gw = split ? (lowv ? gw : gw - 1152) : gw, j_st = split ? (lowv ? 1152 : 896) : NGW;
    if (j_lo + j_gw < j_hi) {
        TrItem cur = j1_item(j_lo + j_gw); float tv[32]; tr_load(cur, tv, lane);
        for (int it = j_lo + j_gw; it < j_hi; it += j_st) {
            const bool more = it + j_st < j_hi;
            TrItem nxt = cur; float tn[32];
            if (more) { nxt = j1_item(it + j_st); tr_load(nxt, tn, lane); }
            tr_finish(cur, tv, scr, lane);
            if (more) { cur = nxt;
#pragma unroll
                for (int i = 0; i < 32; ++i) tv[i] = tn[i]; }
        }
    }
    for (int it = gw; it < 2 * 256 * 4; it += NGW) {
        const int l = it >> 10, kp = (it >> 2) & 255, nc = it & 3;
        const float* pw = a.in[I_CPW] + (size_t)l * 65536 + kp * 256;
        const float* wo = a.in[I_WOUT] + (size_t)l * 1048576 + (size_t)512 * 1024 + nc * 256 + lane * 4;
        f32x4 acc = {0.f, 0.f, 0.f, 0.f};
#pragma unroll 8
        for (int j = 0; j < 256; ++j) acc += pw[j] * *(const f32x4*)(wo + (size_t)j * 1024);
        bf16* dst = (bf16*)(ws + WS_WOUT) + (size_t)l * 1048576 + (size_t)(nc * 256 + lane * 4) * 1024 + 512 + kp;
        dst[0] = (bf16)f2bf(acc[0]); dst[1024] = (bf16)f2bf(acc[1]); dst[2048] = (bf16)f2bf(acc[2]); dst[3072] = (bf16)f2bf(acc[3]);
    }
    if (with_j3) {
        LAS float* sl = (LAS float*)(lds + wave * 16384);
        for (int it = gw; it < 2 * 36 * 16; it += NGW) {
            const int l = it / 576, r = it % 576, nch = r >> 4, ks = r & 15;
            const int n = nch * 256 + lane * 4;
            const float* wm = a.in[I_WMOD] + (size_t)l * 1024 * 9216 + (size_t)(ks * 64) * 9216 + n;
            sl[lane] = silu_acc(a.in[I_CCTX][ks * 64 + lane]);
#pragma unroll
            for (int c = 1; c < 9; ++c) sl[c * 64 + lane] = silu_acc(a.in[I_C][(c - 1) * 1024 + ks * 64 + lane]);
            LDS_WAIT(); asm volatile("" ::: "memory");
            f32x4 acc[9];
#pragma unroll
            for (int c = 0; c < 9; ++c) acc[c] = (f32x4){0.f, 0.f, 0.f, 0.f};
#pragma unroll 1
            for (int kb = 0; kb < 4; ++kb) {
                f32x4 w[16];
#pragma unroll
                for (int k = 0; k < 16; ++k) w[k] = *(const f32x4*)(wm + (size_t)(kb * 16 + k) * 9216);
#pragma unroll
                for (int k = 0; k < 16; ++k)
#pragma unroll
                    for (int c = 0; c < 9; ++c) acc[c] += sl[c * 64 + kb * 16 + k] * w[k];
            }
            float* mod = (float*)(ws + WS_MOD) + (size_t)l * 9 * 9216 + n;
            f32x4 bm = {0.f, 0.f, 0.f, 0.f}; if (ks == 0) bm = *(const f32x4*)(a.in[I_BMOD] + l * 9216 + n);
#pragma unroll
            for (int c = 0; c < 9; ++c)
#pragma unroll
                for (int j = 0; j < 4; ++j) atomicAdd(mod + c * 9216 + j, acc[c][j] + bm[j]);
            LDS_WAIT(); asm volatile("" ::: "memory");
        }
    }
    {
        const int gt = gw * 64 + lane, NGT = NGW * 64;
        for (int e = gt; e < 2 * 8 * 256 * 128; e += NGT) {
            const int gd = e & 127, p = (e >> 7) & 255, b = (e >> 15) & 7, l = e >> 18;
            const size_t src = (((size_t)b * 2 + l) * 256 + p) * 128 + gd;
            const float kv = a.in[I_CK][src], vv = a.in[I_CV][src];
            ((bf16*)(ws + WS_CKB))[e] = (bf16)f2bf(kv);
            ((bf16*)(ws + WS_CVT))[(((size_t)l * 8 + b) * 128 + gd) * 256 + p] = (bf16)f2bf(vv);
        }
        for (int e = gt; e < 1024; e += NGT) { const int p = e >> 4, i = e & 15; const float inv = powf(10000.0f, -(float)i / 16.0f); const float ang = (float)p * inv;
            ((float*)(ws + WS_ROPE))[2 * e] = cosf(ang); ((float*)(ws + WS_ROPE))[2 * e + 1] = sinf(ang); }
    }
    for (int it = gw; it < 2 * 2304; it += NGW) {
        const int l = it / 2304, tt = it % 2304; const int L = tt < 2048 ? 2048 : 256, t = tt < 2048 ? tt : tt - 2048;
        const float tf = (float)t, tn = tf / (float)(L - 1);
        const float* w1 = a.in[I_HW1] + l * 33 * 64; const float* w2 = a.in[I_HW2] + l * 64 * 64;
        float s1 = tn * w1[lane];
#pragma unroll 4
        for (int i = 0; i < 16; ++i) { const float band = 1e-4f + (float)i * ((15.0f - 1e-4f) / 15.0f); const float ang = (6.283185307179586f * tf) * band / (float)L;
            s1 += cosf(ang) * w1[(1 + i) * 64 + lane] - sinf(ang) * w1[(17 + i) * 64 + lane]; }
        const float h1 = sinf(a.in[I_HF1][l * 64 + lane] * (s1 + a.in[I_HB1][l * 64 + lane]));
        float s2 = 0.f;
#pragma unroll 8
        for (int k = 0; k < 64; ++k) s2 += __shfl(h1, k) * w2[k * 64 + lane];
        const float h2 = sinf(a.in[I_HF2][l * 64 + lane] * (s2 + a.in[I_HB2][l * 64 + lane]));
        ((float*)(ws + WS_HYH))[(size_t)it * 64 + lane] = h2;
    }
}

__device__ __forceinline__ void prep_phase(const float* src0, const float* src1, const float* g, const float* mod, int sc_chunk, bf16* H, float* ss, int r_lo, int r_hi, int gw, int NGW, int lane) {
    const int per = (r_hi - r_lo + NGW - 1) / NGW; int r = r_lo + gw * per; r_hi = (r + per < r_hi) ? r + per : r_hi; NGW = 1;
    if (r >= r_hi) return;
    f32x4 v[4], v1[4], v2[4];
#define PREP_LOAD(dst, row) do { const int rr_ = (row); if (rr_ < r_hi) { const float* xr_ = rr_ < MCTX ? src0 + (size_t)rr_ * D : src1 + (size_t)(rr_ - MCTX) * D; \
        _Pragma("unroll") for (int j = 0; j < 4; ++j) dst[j] = ((const f32x4*)xr_)[lane + 64 * j]; } } while (0)
    PREP_LOAD(v, r); PREP_LOAD(v1, r + NGW);
    for (; r < r_hi; r += NGW) {
        PREP_LOAD(v2, r + 2 * NGW);
        const int cond = r < MCTX ? 0 : 1 + ((r - MCTX) >> 11);
        const float* sc = mod + cond * 9216 + sc_chunk * 1024;
        float s = 0.f;
#pragma unroll
        for (int j = 0; j < 4; ++j) s += (v[j][0] * v[j][0] + v[j][1] * v[j][1]) + (v[j][2] * v[j][2] + v[j][3] * v[j][3]);
        s = wave_sum(s); if (lane == 0) ss[r] = s;
#pragma unroll
        for (int j = 0; j < 4; ++j) { const int col = 4 * (lane + 64 * j);
            const f32x4 o = v[j] * *(const f32x4*)(g + col) * (*(const f32x4*)(sc + col) + 1.0f);
            v2u w; w.x = pk2(o[0], o[1]); w.y = pk2(o[2], o[3]); *(v2u*)(H + (size_t)r * D + col) = w; }
#pragma unroll
        for (int j = 0; j < 4; ++j) { v[j] = v1[j]; v1[j] = v2[j]; }
    }
#undef PREP_LOAD
}
__device__ __forceinline__ void bias_phase(const Args& a, int it_lo, int it_hi, int gw, int NGW, int lane) {
    unsigned char* ws = a.ws;
    const int i = lane & 15, q = lane >> 4;
    for (int it = it_lo + gw; it < it_hi; it += NGW) {
        const int l = it / 832; int r = it % 832; int which, n0;
        if (r < 352) { which = 0; n0 = r * 16; } else if (r < 480) { which = 1; n0 = (r - 352) * 16; } else { which = 2; n0 = (r - 480) * 16; }
        const bf16* Wt = which == 1 ? (const bf16*)(ws + WS_WIN) + (size_t)l * 2048 * 1024 : (const bf16*)(ws + WS_WGU) + (size_t)(l * 2 + (which == 2 ? 1 : 0)) * 5632 * 1024;
        const int shc = which == 0 ? 0 : (which == 1 ? 3 : 6), off = which == 0 ? 0 : (which == 1 ? 50688 : 69120), bst = which == 1 ? 2048 : 5632;
        const float* shp = (const float*)(ws + WS_MOD) + (size_t)l * 9 * 9216 + (size_t)(i < 9 ? i : 0) * 9216 + shc * 1024 + 8 * q;
        const bf16* wp = Wt + (size_t)(n0 + i) * 1024 + 8 * q;
        f32x4 acc = {0.f, 0.f, 0.f, 0.f};
#pragma unroll 8
        for (int st = 0; st < 32; ++st) {
            const f32x4 s0 = *(const f32x4*)(shp + 32 * st), s1 = *(const f32x4*)(shp + 32 * st + 4);
            const v4u wv = *(const v4u*)(wp + 32 * st);
            v4u av; av.x = pk2(s0[0], s0[1]); av.y = pk2(s0[2], s0[3]); av.z = pk2(s1[0], s1[1]); av.w = pk2(s1[2], s1[3]);
            if (i >= 9) av = (v4u){0u, 0u, 0u, 0u};
            acc = __builtin_amdgcn_mfma_f32_16x16x32_bf16(__builtin_bit_cast(bf16x8, av), __builtin_bit_cast(bf16x8, wv), acc, 0, 0, 0);
        }
        float* bo = (float*)(ws + WS_BIAS) + (size_t)l * 119808 + off + n0 + i;
#pragma unroll
        for (int rg = 0; rg < 4; ++rg) { const int cond = 4 * q + rg; if (cond < 9) bo[(size_t)cond * bst] = acc[rg]; }
    }
}
__device__ __forceinline__ void final_norm_phase(float* X, const float* g, const float* ss, int gw, int NGW, int lane) {
    for (int r = gw; r < M; r += NGW) {
        float* xr = X + (size_t)r * D;
        const float rstd = 1.0f / sqrtf(ss[r] * (1.0f / D) + EPS);
#pragma unroll
        for (int j = 0; j < 4; ++j) { const int col = 4 * (lane + 64 * j); ((f32x4*)xr)[lane + 64 * j] = (((const f32x4*)xr)[lane + 64 * j] * rstd) * *(const f32x4*)(g + col); }
    }
}

__device__ __forceinline__ void hyena_filter_phase(const Args& a, LAS unsigned char* lds, int gw, int NGW, int wave, int lane) {
    unsigned char* ws = a.ws;
    LAS float* hs = (LAS float*)(lds + wave * 16384);
    for (int it = gw; it < 2 * 36 * 16; it += NGW) {
        const int l = it / 576, r = it % 576, tc = r >> 4, ng = r & 15;
        const int stream = tc < 32 ? 0 : 1; const int L = stream ? 256 : 2048; const int t0 = (stream ? tc - 32 : tc) * 64; const int soff = stream ? 4096 : 0;
        const int n = ng * 64 + lane, o = n >> 9, dir = (n >> 8) & 1, c = n & 255;
        const float* hrow = (const float*)(ws + WS_HYH) + ((size_t)l * 2304 + (stream ? 2048 : 0) + t0) * 64;
        f32x4 hv[16];
#pragma unroll
        for (int i = 0; i < 16; ++i) hv[i] = ((const f32x4*)hrow)[i * 64 + lane];
        const float* w3 = a.in[I_HW3] + (size_t)l * 64 * 1024 + n;
        float w[64];
#pragma unroll
        for (int k = 0; k < 64; ++k) w[k] = w3[k * 1024];
        const float ndecay = -__expf(a.in[I_HLD][l * 1024 + n]) / (float)(L - 1);
#pragma unroll
        for (int i = 0; i < 16; ++i) *(LAS f32x4*)(hs + (i * 64 + lane) * 4) = hv[i];
        LDS_WAIT(); asm volatile("" ::: "memory");
        bf16* dst = (bf16*)(ws + WS_HYRAW) + ((size_t)(l * 2 + o) * 256 + c) * 4608 + soff;
        float sq = 0.f;
        for (int tt = 0; tt < 64; ++tt) {
            const int t = t0 + tt; float dot = 0.f;
#pragma unroll
            for (int k4 = 0; k4 < 16; ++k4) { const f32x4 h = *(const LAS f32x4*)(hs + tt * 64 + k4 * 4); dot += (h[0] * w[4 * k4] + h[1] * w[4 * k4 + 1]) + (h[2] * w[4 * k4 + 2] + h[3] * w[4 * k4 + 3]); }
            const float val = dot * __expf((float)t * ndecay);
            sq += val * val;
            if (dir == 0) dst[L - 1 - t] = (bf16)f2bf(val);
            else if (t > 0) dst[L - 1 + t] = (bf16)f2bf(val);
            else dst[2 * L - 1] = 0;
        }
        atomicAdd((float*)(ws + WS_SUMSQ) + ((l * 2 + stream) * 2 + o) * 256 + c, sq);
        LDS_WAIT(); asm volatile("" ::: "memory");
    }
}

__device__ __forceinline__ void conv_phase(const Args& a, int l, const bf16* Z, bf16* CAT, LAS unsigned char* lds, int tid) {
    LAS float* ybuf = (LAS float*)lds;
    LAS float* cbuf = (LAS float*)(lds + 65536);
    const float* dw = a.in[I_CDW] + l * 31 * 256; const float* dwb = a.in[I_CDWB] + l * 256; const float* lng = a.in[I_CLNG] + l * 256; const float* lnb = a.in[I_CLNB] + l * 256;
    const int lane = tid & 63, wave = tid >> 6;
    for (int u = blockIdx.x; u < M / 32; u += gridDim.x) {
        const int r0 = u * 32;
        const int seq0 = r0 < MCTX ? (r0 & ~255) : MCTX + ((r0 - MCTX) & ~2047); const int seq1 = seq0 + (r0 < MCTX ? 256 : 2048);
        for (int e = tid; e < 62 * 32; e += NTHREADS) {
            const int rr = e >> 5, ch = e & 31; const int row = r0 - 15 + rr;
            float y[8];
            if (row >= seq0 && row < seq1) {
                const v4u av = *(const v4u*)(Z + (size_t)row * ZW + 768 + ch * 8), gv = *(const v4u*)(Z + (size_t)row * ZW + 1024 + ch * 8);
                const float af[8] = {bflo(av.x), bfhi(av.x), bflo(av.y), bfhi(av.y), bflo(av.z), bfhi(av.z), bflo(av.w), bfhi(av.w)};
                const float gf[8] = {bflo(gv.x), bfhi(gv.x), bflo(gv.y), bfhi(gv.y), bflo(gv.z), bfhi(gv.z), bflo(gv.w), bfhi(gv.w)};
#pragma unroll
                for (int j = 0; j < 8; ++j) y[j] = af[j] / (1.0f + __expf(-gf[j]));
            } else {
#pragma unroll
                for (int j = 0; j < 8; ++j) y[j] = 0.f;
            }
            *(LAS f32x4*)(ybuf + rr * 256 + ch * 8) = (f32x4){y[0], y[1], y[2], y[3]}; *(LAS f32x4*)(ybuf + rr * 256 + ch * 8 + 4) = (f32x4){y[4], y[5], y[6], y[7]};
        }
        __syncthreads();
        { const int c = tid & 255, half = tid >> 8;
          float w[31];
#pragma unroll
          for (int k = 0; k < 31; ++k) w[k] = dw[k * 256 + c];
          const float bias = dwb[c];
          float yv[46];
#pragma unroll
          for (int i = 0; i < 46; ++i) yv[i] = ybuf[(half * 16 + i) * 256 + c];
#pragma unroll
          for (int t = 0; t < 16; ++t) { float s = bias;
#pragma unroll
              for (int k = 0; k < 31; ++k) s += w[k] * yv[t + k];
              cbuf[(half * 16 + t) * 256 + c] = s; } }
        __syncthreads();
        for (int rr = wave * 4; rr < wave * 4 + 4; ++rr) {
            const f32x4 x = *(const LAS f32x4*)(cbuf + rr * 256 + lane * 4);
            const float mu = wave_sum((x[0] + x[1]) + (x[2] + x[3])) * (1.0f / 256.0f);
            const f32x4 dx = x - mu;
            const float var = wave_sum((dx[0] * dx[0] + dx[1] * dx[1]) + (dx[2] * dx[2] + dx[3] * dx[3])) * (1.0f / 256.0f);
            const float rstd = 1.0f / sqrtf(var + EPS);
            const f32x4 yv = dx * rstd * *(const f32x4*)(lng + lane * 4) + *(const f32x4*)(lnb + lane * 4);
            v2u wv; wv.x = pk2(silu_acc(yv[0]), silu_acc(yv[1])); wv.y = pk2(silu_acc(yv[2]), silu_acc(yv[3]));
            *(v2u*)(CAT + (size_t)(r0 + rr) * 1024 + 512 + lane * 4) = wv;
        }
        __syncthreads();
    }
}


typedef unsigned long long u64;
typedef u64 u64x2 __attribute__((ext_vector_type(2)));
template <int L> struct HyGeo {
    static constexpr int R = L / 128, NSTEP = L / 32, CS = 4 * L + 64, US = 2 * L + 32, OFF_U = 8 * CS;
};
template <int L>
__device__ __forceinline__ void hy_build_copies(LAS unsigned char* lds, const bf16* raw, int tid) {
    constexpr int CS = HyGeo<L>::CS;
    for (int p = tid; p < L / 4; p += NTHREADS) {
        const v4u a = *(const v4u*)(raw + 8 * p), b = *(const v4u*)(raw + 8 * p + 8);
        const unsigned w[8] = {a.x, a.y, a.z, a.w, b.x, b.y, b.z, b.w};
#pragma unroll
        for (int sg = 0; sg < 8; ++sg) { v4u o;
            if ((sg & 1) == 0) { o.x = w[sg / 2]; o.y = w[sg / 2 + 1]; o.z = w[sg / 2 + 2]; o.w = w[sg / 2 + 3]; }
            else { const int h = sg / 2; o.x = (w[h] >> 16) | (w[h + 1] << 16); o.y = (w[h + 1] >> 16) | (w[h + 2] << 16); o.z = (w[h + 2] >> 16) | (w[h + 3] << 16); o.w = (w[h + 3] >> 16) | (w[h + 4] << 16); }
            *(LAS v4u*)(lds + sg * CS + 16 * p) = o; }
    }
}
template <int L, int NB>
__device__ __forceinline__ void hy_toeplitz(LAS unsigned char* lds, int boff, f32x4 (&acc)[HyGeo<L>::R][NB > 8 ? 2 : 1], int wave, int lane) {
    constexpr int R = HyGeo<L>::R, NT = NB > 8 ? 2 : 1, NSTEP = HyGeo<L>::NSTEP, CS = HyGeo<L>::CS, US = HyGeo<L>::US;
    const int i = lane & 15, q = lane >> 4;
    const int abase = (7 - (i & 7)) * CS + 16 * ((L / 8 - 1) - (i >> 3) + q - 2 * R * wave);
    int bb[NT];
#pragma unroll
    for (int nt = 0; nt < NT; ++nt) bb[nt] = boff + ((NB > 8 ? nt * 16 + i : (i & 7))) * US + 16 * q;
    bf16x8 F[R];
#pragma unroll
    for (int e = 0; e < R; ++e) F[e] = *(const LAS bf16x8*)(lds + abase - 32 * e);
#pragma unroll
    for (int r = 0; r < R; ++r)
#pragma unroll
        for (int nt = 0; nt < NT; ++nt) acc[r][nt] = (f32x4){0.f, 0.f, 0.f, 0.f};
    bf16x8 B[2][NT];
#pragma unroll
    for (int nt = 0; nt < NT; ++nt) B[0][nt] = *(const LAS bf16x8*)(lds + bb[nt]);
#pragma unroll 1
    for (int jo = 0; jo < NSTEP; jo += 8) {
#pragma unroll
        for (int ji = 0; ji < 8; ++ji) {
            const int j = jo + ji; constexpr int dummy = 0; (void)dummy;
#pragma unroll
            for (int r = R - 2; r < R; ++r) { const int slot = (((r - 2 * ji) % R) + R) % R;
#pragma unroll
                for (int nt = 0; nt < NT; ++nt) acc[r][nt] = __builtin_amdgcn_mfma_f32_16x16x32_bf16(F[slot], B[ji & 1][nt], acc[r][nt], 0, 0, 0); }
            __builtin_amdgcn_sched_barrier(0);
            if (j + 1 < NSTEP) {
#pragma unroll
                for (int nt = 0; nt < NT; ++nt) B[(ji + 1) & 1][nt] = *(const LAS bf16x8*)(lds + bb[nt] + 64 * (j + 1));
#pragma unroll
                for (int rr = 0; rr < 2; ++rr) { const int slot = (((rr - 2 * (ji + 1)) % R) + R) % R; F[slot] = *(const LAS bf16x8*)(lds + abase + 64 * (j + 1) - 32 * rr); }
            }
            __builtin_amdgcn_sched_barrier(0);
#pragma unroll
            for (int r = 0; r < R - 2; ++r) { const int slot = (((r - 2 * ji) % R) + R) % R;
#pragma unroll
                for (int nt = 0; nt < NT; ++nt) acc[r][nt] = __builtin_amdgcn_mfma_f32_16x16x32_bf16(F[slot], B[ji & 1][nt], acc[r][nt], 0, 0, 0); }
            __builtin_amdgcn_sched_barrier(0);
        }
    }
}
struct XRaw { v2u z; unsigned zl, zr; };
__device__ __forceinline__ XRaw xraw_load(const bf16* zrow, int t, int L) { XRaw x; x.z = *(const v2u*)zrow; x.zl = t > 0 ? (unsigned)zrow[-1] : 0u; x.zr = t + 4 < L ? (unsigned)zrow[4] : 0u; return x; }
__device__ __forceinline__ void sconv4x(const XRaw& x, float w0, float w1, float w2, float sb, float (&out)[4]) {
    const float zl = bf2f(x.zl), zr = bf2f(x.zr), z0 = bflo(x.z.x), z1 = bfhi(x.z.x), z2 = bflo(x.z.y), z3 = bfhi(x.z.y);
    out[0] = sb + w0 * zl + w1 * z0 + w2 * z1; out[1] = sb + w0 * z0 + w1 * z1 + w2 * z2; out[2] = sb + w0 * z1 + w1 * z2 + w2 * z3; out[3] = sb + w0 * z2 + w1 * z3 + w2 * zr;
}
__device__ __forceinline__ void sconv4(const bf16* zrow, int t, int L, float w0, float w1, float w2, float sb, float (&out)[4]) { const XRaw x = xraw_load(zrow, t, L); sconv4x(x, w0, w1, w2, sb, out); }
template <int L>
__device__ __forceinline__ void hy_store_copies(LAS unsigned char* lds, const v4u a, const v4u b, int p) {
    constexpr int CS = HyGeo<L>::CS;
    const unsigned w[8] = {a.x, a.y, a.z, a.w, b.x, b.y, b.z, b.w};
#pragma unroll
    for (int sg = 0; sg < 8; ++sg) { v4u o;
        if ((sg & 1) == 0) { o.x = w[sg / 2]; o.y = w[sg / 2 + 1]; o.z = w[sg / 2 + 2]; o.w = w[sg / 2 + 3]; }
        else { const int h = sg / 2; o.x = (w[h] >> 16) | (w[h + 1] << 16); o.y = (w[h + 1] >> 16) | (w[h + 2] << 16); o.z = (w[h + 2] >> 16) | (w[h + 3] << 16); o.w = (w[h + 3] >> 16) | (w[h + 4] << 16); }
        *(LAS v4u*)(lds + sg * CS + 16 * p) = o; }
}
template <int L, int NB, bool DUP = false>
__device__ __forceinline__ void hyena_channel(const Args& a, int l, int c, const bf16* ZT, bf16* CAT, LAS unsigned char* lds, int tid, int wave, int lane) {
    constexpr int R = HyGeo<L>::R, NT = NB > 8 ? 2 : 1, US = HyGeo<L>::US, OFF_U = HyGeo<L>::OFF_U, OFF_Y = OFF_U + NB * US;
    constexpr bool LAT = (L == 2048); constexpr int stream = LAT ? 0 : 1; constexpr int rowbase = LAT ? MCTX : 0;
    static_assert(L / 4 <= NTHREADS, "one copy slot per thread");
    unsigned char* ws = a.ws;
    const float* sw = a.in[I_HSW] + l * 3 * 768; const float* sb = a.in[I_HSB] + l * 768;
    const bf16* raw0 = (const bf16*)(ws + WS_HYRAW) + ((size_t)(l * 2 + 0) * 256 + c) * 4608 + (LAT ? 0 : 4096);
    const bf16* raw1 = (const bf16*)(ws + WS_HYRAW) + ((size_t)(l * 2 + 1) * 256 + c) * 4608 + (LAT ? 0 : 4096);
    const int i = lane & 15;
    const bool cp = tid < L / 4;
    v4u f0a = {0u, 0u, 0u, 0u}, f0b = f0a, f1a = f0a, f1b = f0a;
    if (cp) { f0a = *(const v4u*)(raw0 + 8 * tid); f0b = *(const v4u*)(raw0 + 8 * tid + 8); f1a = *(const v4u*)(raw1 + 8 * tid); f1b = *(const v4u*)(raw1 + 8 * tid + 8); }
    __syncthreads();
    if (cp) hy_store_copies<L>(lds, f0a, f0b, tid);
    { const float w0 = sw[c], w1 = sw[768 + c], w2 = sw[1536 + c], b0 = sb[c];
      for (int idx = tid; idx < NB * (L / 8); idx += NTHREADS) {
          const int b = idx / (L / 8), s0 = (idx % (L / 8)) * 8; const bf16* zrow = ZT + (size_t)c * M + rowbase + b * L + s0;
          float o0[4], o1[4]; sconv4(zrow, s0, L, w0, w1, w2, b0, o0); sconv4(zrow + 4, s0 + 4, L, w0, w1, w2, b0, o1);
          v4u w; w.x = pk2(o0[0], o0[1]); w.y = pk2(o0[2], o0[3]); w.z = pk2(o1[0], o1[1]); w.w = pk2(o1[2], o1[3]);
          *(LAS v4u*)(lds + OFF_U + b * US + 2 * s0) = w; } }
    __syncthreads();
    f32x4 acc[R][NT];
    hy_toeplitz<L, NB>(lds, OFF_U, acc, wave, lane);
    if constexpr (DUP) { { _Pragma("unroll") for (int r_ = 0; r_ < R; ++r_) _Pragma("unroll") for (int n_ = 0; n_ < NT; ++n_) asm volatile("" : "+v"(acc[r_][n_])); } hy_toeplitz<L, NB>(lds, OFF_U, acc, wave, lane); }
    { const float scale = 1.0f / sqrtf(((const float*)(ws + WS_SUMSQ))[((l * 2 + stream) * 2 + 0) * 256 + c] + EPS), bias = a.in[I_HBIAS][(l * 2 + 0) * 256 + c];
      const float w0 = sw[256 + c], w1 = sw[768 + 256 + c], w2 = sw[1536 + 256 + c], b0 = sb[256 + c];
      int q = lane >> 4; asm volatile("" : "+v"(q));
#pragma unroll
      for (int nt = 0; nt < NT; ++nt) { const int b = nt * 16 + i;
          if (b < NB) {
#pragma unroll
              for (int r = 0; r < R; ++r) { const int t = 16 * (R * wave + r) + 4 * q;
                  float x1[4]; sconv4(ZT + (size_t)(256 + c) * M + rowbase + b * L + t, t, L, w0, w1, w2, b0, x1);
                  const v2u uv = *(const LAS v2u*)(lds + OFF_U + b * US + 2 * t);
                  const float y0 = x1[0] * (scale * acc[r][nt][0] + bias * bflo(uv.x)), y1 = x1[1] * (scale * acc[r][nt][1] + bias * bfhi(uv.x));
                  const float y2 = x1[2] * (scale * acc[r][nt][2] + bias * bflo(uv.y)), y3 = x1[3] * (scale * acc[r][nt][3] + bias * bfhi(uv.y));
                  v2u w; w.x = pk2(y0, y1); w.y = pk2(y2, y3); *(LAS v2u*)(lds + OFF_Y + b * US + 2 * t) = w; } } } }
    __syncthreads();
    if (cp) hy_store_copies<L>(lds, f1a, f1b, tid);
    __syncthreads();
    hy_toeplitz<L, NB>(lds, OFF_Y, acc, wave, lane);
    if constexpr (DUP) { { _Pragma("unroll") for (int r_ = 0; r_ < R; ++r_) _Pragma("unroll") for (int n_ = 0; n_ < NT; ++n_) asm volatile("" : "+v"(acc[r_][n_])); } hy_toeplitz<L, NB>(lds, OFF_Y, acc, wave, lane); }
    { const float scale = 1.0f / sqrtf(((const float*)(ws + WS_SUMSQ))[((l * 2 + stream) * 2 + 1) * 256 + c] + EPS), bias = a.in[I_HBIAS][(l * 2 + 1) * 256 + c];
      const float w0 = sw[512 + c], w1 = sw[768 + 512 + c], w2 = sw[1536 + 512 + c], b0 = sb[512 + c];
      int q = lane >> 4; asm volatile("" : "+v"(q));
#pragma unroll
      for (int nt = 0; nt < NT; ++nt) { const int b = nt * 16 + i;
          if (b < NB) {
#pragma unroll
              for (int r = 0; r < R; ++r) { const int t = 16 * (R * wave + r) + 4 * q;
                  float x2[4]; sconv4(ZT + (size_t)(512 + c) * M + rowbase + b * L + t, t, L, w0, w1, w2, b0, x2);
                  const v2u yv = *(const LAS v2u*)(lds + OFF_Y + b * US + 2 * t);
                  bf16* dst = CAT + (size_t)(rowbase + b * L + t) * 1024 + 768 + c;
                  dst[0]    = (bf16)f2bf(x2[0] * (scale * acc[r][nt][0] + bias * bflo(yv.x)));
                  dst[1024] = (bf16)f2bf(x2[1] * (scale * acc[r][nt][1] + bias * bfhi(yv.x)));
                  dst[2048] = (bf16)f2bf(x2[2] * (scale * acc[r][nt][2] + bias * bflo(yv.y)));
                  dst[3072] = (bf16)f2bf(x2[3] * (scale * acc[r][nt][3] + bias * bfhi(yv.y))); } } } }
    __syncthreads();
}

typedef float f32x16 __attribute__((ext_vector_type(16)));
constexpr int ATT_KP = 144, ATT_VP = 80, ATT_KB = 32 * ATT_KP, ATT_BUF = ATT_KB + 64 * ATT_VP;
__device__ __forceinline__ void attn_phase(const Args& a, int l, const bf16* Z, const bf16* ZT, bf16* CAT, LAS unsigned char* lds, int tid, int wave, int lane) {
    const bf16* CKB = (const bf16*)(a.ws + WS_CKB) + (size_t)l * 8 * 256 * 128; const bf16* CVT = (const bf16*)(a.ws + WS_CVT) + (size_t)l * 8 * 128 * 256;
    const int r = lane & 31, hh = lane >> 5;
    for (int it = blockIdx.x; it < 768; it += gridDim.x) {
        bool lat; int b, g, qb;
        if (it < 512) { lat = true; b = it >> 6; g = (it >> 5) & 1; qb = it & 31; }
        else { const int rr = it - 512; lat = false; b = rr >> 3; g = (rr >> 2) & 1; qb = rr & 3; }
        const int h = g * 4 + (wave & 3), q0 = qb * 64 + 32 * (wave >> 2);
        const int L = lat ? 2048 : 256, seq0 = lat ? MCTX + b * 2048 : b * 256;
        const int kt_lo = lat ? (qb * 64 - 128 < 0 ? 0 : qb * 64 - 128) : 0, kt_hi = lat ? (qb * 64 + 192 > L ? L : qb * 64 + 192) : 256;
        const int n_local = (kt_hi - kt_lo) >> 5, n_total = n_local + (lat ? 8 : 0);
        const bool isk = tid < 256; const int t2 = tid & 255;
        const bf16* src_loc = isk ? Z + (size_t)(seq0 + kt_lo + (t2 >> 3)) * ZW + 512 + g * 64 + (t2 & 7) * 8 : ZT + (size_t)(768 + g * 64 + (t2 >> 2)) * M + seq0 + kt_lo + (t2 & 3) * 8;
        const bf16* src_ctx = isk ? CKB + ((size_t)b * 256 + (t2 >> 3)) * 128 + g * 64 + (t2 & 7) * 8 : CVT + ((size_t)b * 128 + g * 64 + (t2 >> 2)) * 256 + (t2 & 3) * 8;
        const size_t step_loc = isk ? (size_t)32 * ZW : 32, step_ctx = isk ? (size_t)32 * 128 : 32;
        const int dst = isk ? (t2 >> 3) * ATT_KP + (t2 & 7) * 16 : ATT_KB + (t2 >> 2) * ATT_VP + ((t2 & 3) >> 1) * 32 + ((t2 & 3) & 1) * 8;
#define ATT_GLOAD(ti_) (*(const v4u*)((ti_) < n_local ? src_loc + (size_t)(ti_) * step_loc : src_ctx + (size_t)((ti_) - n_local) * step_ctx))
#define ATT_LSTORE(buf_, v_) do { LAS unsigned char* p_ = lds + (buf_) * ATT_BUF + dst; if (isk) *(LAS v4u*)p_ = (v_); else { v2u lo_, hi_; lo_.x = (v_).x; lo_.y = (v_).y; hi_.x = (v_).z; hi_.y = (v_).w; *(LAS v2u*)p_ = lo_; *(LAS v2u*)(p_ + 16) = hi_; } } while (0)
        bf16x8 qf[4];
        { const bf16* qp = Z + (size_t)(seq0 + q0 + r) * ZW + h * 64 + 8 * hh;
#pragma unroll
          for (int s = 0; s < 4; ++s) qf[s] = *(const bf16x8*)(qp + 16 * s); }
        f32x16 o0, o1;
#pragma unroll
        for (int e = 0; e < 16; ++e) { o0[e] = 0.f; o1[e] = 0.f; }
        float mrun = a.in[I_SINK][l * 8 + h] * LOG2E, lsum = 1.0f;
        __syncthreads();
        v4u g1 = {0u, 0u, 0u, 0u}, g2 = g1;
        { const v4u g0 = ATT_GLOAD(0); if (n_total > 1) g1 = ATT_GLOAD(1); if (n_total > 2) g2 = ATT_GLOAD(2); ATT_LSTORE(0, g0); }
        __syncthreads();
        for (int ti = 0; ti < n_total; ++ti) {
            v4u gn = {0u, 0u, 0u, 0u};
            if (ti + 3 < n_total) gn = ATT_GLOAD(ti + 3);
            const int kt = kt_lo + 32 * ti;
            const bool active = !lat || ti >= n_local || (kt >= q0 - 128 && kt <= q0 + 128);
            if (active) {
                const LAS unsigned char* kb = lds + (ti & 1) * ATT_BUF + r * ATT_KP + 16 * hh;
                const LAS unsigned char* vb = lds + (ti & 1) * ATT_BUF + ATT_KB + r * ATT_VP + 16 * hh;
                f32x16 st;
#pragma unroll
                for (int e = 0; e < 16; ++e) st[e] = 0.f;
#pragma unroll
                for (int s = 0; s < 4; ++s) st = __builtin_amdgcn_mfma_f32_32x32x16_bf16(*(const LAS bf16x8*)(kb + 32 * s), qf[s], st, 0, 0, 0);
                const bf16x8 v00 = *(const LAS bf16x8*)(vb), v01 = *(const LAS bf16x8*)(vb + 32), v10 = *(const LAS bf16x8*)(vb + 32 * ATT_VP), v11 = *(const LAS bf16x8*)(vb + 32 * ATT_VP + 32);
                if (lat && ti < n_local) {
                    if (kt == q0 - 128) {
#pragma unroll
                        for (int e = 0; e < 16; ++e) { const int jj = (e & 3) + 8 * (e >> 2) + 4 * hh; if (jj < r) st[e] = -1e30f; }
                    } else if (kt == q0 + 128) {
#pragma unroll
                        for (int e = 0; e < 16; ++e) { const int jj = (e & 3) + 8 * (e >> 2) + 4 * hh; if (jj > r) st[e] = -1e30f; }
                    }
                }
                float mx = fmaxf(fmaxf(st[0], st[1]), fmaxf(st[2], st[3]));
#pragma unroll
                for (int e = 4; e < 16; e += 4) mx = fmaxf(mx, fmaxf(fmaxf(st[e], st[e + 1]), fmaxf(st[e + 2], st[e + 3])));
                mx = fmaxf(mx, __shfl_xor(mx, 32));
                const float mn = fmaxf(mrun, mx); const bool grew = __any(mn > mrun);
                const float alpha = grew ? __builtin_amdgcn_exp2f(mrun - mn) : 1.0f; mrun = mn;
                float ps = 0.f;
#pragma unroll
                for (int e = 0; e < 16; ++e) { st[e] = __builtin_amdgcn_exp2f(st[e] - mn); ps += st[e]; }
                ps += __shfl_xor(ps, 32);
                lsum = lsum * alpha + ps;
                if (grew) {
#pragma unroll
                    for (int e = 0; e < 16; ++e) { o0[e] *= alpha; o1[e] *= alpha; } }
                v4u pa, pb;
                pa.x = pk2(st[0], st[1]); pa.y = pk2(st[2], st[3]); pa.z = pk2(st[4], st[5]); pa.w = pk2(st[6], st[7]);
                pb.x = pk2(st[8], st[9]); pb.y = pk2(st[10], st[11]); pb.z = pk2(st[12], st[13]); pb.w = pk2(st[14], st[15]);
                const bf16x8 p0 = __builtin_bit_cast(bf16x8, pa), p1 = __builtin_bit_cast(bf16x8, pb);
                o0 = __builtin_amdgcn_mfma_f32_32x32x16_bf16(v00, p0, o0, 0, 0, 0);
                o0 = __builtin_amdgcn_mfma_f32_32x32x16_bf16(v01, p1, o0, 0, 0, 0);
                o1 = __builtin_amdgcn_mfma_f32_32x32x16_bf16(v10, p0, o1, 0, 0, 0);
                o1 = __builtin_amdgcn_mfma_f32_32x32x16_bf16(v11, p1, o1, 0, 0, 0);
            }
            if (ti + 1 < n_total) ATT_LSTORE((ti + 1) & 1, g1);
            g1 = g2; g2 = gn;
            __syncthreads();
        }
#undef ATT_GLOAD
#undef ATT_LSTORE
        const float inv = 1.0f / lsum;
        bf16* op = CAT + (size_t)(seq0 + q0 + r) * 1024 + h * 64 + 4 * hh;
#pragma unroll
        for (int g4 = 0; g4 < 4; ++g4) {
            v2u w; w.x = pk2(o0[4 * g4] * inv, o0[4 * g4 + 1] * inv); w.y = pk2(o0[4 * g4 + 2] * inv, o0[4 * g4 + 3] * inv); *(v2u*)(op + 8 * g4) = w;
            v2u x; x.x = pk2(o1[4 * g4] * inv, o1[4 * g4 + 1] * inv); x.y = pk2(o1[4 * g4 + 2] * inv, o1[4 * g4 + 3] * inv); *(v2u*)(op + 32 + 8 * g4) = x; }
    }
}

#ifndef PROBE_PH
#define PROBE_PH -1
#endif
#ifndef PROBE_TS
#define PROBE_TS -1
#endif
#ifndef PROBE_BLK
#define PROBE_BLK 0
#endif
#define TS_BEGIN(k) do { if constexpr ((k) == PROBE_TS) { if (blockIdx.x == PROBE_BLK && threadIdx.x == 0) *((volatile LAS unsigned long long*)(c.lds + MISC_OFF + 64)) = __builtin_amdgcn_s_memrealtime(); } } while (0)
#define TS_END(k) do { if constexpr ((k) == PROBE_TS) { if (blockIdx.x == PROBE_BLK && threadIdx.x == 0) *((volatile LAS unsigned long long*)(c.lds + MISC_OFF + 72)) = __builtin_amdgcn_s_memrealtime(); } } while (0)
struct Ctx { LAS unsigned char* lds; int tid, lane, wave, G, gw, NGW; };
constexpr int CW_SPLIT = 8192;

__device__ __forceinline__ void sb_arrive(unsigned* ctl, int id) {
    asm volatile("s_waitcnt vmcnt(0)" ::: "memory");
    __syncthreads();
    if (threadIdx.x == 0) __hip_atomic_fetch_add(ctl + CW_SPLIT + 64 * id, 1u, __ATOMIC_RELAXED, __HIP_MEMORY_SCOPE_AGENT);
}
__device__ __forceinline__ void sb_wait(unsigned* ctl, int id, unsigned G) {
    if (threadIdx.x == 0) {
        unsigned sp = 0;
        while (__hip_atomic_load(ctl + CW_SPLIT + 64 * id, __ATOMIC_RELAXED, __HIP_MEMORY_SCOPE_AGENT) < G) {
            __builtin_amdgcn_s_sleep(2);
            if (++sp > (1u << 22)) { atomicAdd(ctl + CW_BAR + XB_TMO, 1u); break; }
        }
        __builtin_amdgcn_fence(__ATOMIC_ACQUIRE, "agent");
        asm volatile("s_waitcnt vmcnt(0)" ::: "memory");
    }
    __syncthreads();
}
struct HalfOrder {
    pg8::StaticOrder S; int pm0;
    __device__ __forceinline__ void init(int N, int G, int c, int pm0_, int off) { const int rot = (G == 256) ? off : 0; S.init(48 * 256, N, G, (c + G - rot) % G); pm0 = pm0_; }
    __device__ __forceinline__ bool next(int i, pg8::Unit& u) const { if (!S.next(i, u)) return false; u.pm += pm0; return true; }
    __device__ __forceinline__ void a_ready(const pg8::Unit&) const {}
    __device__ __forceinline__ void done(const pg8::Unit&) const {}
};

template <int L, int f, int h> __device__ __forceinline__ void stage_G(const Args& a, const Ctx& c, int off) {
    unsigned char* ws = a.ws;
    pg8::Gemm g{(const bf16*)(ws + WS_H), (const bf16*)(ws + WS_WGU) + (size_t)(L * 2 + f) * 5632 * 1024, M, 5632, 1024};
    HalfOrder S; S.init(5632, c.G, (int)blockIdx.x, 48 * h, off);
    pg8::EpiGU E{(bf16*)(ws + WS_BIG), (const float*)(ws + WS_SS) + (size_t)(3 * L + 2 * f) * M, (const float*)(ws + WS_BIAS) + (size_t)L * 119808 + (f ? 69120 : 0)};
    pg8::gemm_phase<pg8::EpiGU, HalfOrder, true, true>(c.lds, g, S, E);
}
template <int L, int f, int h> __device__ __forceinline__ void stage_D(const Args& a, const Ctx& c, int off) {
    unsigned char* ws = a.ws; float* X = a.out; float* SS = (float*)(ws + WS_SS);
    const float* modl = (const float*)(ws + WS_MOD) + (size_t)L * 9 * 9216;
    pg8::Gemm g{(const bf16*)(ws + WS_BIG), (const bf16*)(ws + WS_WD) + (size_t)(L * 2 + f) * 1024 * 2816, M, 1024, 2816};
    HalfOrder S; S.init(1024, c.G, (int)blockIdx.x, 48 * h, off);
    const bool first = (L == 0) && f == 0;
    const float* gn = f == 0 ? a.in[I_GMIX] + L * 1024 : a.in[I_GF1] + 1024;
    const float* scn = f == 0 ? modl + 4 * 1024 : (const float*)(ws + WS_MOD) + 9 * 9216 + 1024;
    bf16* Hn = (f == 1 && L == 1) ? (bf16*)nullptr : (bf16*)(ws + WS_H);
    pg8::EpiRes E{first ? a.in[I_XP] : X, first ? a.in[I_XS] : X + (size_t)MCTX * D, X, modl + (f ? 8 : 2) * 1024, Hn, gn, scn, SS + (size_t)(3 * L + 1 + 2 * f) * M, 0.5f};
    pg8::gemm_phase<pg8::EpiRes, HalfOrder, true, true>(c.lds, g, S, E);
}
template <int L, int h> __device__ __forceinline__ void stage_IN(const Args& a, const Ctx& c, int off) {
    unsigned char* ws = a.ws; float* newk = a.out + (size_t)M * D; float* newv = newk + 32 * 2 * 256 * 128;
    pg8::Gemm g{(const bf16*)(ws + WS_H), (const bf16*)(ws + WS_WIN) + (size_t)L * 2048 * 1024, M, 2048, 1024};
    HalfOrder S; S.init(2048, c.G, (int)blockIdx.x, 48 * h, off);
    pg8::EpiIN E{(bf16*)(ws + WS_Z), (bf16*)(ws + WS_ZT), newk, newv, (const float*)(ws + WS_ROPE), (const float*)(ws + WS_SS) + (size_t)(3 * L + 1) * M, (const float*)(ws + WS_BIAS) + (size_t)L * 119808 + 50688, L, QSCALE};
    pg8::gemm_phase<pg8::EpiIN, HalfOrder, true, true>(c.lds, g, S, E);
}
template <int L, int h> __device__ __forceinline__ void stage_OUT(const Args& a, const Ctx& c, int off) {
    unsigned char* ws = a.ws; float* X = a.out; const float* modl = (const float*)(ws + WS_MOD) + (size_t)L * 9 * 9216;
    pg8::Gemm g{(const bf16*)(ws + WS_CAT), (const bf16*)(ws + WS_WOUT) + (size_t)L * 1024 * 1024, M, 1024, 1024};
    HalfOrder S; S.init(1024, c.G, (int)blockIdx.x, 48 * h, off);
    pg8::EpiRes E{X, X + (size_t)MCTX * D, X, modl + 5 * 1024, (bf16*)(ws + WS_H), a.in[I_GF2] + L * 1024, modl + 7 * 1024, (float*)(ws + WS_SS) + (size_t)(3 * L + 2) * M, 1.0f};
    pg8::gemm_phase<pg8::EpiRes, HalfOrder, true, true>(c.lds, g, S, E);
}
template <int L> __device__ __forceinline__ void mix_stage(const Args& a, const Ctx& c) {
    unsigned char* ws = a.ws; const bf16* Z = (const bf16*)(ws + WS_Z); const bf16* ZT = (const bf16*)(ws + WS_ZT); bf16* CAT = (bf16*)(ws + WS_CAT);
    int tid_ = c.tid; asm volatile("" : "+v"(tid_));
    const int G = c.G, tid = tid_, lane = tid_ & 63; LAS unsigned char* lds = c.lds;
#define HY_CH(w) ((((w) & 7) << 5) | (((w) >> 3) & 31))
    if constexpr (L == 0) TS_BEGIN(301);
    for (int w = blockIdx.x; w < 256; w += G) hyena_channel<2048, 8>(a, L, HY_CH(w), ZT, CAT, lds, tid, c.wave, lane);
    if constexpr (L == 0) { TS_END(301); TS_BEGIN(302); }
    for (int w = blockIdx.x; w < 256; w += G) hyena_channel<256, 32>(a, L, HY_CH(w), ZT, CAT, lds, tid, c.wave, lane);
#undef HY_CH
    if constexpr (L == 0) { TS_END(302); TS_BEGIN(303); }
    attn_phase(a, L, Z, ZT, CAT, lds, tid, c.wave, lane);
    __syncthreads();
    if constexpr (L == 0) { TS_END(303); TS_BEGIN(304); }
    conv_phase(a, L, Z, CAT, lds, tid);
    if constexpr (L == 0) TS_END(304);
}
__device__ __forceinline__ void final_half(const Args& a, const Ctx& c, int h) {
    float* X = a.out; const float* ss = (const float*)(a.ws + WS_SS) + (size_t)6 * M; const float* g = a.in[I_GFIN];
    for (int r = h * 12288 + c.gw; r < (h + 1) * 12288; r += c.NGW) {
        float* xr = X + (size_t)r * D;
        const float rstd = 1.0f / sqrtf(ss[r] * (1.0f / D) + EPS);
#pragma unroll
        for (int j = 0; j < 4; ++j) { const int col = 4 * (c.lane + 64 * j); ((f32x4*)xr)[c.lane + 64 * j] = (((const f32x4*)xr)[c.lane + 64 * j] * rstd) * *(const f32x4*)(g + col); }
    }
}

__global__ void __launch_bounds__(NTHREADS, 2) mega_fwd(Args a) {
    extern __shared__ __attribute__((aligned(16))) unsigned char lds_raw[];
    Ctx c;
    c.lds = (LAS unsigned char*)lds_raw;
    c.tid = threadIdx.x; c.lane = c.tid & 63; c.wave = __builtin_amdgcn_readfirstlane(c.tid >> 6);
    c.G = gridDim.x; c.gw = blockIdx.x * NWAVES + c.wave; c.NGW = c.G * NWAVES;
    unsigned* ctl = (unsigned*)(a.ws + WS_CTL);
    for (int u = c.tid; u < (LDS_BYTES - LDSCTL_OFF) / 4; u += NTHREADS) ((LAS unsigned*)(c.lds + LDSCTL_OFF))[u] = 0u;
    __syncthreads();
    XcdBarrier bar = xcd_barrier_post(ctl + CW_BAR, (volatile LAS unsigned*)(c.lds + MISC_OFF) + 8);
    cg::grid_group grid = cg::this_grid();
    const unsigned G = (unsigned)c.G;
    TS_BEGIN(0);
    p0_prologue(a, c.lds, c.gw, c.NGW, c.wave, c.lane, true);
    if (a.ph_hi > 100000) grid.sync(); else xcd_barrier(bar);
    TS_END(0); TS_BEGIN(1);
    prep_phase(a.in[I_XP], a.in[I_XS], a.in[I_GF1], (const float*)(a.ws + WS_MOD), 1, (bf16*)(a.ws + WS_H), (float*)(a.ws + WS_SS), 0, M, c.gw, c.NGW, c.lane);
    bias_phase(a, 0, 2 * 832, c.gw, c.NGW, c.lane);
    xcd_barrier(bar);
    TS_END(1); TS_BEGIN(2);
    { stage_G<0, 0, 0>(a, c, 0); sb_arrive(ctl, 0); }
    { stage_G<0, 0, 1>(a, c, 32); sb_arrive(ctl, 1); }
    { sb_wait(ctl, 0, G); stage_D<0, 0, 0>(a, c, 64); sb_arrive(ctl, 2); }
    { sb_wait(ctl, 1, G); stage_D<0, 0, 1>(a, c, 0); sb_arrive(ctl, 3); }
    { const int b = (int)blockIdx.x;
      if (b < 64 || b >= 192) hyena_filter_phase(a, c.lds, (b < 64 ? b : b - 128) * NWAVES + c.wave, 128 * NWAVES, c.wave, c.lane); }
    sb_wait(ctl, 2, G); sb_wait(ctl, 3, G);
    stage_IN<0, 0>(a, c, 0);
    stage_IN<0, 1>(a, c, 128);
    xcd_barrier(bar);
    TS_END(2); TS_BEGIN(3);
    mix_stage<0>(a, c);
    xcd_barrier(bar);
    TS_END(3); TS_BEGIN(4);
    { stage_OUT<0, 0>(a, c, 128); sb_arrive(ctl, 4); }
    { stage_OUT<0, 1>(a, c, 64); sb_arrive(ctl, 5); }
    { sb_wait(ctl, 4, G); stage_G<0, 1, 0>(a, c, 0); sb_arrive(ctl, 6); }
    { sb_wait(ctl, 5, G); stage_G<0, 1, 1>(a, c, 32); sb_arrive(ctl, 7); }
    { sb_wait(ctl, 6, G); stage_D<0, 1, 0>(a, c, 0); sb_arrive(ctl, 8); }
    { sb_wait(ctl, 7, G); stage_D<0, 1, 1>(a, c, 192); sb_arrive(ctl, 9); }
    { sb_wait(ctl, 8, G); stage_G<1, 0, 0>(a, c, 64); sb_arrive(ctl, 10); }
    { sb_wait(ctl, 9, G); stage_G<1, 0, 1>(a, c, 96); sb_arrive(ctl, 11); }
    { sb_wait(ctl, 10, G); stage_D<1, 0, 0>(a, c, 128); sb_arrive(ctl, 12); }
    { sb_wait(ctl, 11, G); stage_D<1, 0, 1>(a, c, 64); sb_arrive(ctl, 13); }
    sb_wait(ctl, 12, G); sb_wait(ctl, 13, G);
    stage_IN<1, 0>(a, c, 0);
    stage_IN<1, 1>(a, c, 128);
    xcd_barrier(bar);
    TS_END(4); TS_BEGIN(5);
    mix_stage<1>(a, c);
    xcd_barrier(bar);
    TS_END(5); TS_BEGIN(6);
    { stage_OUT<1, 0>(a, c, 128); sb_arrive(ctl, 14); }
    { stage_OUT<1, 1>(a, c, 64); sb_arrive(ctl, 15); }
    { sb_wait(ctl, 14, G); stage_G<1, 1, 0>(a, c, 128); sb_arrive(ctl, 16); }
    { sb_wait(ctl, 15, G); stage_G<1, 1, 1>(a, c, 160); sb_arrive(ctl, 17); }
    { sb_wait(ctl, 16, G); stage_D<1, 1, 0>(a, c, 0); sb_arrive(ctl, 18); }
    { sb_wait(ctl, 17, G); stage_D<1, 1, 1>(a, c, 192); sb_arrive(ctl, 19); }
    { sb_wait(ctl, 18, G); final_half(a, c, 0); }
    { sb_wait(ctl, 19, G); final_half(a, c, 1); }
    TS_END(6);
    if constexpr (PROBE_TS >= 0) { if (blockIdx.x == PROBE_BLK && threadIdx.x == 0) { const unsigned long long t0 = *((volatile LAS unsigned long long*)(c.lds + MISC_OFF + 64)), t1 = *((volatile LAS unsigned long long*)(c.lds + MISC_OFF + 72)); const unsigned long long now = __builtin_amdgcn_s_memrealtime(); while (__builtin_amdgcn_s_memrealtime() - now < 9ull * (t1 - t0)) __builtin_amdgcn_s_sleep(8); } __syncthreads(); }
}

extern "C" void kernel_launch(void* const* d_in, const int* in_sizes, int n_in, void* d_out, int out_size, void* d_ws, size_t ws_size, hipStream_t stream) {
    static int grid = 0;
    if (grid == 0) {
        if (n_in != N_IN || ws_size < WS_END || out_size != M * D + 2 * 32 * 2 * 256 * 128) { fprintf(stderr, "kernel_launch: unexpected shapes (n_in %d, ws %zu, out %d)\n", n_in, ws_size, out_size); grid = -1; return; }
        int dev = 0, cus = 0, per_cu = 0;
        if (hipGetDevice(&dev) != hipSuccess || hipDeviceGetAttribute(&cus, hipDeviceAttributeMultiprocessorCount, dev) != hipSuccess) { grid = -1; return; }
        if (hipFuncSetAttribute((const void*)mega_fwd, hipFuncAttributeMaxDynamicSharedMemorySize, LDS_BYTES) != hipSuccess) { fprintf(stderr, "kernel_launch: hipFuncSetAttribute failed\n"); grid = -1; return; }
        if (hipOccupancyMaxActiveBlocksPerMultiprocessor(&per_cu, (const void*)mega_fwd, NTHREADS, LDS_BYTES) != hipSuccess || per_cu < 1) { fprintf(stderr, "kernel_launch: occupancy query says %d\n", per_cu); per_cu = 1; }
        (void)hipGetLastError();
        if (cus < 256) { fprintf(stderr, "kernel_launch: built for a 256-CU device (got %d)\n", cus); grid = -1; return; }
        grid = 256;
    }
    if (grid < 0) return;
    (void)hipMemsetAsync((char*)d_ws + WS_CTL, 0, CTL_ZERO_BYTES, stream);
    Args a{};
    for (int i = 0; i < N_IN; ++i) a.in[i] = (const float*)d_in[i];
    a.out = (float*)d_out; a.ws = (unsigned char*)d_ws; a.ph_lo = 0; a.ph_hi = 1;
    void* args[] = {&a};
    hipError_t e = hipLaunchCooperativeKernel((const void*)mega_fwd, dim3(grid), dim3(NTHREADS), args, LDS_BYTES, stream);
    if (e != hipSuccess) fprintf(stderr, "cooperative launch failed: %s (grid %d)\n", hipGetErrorString(e), grid);
}
```

```cpp
#include <hip/hip_runtime.h>
#include <hip/hip_cooperative_groups.h>
#include <cstdio>
#include <cstdint>
namespace cg = cooperative_groups;

constexpr int D = 1024, DFF = 2816, INW = 2048;
constexpr int MCTX = 8192, MLAT = 16384, M = MCTX + MLAT;
constexpr int LCTX = 256, LLAT = 2048;
constexpr int NCOND = 9, MODW = 9 * 1024;
constexpr int ZW = 1280;
constexpr int HYC = 768;
constexpr float EPS = 1e-6f;
constexpr float LOG2E = 1.4426950408889634f;
constexpr float QSCALE = 0.125f * LOG2E;

enum { I_XP = 0, I_XS, I_C, I_CK, I_CV, I_CCTX, I_WMOD, I_BMOD, I_GF1, I_GMIX, I_GF2, I_GFIN, I_W1G, I_W1U, I_W1D, I_W2G, I_W2U, I_W2D, I_WIN, I_WOUT, I_SINK,
       I_CDW, I_CDWB, I_CLNG, I_CLNB, I_CPW, I_HSW, I_HSB, I_HW1, I_HB1, I_HF1, I_HW2, I_HB2, I_HF2, I_HW3, I_HLD, I_HBIAS, N_IN };

constexpr size_t MiB = 1u << 20;
constexpr size_t WS_CTL = 0, CTL_ZERO_BYTES = 2 * MiB;
constexpr size_t WS_SUMSQ = 64 * 1024;
constexpr size_t WS_MOD = 128 * 1024;
constexpr size_t WS_SS = 1 * MiB;
constexpr size_t WS_GCT = 2 * MiB;
constexpr size_t WS_ROPE = 3 * MiB;
constexpr size_t WS_BIAS = 3 * MiB + 64 * 1024;
constexpr size_t WS_WGU = 4 * MiB;
constexpr size_t WS_WD = 48 * MiB;
constexpr size_t WS_WIN = 70 * MiB;
constexpr size_t WS_WOUT = 78 * MiB;
constexpr size_t WS_CKB = 82 * MiB;
constexpr size_t WS_CVT = 83 * MiB;
constexpr size_t WS_HYH = 84 * MiB;
constexpr size_t WS_HYRAW = 86 * MiB;
constexpr size_t WS_H = 96 * MiB;
constexpr size_t WS_BIG = 144 * MiB;
constexpr size_t WS_Z = WS_BIG;
constexpr size_t WS_ZT = 204 * MiB;
constexpr size_t WS_CAT = 276 * MiB;
constexpr size_t WS_END = 324 * MiB;
static_assert(WS_MOD + 2 * 9 * 9216 * 4 <= WS_SS && WS_SS + 7 * (size_t)M * 4 <= CTL_ZERO_BYTES && WS_BIAS + 2 * 9 * 13312 * 4 <= WS_WGU, "ctl");
static_assert(WS_BIG + (size_t)M * DFF * 2 <= WS_END && WS_Z + (size_t)M * ZW * 2 <= WS_ZT && WS_ZT + (size_t)896 * M * 2 <= WS_END, "ws map");
constexpr int CW_BAR = 4096;

constexpr int RING_BYTES = 131072;
constexpr int LDSCTL_OFF = 133120, MISC_OFF = LDSCTL_OFF + 320;
constexpr int LDS_BYTES = 135168;
constexpr int NWAVES = 8, NTHREADS = 512;

namespace pg8 {
#define PG8_LAS __attribute__((address_space(3)))
typedef unsigned short bf16_t;
typedef short bf16x8 __attribute__((ext_vector_type(8)));
typedef float f32x4 __attribute__((ext_vector_type(4)));
typedef unsigned u32x4 __attribute__((ext_vector_type(4)));
constexpr int BM = 256, BK = 64, HALF = 128, HTB = HALF * BK * 2  , STAGE_BYTES = 8 * HTB, NXCD = 8, WGM = 8;

__host__ __device__ __forceinline__ int lds_byte(int r, int c) { const int st = (r >> 4) * 2 + (c >> 5), rr = r & 15, cc = c & 31, ob = rr * 64 + cc * 2; return st * 1024 + (ob ^ (((ob >> 9) & 1) << 5)); }
__host__ __device__ __forceinline__ void stage_rc(int b, int& R, int& C) { const int st = b / 1024, sb = b % 1024, swz = sb ^ (((sb >> 9) & 1) << 5); R = (st >> 1) * 16 + swz / 64; C = (st & 1) * 32 + (swz % 64) / 2; }
__host__ __device__ __forceinline__ int perm32(int rho) { const int n = rho >> 4, i = rho & 15; return 8 * (i >> 2) + 4 * n + (i & 3); }

struct Unit { int pm, pn; };
struct Gemm { const bf16_t* A; const bf16_t* Bt; int M, N, K; };

struct StaticOrder {
    int nM, nN, nwg, G, c;
    __host__ __device__ void init(int M, int N, int G_, int c_) { nM = M / BM; nN = N / BM; nwg = nM * nN; G = G_; c = c_; }
    __host__ __device__ bool next(int i, Unit& u) const {
        const long L = (long)i * G + c; if (L >= nwg) return false;
        int wgid = (int)L; { const int q = nwg / NXCD, r = nwg % NXCD, xcd = wgid % NXCD, off = wgid / NXCD; wgid = (xcd < r ? xcd * (q + 1) : r * (q + 1) + (xcd - r) * q) + off; }
        const int nig = WGM * nN, gid = wgid / nig, fm = gid * WGM, gsz = (nM - fm) < WGM ? (nM - fm) : WGM;
        u.pm = fm + ((wgid % nig) % gsz); u.pn = (wgid % nig) / gsz; return true;
    }
    __device__ __forceinline__ void a_ready(const Unit&) const {}
    __device__ __forceinline__ void done(const Unit&) const {}
};


__device__ __forceinline__ unsigned cvt_pk_bf16(float lo, float hi) { unsigned r; asm volatile("v_cvt_pk_bf16_f32 %0, %1, %2" : "=v"(r) : "v"(lo), "v"(hi)); return r; }
__device__ __forceinline__ float silu_f(float x) { return x * __builtin_amdgcn_rcpf(1.0f + __builtin_amdgcn_exp2f(-1.4426950408889634f * x)); }
__device__ __forceinline__ int cond_of_tile(int pm) { return pm < 32 ? 0 : 1 + ((pm - 32) >> 3); }

__device__ __forceinline__ void st16_wt(void* p, u32x4 v) { asm volatile("global_store_dwordx4 %0, %1, off sc1\n\ts_nop 1" :: "v"(p), "v"(v) : "memory"); }
__device__ __forceinline__ void st16_wt(void* p, f32x4 v) { asm volatile("global_store_dwordx4 %0, %1, off sc1\n\ts_nop 1" :: "v"(p), "v"(v) : "memory"); }
__device__ __forceinline__ void st8_wt(void* p, unsigned lo, unsigned hi) { __hip_atomic_store((unsigned long long*)p, ((unsigned long long)hi << 32) | lo, __ATOMIC_RELAXED, __HIP_MEMORY_SCOPE_AGENT); }
struct EpiGU {
    static constexpr bool PERM = true, AFTER_DRAIN = false;
    bf16_t* O;
    const float* ss; const float* bias;
    __device__ __forceinline__ void operator()(const f32x4 (&acc)[2][2][4][2], const Unit& u, int wr, int wc, int fr, int fq) const {
        const int row0 = u.pm * BM + wr * 64 + fr, col0 = u.pn * HALF + wc * 32 + 8 * fq;
        const float* bp = bias + cond_of_tile(u.pm) * 5632 + u.pn * BM + wc * 32 + 8 * fq;
        const f32x4 bg0 = *(const f32x4*)bp, bg1 = *(const f32x4*)(bp + 4), bu0 = *(const f32x4*)(bp + HALF), bu1 = *(const f32x4*)(bp + HALF + 4);
        float rsv[2][4];
#pragma unroll
        for (int ai = 0; ai < 2; ++ai)
#pragma unroll
            for (int m = 0; m < 4; ++m) rsv[ai][m] = ss[row0 + ai * HALF + m * 16];
#pragma unroll
        for (int ai = 0; ai < 2; ++ai)
#pragma unroll
            for (int m = 0; m < 4; ++m) { const int row = row0 + ai * HALF + m * 16; bf16_t* rowp = O + (size_t)row * 2816 + col0;
                const float rs = __builtin_amdgcn_rsqf(rsv[ai][m] * (1.0f / 1024.0f) + 1e-6f);
                const f32x4 g0 = acc[ai][0][m][0] * rs + bg0, g1 = acc[ai][0][m][1] * rs + bg1, u0 = acc[ai][1][m][0] * rs + bu0, u1 = acc[ai][1][m][1] * rs + bu1;
                u32x4 w;
                w.x = cvt_pk_bf16(silu_f(g0[0]) * u0[0], silu_f(g0[1]) * u0[1]); w.y = cvt_pk_bf16(silu_f(g0[2]) * u0[2], silu_f(g0[3]) * u0[3]);
                w.z = cvt_pk_bf16(silu_f(g1[0]) * u1[0], silu_f(g1[1]) * u1[1]); w.w = cvt_pk_bf16(silu_f(g1[2]) * u1[2], silu_f(g1[3]) * u1[3]);
                st16_wt(rowp, w); }
    }
};
struct EpiRes {
    static constexpr bool PERM = false, AFTER_DRAIN = false;
    const float* in0; const float* in1; float* X; const float* gate;
    bf16_t* Hn; const float* gct; float* ssn; float scale;
    __device__ __forceinline__ void operator()(const f32x4 (&acc)[2][2][4][2], const Unit& u, int wr, int wc, int fr, int fq) const {
        asm volatile("" : "+v"(fr), "+v"(fq));
        const int cond = cond_of_tile(u.pm); const float* gp = gate + cond * 9216; const float* cp = gct + cond * 1024;
        const int col0 = u.pn * BM + wc * 32 + 4 * fq;
        const bool ctx = u.pm < 32; const float* src = ctx ? in0 : in1; const int rbase = u.pm * BM - (ctx ? 0 : 8192);
        f32x4 gv[2][2], gc[2][2], xo[4][2][2];
#define EPIRES_LOAD(slot_, rg_) do { const float* sp = src + (size_t)(rbase + ((rg_) >> 2) * HALF + wr * 64 + ((rg_) & 3) * 16 + fr) * 1024 + col0; \
            _Pragma("unroll") for (int bj = 0; bj < 2; ++bj) _Pragma("unroll") for (int n = 0; n < 2; ++n) xo[slot_][bj][n] = *(const f32x4*)(sp + bj * HALF + n * 16); } while (0)
#define EPIRES_DO(slot_, rg_) do { const int ai = (rg_) >> 2, m = (rg_) & 3, rl = ai * HALF + wr * 64 + m * 16 + fr; \
            float* xp = X + (size_t)(u.pm * BM + rl) * 1024 + col0; float sq = 0.f; \
            _Pragma("unroll") for (int bj = 0; bj < 2; ++bj) _Pragma("unroll") for (int n = 0; n < 2; ++n) { const f32x4 xn = xo[slot_][bj][n] + gv[bj][n] * acc[ai][bj][m][n]; \
                st16_wt(xp + bj * HALF + n * 16, xn); sq += (xn[0] * xn[0] + xn[1] * xn[1]) + (xn[2] * xn[2] + xn[3] * xn[3]); \
                if (Hn) { const f32x4 hv = xn * gc[bj][n]; st8_wt(Hn + (size_t)(u.pm * BM + rl) * 1024 + col0 + bj * HALF + n * 16, cvt_pk_bf16(hv[0], hv[1]), cvt_pk_bf16(hv[2], hv[3])); } } \
            sq += __shfl_xor(sq, 16); sq += __shfl_xor(sq, 32); \
            if (fq == 0) atomicAdd(ssn + u.pm * BM + rl, sq); } while (0)
#pragma unroll
        for (int bj = 0; bj < 2; ++bj)
#pragma unroll
            for (int n = 0; n < 2; ++n) { gv[bj][n] = *(const f32x4*)(gp + col0 + bj * HALF + n * 16); gc[bj][n] = Hn ? *(const f32x4*)(cp + col0 + bj * HALF + n * 16) : (f32x4){0.f, 0.f, 0.f, 0.f}; }
        EPIRES_LOAD(0, 0); EPIRES_LOAD(1, 1);
#pragma unroll
        for (int bj = 0; bj < 2; ++bj)
#pragma unroll
            for (int n = 0; n < 2; ++n) gv[bj][n] = gv[bj][n] * scale;
        EPIRES_DO(0, 0); EPIRES_DO(1, 1);
        EPIRES_LOAD(0, 2); EPIRES_LOAD(1, 3);
        EPIRES_DO(0, 2); EPIRES_DO(1, 3);
        EPIRES_LOAD(0, 4); EPIRES_LOAD(1, 5); EPIRES_LOAD(2, 6); EPIRES_LOAD(3, 7);
        EPIRES_DO(0, 4); EPIRES_DO(1, 5); EPIRES_DO(2, 6); EPIRES_DO(3, 7);
#undef EPIRES_LOAD
#undef EPIRES_DO
    }
};
struct EpiIN {
    static constexpr bool PERM = false, AFTER_DRAIN = false;
    bf16_t* Z; bf16_t* ZT; float* newk; float* newv; const float* rope; const float* ss; const float* bias; int layer; float qscale;
    __device__ __forceinline__ void operator()(const f32x4 (&acc)[2][2][4][2], const Unit& u, int wr, int wc, int fr, int fq) const {
        const bool lat = u.pm >= 32;
        const int colb = u.pn * BM + wc * 32 + 4 * fq;
        const float* bp = bias + cond_of_tile(u.pm) * 2048 + colb;
        f32x4 bv[2][2];
#pragma unroll
        for (int bj = 0; bj < 2; ++bj)
#pragma unroll
            for (int n = 0; n < 2; ++n) bv[bj][n] = *(const f32x4*)(bp + bj * HALF + n * 16);
        const bool roped = lat && u.pn < 3;
        float rsv[2][4];
#pragma unroll
        for (int ai = 0; ai < 2; ++ai)
#pragma unroll
            for (int m = 0; m < 4; ++m) rsv[ai][m] = ss[u.pm * BM + ai * HALF + wr * 64 + m * 16 + fr];
#pragma unroll
        for (int ai = 0; ai < 2; ++ai) {
            f32x4 rc0[4], rc1[4];
#pragma unroll
            for (int m = 0; m < 4; ++m) { rc0[m] = (f32x4){1.f, 0.f, 1.f, 0.f}; rc1[m] = rc0[m];
                if (roped) { const int pos = (u.pm * BM + ai * HALF + wr * 64 + m * 16 + fr - 8192) & 2047; const int p = (wc & 1) ? (pos & 63) : (pos >> 6);
                    const f32x4* rp = (const f32x4*)(rope + (size_t)(p * 16 + 4 * fq) * 2); rc0[m] = rp[0]; rc1[m] = rp[1]; } }
#pragma unroll
            for (int m = 0; m < 4; ++m) { const int row = u.pm * BM + ai * HALF + wr * 64 + m * 16 + fr;
                const float rs = __builtin_amdgcn_rsqf(rsv[ai][m] * (1.0f / 1024.0f) + 1e-6f);
#pragma unroll
                for (int bj = 0; bj < 2; ++bj) { const int col = colb + bj * HALF;
                    f32x4 v0 = acc[ai][bj][m][0] * rs + bv[bj][0], v1 = acc[ai][bj][m][1] * rs + bv[bj][1];
                    if (u.pn < 5) {
                        const int cb = u.pn * BM + bj * HALF;
                        if (lat && cb < 640) {
                            const f32x4 cs0 = rc0[m], cs1 = rc1[m];
                            const float c0 = cs0[0], s0 = cs0[1], c1 = cs0[2], s1 = cs0[3], c2 = cs1[0], s2 = cs1[1], c3 = cs1[2], s3 = cs1[3];
                            const f32x4 a = v0, b = v1;
                            v0[0] = a[0] * c0 - b[0] * s0; v1[0] = b[0] * c0 + a[0] * s0;
                            v0[1] = a[1] * c1 - b[1] * s1; v1[1] = b[1] * c1 + a[1] * s1;
                            v0[2] = a[2] * c2 - b[2] * s2; v1[2] = b[2] * c2 + a[2] * s2;
                            v0[3] = a[3] * c3 - b[3] * s3; v1[3] = b[3] * c3 + a[3] * s3;
                        }
                        if (!lat && cb >= 512 && cb < 768) {
                            const int b = row >> 8, s = row & 255; float* dst = (cb < 640 ? newk : newv) + ((size_t)(b * 2 + layer) * 256 + s) * 128 + (col - cb);
                            *(f32x4*)dst = v0; *(f32x4*)(dst + 16) = v1;
                        }
                        if (cb < 512) { v0 = v0 * qscale; v1 = v1 * qscale; }
                        if (cb == 640) {
                            const int ch = 768 + col - 640;
#pragma unroll
                            for (int j = 0; j < 4; ++j) { ZT[(size_t)(ch + j) * 24576 + row] = (bf16_t)(cvt_pk_bf16(v0[j], 0.f) & 0xffffu); ZT[(size_t)(ch + 16 + j) * 24576 + row] = (bf16_t)(cvt_pk_bf16(v1[j], 0.f) & 0xffffu); }
                        } else {
                        bf16_t* zp = Z + (size_t)row * 1280 + col;
                        typedef unsigned u32x2 __attribute__((ext_vector_type(2)));
                        u32x2 w0, w1; w0.x = cvt_pk_bf16(v0[0], v0[1]); w0.y = cvt_pk_bf16(v0[2], v0[3]); w1.x = cvt_pk_bf16(v1[0], v1[1]); w1.y = cvt_pk_bf16(v1[2], v1[3]);
                        *(u32x2*)zp = w0; *(u32x2*)(zp + 16) = w1; }
                    } else {
                        const int ch = col - 1280;
#pragma unroll
                        for (int j = 0; j < 4; ++j) { ZT[(size_t)(ch + j) * 24576 + row] = (bf16_t)(cvt_pk_bf16(v0[j], 0.f) & 0xffffu); ZT[(size_t)(ch + 16 + j) * 24576 + row] = (bf16_t)(cvt_pk_bf16(v1[j], 0.f) & 0xffffu); }
                    }
                } }
        }
    }
};

template <class Epi, class Sched, bool ALIGN_EPI = false, bool SP2 = false>
__device__ __forceinline__ void gemm_phase(PG8_LAS unsigned char* lds, const Gemm g, const Sched S, const Epi E) {
    int tid_ = threadIdx.x; asm volatile("" : "+v"(tid_));
    const int tid = tid_, wid = __builtin_amdgcn_readfirstlane(tid >> 6), lane = tid & 63, wr = wid >> 2, wc = wid & 3, fr = lane & 15, fq = lane >> 4;
    const int K = g.K, nt = K / BK;
    unsigned voffA[2], voffB[2];
#pragma unroll
    for (int i = 0; i < 2; ++i) { int R, C; stage_rc(tid * 16 + i * 8192, R, C); const int Rb = Epi::PERM ? ((R & ~31) + perm32(R & 31)) : R;
        voffA[i] = (unsigned)(R * K + C) * 2u; voffB[i] = (unsigned)(Rb * K + C) * 2u; }
    const size_t kstep = (size_t)(BK * 2);
    const size_t hstep = (size_t)HALF * K * 2;
    const size_t tstep = 2 * hstep;
    const unsigned ldsw = (unsigned)wid * 1024u;
    const int aoff = lds_byte(wr * 64 + fr, fq * 8), boff = lds_byte(wc * 32 + fr, fq * 8);
#define PG8_SA(b, h) (((b) * 2 + (h)) * HTB)
#define PG8_SB(b, h) ((4 + (b) * 2 + (h)) * HTB)
#define PG8_STAGE(bufoff, gbase, voff) do { _Pragma("unroll") for (int _i = 0; _i < 2; ++_i) \
        __builtin_amdgcn_global_load_lds((const unsigned*)((const char*)(gbase) + (voff)[_i]), (PG8_LAS unsigned*)(lds + (bufoff) + ldsw + _i * 8192), 16, 0, 0); } while (0)
#define PG8_LDA(dst, b, h) do { _Pragma("unroll") for (int m = 0; m < 4; ++m) _Pragma("unroll") for (int k = 0; k < 2; ++k) dst[m][k] = *(const PG8_LAS bf16x8*)(lds + PG8_SA(b, h) + aoff + m * 2048 + k * 1024); } while (0)
#define PG8_LDB(dst, b, h) do { _Pragma("unroll") for (int n = 0; n < 2; ++n) _Pragma("unroll") for (int k = 0; k < 2; ++k) dst[n][k] = *(const PG8_LAS bf16x8*)(lds + PG8_SB(b, h) + boff + n * 2048 + k * 1024); } while (0)
#define PG8_MMA(ai, bj, At, Bt) do { __builtin_amdgcn_s_setprio(1); _Pragma("unroll") for (int m = 0; m < 4; ++m) _Pragma("unroll") for (int n = 0; n < 2; ++n) _Pragma("unroll") for (int k = 0; k < 2; ++k) \
        acc[ai][bj][m][n] = __builtin_amdgcn_mfma_f32_16x16x32_bf16(Bt[n][k], At[m][k], acc[ai][bj][m][n], 0, 0, 0); __builtin_amdgcn_s_setprio(0); } while (0)
#define PG8_WAIT_V(n) asm volatile("s_waitcnt vmcnt(" #n ")" ::: "memory")
#define PG8_WAIT_L(n) asm volatile("s_waitcnt lgkmcnt(" #n ")" ::: "memory")
#define PG8_BAR __builtin_amdgcn_s_barrier()
#define PG8_SCHED __builtin_amdgcn_sched_barrier(0)
    Unit cur, nxt; int ui = 0;
    if (!S.next(0, cur)) return;
    f32x4 acc[2][2][4][2];
#pragma unroll
    for (int a = 0; a < 2; ++a)
#pragma unroll
        for (int b = 0; b < 2; ++b)
#pragma unroll
            for (int m = 0; m < 4; ++m)
#pragma unroll
                for (int n = 0; n < 2; ++n) acc[a][b][m][n] = (f32x4){0.f, 0.f, 0.f, 0.f};
    bf16x8 At[4][2], B0[2][2], B1[2][2];
    const char* cA = (const char*)g.A + (size_t)cur.pm * tstep; const char* cB = (const char*)g.Bt + (size_t)cur.pn * tstep;
    S.a_ready(cur);
    if constexpr (SP2) {
        PG8_STAGE(PG8_SB(0, 0), cB, voffB); PG8_STAGE(PG8_SB(0, 1), cB + hstep, voffB); PG8_STAGE(PG8_SA(0, 0), cA, voffA); PG8_STAGE(PG8_SA(0, 1), cA + hstep, voffA);
        if (wr == 1) PG8_BAR;
        PG8_WAIT_V(2); PG8_BAR;
        PG8_STAGE(PG8_SB(1, 0), cB + kstep, voffB); PG8_STAGE(PG8_SA(1, 0), cA + kstep, voffA); PG8_STAGE(PG8_SB(1, 1), cB + hstep + kstep, voffB);
        PG8_WAIT_V(6); PG8_BAR;
    } else {
        PG8_STAGE(PG8_SB(0, 0), cB, voffB); PG8_STAGE(PG8_SA(0, 0), cA, voffA); PG8_STAGE(PG8_SB(0, 1), cB + hstep, voffB); PG8_STAGE(PG8_SA(0, 1), cA + hstep, voffA);
        if (wr == 1) PG8_BAR;
        PG8_WAIT_V(4); PG8_BAR;
        PG8_STAGE(PG8_SB(1, 0), cB + kstep, voffB); PG8_STAGE(PG8_SA(1, 0), cA + kstep, voffA); PG8_STAGE(PG8_SB(1, 1), cB + hstep + kstep, voffB);
        PG8_WAIT_V(6); PG8_BAR;
    }
    for (;;) {
        const bool has_next = S.next(ui + 1, nxt);
        const char* nA = has_next ? (const char*)g.A + (size_t)nxt.pm * tstep : cA; const char* nB = has_next ? (const char*)g.Bt + (size_t)nxt.pn * tstep : cB;
        for (int t = 0; t < nt; t += 2) {
            const bool last = (t == nt - 2);
            const char* a1 = cA + (size_t)(t + 1) * kstep;
            const char* a2 = last ? nA : cA + (size_t)(t + 2) * kstep; const char* b2 = last ? nB : cB + (size_t)(t + 2) * kstep;
            const char* a3 = a2 + kstep; const char* b3 = b2 + kstep;
            if (last && has_next) S.a_ready(nxt);
            if constexpr (SP2) {
            PG8_LDB(B0, 0, 0); PG8_LDB(B1, 0, 1); PG8_SCHED; PG8_LDA(At, 0, 0); PG8_STAGE(PG8_SA(1, 1), a1 + hstep, voffA);
            PG8_WAIT_V(8); PG8_WAIT_L(0); PG8_BAR; PG8_MMA(0, 0, At, B0); PG8_MMA(0, 1, At, B1); PG8_BAR; PG8_SCHED;
            PG8_LDA(At, 0, 1); PG8_STAGE(PG8_SB(0, 0), b2, voffB); PG8_STAGE(PG8_SB(0, 1), b2 + hstep, voffB); PG8_STAGE(PG8_SA(0, 0), a2, voffA);
            PG8_WAIT_V(8); PG8_WAIT_L(0); PG8_BAR; PG8_MMA(1, 0, At, B0); PG8_MMA(1, 1, At, B1); PG8_BAR; PG8_SCHED;
            PG8_LDB(B0, 1, 0); PG8_LDB(B1, 1, 1); PG8_SCHED; PG8_LDA(At, 1, 0); PG8_STAGE(PG8_SA(0, 1), a2 + hstep, voffA);
            PG8_WAIT_V(8); PG8_WAIT_L(0); PG8_BAR; PG8_MMA(0, 0, At, B0); PG8_MMA(0, 1, At, B1); PG8_BAR; PG8_SCHED;
            PG8_LDA(At, 1, 1); PG8_STAGE(PG8_SB(1, 0), b3, voffB); PG8_STAGE(PG8_SB(1, 1), b3 + hstep, voffB); PG8_STAGE(PG8_SA(1, 0), a3, voffA);
            PG8_WAIT_V(8); PG8_WAIT_L(0); PG8_BAR; PG8_MMA(1, 0, At, B0); PG8_MMA(1, 1, At, B1); PG8_BAR; PG8_SCHED;
            } else {
            PG8_LDB(B0, 0, 0); PG8_SCHED; PG8_LDA(At, 0, 0); PG8_STAGE(PG8_SA(1, 1), a1 + hstep, voffA);
            PG8_WAIT_L(8); PG8_BAR; PG8_WAIT_L(0); PG8_MMA(0, 0, At, B0); PG8_BAR; PG8_SCHED;
            PG8_LDB(B1, 0, 1); PG8_STAGE(PG8_SB(0, 0), b2, voffB);
            PG8_BAR; PG8_WAIT_L(0); PG8_MMA(0, 1, At, B1); PG8_BAR;
            PG8_LDA(At, 0, 1); PG8_STAGE(PG8_SA(0, 0), a2, voffA);
            PG8_BAR; PG8_WAIT_L(0); PG8_MMA(1, 0, At, B0); PG8_BAR; PG8_SCHED;
            PG8_STAGE(PG8_SB(0, 1), b2 + hstep, voffB);
            PG8_WAIT_V(6); PG8_BAR; PG8_MMA(1, 1, At, B1); PG8_BAR;
            PG8_LDB(B0, 1, 0); PG8_SCHED; PG8_LDA(At, 1, 0); PG8_STAGE(PG8_SA(0, 1), a2 + hstep, voffA);
            PG8_WAIT_L(8); PG8_BAR; PG8_WAIT_L(0); PG8_MMA(0, 0, At, B0); PG8_BAR; PG8_SCHED;
            PG8_LDB(B1, 1, 1); PG8_STAGE(PG8_SB(1, 0), b3, voffB);
            PG8_BAR; PG8_WAIT_L(0); PG8_MMA(0, 1, At, B1); PG8_BAR;
            PG8_LDA(At, 1, 1); PG8_STAGE(PG8_SA(1, 0), a3, voffA);
            PG8_BAR; PG8_WAIT_L(0); PG8_MMA(1, 0, At, B0); PG8_BAR; PG8_SCHED;
            PG8_STAGE(PG8_SB(1, 1), b3 + hstep, voffB);
            PG8_WAIT_V(6); PG8_BAR; PG8_MMA(1, 1, At, B1); PG8_BAR;
            }
        }
        if constexpr (ALIGN_EPI) { if (wr == 0) PG8_BAR; }
        if constexpr (!Epi::AFTER_DRAIN) { E(acc, cur, wr, wc, fr, fq); S.done(cur); }
        if (!has_next) break;
#pragma unroll
        for (int a = 0; a < 2; ++a)
#pragma unroll
            for (int b = 0; b < 2; ++b)
#pragma unroll
                for (int m = 0; m < 4; ++m)
#pragma unroll
                    for (int n = 0; n < 2; ++n) acc[a][b][m][n] = (f32x4){0.f, 0.f, 0.f, 0.f};
        cur = nxt; cA = nA; cB = nB; ++ui;
        if constexpr (ALIGN_EPI) { if (wr == 1) PG8_BAR; }
    }
    PG8_WAIT_V(0);
    if constexpr (!ALIGN_EPI) { if (wr == 0) PG8_BAR; }
    PG8_BAR;
    if constexpr (Epi::AFTER_DRAIN) { E.fused(acc, cur, wr, wc, fr, fq, lds, wid, lane); S.done(cur); }
#undef PG8_SA
#undef PG8_SB
#undef PG8_STAGE
#undef PG8_LDA
#undef PG8_LDB
#undef PG8_MMA
#undef PG8_WAIT_V
#undef PG8_WAIT_L
#undef PG8_BAR
#undef PG8_SCHED
}
}

#define GAS __attribute__((address_space(1)))
#define LAS __attribute__((address_space(3)))
typedef unsigned short bf16;
typedef unsigned v4u __attribute__((ext_vector_type(4)));
typedef unsigned v2u __attribute__((ext_vector_type(2)));
typedef float f32x4 __attribute__((ext_vector_type(4)));
typedef short bf16x8 __attribute__((ext_vector_type(8)));
typedef GAS unsigned gu32;
#define RLX_AGENT __ATOMIC_RELAXED, __HIP_MEMORY_SCOPE_AGENT
#define LDS_WAIT() asm volatile("s_waitcnt lgkmcnt(0)" ::: "memory")
#define VM_WAIT() asm volatile("s_waitcnt vmcnt(0)" ::: "memory")
__device__ __forceinline__ unsigned f2bf(float f) { unsigned u = __builtin_bit_cast(unsigned, f); return (u + 0x7fffu + ((u >> 16) & 1u)) >> 16; }
__device__ __forceinline__ unsigned pk2(float lo, float hi) { return f2bf(lo) | (f2bf(hi) << 16); }
__device__ __forceinline__ float bf2f(unsigned h) { return __builtin_bit_cast(float, h << 16); }
__device__ __forceinline__ float bflo(unsigned w) { return __builtin_bit_cast(float, w << 16); }
__device__ __forceinline__ float bfhi(unsigned w) { return __builtin_bit_cast(float, w & 0xffff0000u); }
__device__ __forceinline__ float wave_sum(float v) {
#define WS_DPP(ctrl, rmask) v += __builtin_bit_cast(float, __builtin_amdgcn_update_dpp(0, __builtin_bit_cast(int, v), ctrl, rmask, 0xf, false))
    WS_DPP(0xB1, 0xf); WS_DPP(0x4E, 0xf); WS_DPP(0x141, 0xf); WS_DPP(0x140, 0xf); WS_DPP(0x142, 0xa); WS_DPP(0x143, 0xc);
#undef WS_DPP
    return __builtin_bit_cast(float, __builtin_amdgcn_readlane(__builtin_bit_cast(int, v), 63));
}
__device__ __forceinline__ float silu_acc(float x) { return x / (1.0f + __expf(-x)); }

#define XB_TMO      128
#define XB_XCNT(j)  (256  + 64 * (j))
#define XB_XSUB(j)  (1280 + 64 * (j))
#define XB_XGEN(j)  (2304 + 64 * (j))
#define XB_TOP      3328
#define XB_TOPGEN   3392
#define XCD_BAR_WORDS 3456
#define XB_SPIN_CAP (1u << 18)
__device__ __forceinline__ unsigned xb_ld(unsigned* p)              { return __hip_atomic_load(p, __ATOMIC_RELAXED, __HIP_MEMORY_SCOPE_AGENT); }
__device__ __forceinline__ unsigned xb_add(unsigned* p, unsigned v) { return __hip_atomic_fetch_add(p, v, __ATOMIC_RELAXED, __HIP_MEMORY_SCOPE_AGENT); }
__device__ __forceinline__ unsigned xb_xcc_id() { return (unsigned)__builtin_amdgcn_s_getreg((3 << 11) | 20) & 0xFu; }
#define XB_SPIN(cond, bar) do { unsigned _sp = 0; while (cond) { __builtin_amdgcn_s_sleep(1); \
    if ((++_sp & 255u) == 0u) { if (xb_ld(&(bar)[XB_TMO])) break; if (_sp > XB_SPIN_CAP) { atomicAdd(&(bar)[XB_TMO], 1u); break; } } } } while (0)
struct XcdBarrier { unsigned* bar; unsigned x; volatile LAS unsigned* st; };
__device__ __forceinline__ XcdBarrier xcd_barrier_post(unsigned* bar, volatile LAS unsigned* st) {
    XcdBarrier b; b.bar = bar; b.x = xb_xcc_id(); b.st = st;
    if (threadIdx.x == 0) (void)xb_add(&bar[XB_XCNT(b.x)], 1u);
    return b;
}
__device__ __forceinline__ void xcd_barrier_complete(unsigned* bar, unsigned x, unsigned& nloc, unsigned& nx) {
    const unsigned G = gridDim.x * gridDim.y * gridDim.z;
    unsigned sum, cnt, mine, sp = 0u;
    for (;;) {
        sum = 0u; cnt = 0u; mine = 0u;
#pragma unroll
        for (unsigned j = 0; j < 16; ++j) { const unsigned c = xb_ld(&bar[XB_XCNT(j)]); sum += c; cnt += (c > 0u) ? 1u : 0u; mine = (j == x) ? c : mine; }
        if (sum == G) break;
        __builtin_amdgcn_s_sleep(1);
        if ((++sp & 255u) == 0u) { if (xb_ld(&bar[XB_TMO])) break; if (sp > XB_SPIN_CAP) { atomicAdd(&bar[XB_TMO], 1u); break; } }
    }
    nloc = mine > 0u ? mine : 1u; nx = cnt > 0u ? cnt : 1u;
}
__device__ __forceinline__ void xcd_barrier(const XcdBarrier& b) {
    asm volatile("s_waitcnt vmcnt(0)" ::: "memory");
    __syncthreads();
    if (threadIdx.x == 0) {
        unsigned* bar = b.bar;
        __builtin_amdgcn_s_waitcnt(0);
        unsigned nloc = b.st[0], nx = b.st[1];
        if (nloc == 0u) { xcd_barrier_complete(bar, b.x, nloc, nx); b.st[0] = nloc; b.st[1] = nx; }
        const unsigned old = xb_add(&bar[XB_XSUB(b.x)], 1u);
        const unsigned gen = old / nloc;
        if (old + 1u == (gen + 1u) * nloc) {
            __builtin_amdgcn_fence(__ATOMIC_RELEASE, "agent");
            asm volatile("s_waitcnt vmcnt(0)" ::: "memory");
            const unsigned og = xb_add(&bar[XB_TOP], 1u);
            const unsigned tg = og / nx;
            if (og + 1u == (tg + 1u) * nx) xb_add(&bar[XB_TOPGEN], 1u);
            else XB_SPIN(xb_ld(&bar[XB_TOPGEN]) == tg, bar);
            __builtin_amdgcn_fence(__ATOMIC_ACQUIRE, "agent");
            xb_add(&bar[XB_XGEN(b.x)], 1u);
            asm volatile("s_waitcnt vmcnt(0)" ::: "memory");
        } else {
            XB_SPIN(xb_ld(&bar[XB_XGEN(b.x)]) == gen, bar);
            __builtin_amdgcn_fence(__ATOMIC_ACQUIRE, "agent");
            asm volatile("s_waitcnt vmcnt(0)" ::: "memory");
        }
    }
    __syncthreads();
}

struct Args { const float* in[N_IN]; float* out; unsigned char* ws; int ph_lo, ph_hi; };

struct TrItem { const float* src; bf16* dst; int N, Kd; };
__device__ __forceinline__ TrItem tr_make(const float* W, int N, bf16* WT, int Kd, int kb, int nb, int mode) {
    const int k0 = 64 * kb, n0 = 32 * nb; const int drow0 = mode == 0 ? n0 : ((n0 >> 7) * 256 + (n0 & 127) + (mode == 2 ? 128 : 0));
    TrItem t; t.src = W + (size_t)k0 * N + n0; t.dst = WT + (size_t)drow0 * Kd + k0; t.N = N; t.Kd = Kd; return t;
}
__device__ __forceinline__ void tr_load(const TrItem& t, float (&tv)[32], int lane) {
#pragma unroll
    for (int i = 0; i < 32; ++i) tv[i] = t.src[(size_t)(2 * i + (lane >> 5)) * t.N + (lane & 31)];
}
__device__ __forceinline__ void tr_finish(const TrItem& t, const float (&tv)[32], LAS float* scr, int lane) {
#pragma unroll
    for (int i = 0; i < 32; ++i) scr[(2 * i + (lane >> 5)) * 33 + (lane & 31)] = tv[i];
    LDS_WAIT(); asm volatile("" ::: "memory");
    const int c = lane & 7;
#pragma unroll
    for (int j = 0; j < 4; ++j) { const int n = (lane >> 3) + 8 * j; const LAS float* s = scr + (8 * c) * 33 + n;
        v4u o; o.x = pk2(s[0 * 33], s[1 * 33]); o.y = pk2(s[2 * 33], s[3 * 33]); o.z = pk2(s[4 * 33], s[5 * 33]); o.w = pk2(s[6 * 33], s[7 * 33]);
        *(v4u*)(t.dst + (size_t)n * t.Kd + 8 * c) = o; }
    LDS_WAIT(); asm volatile("" ::: "memory");
}

__device__ __forceinline__ void p0_prologue(const Args& a, LAS unsigned char* lds, int gw, int NGW, int wave, int lane, const bool with_j3) {
    unsigned char* ws = a.ws;
    LAS float* scr = (LAS float*)(lds + wave * 16384);
    constexpr int I_G = 16 * 88, I_D = 44 * 32, I_FF = 3 * I_G, I_IN = 16 * 64, I_OUT = 12 * 32, I_L = 2 * I_FF + I_IN + I_OUT;
    static_assert(I_G == I_D, "items");
    auto j1_item = [&](int it) __attribute__((always_inline)) -> TrItem {
        const int l = it / I_L; int r = it % I_L;
        if (r < 2 * I_FF) {
            const int f = r / I_FF; r %= I_FF; const int part = r / I_G; r %= I_G;
            const size_t lo = (size_t)l * 1024 * 2816;
            if (part == 0)      return tr_make(a.in[f ? I_W2G : I_W1G] + lo, 2816, (bf16*)(ws + WS_WGU) + (size_t)(l * 2 + f) * 5632 * 1024, 1024, r / 88, r % 88, 1);
            else if (part == 1) return tr_make(a.in[f ? I_W2U : I_W1U] + lo, 2816, (bf16*)(ws + WS_WGU) + (size_t)(l * 2 + f) * 5632 * 1024, 1024, r / 88, r % 88, 2);
            else                return tr_make(a.in[f ? I_W2D : I_W1D] + lo, 1024, (bf16*)(ws + WS_WD) + (size_t)(l * 2 + f) * 1024 * 2816, 2816, r / 32, r % 32, 0);
        }
        r -= 2 * I_FF;
        if (r < I_IN) return tr_make(a.in[I_WIN] + (size_t)l * 1024 * 2048, 2048, (bf16*)(ws + WS_WIN) + (size_t)l * 2048 * 1024, 1024, r / 64, r % 64, 0);
        r -= I_IN; int kb = r / 32; if (kb >= 8) kb += 4;
        return tr_make(a.in[I_WOUT] + (size_t)l * 1024 * 1024, 1024, (bf16*)(ws + WS_WOUT) + (size_t)l * 1024 * 1024, 1024, kb, r % 32, 0);
    };
    const bool lowv = (NGW == 2048) && gw < 1152; const bool split = (NGW == 2048);
    const int j_lo = split ? (lowv ? 0 : 9216) : 0, j_hi = split ? (lowv ? 9216 : 2 * I_L) : 2 * I_L, j_gw = split ? (lowv ? gw : gw - 1152) : gw, j_st = split ? (lowv ? 1152 : 896) : NGW;
    if (j_lo + j_gw < j_hi) {
        TrItem cur = j1_item(j_lo + j_gw); float tv[32]; tr_load(cur, tv, lane);
        for (int it = j_lo + j_gw; it < j_hi; it += j_st) {
            const bool more = it + j_st < j_hi;
            TrItem nxt = cur; float tn[32];
            if (more) { nxt = j1_item(it + j_st); tr_load(nxt, tn, lane); }
            tr_finish(cur, tv, scr, lane);
            if (more) { cur = nxt;
#pragma unroll
                for (int i = 0; i < 32; ++i) tv[i] = tn[i]; }
        }
    }
    for (int it = gw; it < 2 * 256 * 4; it += NGW) {
        const int l = it >> 10, kp = (it >> 2) & 255, nc = it & 3;
        const float* pw = a.in[I_CPW] + (size_t)l * 65536 + kp * 256;
        const float* wo = a.in[I_WOUT] + (size_t)l * 1048576 + (size_t)512 * 1024 + nc * 256 + lane * 4;
        f32x4 acc = {0.f, 0.f, 0.f, 0.f};
#pragma unroll 8
        for (int j = 0; j < 256; ++j) acc += pw[j] * *(const f32x4*)(wo + (size_t)j * 1024);
        bf16* dst = (bf16*)(ws + WS_WOUT) + (size_t)l * 1048576 + (size_t)(nc * 256 + lane * 4) * 1024 + 512 + kp;
        dst[0] = (bf16)f2bf(acc[0]); dst[1024] = (bf16)f2bf(acc[1]); dst[2048] = (bf16)f2bf(acc[2]); dst[3072] = (bf16)f2bf(acc[3]);
    }
    if (with_j3) {
        LAS float* sl = (LAS float*)(lds + wave * 16384);
        for (int it = gw; it < 2 * 36 * 16; it += NGW) {
            const int l = it / 576, r = it % 576, nch = r >> 4, ks = r & 15;
            const int n = nch * 256 + lane * 4;
            const float* wm = a.in[I_WMOD] + (size_t)l * 1024 * 9216 + (size_t)(ks * 64) * 9216 + n;
            sl[lane] = silu_acc(a.in[I_CCTX][ks * 64 + lane]);
#pragma unroll
            for (int c = 1; c < 9; ++c) sl[c * 64 + lane] = silu_acc(a.in[I_C][(c - 1) * 1024 + ks * 64 + lane]);
            LDS_WAIT(); asm volatile("" ::: "memory");
            f32x4 acc[9];
#pragma unroll
            for (int c = 0; c < 9; ++c) acc[c] = (f32x4){0.f, 0.f, 0.f, 0.f};
#pragma unroll 1
            for (int kb = 0; kb < 4; ++kb) {
                f32x4 w[16];
#pragma unroll
                for (int k = 0; k < 16; ++k) w[k] = *(const f32x4*)(wm + (size_t)(kb * 16 + k) * 9216);
#pragma unroll
                for (int k = 0; k < 16; ++k)
#pragma unroll
                    for (int c = 0; c < 9; ++c) acc[c] += sl[c * 64 + kb * 16 + k] * w[k];
            }
            float* mod = (float*)(ws + WS_MOD) + (size_t)l * 9 * 9216 + n;
            f32x4 bm = {0.f, 0.f, 0.f, 0.f}; if (ks == 0) bm = *(const f32x4*)(a.in[I_BMOD] + l * 9216 + n);
#pragma unroll
            for (int c = 0; c < 9; ++c)
#pragma unroll
                for (int j = 0; j < 4; ++j) atomicAdd(mod + c * 9216 + j, acc[c][j] + bm[j]);
            LDS_WAIT(); asm volatile("" ::: "memory");
        }
    }
    {
        const int gt = gw * 64 + lane, NGT = NGW * 64;
        for (int e = gt; e < 2 * 8 * 256 * 128; e += NGT) {
            const int gd = e & 127, p = (e >> 7) & 255, b = (e >> 15) & 7, l = e >> 18;
            const size_t src = (((size_t)b * 2 + l) * 256 + p) * 128 + gd;
            const float kv = a.in[I_CK][src], vv = a.in[I_CV][src];
            ((bf16*)(ws + WS_CKB))[e] = (bf16)f2bf(kv);
            ((bf16*)(ws + WS_CVT))[(((size_t)l * 8 + b) * 128 + gd) * 256 + p] = (bf16)f2bf(vv);
        }
        for (int e = gt; e < 1024; e += NGT) { const int p = e >> 4, i = e & 15; const float inv = powf(10000.0f, -(float)i / 16.0f); const float ang = (float)p * inv;
            ((float*)(ws + WS_ROPE))[2 * e] = cosf(ang); ((float*)(ws + WS_ROPE))[2 * e + 1] = sinf(ang); }
    }
    for (int it = gw; it < 2 * 2304; it += NGW) {
        const int l = it / 2304, tt = it % 2304; const int L = tt < 2048 ? 2048 : 256, t = tt < 2048 ? tt : tt - 2048;
        const float tf = (float)t, tn = tf / (float)(L - 1);
        const float* w1 = a.in[I_HW1] + l * 33 * 64; const float* w2 = a.in[I_HW2] + l * 64 * 64;
        float s1 = tn * w1[lane];
#pragma unroll 4
        for (int i = 0; i < 16; ++i) { const float band = 1e-4f + (float)i * ((15.0f - 1e-4f) / 15.0f); const float ang = (6.283185307179586f * tf) * band / (float)L;
            s1 += cosf(ang) * w1[(1 + i) * 64 + lane] - sinf(ang) * w1[(17 + i) * 64 + lane]; }
        const float h1 = sinf(a.in[I_HF1][l * 64 + lane] * (s1 + a.in[I_HB1][l * 64 + lane]));
        float s2 = 0.f;
#pragma unroll 8
        for (int k = 0; k < 64; ++k) s2 += __shfl(h1, k) * w2[k * 64 + lane];
        const float h2 = sinf(a.in[I_HF2][l * 64 + lane] * (s2 + a.in[I_HB2][l * 64 + lane]));
        ((float*)(ws + WS_HYH))[(size_t)it * 64 + lane] = h2;
    }
}

__device__ __forceinline__ void prep_phase(const float* src0, const float* src1, const float* g, const float* mod, int sc_chunk, bf16* H, float* ss, int r_lo, int r_hi, int gw, int NGW, int lane) {
    const int per = (r_hi - r_lo + NGW - 1) / NGW; int r = r_lo + gw * per; r_hi = (r + per < r_hi) ? r + per : r_hi; NGW = 1;
    if (r >= r_hi) return;
    f32x4 v[4], v1[4], v2[4];
#define PREP_LOAD(dst, row) do { const int rr_ = (row); if (rr_ < r_hi) { const float* xr_ = rr_ < MCTX ? src0 + (size_t)rr_ * D : src1 + (size_t)(rr_ - MCTX) * D; \
        _Pragma("unroll") for (int j = 0; j < 4; ++j) dst[j] = ((const f32x4*)xr_)[lane + 64 * j]; } } while (0)
    PREP_LOAD(v, r); PREP_LOAD(v1, r + NGW);
    for (; r < r_hi; r += NGW) {
        PREP_LOAD(v2, r + 2 * NGW);
        const int cond = r < MCTX ? 0 : 1 + ((r - MCTX) >> 11);
        const float* sc = mod + cond * 9216 + sc_chunk * 1024;
        float s = 0.f;
#pragma unroll
        for (int j = 0; j < 4; ++j) s += (v[j][0] * v[j][0] + v[j][1] * v[j][1]) + (v[j][2] * v[j][2] + v[j][3] * v[j][3]);
        s = wave_sum(s); if (lane == 0) ss[r] = s;
#pragma unroll
        for (int j = 0; j < 4; ++j) { const int col = 4 * (lane + 64 * j);
            const f32x4 o = v[j] * *(const f32x4*)(g + col) * (*(const f32x4*)(sc + col) + 1.0f);
            v2u w; w.x = pk2(o[0], o[1]); w.y = pk2(o[2], o[3]); *(v2u*)(H + (size_t)r * D + col) = w; }
#pragma unroll
        for (int j = 0; j < 4; ++j) { v[j] = v1[j]; v1[j] = v2[j]; }
    }
#undef PREP_LOAD
}
__device__ __forceinline__ void bias_phase(const Args& a, int it_lo, int it_hi, int gw, int NGW, int lane) {
    unsigned char* ws = a.ws;
    const int i = lane & 15, q = lane >> 4;
    for (int it = it_lo + gw; it < it_hi; it += NGW) {
        const int l = it / 832; int r = it % 832; int which, n0;
        if (r < 352) { which = 0; n0 = r * 16; } else if (r < 480) { which = 1; n0 = (r - 352) * 16; } else { which = 2; n0 = (r - 480) * 16; }
        const bf16* Wt = which == 1 ? (const bf16*)(ws + WS_WIN) + (size_t)l * 2048 * 1024 : (const bf16*)(ws + WS_WGU) + (size_t)(l * 2 + (which == 2 ? 1 : 0)) * 5632 * 1024;
        const int shc = which == 0 ? 0 : (which == 1 ? 3 : 6), off = which == 0 ? 0 : (which == 1 ? 50688 : 69120), bst = which == 1 ? 2048 : 5632;
        const float* shp = (const float*)(ws + WS_MOD) + (size_t)l * 9 * 9216 + (size_t)(i < 9 ? i : 0) * 9216 + shc * 1024 + 8 * q;
        const bf16* wp = Wt + (size_t)(n0 + i) * 1024 + 8 * q;
        f32x4 acc = {0.f, 0.f, 0.f, 0.f};
#pragma unroll 8
        for (int st = 0; st < 32; ++st) {
            const f32x4 s0 = *(const f32x4*)(shp + 32 * st), s1 = *(const f32x4*)(shp + 32 * st + 4);
            const v4u wv = *(const v4u*)(wp + 32 * st);
            v4u av; av.x = pk2(s0[0], s0[1]); av.y = pk2(s0[2], s0[3]); av.z = pk2(s1[0], s1[1]); av.w = pk2(s1[2], s1[3]);
            if (i >= 9) av = (v4u){0u, 0u, 0u, 0u};
            acc = __builtin_amdgcn_mfma_f32_16x16x32_bf16(__builtin_bit_cast(bf16x8, av), __builtin_bit_cast(bf16x8, wv), acc, 0, 0, 0);
        }
        float* bo = (float*)(ws + WS_BIAS) + (size_t)l * 119808 + off + n0 + i;
#pragma unroll
        for (int rg = 0; rg < 4; ++rg) { const int cond = 4 * q + rg; if (cond < 9) bo[(size_t)cond * bst] = acc[rg]; }
    }
}
__device__ __forceinline__ void gct_phase(const Args& a, int gw, int NGW, int lane) {
    const int gt = gw * 64 + lane, NGT = NGW * 64;
    for (int e = gt; e < 6 * 9 * 1024; e += NGT) {
        const int inst = e / 9216, r = e % 9216, cond = r >> 10, col = r & 1023;
        float v = 0.f;
        if (inst >= 1) { const int l = inst / 3, k = inst % 3;
            const float g = (k == 0 ? a.in[I_GF1] : (k == 1 ? a.in[I_GMIX] : a.in[I_GF2]))[l * 1024 + col];
            const float sc = ((const float*)(a.ws + WS_MOD))[(size_t)l * 9 * 9216 + cond * 9216 + (k == 0 ? 1 : (k == 1 ? 4 : 7)) * 1024 + col];
            v = g * (1.0f + sc); }
        ((float*)(a.ws + WS_GCT))[e] = v;
    }
}
__device__ __forceinline__ void final_norm_phase(float* X, const float* g, const float* ss, int gw, int NGW, int lane) {
    for (int r = gw; r < M; r += NGW) {
        float* xr = X + (size_t)r * D;
        const float rstd = 1.0f / sqrtf(ss[r] * (1.0f / D) + EPS);
#pragma unroll
        for (int j = 0; j < 4; ++j) { const int col = 4 * (lane + 64 * j); ((f32x4*)xr)[lane + 64 * j] = (((const f32x4*)xr)[lane + 64 * j] * rstd) * *(const f32x4*)(g + col); }
    }
}

__device__ __forceinline__ void hyena_filter_phase(const Args& a, LAS unsigned char* lds, int gw, int NGW, int wave, int lane) {
    unsigned char* ws = a.ws;
    LAS float* hs = (LAS float*)(lds + wave * 16384);
    for (int it = gw; it < 2 * 36 * 16; it += NGW) {
        const int l = it / 576, r = it % 576, tc = r >> 4, ng = r & 15;
        const int stream = tc < 32 ? 0 : 1; const int L = stream ? 256 : 2048; const int t0 = (stream ? tc - 32 : tc) * 64; const int soff = stream ? 4096 : 0;
        const int n = ng * 64 + lane, o = n >> 9, dir = (n >> 8) & 1, c = n & 255;
        const float* hrow = (const float*)(ws + WS_HYH) + ((size_t)l * 2304 + (stream ? 2048 : 0) + t0) * 64;
        f32x4 hv[16];
#pragma unroll
        for (int i = 0; i < 16; ++i) hv[i] = ((const f32x4*)hrow)[i * 64 + lane];
        const float* w3 = a.in[I_HW3] + (size_t)l * 64 * 1024 + n;
        float w[64];
#pragma unroll
        for (int k = 0; k < 64; ++k) w[k] = w3[k * 1024];
        const float ndecay = -__expf(a.in[I_HLD][l * 1024 + n]) / (float)(L - 1);
#pragma unroll
        for (int i = 0; i < 16; ++i) *(LAS f32x4*)(hs + (i * 64 + lane) * 4) = hv[i];
        LDS_WAIT(); asm volatile("" ::: "memory");
        bf16* dst = (bf16*)(ws + WS_HYRAW) + ((size_t)(l * 2 + o) * 256 + c) * 4608 + soff;
        float sq = 0.f;
        for (int tt = 0; tt < 64; ++tt) {
            const int t = t0 + tt; float dot = 0.f;
#pragma unroll
            for (int k4 = 0; k4 < 16; ++k4) { const f32x4 h = *(const LAS f32x4*)(hs + tt * 64 + k4 * 4); dot += (h[0] * w[4 * k4] + h[1] * w[4 * k4 + 1]) + (h[2] * w[4 * k4 + 2] + h[3] * w[4 * k4 + 3]); }
            const float val = dot * __expf((float)t * ndecay);
            sq += val * val;
            if (dir == 0) dst[L - 1 - t] = (bf16)f2bf(val);
            else if (t > 0) dst[L - 1 + t] = (bf16)f2bf(val);
            else dst[2 * L - 1] = 0;
        }
        atomicAdd((float*)(ws + WS_SUMSQ) + ((l * 2 + stream) * 2 + o) * 256 + c, sq);
        LDS_WAIT(); asm volatile("" ::: "memory");
    }
}

__device__ __forceinline__ void conv_phase(const Args& a, int l, const bf16* Z, bf16* CAT, LAS unsigned char* lds, int tid) {
    LAS float* ybuf = (LAS float*)lds;
    LAS float* cbuf = (LAS float*)(lds + 65536);
    const float* dw = a.in[I_CDW] + l * 31 * 256; const float* dwb = a.in[I_CDWB] + l * 256; const float* lng = a.in[I_CLNG] + l * 256; const float* lnb = a.in[I_CLNB] + l * 256;
    const int lane = tid & 63, wave = tid >> 6;
    for (int u = blockIdx.x; u < M / 32; u += gridDim.x) {
        const int r0 = u * 32;
        const int seq0 = r0 < MCTX ? (r0 & ~255) : MCTX + ((r0 - MCTX) & ~2047); const int seq1 = seq0 + (r0 < MCTX ? 256 : 2048);
        for (int e = tid; e < 62 * 32; e += NTHREADS) {
            const int rr = e >> 5, ch = e & 31; const int row = r0 - 15 + rr;
            float y[8];
            if (row >= seq0 && row < seq1) {
                const v4u av = *(const v4u*)(Z + (size_t)row * ZW + 768 + ch * 8), gv = *(const v4u*)(Z + (size_t)row * ZW + 1024 + ch * 8);
                const float af[8] = {bflo(av.x), bfhi(av.x), bflo(av.y), bfhi(av.y), bflo(av.z), bfhi(av.z), bflo(av.w), bfhi(av.w)};
                const float gf[8] = {bflo(gv.x), bfhi(gv.x), bflo(gv.y), bfhi(gv.y), bflo(gv.z), bfhi(gv.z), bflo(gv.w), bfhi(gv.w)};
#pragma unroll
                for (int j = 0; j < 8; ++j) y[j] = af[j] / (1.0f + __expf(-gf[j]));
            } else {
#pragma unroll
                for (int j = 0; j < 8; ++j) y[j] = 0.f;
            }
            *(LAS f32x4*)(ybuf + rr * 256 + ch * 8) = (f32x4){y[0], y[1], y[2], y[3]}; *(LAS f32x4*)(ybuf + rr * 256 + ch * 8 + 4) = (f32x4){y[4], y[5], y[6], y[7]};
        }
        __syncthreads();
        { const int c = tid & 255, half = tid >> 8;
          float w[31];
#pragma unroll
          for (int k = 0; k < 31; ++k) w[k] = dw[k * 256 + c];
          const float bias = dwb[c];
          float yv[46];
#pragma unroll
          for (int i = 0; i < 46; ++i) yv[i] = ybuf[(half * 16 + i) * 256 + c];
#pragma unroll
          for (int t = 0; t < 16; ++t) { float s = bias;
#pragma unroll
              for (int k = 0; k < 31; ++k) s += w[k] * yv[t + k];
              cbuf[(half * 16 + t) * 256 + c] = s; } }
        __syncthreads();
        for (int rr = wave * 4; rr < wave * 4 + 4; ++rr) {
            const f32x4 x = *(const LAS f32x4*)(cbuf + rr * 256 + lane * 4);
            const float mu = wave_sum((x[0] + x[1]) + (x[2] + x[3])) * (1.0f / 256.0f);
            const f32x4 dx = x - mu;
            const float var = wave_sum((dx[0] * dx[0] + dx[1] * dx[1]) + (dx[2] * dx[2] + dx[3] * dx[3])) * (1.0f / 256.0f);
            const float rstd = 1.0f / sqrtf(var + EPS);
            const f32x4 yv = dx * rstd * *(const f32x4*)(lng + lane * 4) + *(const f32x4*)(lnb + lane * 4);
            v2u wv; wv.x = pk2(silu_acc(yv[0]), silu_acc(yv[1])); wv.y = pk2(silu_acc(yv[2]), silu_acc(yv[3]));
            *(v2u*)(CAT + (size_t)(r0 + rr) * 1024 + 512 + lane * 4) = wv;
        }
        __syncthreads();
    }
}


typedef unsigned long long u64;
typedef u64 u64x2 __attribute__((ext_vector_type(2)));
template <int L> struct HyGeo {
    static constexpr int R = L / 128, NSTEP = L / 32, CS = 4 * L + 64, US = 2 * L + 32, OFF_U = 8 * CS;
};
template <int L>
__device__ __forceinline__ void hy_build_copies(LAS unsigned char* lds, const bf16* raw, int tid) {
    constexpr int CS = HyGeo<L>::CS;
    for (int p = tid; p < L / 4; p += NTHREADS) {
        const v4u a = *(const v4u*)(raw + 8 * p), b = *(const v4u*)(raw + 8 * p + 8);
        const unsigned w[8] = {a.x, a.y, a.z, a.w, b.x, b.y, b.z, b.w};
#pragma unroll
        for (int sg = 0; sg < 8; ++sg) { v4u o;
            if ((sg & 1) == 0) { o.x = w[sg / 2]; o.y = w[sg / 2 + 1]; o.z = w[sg / 2 + 2]; o.w = w[sg / 2 + 3]; }
            else { const int h = sg / 2; o.x = (w[h] >> 16) | (w[h + 1] << 16); o.y = (w[h + 1] >> 16) | (w[h + 2] << 16); o.z = (w[h + 2] >> 16) | (w[h + 3] << 16); o.w = (w[h + 3] >> 16) | (w[h + 4] << 16); }
            *(LAS v4u*)(lds + sg * CS + 16 * p) = o; }
    }
}
template <int L, int NB>
__device__ __forceinline__ void hy_toeplitz(LAS unsigned char* lds, int boff, f32x4 (&acc)[HyGeo<L>::R][NB > 8 ? 2 : 1], int wave, int lane) {
    constexpr int R = HyGeo<L>::R, NT = NB > 8 ? 2 : 1, NSTEP = HyGeo<L>::NSTEP, CS = HyGeo<L>::CS, US = HyGeo<L>::US;
    const int i = lane & 15, q = lane >> 4;
    const int abase = (7 - (i & 7)) * CS + 16 * ((L / 8 - 1) - (i >> 3) + q - 2 * R * wave);
    int bb[NT];
#pragma unroll
    for (int nt = 0; nt < NT; ++nt) bb[nt] = boff + ((NB > 8 ? nt * 16 + i : (i & 7))) * US + 16 * q;
    bf16x8 F[R];
#pragma unroll
    for (int e = 0; e < R; ++e) F[e] = *(const LAS bf16x8*)(lds + abase - 32 * e);
#pragma unroll
    for (int r = 0; r < R; ++r)
#pragma unroll
        for (int nt = 0; nt < NT; ++nt) acc[r][nt] = (f32x4){0.f, 0.f, 0.f, 0.f};
    bf16x8 B[2][NT];
#pragma unroll
    for (int nt = 0; nt < NT; ++nt) B[0][nt] = *(const LAS bf16x8*)(lds + bb[nt]);
#pragma unroll 1
    for (int jo = 0; jo < NSTEP; jo += 8) {
#pragma unroll
        for (int ji = 0; ji < 8; ++ji) {
            const int j = jo + ji; constexpr int dummy = 0; (void)dummy;
#pragma unroll
            for (int r = R - 2; r < R; ++r) { const int slot = (((r - 2 * ji) % R) + R) % R;
#pragma unroll
                for (int nt = 0; nt < NT; ++nt) acc[r][nt] = __builtin_amdgcn_mfma_f32_16x16x32_bf16(F[slot], B[ji & 1][nt], acc[r][nt], 0, 0, 0); }
            __builtin_amdgcn_sched_barrier(0);
            if (j + 1 < NSTEP) {
#pragma unroll
                for (int nt = 0; nt < NT; ++nt) B[(ji + 1) & 1][nt] = *(const LAS bf16x8*)(lds + bb[nt] + 64 * (j + 1));
#pragma unroll
                for (int rr = 0; rr < 2; ++rr) { const int slot = (((rr - 2 * (ji + 1)) % R) + R) % R; F[slot] = *(const LAS bf16x8*)(lds + abase + 64 * (j + 1) - 32 * rr); }
            }
            __builtin_amdgcn_sched_barrier(0);
#pragma unroll
            for (int r = 0; r < R - 2; ++r) { const int slot = (((r - 2 * ji) % R) + R) % R;
#pragma unroll
                for (int nt = 0; nt < NT; ++nt) acc[r][nt] = __builtin_amdgcn_mfma_f32_16x16x32_bf16(F[slot], B[ji & 1][nt], acc[r][nt], 0, 0, 0); }
            __builtin_amdgcn_sched_barrier(0);
        }
    }
}
struct XRaw { v2u z; unsigned zl, zr; };
__device__ __forceinline__ XRaw xraw_load(const bf16* zrow, int t, int L) { XRaw x; x.z = *(const v2u*)zrow; x.zl = t > 0 ? (unsigned)zrow[-1] : 0u; x.zr = t + 4 < L ? (unsigned)zrow[4] : 0u; return x; }
__device__ __forceinline__ void sconv4x(const XRaw& x, float w0, float w1, float w2, float sb, float (&out)[4]) {
    const float zl = bf2f(x.zl), zr = bf2f(x.zr), z0 = bflo(x.z.x), z1 = bfhi(x.z.x), z2 = bflo(x.z.y), z3 = bfhi(x.z.y);
    out[0] = sb + w0 * zl + w1 * z0 + w2 * z1; out[1] = sb + w0 * z0 + w1 * z1 + w2 * z2; out[2] = sb + w0 * z1 + w1 * z2 + w2 * z3; out[3] = sb + w0 * z2 + w1 * z3 + w2 * zr;
}
__device__ __forceinline__ void sconv4(const bf16* zrow, int t, int L, float w0, float w1, float w2, float sb, float (&out)[4]) { const XRaw x = xraw_load(zrow, t, L); sconv4x(x, w0, w1, w2, sb, out); }
template <int L>
__device__ __forceinline__ void hy_store_copies(LAS unsigned char* lds, const v4u a, const v4u b, int p) {
    constexpr int CS = HyGeo<L>::CS;
    const unsigned w[8] = {a.x, a.y, a.z, a.w, b.x, b.y, b.z, b.w};
#pragma unroll
    for (int sg = 0; sg < 8; ++sg) { v4u o;
        if ((sg & 1) == 0) { o.x = w[sg / 2]; o.y = w[sg / 2 + 1]; o.z = w[sg / 2 + 2]; o.w = w[sg / 2 + 3]; }
        else { const int h = sg / 2; o.x = (w[h] >> 16) | (w[h + 1] << 16); o.y = (w[h + 1] >> 16) | (w[h + 2] << 16); o.z = (w[h + 2] >> 16) | (w[h + 3] << 16); o.w = (w[h + 3] >> 16) | (w[h + 4] << 16); }
        *(LAS v4u*)(lds + sg * CS + 16 * p) = o; }
}
template <int L, int NB, bool DUP = false>
__device__ __forceinline__ void hyena_channel(const Args& a, int l, int c, const bf16* ZT, bf16* CAT, LAS unsigned char* lds, int tid, int wave, int lane) {
    constexpr int R = HyGeo<L>::R, NT = NB > 8 ? 2 : 1, US = HyGeo<L>::US, OFF_U = HyGeo<L>::OFF_U, OFF_Y = OFF_U + NB * US;
    constexpr bool LAT = (L == 2048); constexpr int stream = LAT ? 0 : 1; constexpr int rowbase = LAT ? MCTX : 0;
    static_assert(L / 4 <= NTHREADS, "one copy slot per thread");
    unsigned char* ws = a.ws;
    const float* sw = a.in[I_HSW] + l * 3 * 768; const float* sb = a.in[I_HSB] + l * 768;
    const bf16* raw0 = (const bf16*)(ws + WS_HYRAW) + ((size_t)(l * 2 + 0) * 256 + c) * 4608 + (LAT ? 0 : 4096);
    const bf16* raw1 = (const bf16*)(ws + WS_HYRAW) + ((size_t)(l * 2 + 1) * 256 + c) * 4608 + (LAT ? 0 : 4096);
    const int i = lane & 15;
    const bool cp = tid < L / 4;
    v4u f0a = {0u, 0u, 0u, 0u}, f0b = f0a, f1a = f0a, f1b = f0a;
    if (cp) { f0a = *(const v4u*)(raw0 + 8 * tid); f0b = *(const v4u*)(raw0 + 8 * tid + 8); f1a = *(const v4u*)(raw1 + 8 * tid); f1b = *(const v4u*)(raw1 + 8 * tid + 8); }
    __syncthreads();
    if (cp) hy_store_copies<L>(lds, f0a, f0b, tid);
    { const float w0 = sw[c], w1 = sw[768 + c], w2 = sw[1536 + c], b0 = sb[c];
      for (int idx = tid; idx < NB * (L / 8); idx += NTHREADS) {
          const int b = idx / (L / 8), s0 = (idx % (L / 8)) * 8; const bf16* zrow = ZT + (size_t)c * M + rowbase + b * L + s0;
          float o0[4], o1[4]; sconv4(zrow, s0, L, w0, w1, w2, b0, o0); sconv4(zrow + 4, s0 + 4, L, w0, w1, w2, b0, o1);
          v4u w; w.x = pk2(o0[0], o0[1]); w.y = pk2(o0[2], o0[3]); w.z = pk2(o1[0], o1[1]); w.w = pk2(o1[2], o1[3]);
          *(LAS v4u*)(lds + OFF_U + b * US + 2 * s0) = w; } }
    __syncthreads();
    f32x4 acc[R][NT];
    hy_toeplitz<L, NB>(lds, OFF_U, acc, wave, lane);
    if constexpr (DUP) { { _Pragma("unroll") for (int r_ = 0; r_ < R; ++r_) _Pragma("unroll") for (int n_ = 0; n_ < NT; ++n_) asm volatile("" : "+v"(acc[r_][n_])); } hy_toeplitz<L, NB>(lds, OFF_U, acc, wave, lane); }
    { const float scale = 1.0f / sqrtf(((const float*)(ws + WS_SUMSQ))[((l * 2 + stream) * 2 + 0) * 256 + c] + EPS), bias = a.in[I_HBIAS][(l * 2 + 0) * 256 + c];
      const float w0 = sw[256 + c], w1 = sw[768 + 256 + c], w2 = sw[1536 + 256 + c], b0 = sb[256 + c];
      int q = lane >> 4; asm volatile("" : "+v"(q));
#pragma unroll
      for (int nt = 0; nt < NT; ++nt) { const int b = nt * 16 + i;
          if (b < NB) {
#pragma unroll
              for (int r = 0; r < R; ++r) { const int t = 16 * (R * wave + r) + 4 * q;
                  float x1[4]; sconv4(ZT + (size_t)(256 + c) * M + rowbase + b * L + t, t, L, w0, w1, w2, b0, x1);
                  const v2u uv = *(const LAS v2u*)(lds + OFF_U + b * US + 2 * t);
                  const float y0 = x1[0] * (scale * acc[r][nt][0] + bias * bflo(uv.x)), y1 = x1[1] * (scale * acc[r][nt][1] + bias * bfhi(uv.x));
                  const float y2 = x1[2] * (scale * acc[r][nt][2] + bias * bflo(uv.y)), y3 = x1[3] * (scale * acc[r][nt][3] + bias * bfhi(uv.y));
                  v2u w; w.x = pk2(y0, y1); w.y = pk2(y2, y3); *(LAS v2u*)(lds + OFF_Y + b * US + 2 * t) = w; } } } }
    __syncthreads();
    if (cp) hy_store_copies<L>(lds, f1a, f1b, tid);
    __syncthreads();
    hy_toeplitz<L, NB>(lds, OFF_Y, acc, wave, lane);
    if constexpr (DUP) { { _Pragma("unroll") for (int r_ = 0; r_ < R; ++r_) _Pragma("unroll") for (int n_ = 0; n_ < NT; ++n_) asm volatile("" : "+v"(acc[r_][n_])); } hy_toeplitz<L, NB>(lds, OFF_Y, acc, wave, lane); }
    { const float scale = 1.0f / sqrtf(((const float*)(ws + WS_SUMSQ))[((l * 2 + stream) * 2 + 1) * 256 + c] + EPS), bias = a.in[I_HBIAS][(l * 2 + 1) * 256 + c];
      const float w0 = sw[512 + c], w1 = sw[768 + 512 + c], w2 = sw[1536 + 512 + c], b0 = sb[512 + c];
      int q = lane >> 4; asm volatile("" : "+v"(q));
#pragma unroll
      for (int nt = 0; nt < NT; ++nt) { const int b = nt * 16 + i;
          if (b < NB) {
#pragma unroll
              for (int r = 0; r < R; ++r) { const int t = 16 * (R * wave + r) + 4 * q;
                  float x2[4]; sconv4(ZT + (size_t)(512 + c) * M + rowbase + b * L + t, t, L, w0, w1, w2, b0, x2);
                  const v2u yv = *(const LAS v2u*)(lds + OFF_Y + b * US + 2 * t);
                  bf16* dst = CAT + (size_t)(rowbase + b * L + t) * 1024 + 768 + c;
                  dst[0]    = (bf16)f2bf(x2[0] * (scale * acc[r][nt][0] + bias * bflo(yv.x)));
                  dst[1024] = (bf16)f2bf(x2[1] * (scale * acc[r][nt][1] + bias * bfhi(yv.x)));
                  dst[2048] = (bf16)f2bf(x2[2] * (scale * acc[r][nt][2] + bias * bflo(yv.y)));
                  dst[3072] = (bf16)f2bf(x2[3] * (scale * acc[r][nt][3] + bias * bfhi(yv.y))); } } } }
    __syncthreads();
}

typedef float f32x16 __attribute__((ext_vector_type(16)));
constexpr int ATT_KP = 144, ATT_VP = 80, ATT_KB = 32 * ATT_KP, ATT_BUF = ATT_KB + 64 * ATT_VP;
__device__ __forceinline__ void attn_phase(const Args& a, int l, const bf16* Z, const bf16* ZT, bf16* CAT, LAS unsigned char* lds, int tid, int wave, int lane) {
    const bf16* CKB = (const bf16*)(a.ws + WS_CKB) + (size_t)l * 8 * 256 * 128; const bf16* CVT = (const bf16*)(a.ws + WS_CVT) + (size_t)l * 8 * 128 * 256;
    const int r = lane & 31, hh = lane >> 5;
    for (int it = blockIdx.x; it < 768; it += gridDim.x) {
        bool lat; int b, g, qb;
        if (it < 512) { lat = true; b = it >> 6; g = (it >> 5) & 1; qb = it & 31; }
        else { const int rr = it - 512; lat = false; b = rr >> 3; g = (rr >> 2) & 1; qb = rr & 3; }
        const int h = g * 4 + (wave & 3), q0 = qb * 64 + 32 * (wave >> 2);
        const int L = lat ? 2048 : 256, seq0 = lat ? MCTX + b * 2048 : b * 256;
        const int kt_lo = lat ? (qb * 64 - 128 < 0 ? 0 : qb * 64 - 128) : 0, kt_hi = lat ? (qb * 64 + 192 > L ? L : qb * 64 + 192) : 256;
        const int n_local = (kt_hi - kt_lo) >> 5, n_total = n_local + (lat ? 8 : 0);
        const bool isk = tid < 256; const int t2 = tid & 255;
        const bf16* src_loc = isk ? Z + (size_t)(seq0 + kt_lo + (t2 >> 3)) * ZW + 512 + g * 64 + (t2 & 7) * 8 : ZT + (size_t)(768 + g * 64 + (t2 >> 2)) * M + seq0 + kt_lo + (t2 & 3) * 8;
        const bf16* src_ctx = isk ? CKB + ((size_t)b * 256 + (t2 >> 3)) * 128 + g * 64 + (t2 & 7) * 8 : CVT + ((size_t)b * 128 + g * 64 + (t2 >> 2)) * 256 + (t2 & 3) * 8;
        const size_t step_loc = isk ? (size_t)32 * ZW : 32, step_ctx = isk ? (size_t)32 * 128 : 32;
        const int dst = isk ? (t2 >> 3) * ATT_KP + (t2 & 7) * 16 : ATT_KB + (t2 >> 2) * ATT_VP + ((t2 & 3) >> 1) * 32 + ((t2 & 3) & 1) * 8;
#define ATT_GLOAD(ti_) (*(const v4u*)((ti_) < n_local ? src_loc + (size_t)(ti_) * step_loc : src_ctx + (size_t)((ti_) - n_local) * step_ctx))
#define ATT_LSTORE(buf_, v_) do { LAS unsigned char* p_ = lds + (buf_) * ATT_BUF + dst; if (isk) *(LAS v4u*)p_ = (v_); else { v2u lo_, hi_; lo_.x = (v_).x; lo_.y = (v_).y; hi_.x = (v_).z; hi_.y = (v_).w; *(LAS v2u*)p_ = lo_; *(LAS v2u*)(p_ + 16) = hi_; } } while (0)
        bf16x8 qf[4];
        { const bf16* qp = Z + (size_t)(seq0 + q0 + r) * ZW + h * 64 + 8 * hh;
#pragma unroll
          for (int s = 0; s < 4; ++s) qf[s] = *(const bf16x8*)(qp + 16 * s); }
        f32x16 o0, o1;
#pragma unroll
        for (int e = 0; e < 16; ++e) { o0[e] = 0.f; o1[e] = 0.f; }
        float mrun = a.in[I_SINK][l * 8 + h] * LOG2E, lsum = 1.0f;
        __syncthreads();
        v4u g1 = {0u, 0u, 0u, 0u}, g2 = g1;
        { const v4u g0 = ATT_GLOAD(0); if (n_total > 1) g1 = ATT_GLOAD(1); if (n_total > 2) g2 = ATT_GLOAD(2); ATT_LSTORE(0, g0); }
        __syncthreads();
        for (int ti = 0; ti < n_total; ++ti) {
            v4u gn = {0u, 0u, 0u, 0u};
            if (ti + 3 < n_total) gn = ATT_GLOAD(ti + 3);
            const int kt = kt_lo + 32 * ti;
            const bool active = !lat || ti >= n_local || (kt >= q0 - 128 && kt <= q0 + 128);
            if (active) {
                const LAS unsigned char* kb = lds + (ti & 1) * ATT_BUF + r * ATT_KP + 16 * hh;
                const LAS unsigned char* vb = lds + (ti & 1) * ATT_BUF + ATT_KB + r * ATT_VP + 16 * hh;
                f32x16 st;
#pragma unroll
                for (int e = 0; e < 16; ++e) st[e] = 0.f;
#pragma unroll
                for (int s = 0; s < 4; ++s) st = __builtin_amdgcn_mfma_f32_32x32x16_bf16(*(const LAS bf16x8*)(kb + 32 * s), qf[s], st, 0, 0, 0);
                const bf16x8 v00 = *(const LAS bf16x8*)(vb), v01 = *(const LAS bf16x8*)(vb + 32), v10 = *(const LAS bf16x8*)(vb + 32 * ATT_VP), v11 = *(const LAS bf16x8*)(vb + 32 * ATT_VP + 32);
                if (lat && ti < n_local) {
                    if (kt == q0 - 128) {
#pragma unroll
                        for (int e = 0; e < 16; ++e) { const int jj = (e & 3) + 8 * (e >> 2) + 4 * hh; if (jj < r) st[e] = -1e30f; }
                    } else if (kt == q0 + 128) {
#pragma unroll
                        for (int e = 0; e < 16; ++e) { const int jj = (e & 3) + 8 * (e >> 2) + 4 * hh; if (jj > r) st[e] = -1e30f; }
                    }
                }
                float mx = fmaxf(fmaxf(st[0], st[1]), fmaxf(st[2], st[3]));
#pragma unroll
                for (int e = 4; e < 16; e += 4) mx = fmaxf(mx, fmaxf(fmaxf(st[e], st[e + 1]), fmaxf(st[e + 2], st[e + 3])));
                mx = fmaxf(mx, __shfl_xor(mx, 32));
                const float mn = fmaxf(mrun, mx); const bool grew = __any(mn > mrun);
                const float alpha = grew ? __builtin_amdgcn_exp2f(mrun - mn) : 1.0f; mrun = mn;
                float ps = 0.f;
#pragma unroll
                for (int e = 0; e < 16; ++e) { st[e] = __builtin_amdgcn_exp2f(st[e] - mn); ps += st[e]; }
                ps += __shfl_xor(ps, 32);
                lsum = lsum * alpha + ps;
                if (grew) {
#pragma unroll
                    for (int e = 0; e < 16; ++e) { o0[e] *= alpha; o1[e] *= alpha; } }
                v4u pa, pb;
                pa.x = pk2(st[0], st[1]); pa.y = pk2(st[2], st[3]); pa.z = pk2(st[4], st[5]); pa.w = pk2(st[6], st[7]);
                pb.x = pk2(st[8], st[9]); pb.y = pk2(st[10], st[11]); pb.z = pk2(st[12], st[13]); pb.w = pk2(st[14], st[15]);
                const bf16x8 p0 = __builtin_bit_cast(bf16x8, pa), p1 = __builtin_bit_cast(bf16x8, pb);
                o0 = __builtin_amdgcn_mfma_f32_32x32x16_bf16(v00, p0, o0, 0, 0, 0);
                o0 = __builtin_amdgcn_mfma_f32_32x32x16_bf16(v01, p1, o0, 0, 0, 0);
                o1 = __builtin_amdgcn_mfma_f32_32x32x16_bf16(v10, p0, o1, 0, 0, 0);
                o1 = __builtin_amdgcn_mfma_f32_32x32x16_bf16(v11, p1, o1, 0, 0, 0);
            }
            if (ti + 1 < n_total) ATT_LSTORE((ti + 1) & 1, g1);
            g1 = g2; g2 = gn;
            __syncthreads();
        }
#undef ATT_GLOAD
#undef ATT_LSTORE
        const float inv = 1.0f / lsum;
        bf16* op = CAT + (size_t)(seq0 + q0 + r) * 1024 + h * 64 + 4 * hh;
#pragma unroll
        for (int g4 = 0; g4 < 4; ++g4) {
            v2u w; w.x = pk2(o0[4 * g4] * inv, o0[4 * g4 + 1] * inv); w.y = pk2(o0[4 * g4 + 2] * inv, o0[4 * g4 + 3] * inv); *(v2u*)(op + 8 * g4) = w;
            v2u x; x.x = pk2(o1[4 * g4] * inv, o1[4 * g4 + 1] * inv); x.y = pk2(o1[4 * g4 + 2] * inv, o1[4 * g4 + 3] * inv); *(v2u*)(op + 32 + 8 * g4) = x; }
    }
}

#ifndef PROBE_PH
#define PROBE_PH -1
#endif
#ifndef PROBE_TS
#define PROBE_TS -1
#endif
#ifndef PROBE_BLK
#define PROBE_BLK 0
#endif
#define TS_BEGIN(k) do { if constexpr ((k) == PROBE_TS) { if (blockIdx.x == PROBE_BLK && threadIdx.x == 0) *((volatile LAS unsigned long long*)(c.lds + MISC_OFF + 64)) = __builtin_amdgcn_s_memrealtime(); } } while (0)
#define TS_END(k) do { if constexpr ((k) == PROBE_TS) { if (blockIdx.x == PROBE_BLK && threadIdx.x == 0) *((volatile LAS unsigned long long*)(c.lds + MISC_OFF + 72)) = __builtin_amdgcn_s_memrealtime(); } } while (0)
struct Ctx { LAS unsigned char* lds; int tid, lane, wave, G, gw, NGW; };
constexpr int CW_SPLIT = 8192;

__device__ __forceinline__ void sb_arrive(unsigned* ctl, int id) {
    asm volatile("s_waitcnt vmcnt(0)" ::: "memory");
    __syncthreads();
    if (threadIdx.x == 0) __hip_atomic_fetch_add(ctl + CW_SPLIT + 64 * id, 1u, __ATOMIC_RELAXED, __HIP_MEMORY_SCOPE_AGENT);
}
__device__ __forceinline__ void sb_wait(unsigned* ctl, int id, unsigned G) {
    if (threadIdx.x == 0) {
        unsigned sp = 0;
        while (__hip_atomic_load(ctl + CW_SPLIT + 64 * id, __ATOMIC_RELAXED, __HIP_MEMORY_SCOPE_AGENT) < G) {
            __builtin_amdgcn_s_sleep(2);
            if (++sp > (1u << 22)) { atomicAdd(ctl + CW_BAR + XB_TMO, 1u); break; }
        }
        __builtin_amdgcn_fence(__ATOMIC_ACQUIRE, "agent");
        asm volatile("s_waitcnt vmcnt(0)" ::: "memory");
    }
    __syncthreads();
}
struct HalfOrder {
    pg8::StaticOrder S; int pm0;
    __device__ __forceinline__ void init(int N, int G, int c, int pm0_, int off) { const int rot = (G == 256) ? off : 0; S.init(48 * 256, N, G, (c + G - rot) % G); pm0 = pm0_; }
    __device__ __forceinline__ bool next(int i, pg8::Unit& u) const { if (!S.next(i, u)) return false; u.pm += pm0; return true; }
    __device__ __forceinline__ void a_ready(const pg8::Unit&) const {}
    __device__ __forceinline__ void done(const pg8::Unit&) const {}
};

template <int L, int f, int h> __device__ __forceinline__ void stage_G(const Args& a, const Ctx& c, int off) {
    unsigned char* ws = a.ws;
    pg8::Gemm g{(const bf16*)(ws + WS_H), (const bf16*)(ws + WS_WGU) + (size_t)(L * 2 + f) * 5632 * 1024, M, 5632, 1024};
    HalfOrder S; S.init(5632, c.G, (int)blockIdx.x, 48 * h, off);
    pg8::EpiGU E{(bf16*)(ws + WS_BIG), (const float*)(ws + WS_SS) + (size_t)(3 * L + 2 * f) * M, (const float*)(ws + WS_BIAS) + (size_t)L * 119808 + (f ? 69120 : 0)};
    pg8::gemm_phase<pg8::EpiGU, HalfOrder, true, true>(c.lds, g, S, E);
}
template <int L, int f, int h> __device__ __forceinline__ void stage_D(const Args& a, const Ctx& c, int off) {
    unsigned char* ws = a.ws; float* X = a.out; float* SS = (float*)(ws + WS_SS);
    const float* modl = (const float*)(ws + WS_MOD) + (size_t)L * 9 * 9216;
    pg8::Gemm g{(const bf16*)(ws + WS_BIG), (const bf16*)(ws + WS_WD) + (size_t)(L * 2 + f) * 1024 * 2816, M, 1024, 2816};
    HalfOrder S; S.init(1024, c.G, (int)blockIdx.x, 48 * h, off);
    const bool first = (L == 0) && f == 0;
    bf16* Hn = (f == 1 && L == 1) ? (bf16*)nullptr : (bf16*)(ws + WS_H);
    const float* gct = (const float*)(ws + WS_GCT) + (size_t)(f == 0 ? 3 * L + 1 : (L == 0 ? 3 : 0)) * 9216;
    pg8::EpiRes E{first ? a.in[I_XP] : X, first ? a.in[I_XS] : X + (size_t)MCTX * D, X, modl + (f ? 8 : 2) * 1024, Hn, gct, SS + (size_t)(3 * L + 1 + 2 * f) * M, 0.5f};
    pg8::gemm_phase<pg8::EpiRes, HalfOrder, true, true>(c.lds, g, S, E);
}
template <int L, int h> __device__ __forceinline__ void stage_IN(const Args& a, const Ctx& c, int off) {
    unsigned char* ws = a.ws; float* newk = a.out + (size_t)M * D; float* newv = newk + 32 * 2 * 256 * 128;
    pg8::Gemm g{(const bf16*)(ws + WS_H), (const bf16*)(ws + WS_WIN) + (size_t)L * 2048 * 1024, M, 2048, 1024};
    HalfOrder S; S.init(2048, c.G, (int)blockIdx.x, 48 * h, off);
    pg8::EpiIN E{(bf16*)(ws + WS_Z), (bf16*)(ws + WS_ZT), newk, newv, (const float*)(ws + WS_ROPE), (const float*)(ws + WS_SS) + (size_t)(3 * L + 1) * M, (const float*)(ws + WS_BIAS) + (size_t)L * 119808 + 50688, L, QSCALE};
    pg8::gemm_phase<pg8::EpiIN, HalfOrder, true, true>(c.lds, g, S, E);
}
template <int L, int h> __device__ __forceinline__ void stage_OUT(const Args& a, const Ctx& c, int off) {
    unsigned char* ws = a.ws; float* X = a.out; const float* modl = (const float*)(ws + WS_MOD) + (size_t)L * 9 * 9216;
    pg8::Gemm g{(const bf16*)(ws + WS_CAT), (const bf16*)(ws + WS_WOUT) + (size_t)L * 1024 * 1024, M, 1024, 1024};
    HalfOrder S; S.init(1024, c.G, (int)blockIdx.x, 48 * h, off);
    pg8::EpiRes E{X, X + (size_t)MCTX * D, X, modl + 5 * 1024, (bf16*)(ws + WS_H), (const float*)(ws + WS_GCT) + (size_t)(3 * L + 2) * 9216, (float*)(ws + WS_SS) + (size_t)(3 * L + 2) * M, 1.0f};
    pg8::gemm_phase<pg8::EpiRes, HalfOrder, true, true>(c.lds, g, S, E);
}
template <int L> __device__ __forceinline__ void mix_stage(const Args& a, const Ctx& c) {
    unsigned char* ws = a.ws; const bf16* Z = (const bf16*)(ws + WS_Z); const bf16* ZT = (const bf16*)(ws + WS_ZT); bf16* CAT = (bf16*)(ws + WS_CAT);
    int tid_ = c.tid; asm volatile("" : "+v"(tid_));
    const int G = c.G, tid = tid_, lane = tid_ & 63; LAS unsigned char* lds = c.lds;
#define HY_CH(w) ((((w) & 7) << 5) | (((w) >> 3) & 31))
    if constexpr (L == 0) TS_BEGIN(301);
    for (int w = blockIdx.x; w < 256; w += G) hyena_channel<2048, 8>(a, L, HY_CH(w), ZT, CAT, lds, tid, c.wave, lane);
    if constexpr (L == 0) { TS_END(301); TS_BEGIN(302); }
    for (int w = blockIdx.x; w < 256; w += G) hyena_channel<256, 32>(a, L, HY_CH(w), ZT, CAT, lds, tid, c.wave, lane);
#undef HY_CH
    if constexpr (L == 0) { TS_END(302); TS_BEGIN(303); }
    attn_phase(a, L, Z, ZT, CAT, lds, tid, c.wave, lane);
    __syncthreads();
    if constexpr (L == 0) { TS_END(303); TS_BEGIN(304); }
    conv_phase(a, L, Z, CAT, lds, tid);
    if constexpr (L == 0) TS_END(304);
}
__device__ __forceinline__ void final_half(const Args& a, const Ctx& c, int h) {
    float* X = a.out; const float* ss = (const float*)(a.ws + WS_SS) + (size_t)6 * M; const float* g = a.in[I_GFIN];
    for (int r = h * 12288 + c.gw; r < (h + 1) * 12288; r += c.NGW) {
        float* xr = X + (size_t)r * D;
        const float rstd = 1.0f / sqrtf(ss[r] * (1.0f / D) + EPS);
#pragma unroll
        for (int j = 0; j < 4; ++j) { const int col = 4 * (c.lane + 64 * j); ((f32x4*)xr)[c.lane + 64 * j] = (((const f32x4*)xr)[c.lane + 64 * j] * rstd) * *(const f32x4*)(g + col); }
    }
}

__global__ void __launch_bounds__(NTHREADS, 2) mega_fwd(Args a) {
    extern __shared__ __attribute__((aligned(16))) unsigned char lds_raw[];
    Ctx c;
    c.lds = (LAS unsigned char*)lds_raw;
    c.tid = threadIdx.x; c.lane = c.tid & 63; c.wave = __builtin_amdgcn_readfirstlane(c.tid >> 6);
    c.G = gridDim.x; c.gw = blockIdx.x * NWAVES + c.wave; c.NGW = c.G * NWAVES;
    unsigned* ctl = (unsigned*)(a.ws + WS_CTL);
    for (int u = c.tid; u < (LDS_BYTES - LDSCTL_OFF) / 4; u += NTHREADS) ((LAS unsigned*)(c.lds + LDSCTL_OFF))[u] = 0u;
    __syncthreads();
    XcdBarrier bar = xcd_barrier_post(ctl + CW_BAR, (volatile LAS unsigned*)(c.lds + MISC_OFF) + 8);
    cg::grid_group grid = cg::this_grid();
    const unsigned G = (unsigned)c.G;
    TS_BEGIN(0);
    p0_prologue(a, c.lds, c.gw, c.NGW, c.wave, c.lane, true);
    if (a.ph_hi > 100000) grid.sync(); else xcd_barrier(bar);
    TS_END(0); TS_BEGIN(1);
    prep_phase(a.in[I_XP], a.in[I_XS], a.in[I_GF1], (const float*)(a.ws + WS_MOD), 1, (bf16*)(a.ws + WS_H), (float*)(a.ws + WS_SS), 0, M, c.gw, c.NGW, c.lane);
    bias_phase(a, 0, 2 * 832, c.gw, c.NGW, c.lane);
    gct_phase(a, c.gw, c.NGW, c.lane);
    xcd_barrier(bar);
    TS_END(1); TS_BEGIN(2);
    { stage_G<0, 0, 0>(a, c, 0); sb_arrive(ctl, 0); }
    { stage_G<0, 0, 1>(a, c, 32); sb_arrive(ctl, 1); }
    { sb_wait(ctl, 0, G); stage_D<0, 0, 0>(a, c, 64); sb_arrive(ctl, 2); }
    { sb_wait(ctl, 1, G); stage_D<0, 0, 1>(a, c, 0); sb_arrive(ctl, 3); }
    { const int b = (int)blockIdx.x;
      if (b < 64 || b >= 192) hyena_filter_phase(a, c.lds, (b < 64 ? b : b - 128) * NWAVES + c.wave, 128 * NWAVES, c.wave, c.lane); }
    sb_wait(ctl, 2, G); sb_wait(ctl, 3, G);
    stage_IN<0, 0>(a, c, 0);
    stage_IN<0, 1>(a, c, 128);
    xcd_barrier(bar);
    TS_END(2); TS_BEGIN(3);
    mix_stage<0>(a, c);
    xcd_barrier(bar);
    TS_END(3); TS_BEGIN(4);
    { stage_OUT<0, 0>(a, c, 128); sb_arrive(ctl, 4); }
    { stage_OUT<0, 1>(a, c, 64); sb_arrive(ctl, 5); }
    { sb_wait(ctl, 4, G); stage_G<0, 1, 0>(a, c, 0); sb_arrive(ctl, 6); }
    { sb_wait(ctl, 5, G); stage_G<0, 1, 1>(a, c, 32); sb_arrive(ctl, 7); }
    { sb_wait(ctl, 6, G); stage_D<0, 1, 0>(a, c, 0); sb_arrive(ctl, 8); }
    { sb_wait(ctl, 7, G); stage_D<0, 1, 1>(a, c, 192); sb_arrive(ctl, 9); }
    { sb_wait(ctl, 8, G); stage_G<1, 0, 0>(a, c, 64); sb_arrive(ctl, 10); }
    { sb_wait(ctl, 9, G); stage_G<1, 0, 1>(a, c, 96); sb_arrive(ctl, 11); }
    { sb_wait(ctl, 10, G); stage_D<1, 0, 0>(a, c, 128); sb_arrive(ctl, 12); }
    { sb_wait(ctl, 11, G); stage_D<1, 0, 1>(a, c, 64); sb_arrive(ctl, 13); }
    sb_wait(ctl, 12, G); sb_wait(ctl, 13, G);
    stage_IN<1, 0>(a, c, 0);
    stage_IN<1, 1>(a, c, 128);
    xcd_barrier(bar);
    TS_END(4); TS_BEGIN(5);
    mix_stage<1>(a, c);
    xcd_barrier(bar);
    TS_END(5); TS_BEGIN(6);
    { stage_OUT<1, 0>(a, c, 128); sb_arrive(ctl, 14); }
    { stage_OUT<1, 1>(a, c, 64); sb_arrive(ctl, 15); }
    { sb_wait(ctl, 14, G); stage_G<1, 1, 0>(a, c, 128); sb_arrive(ctl, 16); }
    { sb_wait(ctl, 15, G); stage_G<1, 1, 1>(a, c, 160); sb_arrive(ctl, 17); }
    { sb_wait(ctl, 16, G); stage_D<1, 1, 0>(a, c, 0); sb_arrive(ctl, 18); }
    { sb_wait(ctl, 17, G); stage_D<1, 1, 1>(a, c, 192); sb_arrive(ctl, 19); }
    { sb_wait(ctl, 18, G); final_half(a, c, 0); }
    { sb_wait(ctl, 19, G); final_half(a, c, 1); }
    TS_END(6);
    if constexpr (PROBE_TS >= 0) { if (blockIdx.x == PROBE_BLK && threadIdx.x == 0) { const unsigned long long t0 = *((volatile LAS unsigned long long*)(c.lds + MISC_OFF + 64)), t1 = *((volatile LAS unsigned long long*)(c.lds + MISC_OFF + 72)); const unsigned long long now = __builtin_amdgcn_s_memrealtime(); while (__builtin_amdgcn_s_memrealtime() - now < 9ull * (t1 - t0)) __builtin_amdgcn_s_sleep(8); } __syncthreads(); }
}

extern "C" void kernel_launch(void* const* d_in, const int* in_sizes, int n_in, void* d_out, int out_size, void* d_ws, size_t ws_size, hipStream_t stream) {
    static int grid = 0;
    if (grid == 0) {
        if (n_in != N_IN || ws_size < WS_END || out_size != M * D + 2 * 32 * 2 * 256 * 128) { fprintf(stderr, "kernel_launch: unexpected shapes (n_in %d, ws %zu, out %d)\n", n_in, ws_size, out_size); grid = -1; return; }
        int dev = 0, cus = 0, per_cu = 0;
        if (hipGetDevice(&dev) != hipSuccess || hipDeviceGetAttribute(&cus, hipDeviceAttributeMultiprocessorCount, dev) != hipSuccess) { grid = -1; return; }
        if (hipFuncSetAttribute((const void*)mega_fwd, hipFuncAttributeMaxDynamicSharedMemorySize, LDS_BYTES) != hipSuccess) { fprintf(stderr, "kernel_launch: hipFuncSetAttribute failed\n"); grid = -1; return; }
        if (hipOccupancyMaxActiveBlocksPerMultiprocessor(&per_cu, (const void*)mega_fwd, NTHREADS, LDS_BYTES) != hipSuccess || per_cu < 1) { fprintf(stderr, "kernel_launch: occupancy query says %d\n", per_cu); per_cu = 1; }
        (void)hipGetLastError();
        if (cus < 256) { fprintf(stderr, "kernel_launch: built for a 256-CU device (got %d)\n", cus); grid = -1; return; }
        grid = 256;
    }
    if (grid < 0) return;
    (void)hipMemsetAsync((char*)d_ws + WS_CTL, 0, CTL_ZERO_BYTES, stream);
    Args a{};
    for (int i = 0; i < N_IN; ++i) a.in[i] = (const float*)d_in[i];
    a.out = (float*)d_out; a.ws = (unsigned char*)d_ws; a.ph_lo = 0; a.ph_hi = 1;
    void* args[] = {&a};
    hipError_t e = hipLaunchCooperativeKernel((const void*)mega_fwd, dim3(grid), dim3(NTHREADS), args, LDS_BYTES, stream);
    if (e != hipSuccess) fprintf(stderr, "cooperative launch failed: %s (grid %d)\n", hipGetErrorString(e), grid);
}
```

```cpp
#include <hip/hip_runtime.h>
#include <hip/hip_cooperative_groups.h>
#include <cstdio>
#include <cstdint>
namespace cg = cooperative_groups;

constexpr int D = 1024, DFF = 2816, INW = 2048;
constexpr int MCTX = 8192, MLAT = 16384, M = MCTX + MLAT;
constexpr int LCTX = 256, LLAT = 2048;
constexpr int NCOND = 9, MODW = 9 * 1024;
constexpr int ZW = 1280;
constexpr int HYC = 768;
constexpr float EPS = 1e-6f;
constexpr float SS_FIX = 16777216.0f, SS_UNFIX = 1.0f / 16777216.0f;
constexpr float FSQ_FIX = 68719476736.0f, FSQ_UNFIX = 1.0f / 68719476736.0f;
constexpr float LOG2E = 1.4426950408889634f;
constexpr float QSCALE = 0.125f * LOG2E;

enum { I_XP = 0, I_XS, I_C, I_CK, I_CV, I_CCTX, I_WMOD, I_BMOD, I_GF1, I_GMIX, I_GF2, I_GFIN, I_W1G, I_W1U, I_W1D, I_W2G, I_W2U, I_W2D, I_WIN, I_WOUT, I_SINK,
       I_CDW, I_CDWB, I_CLNG, I_CLNB, I_CPW, I_HSW, I_HSB, I_HW1, I_HB1, I_HF1, I_HW2, I_HB2, I_HF2, I_HW3, I_HLD, I_HBIAS, N_IN };

constexpr size_t MiB = 1u << 20;
constexpr size_t WS_CTL = 0, CTL_ZERO_BYTES = 3 * MiB;
constexpr size_t WS_SUMSQ = 64 * 1024;
constexpr size_t WS_MOD = 128 * 1024;
constexpr size_t WS_SS = 1 * MiB;
constexpr size_t WS_ROPE = 3 * MiB;
constexpr size_t WS_BIAS = 3 * MiB + 64 * 1024;
constexpr size_t WS_WGU = 4 * MiB;
constexpr size_t WS_WD = 48 * MiB;
constexpr size_t WS_WIN = 70 * MiB;
constexpr size_t WS_WOUT = 78 * MiB;
constexpr size_t WS_CKB = 82 * MiB;
constexpr size_t WS_CVT = 83 * MiB;
constexpr size_t WS_HYH = 84 * MiB;
constexpr size_t WS_HYRAW = 86 * MiB;
constexpr size_t WS_X = 96 * MiB;
constexpr size_t WS_BIG = 144 * MiB;
constexpr size_t WS_Z = WS_BIG;
constexpr size_t WS_ZT = 204 * MiB;
constexpr size_t WS_GCT = 276 * MiB;
constexpr size_t WS_END = 277 * MiB;
static_assert(WS_MOD + 2 * 9 * 9216 * 4 <= WS_SS && WS_SS + 7 * (size_t)M * 8 <= CTL_ZERO_BYTES && CTL_ZERO_BYTES <= WS_ROPE && WS_BIAS + 2 * 9 * 13312 * 4 <= WS_WGU, "ctl");
static_assert(WS_BIG + (size_t)M * DFF * 2 <= WS_GCT && WS_Z + (size_t)M * ZW * 2 <= WS_ZT && WS_ZT + (size_t)896 * M * 2 <= WS_GCT, "ws map");
constexpr int CW_BAR = 4096;

constexpr int RING_BYTES = 131072;
constexpr int LDSCTL_OFF = 133120, MISC_OFF = LDSCTL_OFF + 320;
constexpr int LDS_BYTES = 135168;
constexpr int NWAVES = 8, NTHREADS = 512;

namespace pg8 {
#define PG8_LAS __attribute__((address_space(3)))
typedef unsigned short bf16_t;
typedef short bf16x8 __attribute__((ext_vector_type(8)));
typedef float f32x4 __attribute__((ext_vector_type(4)));
typedef unsigned u32x4 __attribute__((ext_vector_type(4)));
constexpr int BM = 256, BK = 64, HALF = 128, HTB = HALF * BK * 2  , STAGE_BYTES = 8 * HTB, NXCD = 8, WGM = 8;

__host__ __device__ __forceinline__ int lds_byte(int r, int c) { const int st = (r >> 4) * 2 + (c >> 5), rr = r & 15, cc = c & 31, ob = rr * 64 + cc * 2; return st * 1024 + (ob ^ (((ob >> 9) & 1) << 5)); }
__host__ __device__ __forceinline__ void stage_rc(int b, int& R, int& C) { const int st = b / 1024, sb = b % 1024, swz = sb ^ (((sb >> 9) & 1) << 5); R = (st >> 1) * 16 + swz / 64; C = (st & 1) * 32 + (swz % 64) / 2; }
__host__ __device__ __forceinline__ int perm32(int rho) { const int n = rho >> 4, i = rho & 15; return 8 * (i >> 2) + 4 * n + (i & 3); }

struct Unit { int pm, pn; };
struct Gemm { const bf16_t* A; const bf16_t* Bt; int M, N, K; };

struct StaticOrder {
    int nM, nN, nwg, G, c;
    __host__ __device__ void init(int M, int N, int G_, int c_) { nM = M / BM; nN = N / BM; nwg = nM * nN; G = G_; c = c_; }
    __host__ __device__ bool next(int i, Unit& u) const {
        const long L = (long)i * G + c; if (L >= nwg) return false;
        int wgid = (int)L; { const int q = nwg / NXCD, r = nwg % NXCD, xcd = wgid % NXCD, off = wgid / NXCD; wgid = (xcd < r ? xcd * (q + 1) : r * (q + 1) + (xcd - r) * q) + off; }
        const int nig = WGM * nN, gid = wgid / nig, fm = gid * WGM, gsz = (nM - fm) < WGM ? (nM - fm) : WGM;
        u.pm = fm + ((wgid % nig) % gsz); u.pn = (wgid % nig) / gsz; return true;
    }
    __device__ __forceinline__ void a_ready(const Unit&) const {}
    __device__ __forceinline__ void done(const Unit&) const {}
};


__device__ __forceinline__ unsigned cvt_pk_bf16(float lo, float hi) { unsigned r; asm volatile("v_cvt_pk_bf16_f32 %0, %1, %2" : "=v"(r) : "v"(lo), "v"(hi)); return r; }
__device__ __forceinline__ float silu_f(float x) { return x * __builtin_amdgcn_rcpf(1.0f + __builtin_amdgcn_exp2f(-1.4426950408889634f * x)); }
__device__ __forceinline__ int cond_of_tile(int pm) { return pm < 32 ? 0 : 1 + ((pm - 32) >> 3); }

__device__ __forceinline__ void st16_wt(void* p, u32x4 v) { asm volatile("global_store_dwordx4 %0, %1, off sc1\n\ts_nop 1" :: "v"(p), "v"(v) : "memory"); }
__device__ __forceinline__ void st16_wt(void* p, f32x4 v) { asm volatile("global_store_dwordx4 %0, %1, off sc1\n\ts_nop 1" :: "v"(p), "v"(v) : "memory"); }
__device__ __forceinline__ void st8_wt(void* p, unsigned lo, unsigned hi) { __hip_atomic_store((unsigned long long*)p, ((unsigned long long)hi << 32) | lo, __ATOMIC_RELAXED, __HIP_MEMORY_SCOPE_AGENT); }
struct EpiGU {
    static constexpr bool PERM = true, AFTER_DRAIN = false;
    bf16_t* O;
    const unsigned long long* ss; const float* bias;
    __device__ __forceinline__ void operator()(const f32x4 (&acc)[2][2][4][2], const Unit& u, int wr, int wc, int fr, int fq) const {
        const int row0 = u.pm * BM + wr * 64 + fr, col0 = u.pn * HALF + wc * 32 + 8 * fq;
        const float* bp = bias + cond_of_tile(u.pm) * 5632 + u.pn * BM + wc * 32 + 8 * fq;
        const f32x4 bg0 = *(const f32x4*)bp, bg1 = *(const f32x4*)(bp + 4), bu0 = *(const f32x4*)(bp + HALF), bu1 = *(const f32x4*)(bp + HALF + 4);
        unsigned long long rsq[2][4]; float rsv[2][4];
#pragma unroll
        for (int ai = 0; ai < 2; ++ai)
#pragma unroll
            for (int m = 0; m < 4; ++m) rsq[ai][m] = ss[row0 + ai * HALF + m * 16];
#pragma unroll
        for (int ai = 0; ai < 2; ++ai)
#pragma unroll
            for (int m = 0; m < 4; ++m) rsv[ai][m] = (float)rsq[ai][m];
#pragma unroll
        for (int ai = 0; ai < 2; ++ai)
#pragma unroll
            for (int m = 0; m < 4; ++m) { const int row = row0 + ai * HALF + m * 16; bf16_t* rowp = O + (size_t)row * 2816 + col0;
                const float rs = __builtin_amdgcn_rsqf(rsv[ai][m] * (SS_UNFIX / 1024.0f) + 1e-6f);
                const f32x4 g0 = acc[ai][0][m][0] * rs + bg0, g1 = acc[ai][0][m][1] * rs + bg1, u0 = acc[ai][1][m][0] * rs + bu0, u1 = acc[ai][1][m][1] * rs + bu1;
                u32x4 w;
                w.x = cvt_pk_bf16(silu_f(g0[0]) * u0[0], silu_f(g0[1]) * u0[1]); w.y = cvt_pk_bf16(silu_f(g0[2]) * u0[2], silu_f(g0[3]) * u0[3]);
                w.z = cvt_pk_bf16(silu_f(g1[0]) * u1[0], silu_f(g1[1]) * u1[1]); w.w = cvt_pk_bf16(silu_f(g1[2]) * u1[2], silu_f(g1[3]) * u1[3]);
                st16_wt(rowp, w); }
    }
};
template <bool SRC32> struct EpiResT {
    static constexpr bool PERM = true, AFTER_DRAIN = false;
    const void* in0; const void* in1; bf16_t* X; const float* gate;
    bf16_t* Hn; const float* gct; unsigned long long* ssn; float scale;
    static __device__ __forceinline__ float lo16(unsigned w) { return __uint_as_float(w << 16); }
    static __device__ __forceinline__ float hi16(unsigned w) { return __uint_as_float(w & 0xffff0000u); }
    __device__ __forceinline__ void operator()(const f32x4 (&acc)[2][2][4][2], const Unit& u, int wr, int wc, int fr, int fq) const {
        asm volatile("" : "+v"(fr), "+v"(fq));
        const int cond = cond_of_tile(u.pm); const float* gp = gate + cond * 9216; const float* cp = gct + cond * 1024;
        const int col0 = u.pn * BM + wc * 32 + 8 * fq;
        const bool ctx = u.pm < 32; const void* src = ctx ? in0 : in1; const int rbase = u.pm * BM - (ctx ? 0 : 8192);
        f32x4 gv[2][2], gc[2][2], xo32[4][2][2]; u32x4 xo16[4][2];
#define EPIRES_LOAD(slot_, rg_) do { const size_t ro = (size_t)(rbase + ((rg_) >> 2) * HALF + wr * 64 + ((rg_) & 3) * 16 + fr) * 1024 + col0; \
            if constexpr (SRC32) { const float* sp = (const float*)src + ro; \
                _Pragma("unroll") for (int bj = 0; bj < 2; ++bj) _Pragma("unroll") for (int n = 0; n < 2; ++n) xo32[slot_][bj][n] = *(const f32x4*)(sp + bj * HALF + n * 4); } \
            else { const bf16_t* sp = (const bf16_t*)src + ro; \
                _Pragma("unroll") for (int bj = 0; bj < 2; ++bj) xo16[slot_][bj] = *(const u32x4*)(sp + bj * HALF); } } while (0)
#define EPIRES_DO(slot_, rg_) do { const int ai = (rg_) >> 2, m = (rg_) & 3, rl = ai * HALF + wr * 64 + m * 16 + fr; \
            const size_t oo = (size_t)(u.pm * BM + rl) * 1024 + col0; float sq = 0.f; \
            _Pragma("unroll") for (int bj = 0; bj < 2; ++bj) { f32x4 x0, x1; \
                if constexpr (SRC32) { x0 = xo32[slot_][bj][0]; x1 = xo32[slot_][bj][1]; } \
                else { const u32x4 w = xo16[slot_][bj]; x0 = (f32x4){lo16(w[0]), hi16(w[0]), lo16(w[1]), hi16(w[1])}; x1 = (f32x4){lo16(w[2]), hi16(w[2]), lo16(w[3]), hi16(w[3])}; } \
                const f32x4 xa = x0 + gv[bj][0] * acc[ai][bj][m][0], xb = x1 + gv[bj][1] * acc[ai][bj][m][1]; \
                st16_wt(X + oo + bj * HALF, (u32x4){cvt_pk_bf16(xa[0], xa[1]), cvt_pk_bf16(xa[2], xa[3]), cvt_pk_bf16(xb[0], xb[1]), cvt_pk_bf16(xb[2], xb[3])}); \
                sq += ((xa[0] * xa[0] + xa[1] * xa[1]) + (xa[2] * xa[2] + xa[3] * xa[3])) + ((xb[0] * xb[0] + xb[1] * xb[1]) + (xb[2] * xb[2] + xb[3] * xb[3])); \
                if (Hn) { const f32x4 ha = xa * gc[bj][0], hb = xb * gc[bj][1]; \
                    st16_wt(Hn + oo + bj * HALF, (u32x4){cvt_pk_bf16(ha[0], ha[1]), cvt_pk_bf16(ha[2], ha[3]), cvt_pk_bf16(hb[0], hb[1]), cvt_pk_bf16(hb[2], hb[3])}); } } \
            sq += __shfl_xor(sq, 16); sq += __shfl_xor(sq, 32); \
            if (fq == 0) atomicAdd(ssn + u.pm * BM + rl, (unsigned long long)(sq * SS_FIX)); } while (0)
#pragma unroll
        for (int bj = 0; bj < 2; ++bj)
#pragma unroll
            for (int n = 0; n < 2; ++n) { gv[bj][n] = *(const f32x4*)(gp + col0 + bj * HALF + n * 4); gc[bj][n] = Hn ? *(const f32x4*)(cp + col0 + bj * HALF + n * 4) : (f32x4){0.f, 0.f, 0.f, 0.f}; }
        EPIRES_LOAD(0, 0); EPIRES_LOAD(1, 1);
#pragma unroll
        for (int bj = 0; bj < 2; ++bj)
#pragma unroll
            for (int n = 0; n < 2; ++n) gv[bj][n] = gv[bj][n] * scale;
        EPIRES_DO(0, 0); EPIRES_DO(1, 1);
        EPIRES_LOAD(0, 2); EPIRES_LOAD(1, 3);
        EPIRES_DO(0, 2); EPIRES_DO(1, 3);
        EPIRES_LOAD(0, 4); EPIRES_LOAD(1, 5); EPIRES_LOAD(2, 6); EPIRES_LOAD(3, 7);
        EPIRES_DO(0, 4); EPIRES_DO(1, 5); EPIRES_DO(2, 6); EPIRES_DO(3, 7);
#undef EPIRES_LOAD
#undef EPIRES_DO
    }
};
struct EpiIN {
    static constexpr bool PERM = false, AFTER_DRAIN = false;
    bf16_t* Z; bf16_t* ZT; float* newk; float* newv; const float* rope; const unsigned long long* ss; const float* bias; int layer; float qscale;
    __device__ __forceinline__ void operator()(const f32x4 (&acc)[2][2][4][2], const Unit& u, int wr, int wc, int fr, int fq) const {
        const bool lat = u.pm >= 32;
        const int colb = u.pn * BM + wc * 32 + 4 * fq;
        const float* bp = bias + cond_of_tile(u.pm) * 2048 + colb;
        f32x4 bv[2][2];
#pragma unroll
        for (int bj = 0; bj < 2; ++bj)
#pragma unroll
            for (int n = 0; n < 2; ++n) bv[bj][n] = *(const f32x4*)(bp + bj * HALF + n * 16);
        const bool roped = lat && u.pn < 3;
        float rsl[2];
        { const unsigned long long q0 = ss[u.pm * BM + wr * 64 + 16 * fq + fr], q1 = ss[u.pm * BM + HALF + wr * 64 + 16 * fq + fr];
          rsl[0] = __builtin_amdgcn_rsqf((float)q0 * (SS_UNFIX / 1024.0f) + 1e-6f); rsl[1] = __builtin_amdgcn_rsqf((float)q1 * (SS_UNFIX / 1024.0f) + 1e-6f); }
#pragma unroll
        for (int ai = 0; ai < 2; ++ai) {
            f32x4 rc0[4], rc1[4];
#pragma unroll
            for (int m = 0; m < 4; ++m) { rc0[m] = (f32x4){1.f, 0.f, 1.f, 0.f}; rc1[m] = rc0[m];
                if (roped) { const int pos = (u.pm * BM + ai * HALF + wr * 64 + m * 16 + fr - 8192) & 2047; const int p = (wc & 1) ? (pos & 63) : (pos >> 6);
                    const f32x4* rp = (const f32x4*)(rope + (size_t)(p * 16 + 4 * fq) * 2); rc0[m] = rp[0]; rc1[m] = rp[1]; } }
#pragma unroll
            for (int m = 0; m < 4; ++m) { const int row = u.pm * BM + ai * HALF + wr * 64 + m * 16 + fr;
                const float rs = __shfl(rsl[ai], 16 * m + fr);
#pragma unroll
                for (int bj = 0; bj < 2; ++bj) { const int col = colb + bj * HALF;
                    f32x4 v0 = acc[ai][bj][m][0] * rs + bv[bj][0], v1 = acc[ai][bj][m][1] * rs + bv[bj][1];
                    if (u.pn < 5) {
                        const int cb = u.pn * BM + bj * HALF;
                        if (lat && cb < 640) {
                            const f32x4 cs0 = rc0[m], cs1 = rc1[m];
                            const float c0 = cs0[0], s0 = cs0[1], c1 = cs0[2], s1 = cs0[3], c2 = cs1[0], s2 = cs1[1], c3 = cs1[2], s3 = cs1[3];
                            const f32x4 a = v0, b = v1;
                            v0[0] = a[0] * c0 - b[0] * s0; v1[0] = b[0] * c0 + a[0] * s0;
                            v0[1] = a[1] * c1 - b[1] * s1; v1[1] = b[1] * c1 + a[1] * s1;
                            v0[2] = a[2] * c2 - b[2] * s2; v1[2] = b[2] * c2 + a[2] * s2;
                            v0[3] = a[3] * c3 - b[3] * s3; v1[3] = b[3] * c3 + a[3] * s3;
                        }
                        if (!lat && cb >= 512 && cb < 768) {
                            const int b = row >> 8, s = row & 255; float* dst = (cb < 640 ? newk : newv) + ((size_t)(b * 2 + layer) * 256 + s) * 128 + (col - cb);
                            *(f32x4*)dst = v0; *(f32x4*)(dst + 16) = v1;
                        }
                        if (cb < 512) { v0 = v0 * qscale; v1 = v1 * qscale; }
                        if (cb == 640) {
                            const int ch = 768 + col - 640;
#pragma unroll
                            for (int j = 0; j < 4; ++j) { ZT[(size_t)(ch + j) * 24576 + row] = (bf16_t)(cvt_pk_bf16(v0[j], 0.f) & 0xffffu); ZT[(size_t)(ch + 16 + j) * 24576 + row] = (bf16_t)(cvt_pk_bf16(v1[j], 0.f) & 0xffffu); }
                        } else {
                        bf16_t* zp = Z + (size_t)row * 1280 + col;
                        typedef unsigned u32x2 __attribute__((ext_vector_type(2)));
                        u32x2 w0, w1; w0.x = cvt_pk_bf16(v0[0], v0[1]); w0.y = cvt_pk_bf16(v0[2], v0[3]); w1.x = cvt_pk_bf16(v1[0], v1[1]); w1.y = cvt_pk_bf16(v1[2], v1[3]);
                        *(u32x2*)zp = w0; *(u32x2*)(zp + 16) = w1; }
                    } else {
                        const int ch = col - 1280;
#pragma unroll
                        for (int j = 0; j < 4; ++j) { ZT[(size_t)(ch + j) * 24576 + row] = (bf16_t)(cvt_pk_bf16(v0[j], 0.f) & 0xffffu); ZT[(size_t)(ch + 16 + j) * 24576 + row] = (bf16_t)(cvt_pk_bf16(v1[j], 0.f) & 0xffffu); }
                    }
                } }
        }
    }
};

template <class Epi, class Sched, bool ALIGN_EPI = false, bool SP2 = false>
__device__ __forceinline__ void gemm_phase(PG8_LAS unsigned char* lds, const Gemm g, const Sched S, const Epi E) {
    int tid_ = threadIdx.x; asm volatile("" : "+v"(tid_));
    const int tid = tid_, wid = __builtin_amdgcn_readfirstlane(tid >> 6), lane = tid & 63, wr = wid >> 2, wc = wid & 3, fr = lane & 15, fq = lane >> 4;
    const int K = g.K, nt = K / BK;
    unsigned voffA[2], voffB[2];
#pragma unroll
    for (int i = 0; i < 2; ++i) { int R, C; stage_rc(tid * 16 + i * 8192, R, C); const int Rb = Epi::PERM ? ((R & ~31) + perm32(R & 31)) : R;
        voffA[i] = (unsigned)(R * K + C) * 2u; voffB[i] = (unsigned)(Rb * K + C) * 2u; }
    const size_t kstep = (size_t)(BK * 2);
    const size_t hstep = (size_t)HALF * K * 2;
    const size_t tstep = 2 * hstep;
    const unsigned ldsw = (unsigned)wid * 1024u;
    const int aoff = lds_byte(wr * 64 + fr, fq * 8), boff = lds_byte(wc * 32 + fr, fq * 8);
#define PG8_SA(b, h) (((b) * 2 + (h)) * HTB)
#define PG8_SB(b, h) ((4 + (b) * 2 + (h)) * HTB)
#define PG8_STAGE(bufoff, gbase, voff) do { _Pragma("unroll") for (int _i = 0; _i < 2; ++_i) \
        __builtin_amdgcn_global_load_lds((const unsigned*)((const char*)(gbase) + (voff)[_i]), (PG8_LAS unsigned*)(lds + (bufoff) + ldsw + _i * 8192), 16, 0, 0); } while (0)
#define PG8_LDA(dst, b, h) do { _Pragma("unroll") for (int m = 0; m < 4; ++m) _Pragma("unroll") for (int k = 0; k < 2; ++k) dst[m][k] = *(const PG8_LAS bf16x8*)(lds + PG8_SA(b, h) + aoff + m * 2048 + k * 1024); } while (0)
#define PG8_LDB(dst, b, h) do { _Pragma("unroll") for (int n = 0; n < 2; ++n) _Pragma("unroll") for (int k = 0; k < 2; ++k) dst[n][k] = *(const PG8_LAS bf16x8*)(lds + PG8_SB(b, h) + boff + n * 2048 + k * 1024); } while (0)
#define PG8_MMA(ai, bj, At, Bt) do { __builtin_amdgcn_s_setprio(1); _Pragma("unroll") for (int m = 0; m < 4; ++m) _Pragma("unroll") for (int n = 0; n < 2; ++n) _Pragma("unroll") for (int k = 0; k < 2; ++k) \
        acc[ai][bj][m][n] = __builtin_amdgcn_mfma_f32_16x16x32_bf16(Bt[n][k], At[m][k], acc[ai][bj][m][n], 0, 0, 0); __builtin_amdgcn_s_setprio(0); } while (0)
#define PG8_WAIT_V(n) asm volatile("s_waitcnt vmcnt(" #n ")" ::: "memory")
#define PG8_WAIT_L(n) asm volatile("s_waitcnt lgkmcnt(" #n ")" ::: "memory")
#define PG8_BAR __builtin_amdgcn_s_barrier()
#define PG8_SCHED __builtin_amdgcn_sched_barrier(0)
    Unit cur, nxt; int ui = 0;
    if (!S.next(0, cur)) return;
    f32x4 acc[2][2][4][2];
#pragma unroll
    for (int a = 0; a < 2; ++a)
#pragma unroll
        for (int b = 0; b < 2; ++b)
#pragma unroll
            for (int m = 0; m < 4; ++m)
#pragma unroll
                for (int n = 0; n < 2; ++n) acc[a][b][m][n] = (f32x4){0.f, 0.f, 0.f, 0.f};
    bf16x8 At[4][2], B0[2][2], B1[2][2];
    const char* cA = (const char*)g.A + (size_t)cur.pm * tstep; const char* cB = (const char*)g.Bt + (size_t)cur.pn * tstep;
    S.a_ready(cur);
    if constexpr (SP2) {
        PG8_STAGE(PG8_SB(0, 0), cB, voffB); PG8_STAGE(PG8_SB(0, 1), cB + hstep, voffB); PG8_STAGE(PG8_SA(0, 0), cA, voffA); PG8_STAGE(PG8_SA(0, 1), cA + hstep, voffA);
        if (wr == 1) PG8_BAR;
        PG8_WAIT_V(2); PG8_BAR;
        PG8_STAGE(PG8_SB(1, 0), cB + kstep, voffB); PG8_STAGE(PG8_SA(1, 0), cA + kstep, voffA); PG8_STAGE(PG8_SB(1, 1), cB + hstep + kstep, voffB);
        PG8_WAIT_V(6); PG8_BAR;
    } else {
        PG8_STAGE(PG8_SB(0, 0), cB, voffB); PG8_STAGE(PG8_SA(0, 0), cA, voffA); PG8_STAGE(PG8_SB(0, 1), cB + hstep, voffB); PG8_STAGE(PG8_SA(0, 1), cA + hstep, voffA);
        if (wr == 1) PG8_BAR;
        PG8_WAIT_V(4); PG8_BAR;
        PG8_STAGE(PG8_SB(1, 0), cB + kstep, voffB); PG8_STAGE(PG8_SA(1, 0), cA + kstep, voffA); PG8_STAGE(PG8_SB(1, 1), cB + hstep + kstep, voffB);
        PG8_WAIT_V(6); PG8_BAR;
    }
    for (;;) {
        const bool has_next = S.next(ui + 1, nxt);
        const char* nA = has_next ? (const char*)g.A + (size_t)nxt.pm * tstep : cA; const char* nB = has_next ? (const char*)g.Bt + (size_t)nxt.pn * tstep : cB;
        for (int t = 0; t < nt; t += 2) {
            const bool last = (t == nt - 2);
            const char* a1 = cA + (size_t)(t + 1) * kstep;
            const char* a2 = last ? nA : cA + (size_t)(t + 2) * kstep; const char* b2 = last ? nB : cB + (size_t)(t + 2) * kstep;
            const char* a3 = a2 + kstep; const char* b3 = b2 + kstep;
            if (last && has_next) S.a_ready(nxt);
            if constexpr (SP2) {
            PG8_LDB(B0, 0, 0); PG8_LDB(B1, 0, 1); PG8_SCHED; PG8_LDA(At, 0, 0); PG8_STAGE(PG8_SA(1, 1), a1 + hstep, voffA);
            PG8_WAIT_V(8); PG8_WAIT_L(0); PG8_BAR; PG8_MMA(0, 0, At, B0); PG8_MMA(0, 1, At, B1); PG8_BAR; PG8_SCHED;
            PG8_LDA(At, 0, 1); PG8_STAGE(PG8_SB(0, 0), b2, voffB); PG8_STAGE(PG8_SB(0, 1), b2 + hstep, voffB); PG8_STAGE(PG8_SA(0, 0), a2, voffA);
            PG8_WAIT_V(8); PG8_WAIT_L(0); PG8_BAR; PG8_MMA(1, 0, At, B0); PG8_MMA(1, 1, At, B1); PG8_BAR; PG8_SCHED;
            PG8_LDB(B0, 1, 0); PG8_LDB(B1, 1, 1); PG8_SCHED; PG8_LDA(At, 1, 0); PG8_STAGE(PG8_SA(0, 1), a2 + hstep, voffA);
            PG8_WAIT_V(8); PG8_WAIT_L(0); PG8_BAR; PG8_MMA(0, 0, At, B0); PG8_MMA(0, 1, At, B1); PG8_BAR; PG8_SCHED;
            PG8_LDA(At, 1, 1); PG8_STAGE(PG8_SB(1, 0), b3, voffB); PG8_STAGE(PG8_SB(1, 1), b3 + hstep, voffB); PG8_STAGE(PG8_SA(1, 0), a3, voffA);
            PG8_WAIT_V(8); PG8_WAIT_L(0); PG8_BAR; PG8_MMA(1, 0, At, B0); PG8_MMA(1, 1, At, B1); PG8_BAR; PG8_SCHED;
            } else {
            PG8_LDB(B0, 0, 0); PG8_SCHED; PG8_LDA(At, 0, 0); PG8_STAGE(PG8_SA(1, 1), a1 + hstep, voffA);
            PG8_WAIT_L(8); PG8_BAR; PG8_WAIT_L(0); PG8_MMA(0, 0, At, B0); PG8_BAR; PG8_SCHED;
            PG8_LDB(B1, 0, 1); PG8_STAGE(PG8_SB(0, 0), b2, voffB);
            PG8_BAR; PG8_WAIT_L(0); PG8_MMA(0, 1, At, B1); PG8_BAR;
            PG8_LDA(At, 0, 1); PG8_STAGE(PG8_SA(0, 0), a2, voffA);
            PG8_BAR; PG8_WAIT_L(0); PG8_MMA(1, 0, At, B0); PG8_BAR; PG8_SCHED;
            PG8_STAGE(PG8_SB(0, 1), b2 + hstep, voffB);
            PG8_WAIT_V(6); PG8_BAR; PG8_MMA(1, 1, At, B1); PG8_BAR;
            PG8_LDB(B0, 1, 0); PG8_SCHED; PG8_LDA(At, 1, 0); PG8_STAGE(PG8_SA(0, 1), a2 + hstep, voffA);
            PG8_WAIT_L(8); PG8_BAR; PG8_WAIT_L(0); PG8_MMA(0, 0, At, B0); PG8_BAR; PG8_SCHED;
            PG8_LDB(B1, 1, 1); PG8_STAGE(PG8_SB(1, 0), b3, voffB);
            PG8_BAR; PG8_WAIT_L(0); PG8_MMA(0, 1, At, B1); PG8_BAR;
            PG8_LDA(At, 1, 1); PG8_STAGE(PG8_SA(1, 0), a3, voffA);
            PG8_BAR; PG8_WAIT_L(0); PG8_MMA(1, 0, At, B0); PG8_BAR; PG8_SCHED;
            PG8_STAGE(PG8_SB(1, 1), b3 + hstep, voffB);
            PG8_WAIT_V(6); PG8_BAR; PG8_MMA(1, 1, At, B1); PG8_BAR;
            }
        }
        if constexpr (ALIGN_EPI) { if (wr == 0) PG8_BAR; }
        if constexpr (!Epi::AFTER_DRAIN) { E(acc, cur, wr, wc, fr, fq); S.done(cur); }
        if (!has_next) break;
#pragma unroll
        for (int a = 0; a < 2; ++a)
#pragma unroll
            for (int b = 0; b < 2; ++b)
#pragma unroll
                for (int m = 0; m < 4; ++m)
#pragma unroll
                    for (int n = 0; n < 2; ++n) acc[a][b][m][n] = (f32x4){0.f, 0.f, 0.f, 0.f};
        cur = nxt; cA = nA; cB = nB; ++ui;
        if constexpr (ALIGN_EPI) { if (wr == 1) PG8_BAR; }
    }
    PG8_WAIT_V(0);
    if constexpr (!ALIGN_EPI) { if (wr == 0) PG8_BAR; }
    PG8_BAR;
    if constexpr (Epi::AFTER_DRAIN) { E.fused(acc, cur, wr, wc, fr, fq, lds, wid, lane); S.done(cur); }
#undef PG8_SA
#undef PG8_SB
#undef PG8_STAGE
#undef PG8_LDA
#undef PG8_LDB
#undef PG8_MMA
#undef PG8_WAIT_V
#undef PG8_WAIT_L
#undef PG8_BAR
#undef PG8_SCHED
}
}

#define GAS __attribute__((address_space(1)))
#define LAS __attribute__((address_space(3)))
typedef unsigned short bf16;
typedef unsigned v4u __attribute__((ext_vector_type(4)));
typedef unsigned v2u __attribute__((ext_vector_type(2)));
typedef float f32x4 __attribute__((ext_vector_type(4)));
typedef short bf16x8 __attribute__((ext_vector_type(8)));
typedef GAS unsigned gu32;
#define RLX_AGENT __ATOMIC_RELAXED, __HIP_MEMORY_SCOPE_AGENT
#define LDS_WAIT() asm volatile("s_waitcnt lgkmcnt(0)" ::: "memory")
#define VM_WAIT() asm volatile("s_waitcnt vmcnt(0)" ::: "memory")
__device__ __forceinline__ unsigned f2bf(float f) { unsigned u = __builtin_bit_cast(unsigned, f); return (u + 0x7fffu + ((u >> 16) & 1u)) >> 16; }
__device__ __forceinline__ unsigned pk2(float lo, float hi) { return f2bf(lo) | (f2bf(hi) << 16); }
__device__ __forceinline__ float bf2f(unsigned h) { return __builtin_bit_cast(float, h << 16); }
__device__ __forceinline__ float bflo(unsigned w) { return __builtin_bit_cast(float, w << 16); }
__device__ __forceinline__ float bfhi(unsigned w) { return __builtin_bit_cast(float, w & 0xffff0000u); }
__device__ __forceinline__ float wave_sum(float v) {
#define WS_DPP(ctrl, rmask) v += __builtin_bit_cast(float, __builtin_amdgcn_update_dpp(0, __builtin_bit_cast(int, v), ctrl, rmask, 0xf, false))
    WS_DPP(0xB1, 0xf); WS_DPP(0x4E, 0xf); WS_DPP(0x141, 0xf); WS_DPP(0x140, 0xf); WS_DPP(0x142, 0xa); WS_DPP(0x143, 0xc);
#undef WS_DPP
    return __builtin_bit_cast(float, __builtin_amdgcn_readlane(__builtin_bit_cast(int, v), 63));
}
__device__ __forceinline__ float silu_acc(float x) { return x / (1.0f + __expf(-x)); }

#define XB_TMO      128
#define XB_XCNT(j)  (256  + 64 * (j))
#define XB_XSUB(j)  (1280 + 64 * (j))
#define XB_XGEN(j)  (2304 + 64 * (j))
#define XB_TOP      3328
#define XB_TOPGEN   3392
#define XCD_BAR_WORDS 3456
#define XB_SPIN_CAP (1u << 18)
__device__ __forceinline__ unsigned xb_ld(unsigned* p)              { return __hip_atomic_load(p, __ATOMIC_RELAXED, __HIP_MEMORY_SCOPE_AGENT); }
__device__ __forceinline__ unsigned xb_add(unsigned* p, unsigned v) { return __hip_atomic_fetch_add(p, v, __ATOMIC_RELAXED, __HIP_MEMORY_SCOPE_AGENT); }
__device__ __forceinline__ unsigned xb_xcc_id() { return (unsigned)__builtin_amdgcn_s_getreg((3 << 11) | 20) & 0xFu; }
#define XB_SPIN(cond, bar) do { unsigned _sp = 0; while (cond) { __builtin_amdgcn_s_sleep(1); \
    if ((++_sp & 255u) == 0u) { if (xb_ld(&(bar)[XB_TMO])) break; if (_sp > XB_SPIN_CAP) { atomicAdd(&(bar)[XB_TMO], 1u); break; } } } } while (0)
struct XcdBarrier { unsigned* bar; unsigned x; volatile LAS unsigned* st; };
__device__ __forceinline__ XcdBarrier xcd_barrier_post(unsigned* bar, volatile LAS unsigned* st) {
    XcdBarrier b; b.bar = bar; b.x = xb_xcc_id(); b.st = st;
    if (threadIdx.x == 0) (void)xb_add(&bar[XB_XCNT(b.x)], 1u);
    return b;
}
__device__ __forceinline__ void xcd_barrier_complete(unsigned* bar, unsigned x, unsigned& nloc, unsigned& nx) {
    const unsigned G = gridDim.x * gridDim.y * gridDim.z;
    unsigned sum, cnt, mine, sp = 0u;
    for (;;) {
        sum = 0u; cnt = 0u; mine = 0u;
#pragma unroll
        for (unsigned j = 0; j < 16; ++j) { const unsigned c = xb_ld(&bar[XB_XCNT(j)]); sum += c; cnt += (c > 0u) ? 1u : 0u; mine = (j == x) ? c : mine; }
        if (sum == G) break;
        __builtin_amdgcn_s_sleep(1);
        if ((++sp & 255u) == 0u) { if (xb_ld(&bar[XB_TMO])) break; if (sp > XB_SPIN_CAP) { atomicAdd(&bar[XB_TMO], 1u); break; } }
    }
    nloc = mine > 0u ? mine : 1u; nx = cnt > 0u ? cnt : 1u;
}
__device__ __forceinline__ void xcd_barrier(const XcdBarrier& b) {
    asm volatile("s_waitcnt vmcnt(0)" ::: "memory");
    __syncthreads();
    if (threadIdx.x == 0) {
        unsigned* bar = b.bar;
        __builtin_amdgcn_s_waitcnt(0);
        unsigned nloc = b.st[0], nx = b.st[1];
        if (nloc == 0u) { xcd_barrier_complete(bar, b.x, nloc, nx); b.st[0] = nloc; b.st[1] = nx; }
        const unsigned old = xb_add(&bar[XB_XSUB(b.x)], 1u);
        const unsigned gen = old / nloc;
        if (old + 1u == (gen + 1u) * nloc) {
            __builtin_amdgcn_fence(__ATOMIC_RELEASE, "agent");
            asm volatile("s_waitcnt vmcnt(0)" ::: "memory");
            const unsigned og = xb_add(&bar[XB_TOP], 1u);
            const unsigned tg = og / nx;
            if (og + 1u == (tg + 1u) * nx) xb_add(&bar[XB_TOPGEN], 1u);
            else XB_SPIN(xb_ld(&bar[XB_TOPGEN]) == tg, bar);
            __builtin_amdgcn_fence(__ATOMIC_ACQUIRE, "agent");
            xb_add(&bar[XB_XGEN(b.x)], 1u);
            asm volatile("s_waitcnt vmcnt(0)" ::: "memory");
        } else {
            XB_SPIN(xb_ld(&bar[XB_XGEN(b.x)]) == gen, bar);
            __builtin_amdgcn_fence(__ATOMIC_ACQUIRE, "agent");
            asm volatile("s_waitcnt vmcnt(0)" ::: "memory");
        }
    }
    __syncthreads();
}

struct Args { const float* in[N_IN]; float* out; unsigned char* ws; int ph_lo, ph_hi; };

struct TrItem { const float* src; bf16* dst; int N, Kd; };
__device__ __forceinline__ TrItem tr_make(const float* W, int N, bf16* WT, int Kd, int kb, int nb, int mode) {
    const int k0 = 64 * kb, n0 = 32 * nb; const int drow0 = mode == 0 ? n0 : ((n0 >> 7) * 256 + (n0 & 127) + (mode == 2 ? 128 : 0));
    TrItem t; t.src = W + (size_t)k0 * N + n0; t.dst = WT + (size_t)drow0 * Kd + k0; t.N = N; t.Kd = Kd; return t;
}
__device__ __forceinline__ void tr_load(const TrItem& t, float (&tv)[32], int lane) {
#pragma unroll
    for (int i = 0; i < 32; ++i) tv[i] = t.src[(size_t)(2 * i + (lane >> 5)) * t.N + (lane & 31)];
}
__device__ __forceinline__ void tr_finish(const TrItem& t, const float (&tv)[32], LAS float* scr, int lane) {
#pragma unroll
    for (int i = 0; i < 32; ++i) scr[(2 * i + (lane >> 5)) * 33 + (lane & 31)] = tv[i];
    LDS_WAIT(); asm volatile("" ::: "memory");
    const int c = lane & 7;
#pragma unroll
    for (int j = 0; j < 4; ++j) { const int n = (lane >> 3) + 8 * j; const LAS float* s = scr + (8 * c) * 33 + n;
        v4u o; o.x = pk2(s[0 * 33], s[1 * 33]); o.y = pk2(s[2 * 33], s[3 * 33]); o.z = pk2(s[4 * 33], s[5 * 33]); o.w = pk2(s[6 * 33], s[7 * 33]);
        *(v4u*)(t.dst + (size_t)n * t.Kd + 8 * c) = o; }
    LDS_WAIT(); asm volatile("" ::: "memory");
}

__device__ __forceinline__ void p0_prologue(const Args& a, LAS unsigned char* lds, int gw, int NGW, int wave, int lane, const bool with_j3) {
    unsigned char* ws = a.ws;
    LAS float* scr = (LAS float*)(lds + wave * 16384);
    if (with_j3) {
        LAS float* sl = (LAS float*)lds;
        LAS float* red = (LAS float*)(lds + 40960);
        const int tid = threadIdx.x, sub = lane >> 4, q = lane & 15;
        for (int e = tid; e < 9 * 1024; e += NTHREADS) { const int cc = e >> 10, k = e & 1023; sl[e] = silu_acc(cc == 0 ? a.in[I_CCTX][k] : a.in[I_C][(cc - 1) * 1024 + k]); }
        __syncthreads();
        for (int it = blockIdx.x; it < 2 * 144 * 2; it += NGW / NWAVES) {
            const int l = it / 288, r = it % 288, nch = r >> 1, kh = r & 1;
            const int k0 = kh * 512 + wave * 64;
            const float* wm = a.in[I_WMOD] + (size_t)l * 1024 * 9216 + (size_t)(k0 + sub) * 9216 + nch * 64 + q * 4;
            f32x4 w[16];
#pragma unroll
            for (int i = 0; i < 16; ++i) w[i] = *(const f32x4*)(wm + (size_t)(4 * i) * 9216);
            f32x4 acc[9];
#pragma unroll
            for (int c = 0; c < 9; ++c) acc[c] = (f32x4){0.f, 0.f, 0.f, 0.f};
#pragma unroll
            for (int i = 0; i < 16; ++i)
#pragma unroll
                for (int c = 0; c < 9; ++c) acc[c] += sl[c * 1024 + k0 + 4 * i + sub] * w[i];
#pragma unroll
            for (int c = 0; c < 9; ++c)
#pragma unroll
                for (int j = 0; j < 4; ++j) { float v = acc[c][j]; v += __shfl_xor(v, 16); v += __shfl_xor(v, 32); acc[c][j] = v; }
            if (lane < 16) {
#pragma unroll
                for (int c = 0; c < 9; ++c) *(LAS f32x4*)(red + (wave * 9 + c) * 64 + q * 4) = acc[c];
            }
            __syncthreads();
            for (int e = tid; e < 9 * 64; e += NTHREADS) { const int c = e >> 6, col = e & 63, n = nch * 64 + col; float sm = 0.f;
#pragma unroll
                for (int w8 = 0; w8 < 8; ++w8) sm += red[(w8 * 9 + c) * 64 + col];
                if (kh == 0) sm += a.in[I_BMOD][l * 9216 + n];
                atomicAdd((float*)(ws + WS_MOD) + (size_t)(l * 9 + c) * 9216 + n, sm); }
            __syncthreads();
        }
    }
    constexpr int I_G = 16 * 88, I_D = 44 * 32, I_FF = 3 * I_G, I_IN = 16 * 64, I_OUT = 12 * 32, I_L = 2 * I_FF + I_IN + I_OUT;
    static_assert(I_G == I_D, "items");
    auto j1_item = [&](int it) __attribute__((always_inline)) -> TrItem {
        const int l = it / I_L; int r = it % I_L;
        if (r < 2 * I_FF) {
            const int f = r / I_FF; r %= I_FF; const int part = r / I_G; r %= I_G;
            const size_t lo = (size_t)l * 1024 * 2816;
            if (part == 0)      return tr_make(a.in[f ? I_W2G : I_W1G] + lo, 2816, (bf16*)(ws + WS_WGU) + (size_t)(l * 2 + f) * 5632 * 1024, 1024, r / 88, r % 88, 1);
            else if (part == 1) return tr_make(a.in[f ? I_W2U : I_W1U] + lo, 2816, (bf16*)(ws + WS_WGU) + (size_t)(l * 2 + f) * 5632 * 1024, 1024, r / 88, r % 88, 2);
            else                return tr_make(a.in[f ? I_W2D : I_W1D] + lo, 1024, (bf16*)(ws + WS_WD) + (size_t)(l * 2 + f) * 1024 * 2816, 2816, r / 32, r % 32, 0);
        }
        r -= 2 * I_FF;
        if (r < I_IN) return tr_make(a.in[I_WIN] + (size_t)l * 1024 * 2048, 2048, (bf16*)(ws + WS_WIN) + (size_t)l * 2048 * 1024, 1024, r / 64, r % 64, 0);
        r -= I_IN; int kb = r / 32; if (kb >= 8) kb += 4;
        return tr_make(a.in[I_WOUT] + (size_t)l * 1024 * 1024, 1024, (bf16*)(ws + WS_WOUT) + (size_t)l * 1024 * 1024, 1024, kb, r % 32, 0);
    };
    const int j_lo = 0, j_hi = 2 * I_L, j_gw = gw, j_st = NGW;
    if (j_lo + j_gw < j_hi) {
        TrItem cur = j1_item(j_lo + j_gw); float tv[32]; tr_load(cur, tv, lane);
        for (int it = j_lo + j_gw; it < j_hi; it += j_st) {
            const bool more = it + j_st < j_hi;
            TrItem nxt = cur; float tn[32];
            if (more) { nxt = j1_item(it + j_st); tr_load(nxt, tn, lane); }
            tr_finish(cur, tv, scr, lane);
            if (more) { cur = nxt;
#pragma unroll
                for (int i = 0; i < 32; ++i) tv[i] = tn[i]; }
        }
    }
    for (int it = gw; it < 2 * 256 * 4; it += NGW) {
        const int l = it >> 10, kp = (it >> 2) & 255, nc = it & 3;
        const float* pw = a.in[I_CPW] + (size_t)l * 65536 + kp * 256;
        const float* wo = a.in[I_WOUT] + (size_t)l * 1048576 + (size_t)512 * 1024 + nc * 256 + lane * 4;
        f32x4 acc = {0.f, 0.f, 0.f, 0.f};
#pragma unroll 8
        for (int j = 0; j < 256; ++j) acc += pw[j] * *(const f32x4*)(wo + (size_t)j * 1024);
        bf16* dst = (bf16*)(ws + WS_WOUT) + (size_t)l * 1048576 + (size_t)(nc * 256 + lane * 4) * 1024 + 512 + kp;
        dst[0] = (bf16)f2bf(acc[0]); dst[1024] = (bf16)f2bf(acc[1]); dst[2048] = (bf16)f2bf(acc[2]); dst[3072] = (bf16)f2bf(acc[3]);
    }
    {
        const int gt = gw * 64 + lane, NGT = NGW * 64;
        for (int e = gt; e < 2 * 8 * 256 * 128; e += NGT) {
            const int gd = e & 127, p = (e >> 7) & 255, b = (e >> 15) & 7, l = e >> 18;
            const size_t src = (((size_t)b * 2 + l) * 256 + p) * 128 + gd;
            const float kv = a.in[I_CK][src], vv = a.in[I_CV][src];
            ((bf16*)(ws + WS_CKB))[e] = (bf16)f2bf(kv);
            ((bf16*)(ws + WS_CVT))[(((size_t)l * 8 + b) * 128 + gd) * 256 + p] = (bf16)f2bf(vv);
        }
        for (int e = gt; e < 1024; e += NGT) { const int p = e >> 4, i = e & 15; const float inv = powf(10000.0f, -(float)i / 16.0f); const float ang = (float)p * inv;
            ((float*)(ws + WS_ROPE))[2 * e] = cosf(ang); ((float*)(ws + WS_ROPE))[2 * e + 1] = sinf(ang); }
    }
    for (int it = gw; it < 2 * 2304; it += NGW) {
        const int l = it / 2304, tt = it % 2304; const int L = tt < 2048 ? 2048 : 256, t = tt < 2048 ? tt : tt - 2048;
        const float tf = (float)t, tn = tf / (float)(L - 1);
        const float* w1 = a.in[I_HW1] + l * 33 * 64; const float* w2 = a.in[I_HW2] + l * 64 * 64;
        float s1 = tn * w1[lane];
#pragma unroll 4
        for (int i = 0; i < 16; ++i) { const float band = 1e-4f + (float)i * ((15.0f - 1e-4f) / 15.0f); const float ang = (6.283185307179586f * tf) * band / (float)L;
            s1 += cosf(ang) * w1[(1 + i) * 64 + lane] - sinf(ang) * w1[(17 + i) * 64 + lane]; }
        const float h1 = sinf(a.in[I_HF1][l * 64 + lane] * (s1 + a.in[I_HB1][l * 64 + lane]));
        float s2 = 0.f;
#pragma unroll 8
        for (int k = 0; k < 64; ++k) s2 += __shfl(h1, k) * w2[k * 64 + lane];
        const float h2 = sinf(a.in[I_HF2][l * 64 + lane] * (s2 + a.in[I_HB2][l * 64 + lane]));
        ((float*)(ws + WS_HYH))[(size_t)it * 64 + lane] = h2;
    }
}

__device__ __forceinline__ void prep_phase(const float* src0, const float* src1, const float* g, const float* mod, int sc_chunk, bf16* H, unsigned long long* ss, int r_lo, int r_hi, int gw, int NGW, int lane) {
    const int per = (r_hi - r_lo + NGW - 1) / NGW; int r = r_lo + gw * per; r_hi = (r + per < r_hi) ? r + per : r_hi; NGW = 1;
    if (r >= r_hi) return;
    f32x4 v[4], v1[4], v2[4];
#define PREP_LOAD(dst, row) do { const int rr_ = (row); if (rr_ < r_hi) { const float* xr_ = rr_ < MCTX ? src0 + (size_t)rr_ * D : src1 + (size_t)(rr_ - MCTX) * D; \
        _Pragma("unroll") for (int j = 0; j < 4; ++j) dst[j] = ((const f32x4*)xr_)[lane + 64 * j]; } } while (0)
    PREP_LOAD(v, r); PREP_LOAD(v1, r + NGW);
    for (; r < r_hi; r += NGW) {
        PREP_LOAD(v2, r + 2 * NGW);
        const int cond = r < MCTX ? 0 : 1 + ((r - MCTX) >> 11);
        const float* sc = mod + cond * 9216 + sc_chunk * 1024;
        float s = 0.f;
#pragma unroll
        for (int j = 0; j < 4; ++j) s += (v[j][0] * v[j][0] + v[j][1] * v[j][1]) + (v[j][2] * v[j][2] + v[j][3] * v[j][3]);
        s = wave_sum(s); if (lane == 0) ss[r] = (unsigned long long)(s * SS_FIX);
#pragma unroll
        for (int j = 0; j < 4; ++j) { const int col = 4 * (lane + 64 * j);
            const f32x4 o = v[j] * *(const f32x4*)(g + col) * (*(const f32x4*)(sc + col) + 1.0f);
            v2u w; w.x = pk2(o[0], o[1]); w.y = pk2(o[2], o[3]); *(v2u*)(H + (size_t)r * D + col) = w; }
#pragma unroll
        for (int j = 0; j < 4; ++j) { v[j] = v1[j]; v1[j] = v2[j]; }
    }
#undef PREP_LOAD
}
__device__ __forceinline__ void bias_phase(const Args& a, int it_lo, int it_hi, int gw, int NGW, int lane) {
    unsigned char* ws = a.ws;
    const int i = lane & 15, q = lane >> 4;
    for (int it = it_lo + gw; it < it_hi; it += NGW) {
        const int l = it / 832; int r = it % 832; int which, n0;
        if (r < 352) { which = 0; n0 = r * 16; } else if (r < 480) { which = 1; n0 = (r - 352) * 16; } else { which = 2; n0 = (r - 480) * 16; }
        const bf16* Wt = which == 1 ? (const bf16*)(ws + WS_WIN) + (size_t)l * 2048 * 1024 : (const bf16*)(ws + WS_WGU) + (size_t)(l * 2 + (which == 2 ? 1 : 0)) * 5632 * 1024;
        const int shc = which == 0 ? 0 : (which == 1 ? 3 : 6), off = which == 0 ? 0 : (which == 1 ? 50688 : 69120), bst = which == 1 ? 2048 : 5632;
        const float* shp = (const float*)(ws + WS_MOD) + (size_t)l * 9 * 9216 + (size_t)(i < 9 ? i : 0) * 9216 + shc * 1024 + 8 * q;
        const bf16* wp = Wt + (size_t)(n0 + i) * 1024 + 8 * q;
        f32x4 acc = {0.f, 0.f, 0.f, 0.f};
#pragma unroll 8
        for (int st = 0; st < 32; ++st) {
            const f32x4 s0 = *(const f32x4*)(shp + 32 * st), s1 = *(const f32x4*)(shp + 32 * st + 4);
            const v4u wv = *(const v4u*)(wp + 32 * st);
            v4u av; av.x = pk2(s0[0], s0[1]); av.y = pk2(s0[2], s0[3]); av.z = pk2(s1[0], s1[1]); av.w = pk2(s1[2], s1[3]);
            if (i >= 9) av = (v4u){0u, 0u, 0u, 0u};
            acc = __builtin_amdgcn_mfma_f32_16x16x32_bf16(__builtin_bit_cast(bf16x8, av), __builtin_bit_cast(bf16x8, wv), acc, 0, 0, 0);
        }
        float* bo = (float*)(ws + WS_BIAS) + (size_t)l * 119808 + off + n0 + i;
#pragma unroll
        for (int rg = 0; rg < 4; ++rg) { const int cond = 4 * q + rg; if (cond < 9) bo[(size_t)cond * bst] = acc[rg]; }
    }
}
__device__ __forceinline__ void gct_phase(const Args& a, int gw, int NGW, int lane) {
    const int gt = gw * 64 + lane, NGT = NGW * 64;
    for (int e = gt; e < 6 * 9 * 1024; e += NGT) {
        const int inst = e / 9216, r = e % 9216, cond = r >> 10, col = r & 1023;
        float v = 0.f;
        if (inst >= 1) { const int l = inst / 3, k = inst % 3;
            const float g = (k == 0 ? a.in[I_GF1] : (k == 1 ? a.in[I_GMIX] : a.in[I_GF2]))[l * 1024 + col];
            const float sc = ((const float*)(a.ws + WS_MOD))[(size_t)l * 9 * 9216 + cond * 9216 + (k == 0 ? 1 : (k == 1 ? 4 : 7)) * 1024 + col];
            v = g * (1.0f + sc); }
        ((float*)(a.ws + WS_GCT))[e] = v;
    }
}
__device__ __forceinline__ void final_norm_phase(float* X, const float* g, const float* ss, int gw, int NGW, int lane) {
    for (int r = gw; r < M; r += NGW) {
        float* xr = X + (size_t)r * D;
        const float rstd = 1.0f / sqrtf(ss[r] * (1.0f / D) + EPS);
#pragma unroll
        for (int j = 0; j < 4; ++j) { const int col = 4 * (lane + 64 * j); ((f32x4*)xr)[lane + 64 * j] = (((const f32x4*)xr)[lane + 64 * j] * rstd) * *(const f32x4*)(g + col); }
    }
}

__device__ __forceinline__ void hyena_filter_phase(const Args& a, LAS unsigned char* lds, int gw, int NGW, int wave, int lane) {
    unsigned char* ws = a.ws;
    LAS float* hs = (LAS float*)(lds + wave * 16384);
    for (int it = gw; it < 2 * 36 * 16; it += NGW) {
        const int l = it / 576, r = it % 576, tc = r >> 4, ng = r & 15;
        const int stream = tc < 32 ? 0 : 1; const int L = stream ? 256 : 2048; const int t0 = (stream ? tc - 32 : tc) * 64; const int soff = stream ? 4096 : 0;
        const int n = ng * 64 + lane, o = n >> 9, dir = (n >> 8) & 1, c = n & 255;
        const float* hrow = (const float*)(ws + WS_HYH) + ((size_t)l * 2304 + (stream ? 2048 : 0) + t0) * 64;
        f32x4 hv[16];
#pragma unroll
        for (int i = 0; i < 16; ++i) hv[i] = ((const f32x4*)hrow)[i * 64 + lane];
        const float* w3 = a.in[I_HW3] + (size_t)l * 64 * 1024 + n;
        float w[64];
#pragma unroll
        for (int k = 0; k < 64; ++k) w[k] = w3[k * 1024];
        const float ndecay = -__expf(a.in[I_HLD][l * 1024 + n]) / (float)(L - 1);
#pragma unroll
        for (int i = 0; i < 16; ++i) *(LAS f32x4*)(hs + (i * 64 + lane) * 4) = hv[i];
        LDS_WAIT(); asm volatile("" ::: "memory");
        bf16* dst = (bf16*)(ws + WS_HYRAW) + ((size_t)(l * 2 + o) * 256 + c) * 4608 + soff;
        float sq = 0.f;
        for (int tt = 0; tt < 64; ++tt) {
            const int t = t0 + tt; float dot = 0.f;
#pragma unroll
            for (int k4 = 0; k4 < 16; ++k4) { const f32x4 h = *(const LAS f32x4*)(hs + tt * 64 + k4 * 4); dot += (h[0] * w[4 * k4] + h[1] * w[4 * k4 + 1]) + (h[2] * w[4 * k4 + 2] + h[3] * w[4 * k4 + 3]); }
            const float val = dot * __expf((float)t * ndecay);
            sq += val * val;
            if (dir == 0) dst[L - 1 - t] = (bf16)f2bf(val);
            else if (t > 0) dst[L - 1 + t] = (bf16)f2bf(val);
            else dst[2 * L - 1] = 0;
        }
        atomicAdd((unsigned long long*)(ws + WS_SUMSQ) + ((l * 2 + stream) * 2 + o) * 256 + c, (unsigned long long)(sq * FSQ_FIX));
        LDS_WAIT(); asm volatile("" ::: "memory");
    }
}

__device__ __forceinline__ void conv_phase(const Args& a, int l, const bf16* Z, bf16* CAT, LAS unsigned char* lds, int tid) {
    LAS float* ybuf = (LAS float*)lds;
    LAS float* cbuf = (LAS float*)(lds + 65536);
    const float* dw = a.in[I_CDW] + l * 31 * 256; const float* dwb = a.in[I_CDWB] + l * 256; const float* lng = a.in[I_CLNG] + l * 256; const float* lnb = a.in[I_CLNB] + l * 256;
    const int lane = tid & 63, wave = tid >> 6;
    for (int u = blockIdx.x; u < M / 32; u += gridDim.x) {
        const int r0 = u * 32;
        const int seq0 = r0 < MCTX ? (r0 & ~255) : MCTX + ((r0 - MCTX) & ~2047); const int seq1 = seq0 + (r0 < MCTX ? 256 : 2048);
        for (int e = tid; e < 62 * 32; e += NTHREADS) {
            const int rr = e >> 5, ch = e & 31; const int row = r0 - 15 + rr;
            float y[8];
            if (row >= seq0 && row < seq1) {
                const v4u av = *(const v4u*)(Z + (size_t)row * ZW + 768 + ch * 8), gv = *(const v4u*)(Z + (size_t)row * ZW + 1024 + ch * 8);
                const float af[8] = {bflo(av.x), bfhi(av.x), bflo(av.y), bfhi(av.y), bflo(av.z), bfhi(av.z), bflo(av.w), bfhi(av.w)};
                const float gf[8] = {bflo(gv.x), bfhi(gv.x), bflo(gv.y), bfhi(gv.y), bflo(gv.z), bfhi(gv.z), bflo(gv.w), bfhi(gv.w)};
#pragma unroll
                for (int j = 0; j < 8; ++j) y[j] = af[j] / (1.0f + __expf(-gf[j]));
            } else {
#pragma unroll
                for (int j = 0; j < 8; ++j) y[j] = 0.f;
            }
            *(LAS f32x4*)(ybuf + rr * 256 + ch * 8) = (f32x4){y[0], y[1], y[2], y[3]}; *(LAS f32x4*)(ybuf + rr * 256 + ch * 8 + 4) = (f32x4){y[4], y[5], y[6], y[7]};
        }
        __syncthreads();
        { const int c = tid & 255, half = tid >> 8;
          float w[31];
#pragma unroll
          for (int k = 0; k < 31; ++k) w[k] = dw[k * 256 + c];
          const float bias = dwb[c];
          float yv[46];
#pragma unroll
          for (int i = 0; i < 46; ++i) yv[i] = ybuf[(half * 16 + i) * 256 + c];
#pragma unroll
          for (int t = 0; t < 16; ++t) { float s = bias;
#pragma unroll
              for (int k = 0; k < 31; ++k) s += w[k] * yv[t + k];
              cbuf[(half * 16 + t) * 256 + c] = s; } }
        __syncthreads();
        for (int rr = wave * 4; rr < wave * 4 + 4; ++rr) {
            const f32x4 x = *(const LAS f32x4*)(cbuf + rr * 256 + lane * 4);
            const float mu = wave_sum((x[0] + x[1]) + (x[2] + x[3])) * (1.0f / 256.0f);
            const f32x4 dx = x - mu;
            const float var = wave_sum((dx[0] * dx[0] + dx[1] * dx[1]) + (dx[2] * dx[2] + dx[3] * dx[3])) * (1.0f / 256.0f);
            const float rstd = 1.0f / sqrtf(var + EPS);
            const f32x4 yv = dx * rstd * *(const f32x4*)(lng + lane * 4) + *(const f32x4*)(lnb + lane * 4);
            v2u wv; wv.x = pk2(silu_acc(yv[0]), silu_acc(yv[1])); wv.y = pk2(silu_acc(yv[2]), silu_acc(yv[3]));
            *(v2u*)(CAT + (size_t)(r0 + rr) * 1024 + 512 + lane * 4) = wv;
        }
        __syncthreads();
    }
}


typedef unsigned long long u64;
typedef u64 u64x2 __attribute__((ext_vector_type(2)));
template <int L> struct HyGeo {
    static constexpr int R = L / 128, NSTEP = L / 32, CS = 4 * L + 64, US = 2 * L + 32, OFF_U = 8 * CS;
};
template <int L>
__device__ __forceinline__ void hy_build_copies(LAS unsigned char* lds, const bf16* raw, int tid) {
    constexpr int CS = HyGeo<L>::CS;
    for (int p = tid; p < L / 4; p += NTHREADS) {
        const v4u a = *(const v4u*)(raw + 8 * p), b = *(const v4u*)(raw + 8 * p + 8);
        const unsigned w[8] = {a.x, a.y, a.z, a.w, b.x, b.y, b.z, b.w};
#pragma unroll
        for (int sg = 0; sg < 8; ++sg) { v4u o;
            if ((sg & 1) == 0) { o.x = w[sg / 2]; o.y = w[sg / 2 + 1]; o.z = w[sg / 2 + 2]; o.w = w[sg / 2 + 3]; }
            else { const int h = sg / 2; o.x = (w[h] >> 16) | (w[h + 1] << 16); o.y = (w[h + 1] >> 16) | (w[h + 2] << 16); o.z = (w[h + 2] >> 16) | (w[h + 3] << 16); o.w = (w[h + 3] >> 16) | (w[h + 4] << 16); }
            *(LAS v4u*)(lds + sg * CS + 16 * p) = o; }
    }
}
template <int L, int NB>
__device__ __forceinline__ void hy_toeplitz(LAS unsigned char* lds, int boff, f32x4 (&acc)[HyGeo<L>::R][NB > 8 ? 2 : 1], int wave, int lane) {
    constexpr int R = HyGeo<L>::R, NT = NB > 8 ? 2 : 1, NSTEP = HyGeo<L>::NSTEP, CS = HyGeo<L>::CS, US = HyGeo<L>::US;
    const int i = lane & 15, q = lane >> 4;
    const int abase = (7 - (i & 7)) * CS + 16 * ((L / 8 - 1) - (i >> 3) + q - 2 * R * wave);
    int bb[NT];
#pragma unroll
    for (int nt = 0; nt < NT; ++nt) bb[nt] = boff + ((NB > 8 ? nt * 16 + i : (i & 7))) * US + 16 * q;
    bf16x8 F[R];
#pragma unroll
    for (int e = 0; e < R; ++e) F[e] = *(const LAS bf16x8*)(lds + abase - 32 * e);
#pragma unroll
    for (int r = 0; r < R; ++r)
#pragma unroll
        for (int nt = 0; nt < NT; ++nt) acc[r][nt] = (f32x4){0.f, 0.f, 0.f, 0.f};
    bf16x8 B[2][NT];
#pragma unroll
    for (int nt = 0; nt < NT; ++nt) B[0][nt] = *(const LAS bf16x8*)(lds + bb[nt]);
#pragma unroll 1
    for (int jo = 0; jo < NSTEP; jo += 8) {
#pragma unroll
        for (int ji = 0; ji < 8; ++ji) {
            const int j = jo + ji; constexpr int dummy = 0; (void)dummy;
#pragma unroll
            for (int r = R - 2; r < R; ++r) { const int slot = (((r - 2 * ji) % R) + R) % R;
#pragma unroll
                for (int nt = 0; nt < NT; ++nt) acc[r][nt] = __builtin_amdgcn_mfma_f32_16x16x32_bf16(F[slot], B[ji & 1][nt], acc[r][nt], 0, 0, 0); }
            __builtin_amdgcn_sched_barrier(0);
            if (j + 1 < NSTEP) {
#pragma unroll
                for (int nt = 0; nt < NT; ++nt) B[(ji + 1) & 1][nt] = *(const LAS bf16x8*)(lds + bb[nt] + 64 * (j + 1));
#pragma unroll
                for (int rr = 0; rr < 2; ++rr) { const int slot = (((rr - 2 * (ji + 1)) % R) + R) % R; F[slot] = *(const LAS bf16x8*)(lds + abase + 64 * (j + 1) - 32 * rr); }
            }
            __builtin_amdgcn_sched_barrier(0);
#pragma unroll
            for (int r = 0; r < R - 2; ++r) { const int slot = (((r - 2 * ji) % R) + R) % R;
#pragma unroll
                for (int nt = 0; nt < NT; ++nt) acc[r][nt] = __builtin_amdgcn_mfma_f32_16x16x32_bf16(F[slot], B[ji & 1][nt], acc[r][nt], 0, 0, 0); }
            __builtin_amdgcn_sched_barrier(0);
        }
    }
}
struct XRaw { v2u z; unsigned zl, zr; };
__device__ __forceinline__ XRaw xraw_load(const bf16* zrow, int t, int L) { XRaw x; x.z = *(const v2u*)zrow; x.zl = t > 0 ? (unsigned)zrow[-1] : 0u; x.zr = t + 4 < L ? (unsigned)zrow[4] : 0u; return x; }
__device__ __forceinline__ void sconv4x(const XRaw& x, float w0, float w1, float w2, float sb, float (&out)[4]) {
    const float zl = bf2f(x.zl), zr = bf2f(x.zr), z0 = bflo(x.z.x), z1 = bfhi(x.z.x), z2 = bflo(x.z.y), z3 = bfhi(x.z.y);
    out[0] = sb + w0 * zl + w1 * z0 + w2 * z1; out[1] = sb + w0 * z0 + w1 * z1 + w2 * z2; out[2] = sb + w0 * z1 + w1 * z2 + w2 * z3; out[3] = sb + w0 * z2 + w1 * z3 + w2 * zr;
}
__device__ __forceinline__ void sconv4(const bf16* zrow, int t, int L, float w0, float w1, float w2, float sb, float (&out)[4]) { const XRaw x = xraw_load(zrow, t, L); sconv4x(x, w0, w1, w2, sb, out); }
template <int L>
__device__ __forceinline__ void hy_store_copies(LAS unsigned char* lds, const v4u a, const v4u b, int p) {
    constexpr int CS = HyGeo<L>::CS;
    const unsigned w[8] = {a.x, a.y, a.z, a.w, b.x, b.y, b.z, b.w};
#pragma unroll
    for (int sg = 0; sg < 8; ++sg) { v4u o;
        if ((sg & 1) == 0) { o.x = w[sg / 2]; o.y = w[sg / 2 + 1]; o.z = w[sg / 2 + 2]; o.w = w[sg / 2 + 3]; }
        else { const int h = sg / 2; o.x = (w[h] >> 16) | (w[h + 1] << 16); o.y = (w[h + 1] >> 16) | (w[h + 2] << 16); o.z = (w[h + 2] >> 16) | (w[h + 3] << 16); o.w = (w[h + 3] >> 16) | (w[h + 4] << 16); }
        *(LAS v4u*)(lds + sg * CS + 16 * p) = o; }
}
template <int L, int NB, bool DUP = false>
__device__ __forceinline__ void hyena_channel(const Args& a, int l, int c, const bf16* ZT, bf16* CAT, LAS unsigned char* lds, int tid, int wave, int lane) {
    constexpr int R = HyGeo<L>::R, NT = NB > 8 ? 2 : 1, US = HyGeo<L>::US, OFF_U = HyGeo<L>::OFF_U, OFF_Y = OFF_U + NB * US;
    constexpr bool LAT = (L == 2048); constexpr int stream = LAT ? 0 : 1; constexpr int rowbase = LAT ? MCTX : 0;
    static_assert(L / 4 <= NTHREADS, "one copy slot per thread");
    unsigned char* ws = a.ws;
    const float* sw = a.in[I_HSW] + l * 3 * 768; const float* sb = a.in[I_HSB] + l * 768;
    const bf16* raw0 = (const bf16*)(ws + WS_HYRAW) + ((size_t)(l * 2 + 0) * 256 + c) * 4608 + (LAT ? 0 : 4096);
    const bf16* raw1 = (const bf16*)(ws + WS_HYRAW) + ((size_t)(l * 2 + 1) * 256 + c) * 4608 + (LAT ? 0 : 4096);
    const int i = lane & 15;
    const bool cp = tid < L / 4;
    v4u f0a = {0u, 0u, 0u, 0u}, f0b = f0a, f1a = f0a, f1b = f0a;
    if (cp) { f0a = *(const v4u*)(raw0 + 8 * tid); f0b = *(const v4u*)(raw0 + 8 * tid + 8); f1a = *(const v4u*)(raw1 + 8 * tid); f1b = *(const v4u*)(raw1 + 8 * tid + 8); }
    __syncthreads();
    if (cp) hy_store_copies<L>(lds, f0a, f0b, tid);
    { const float w0 = sw[c], w1 = sw[768 + c], w2 = sw[1536 + c], b0 = sb[c];
      for (int idx = tid; idx < NB * (L / 8); idx += NTHREADS) {
          const int b = idx / (L / 8), s0 = (idx % (L / 8)) * 8; const bf16* zrow = ZT + (size_t)c * M + rowbase + b * L + s0;
          float o0[4], o1[4]; sconv4(zrow, s0, L, w0, w1, w2, b0, o0); sconv4(zrow + 4, s0 + 4, L, w0, w1, w2, b0, o1);
          v4u w; w.x = pk2(o0[0], o0[1]); w.y = pk2(o0[2], o0[3]); w.z = pk2(o1[0], o1[1]); w.w = pk2(o1[2], o1[3]);
          *(LAS v4u*)(lds + OFF_U + b * US + 2 * s0) = w; } }
    __syncthreads();
    f32x4 acc[R][NT];
    hy_toeplitz<L, NB>(lds, OFF_U, acc, wave, lane);
    if constexpr (DUP) { { _Pragma("unroll") for (int r_ = 0; r_ < R; ++r_) _Pragma("unroll") for (int n_ = 0; n_ < NT; ++n_) asm volatile("" : "+v"(acc[r_][n_])); } hy_toeplitz<L, NB>(lds, OFF_U, acc, wave, lane); }
    { const float scale = 1.0f / sqrtf((float)((const unsigned long long*)(ws + WS_SUMSQ))[((l * 2 + stream) * 2 + 0) * 256 + c] * FSQ_UNFIX + EPS), bias = a.in[I_HBIAS][(l * 2 + 0) * 256 + c];
      const float w0 = sw[256 + c], w1 = sw[768 + 256 + c], w2 = sw[1536 + 256 + c], b0 = sb[256 + c];
      int q = lane >> 4; asm volatile("" : "+v"(q));
#pragma unroll
      for (int nt = 0; nt < NT; ++nt) { const int b = nt * 16 + i;
          if (b < NB) {
#pragma unroll
              for (int r = 0; r < R; ++r) { const int t = 16 * (R * wave + r) + 4 * q;
                  float x1[4]; sconv4(ZT + (size_t)(256 + c) * M + rowbase + b * L + t, t, L, w0, w1, w2, b0, x1);
                  const v2u uv = *(const LAS v2u*)(lds + OFF_U + b * US + 2 * t);
                  const float y0 = x1[0] * (scale * acc[r][nt][0] + bias * bflo(uv.x)), y1 = x1[1] * (scale * acc[r][nt][1] + bias * bfhi(uv.x));
                  const float y2 = x1[2] * (scale * acc[r][nt][2] + bias * bflo(uv.y)), y3 = x1[3] * (scale * acc[r][nt][3] + bias * bfhi(uv.y));
                  v2u w; w.x = pk2(y0, y1); w.y = pk2(y2, y3); *(LAS v2u*)(lds + OFF_Y + b * US + 2 * t) = w; } } } }
    __syncthreads();
    if (cp) hy_store_copies<L>(lds, f1a, f1b, tid);
    __syncthreads();
    hy_toeplitz<L, NB>(lds, OFF_Y, acc, wave, lane);
    if constexpr (DUP) { { _Pragma("unroll") for (int r_ = 0; r_ < R; ++r_) _Pragma("unroll") for (int n_ = 0; n_ < NT; ++n_) asm volatile("" : "+v"(acc[r_][n_])); } hy_toeplitz<L, NB>(lds, OFF_Y, acc, wave, lane); }
    { const float scale = 1.0f / sqrtf((float)((const unsigned long long*)(ws + WS_SUMSQ))[((l * 2 + stream) * 2 + 1) * 256 + c] * FSQ_UNFIX + EPS), bias = a.in[I_HBIAS][(l * 2 + 1) * 256 + c];
      const float w0 = sw[512 + c], w1 = sw[768 + 512 + c], w2 = sw[1536 + 512 + c], b0 = sb[512 + c];
      int q = lane >> 4; asm volatile("" : "+v"(q));
#pragma unroll
      for (int nt = 0; nt < NT; ++nt) { const int b = nt * 16 + i;
          if (b < NB) {
#pragma unroll
              for (int r = 0; r < R; ++r) { const int t = 16 * (R * wave + r) + 4 * q;
                  float x2[4]; sconv4(ZT + (size_t)(512 + c) * M + rowbase + b * L + t, t, L, w0, w1, w2, b0, x2);
                  const v2u yv = *(const LAS v2u*)(lds + OFF_Y + b * US + 2 * t);
                  bf16* dst = CAT + (size_t)(rowbase + b * L + t) * 1024 + 768 + c;
                  dst[0]    = (bf16)f2bf(x2[0] * (scale * acc[r][nt][0] + bias * bflo(yv.x)));
                  dst[1024] = (bf16)f2bf(x2[1] * (scale * acc[r][nt][1] + bias * bfhi(yv.x)));
                  dst[2048] = (bf16)f2bf(x2[2] * (scale * acc[r][nt][2] + bias * bflo(yv.y)));
                  dst[3072] = (bf16)f2bf(x2[3] * (scale * acc[r][nt][3] + bias * bfhi(yv.y))); } } } }
    __syncthreads();
}

typedef float f32x16 __attribute__((ext_vector_type(16)));
constexpr int ATT_KP = 144, ATT_VP = 80, ATT_KB = 32 * ATT_KP, ATT_BUF = ATT_KB + 64 * ATT_VP;
__device__ __forceinline__ void attn_phase(const Args& a, int l, const bf16* Z, const bf16* ZT, bf16* CAT, LAS unsigned char* lds, int tid, int wave, int lane) {
    const bf16* CKB = (const bf16*)(a.ws + WS_CKB) + (size_t)l * 8 * 256 * 128; const bf16* CVT = (const bf16*)(a.ws + WS_CVT) + (size_t)l * 8 * 128 * 256;
    const int r = lane & 31, hh = lane >> 5;
    for (int it = blockIdx.x; it < 768; it += gridDim.x) {
        bool lat; int b, g, qb;
        if (it < 512) { lat = true; b = it >> 6; g = (it >> 5) & 1; qb = it & 31; }
        else { const int rr = it - 512; lat = false; b = rr >> 3; g = (rr >> 2) & 1; qb = rr & 3; }
        const int h = g * 4 + (wave & 3), q0 = qb * 64 + 32 * (wave >> 2);
        const int L = lat ? 2048 : 256, seq0 = lat ? MCTX + b * 2048 : b * 256;
        const int kt_lo = lat ? (qb * 64 - 128 < 0 ? 0 : qb * 64 - 128) : 0, kt_hi = lat ? (qb * 64 + 192 > L ? L : qb * 64 + 192) : 256;
        const int n_local = (kt_hi - kt_lo) >> 5, n_total = n_local + (lat ? 8 : 0);
        const bool isk = tid < 256; const int t2 = tid & 255;
        const bf16* src_loc = isk ? Z + (size_t)(seq0 + kt_lo + (t2 >> 3)) * ZW + 512 + g * 64 + (t2 & 7) * 8 : ZT + (size_t)(768 + g * 64 + (t2 >> 2)) * M + seq0 + kt_lo + (t2 & 3) * 8;
        const bf16* src_ctx = isk ? CKB + ((size_t)b * 256 + (t2 >> 3)) * 128 + g * 64 + (t2 & 7) * 8 : CVT + ((size_t)b * 128 + g * 64 + (t2 >> 2)) * 256 + (t2 & 3) * 8;
        const size_t step_loc = isk ? (size_t)32 * ZW : 32, step_ctx = isk ? (size_t)32 * 128 : 32;
        const int dst = isk ? (t2 >> 3) * ATT_KP + (t2 & 7) * 16 : ATT_KB + (t2 >> 2) * ATT_VP + ((t2 & 3) >> 1) * 32 + ((t2 & 3) & 1) * 8;
#define ATT_GLOAD(ti_) (*(const v4u*)((ti_) < n_local ? src_loc + (size_t)(ti_) * step_loc : src_ctx + (size_t)((ti_) - n_local) * step_ctx))
#define ATT_LSTORE(buf_, v_) do { LAS unsigned char* p_ = lds + (buf_) * ATT_BUF + dst; if (isk) *(LAS v4u*)p_ = (v_); else { v2u lo_, hi_; lo_.x = (v_).x; lo_.y = (v_).y; hi_.x = (v_).z; hi_.y = (v_).w; *(LAS v2u*)p_ = lo_; *(LAS v2u*)(p_ + 16) = hi_; } } while (0)
        bf16x8 qf[4];
        { const bf16* qp = Z + (size_t)(seq0 + q0 + r) * ZW + h * 64 + 8 * hh;
#pragma unroll
          for (int s = 0; s < 4; ++s) qf[s] = *(const bf16x8*)(qp + 16 * s); }
        f32x16 o0, o1;
#pragma unroll
        for (int e = 0; e < 16; ++e) { o0[e] = 0.f; o1[e] = 0.f; }
        float mrun = a.in[I_SINK][l * 8 + h] * LOG2E, lsum = 1.0f;
        __syncthreads();
        v4u g1 = {0u, 0u, 0u, 0u}, g2 = g1;
        { const v4u g0 = ATT_GLOAD(0); if (n_total > 1) g1 = ATT_GLOAD(1); if (n_total > 2) g2 = ATT_GLOAD(2); ATT_LSTORE(0, g0); }
        __syncthreads();
        for (int ti = 0; ti < n_total; ++ti) {
            v4u gn = {0u, 0u, 0u, 0u};
            if (ti + 3 < n_total) gn = ATT_GLOAD(ti + 3);
            const int kt = kt_lo + 32 * ti;
            const bool active = !lat || ti >= n_local || (kt >= q0 - 128 && kt <= q0 + 128);
            if (active) {
                const LAS unsigned char* kb = lds + (ti & 1) * ATT_BUF + r * ATT_KP + 16 * hh;
                const LAS unsigned char* vb = lds + (ti & 1) * ATT_BUF + ATT_KB + r * ATT_VP + 16 * hh;
                f32x16 st;
#pragma unroll
                for (int e = 0; e < 16; ++e) st[e] = 0.f;
#pragma unroll
                for (int s = 0; s < 4; ++s) st = __builtin_amdgcn_mfma_f32_32x32x16_bf16(*(const LAS bf16x8*)(kb + 32 * s), qf[s], st, 0, 0, 0);
                const bf16x8 v00 = *(const LAS bf16x8*)(vb), v01 = *(const LAS bf16x8*)(vb + 32), v10 = *(const LAS bf16x8*)(vb + 32 * ATT_VP), v11 = *(const LAS bf16x8*)(vb + 32 * ATT_VP + 32);
                if (lat && ti < n_local) {
                    if (kt == q0 - 128) {
#pragma unroll
                        for (int e = 0; e < 16; ++e) { const int jj = (e & 3) + 8 * (e >> 2) + 4 * hh; if (jj < r) st[e] = -1e30f; }
                    } else if (kt == q0 + 128) {
#pragma unroll
                        for (int e = 0; e < 16; ++e) { const int jj = (e & 3) + 8 * (e >> 2) + 4 * hh; if (jj > r) st[e] = -1e30f; }
                    }
                }
                float mx = fmaxf(fmaxf(st[0], st[1]), fmaxf(st[2], st[3]));
#pragma unroll
                for (int e = 4; e < 16; e += 4) mx = fmaxf(mx, fmaxf(fmaxf(st[e], st[e + 1]), fmaxf(st[e + 2], st[e + 3])));
                mx = fmaxf(mx, __shfl_xor(mx, 32));
                const float mn = fmaxf(mrun, mx); const bool grew = __any(mn > mrun);
                const float alpha = grew ? __builtin_amdgcn_exp2f(mrun - mn) : 1.0f; mrun = mn;
                float ps = 0.f;
#pragma unroll
                for (int e = 0; e < 16; ++e) { st[e] = __builtin_amdgcn_exp2f(st[e] - mn); ps += st[e]; }
                ps += __shfl_xor(ps, 32);
                lsum = lsum * alpha + ps;
                if (grew) {
#pragma unroll
                    for (int e = 0; e < 16; ++e) { o0[e] *= alpha; o1[e] *= alpha; } }
                v4u pa, pb;
                pa.x = pk2(st[0], st[1]); pa.y = pk2(st[2], st[3]); pa.z = pk2(st[4], st[5]); pa.w = pk2(st[6], st[7]);
                pb.x = pk2(st[8], st[9]); pb.y = pk2(st[10], st[11]); pb.z = pk2(st[12], st[13]); pb.w = pk2(st[14], st[15]);
                const bf16x8 p0 = __builtin_bit_cast(bf16x8, pa), p1 = __builtin_bit_cast(bf16x8, pb);
                o0 = __builtin_amdgcn_mfma_f32_32x32x16_bf16(v00, p0, o0, 0, 0, 0);
                o0 = __builtin_amdgcn_mfma_f32_32x32x16_bf16(v01, p1, o0, 0, 0, 0);
                o1 = __builtin_amdgcn_mfma_f32_32x32x16_bf16(v10, p0, o1, 0, 0, 0);
                o1 = __builtin_amdgcn_mfma_f32_32x32x16_bf16(v11, p1, o1, 0, 0, 0);
            }
            if (ti + 1 < n_total) ATT_LSTORE((ti + 1) & 1, g1);
            g1 = g2; g2 = gn;
            __syncthreads();
        }
#undef ATT_GLOAD
#undef ATT_LSTORE
        const float inv = 1.0f / lsum;
        bf16* op = CAT + (size_t)(seq0 + q0 + r) * 1024 + h * 64 + 4 * hh;
#pragma unroll
        for (int g4 = 0; g4 < 4; ++g4) {
            v2u w; w.x = pk2(o0[4 * g4] * inv, o0[4 * g4 + 1] * inv); w.y = pk2(o0[4 * g4 + 2] * inv, o0[4 * g4 + 3] * inv); *(v2u*)(op + 8 * g4) = w;
            v2u x; x.x = pk2(o1[4 * g4] * inv, o1[4 * g4 + 1] * inv); x.y = pk2(o1[4 * g4 + 2] * inv, o1[4 * g4 + 3] * inv); *(v2u*)(op + 32 + 8 * g4) = x; }
    }
}

#ifndef PROBE_PH
#define PROBE_PH -1
#endif
#ifndef PROBE_TS
#define PROBE_TS -1
#endif
#ifndef PROBE_BLK
#define PROBE_BLK 0
#endif
#define TS_BEGIN(k) do { if constexpr ((k) == PROBE_TS) { if (blockIdx.x == PROBE_BLK && threadIdx.x == 0) *((volatile LAS unsigned long long*)(c.lds + MISC_OFF + 64)) = __builtin_amdgcn_s_memrealtime(); } } while (0)
#define TS_END(k) do { if constexpr ((k) == PROBE_TS) { if (blockIdx.x == PROBE_BLK && threadIdx.x == 0) *((volatile LAS unsigned long long*)(c.lds + MISC_OFF + 72)) = __builtin_amdgcn_s_memrealtime(); } } while (0)
struct Ctx { LAS unsigned char* lds; int tid, lane, wave, G, gw, NGW; };
constexpr int CW_SPLIT = 8192;

__device__ __forceinline__ void sb_arrive(unsigned* ctl, int id) {
    asm volatile("s_waitcnt vmcnt(0)" ::: "memory");
    __syncthreads();
    if (threadIdx.x == 0) __hip_atomic_fetch_add(ctl + CW_SPLIT + 64 * id, 1u, __ATOMIC_RELAXED, __HIP_MEMORY_SCOPE_AGENT);
}
__device__ __forceinline__ void sb_wait(unsigned* ctl, int id, unsigned G) {
    if (threadIdx.x == 0) {
        unsigned sp = 0;
        while (__hip_atomic_load(ctl + CW_SPLIT + 64 * id, __ATOMIC_RELAXED, __HIP_MEMORY_SCOPE_AGENT) < G) {
            __builtin_amdgcn_s_sleep(2);
            if (++sp > (1u << 22)) { atomicAdd(ctl + CW_BAR + XB_TMO, 1u); break; }
        }
        __builtin_amdgcn_fence(__ATOMIC_ACQUIRE, "agent");
        asm volatile("s_waitcnt vmcnt(0)" ::: "memory");
    }
    __syncthreads();
}
struct HalfOrder {
    pg8::StaticOrder S; int pm0;
    __device__ __forceinline__ void init(int N, int G, int c, int pm0_, int off) { const int rot = (G == 256) ? off : 0; S.init(48 * 256, N, G, (c + G - rot) % G); pm0 = pm0_; }
    __device__ __forceinline__ bool next(int i, pg8::Unit& u) const { if (!S.next(i, u)) return false; u.pm += pm0; return true; }
    __device__ __forceinline__ void a_ready(const pg8::Unit&) const {}
    __device__ __forceinline__ void done(const pg8::Unit&) const {}
};

template <int L, int f, int h> __device__ __forceinline__ void stage_G(const Args& a, const Ctx& c, int off) {
    unsigned char* ws = a.ws;
    pg8::Gemm g{(const bf16*)a.out, (const bf16*)(ws + WS_WGU) + (size_t)(L * 2 + f) * 5632 * 1024, M, 5632, 1024};
    HalfOrder S; S.init(5632, c.G, (int)blockIdx.x, 48 * h, off);
    pg8::EpiGU E{(bf16*)(ws + WS_BIG), (const unsigned long long*)(ws + WS_SS) + (size_t)(3 * L + 2 * f) * M, (const float*)(ws + WS_BIAS) + (size_t)L * 119808 + (f ? 69120 : 0)};
    pg8::gemm_phase<pg8::EpiGU, HalfOrder, true, true>(c.lds, g, S, E);
}
template <int L, int f, int h> __device__ __forceinline__ void stage_D(const Args& a, const Ctx& c, int off) {
    unsigned char* ws = a.ws; bf16* X = (bf16*)(ws + WS_X); unsigned long long* SS = (unsigned long long*)(ws + WS_SS);
    const float* modl = (const float*)(ws + WS_MOD) + (size_t)L * 9 * 9216;
    pg8::Gemm g{(const bf16*)(ws + WS_BIG), (const bf16*)(ws + WS_WD) + (size_t)(L * 2 + f) * 1024 * 2816, M, 1024, 2816};
    HalfOrder S; S.init(1024, c.G, (int)blockIdx.x, 48 * h, off);
    constexpr bool first = (L == 0) && f == 0;
    bf16* Hn = (f == 1 && L == 1) ? (bf16*)nullptr : (bf16*)a.out;
    const float* gct = (const float*)(ws + WS_GCT) + (size_t)(f == 0 ? 3 * L + 1 : (L == 0 ? 3 : 0)) * 9216;
    typedef pg8::EpiResT<first> Epi;
    Epi E{first ? (const void*)a.in[I_XP] : (const void*)X, first ? (const void*)a.in[I_XS] : (const void*)(X + (size_t)MCTX * D), X, modl + (f ? 8 : 2) * 1024, Hn, gct, SS + (size_t)(3 * L + 1 + 2 * f) * M, 0.5f};
    pg8::gemm_phase<Epi, HalfOrder, true, true>(c.lds, g, S, E);
}
template <int L, int h> __device__ __forceinline__ void stage_IN(const Args& a, const Ctx& c, int off) {
    unsigned char* ws = a.ws; float* newk = a.out + (size_t)M * D; float* newv = newk + 32 * 2 * 256 * 128;
    pg8::Gemm g{(const bf16*)a.out, (const bf16*)(ws + WS_WIN) + (size_t)L * 2048 * 1024, M, 2048, 1024};
    HalfOrder S; S.init(2048, c.G, (int)blockIdx.x, 48 * h, off);
    pg8::EpiIN E{(bf16*)(ws + WS_Z), (bf16*)(ws + WS_ZT), newk, newv, (const float*)(ws + WS_ROPE), (const unsigned long long*)(ws + WS_SS) + (size_t)(3 * L + 1) * M, (const float*)(ws + WS_BIAS) + (size_t)L * 119808 + 50688, L, QSCALE};
    pg8::gemm_phase<pg8::EpiIN, HalfOrder, true, true>(c.lds, g, S, E);
}
template <int L, int h> __device__ __forceinline__ void stage_OUT(const Args& a, const Ctx& c, int off) {
    unsigned char* ws = a.ws; bf16* X = (bf16*)(ws + WS_X); const float* modl = (const float*)(ws + WS_MOD) + (size_t)L * 9 * 9216;
    pg8::Gemm g{(const bf16*)a.out + (size_t)M * D, (const bf16*)(ws + WS_WOUT) + (size_t)L * 1024 * 1024, M, 1024, 1024};
    HalfOrder S; S.init(1024, c.G, (int)blockIdx.x, 48 * h, off);
    typedef pg8::EpiResT<false> Epi;
    Epi E{X, X + (size_t)MCTX * D, X, modl + 5 * 1024, (bf16*)a.out, (const float*)(ws + WS_GCT) + (size_t)(3 * L + 2) * 9216, (unsigned long long*)(ws + WS_SS) + (size_t)(3 * L + 2) * M, 1.0f};
    pg8::gemm_phase<Epi, HalfOrder, true, true>(c.lds, g, S, E);
}
template <int L> __device__ __forceinline__ void mix_stage(const Args& a, const Ctx& c) {
    unsigned char* ws = a.ws; const bf16* Z = (const bf16*)(ws + WS_Z); const bf16* ZT = (const bf16*)(ws + WS_ZT); bf16* CAT = (bf16*)a.out + (size_t)M * D;
    int tid_ = c.tid; asm volatile("" : "+v"(tid_));
    const int G = c.G, tid = tid_, lane = tid_ & 63; LAS unsigned char* lds = c.lds;
#define HY_CH(w) ((((w) & 7) << 5) | (((w) >> 3) & 31))
    if constexpr (L == 0) TS_BEGIN(301);
    for (int w = blockIdx.x; w < 256; w += G) hyena_channel<2048, 8>(a, L, HY_CH(w), ZT, CAT, lds, tid, c.wave, lane);
    if constexpr (L == 0) { TS_END(301); TS_BEGIN(302); }
    for (int w = blockIdx.x; w < 256; w += G) hyena_channel<256, 32>(a, L, HY_CH(w), ZT, CAT, lds, tid, c.wave, lane);
#undef HY_CH
    if constexpr (L == 0) { TS_END(302); TS_BEGIN(303); }
    attn_phase(a, L, Z, ZT, CAT, lds, tid, c.wave, lane);
    __syncthreads();
    if constexpr (L == 0) { TS_END(303); TS_BEGIN(304); }
    conv_phase(a, L, Z, CAT, lds, tid);
    if constexpr (L == 0) TS_END(304);
}
__device__ __forceinline__ void final_half(const Args& a, const Ctx& c, int h) {
    const bf16* X = (const bf16*)(a.ws + WS_X); float* Y = a.out; const unsigned long long* ss = (const unsigned long long*)(a.ws + WS_SS) + (size_t)6 * M; const float* g = a.in[I_GFIN];
    for (int r = h * 12288 + c.gw; r < (h + 1) * 12288; r += c.NGW) {
        const float rstd = 1.0f / sqrtf((float)ss[r] * (SS_UNFIX / D) + EPS);
#pragma unroll
        for (int j = 0; j < 2; ++j) { const int col = 8 * (c.lane + 64 * j); const v4u w = *(const v4u*)(X + (size_t)r * D + col);
            const f32x4 x0 = {bflo(w.x), bfhi(w.x), bflo(w.y), bfhi(w.y)}, x1 = {bflo(w.z), bfhi(w.z), bflo(w.w), bfhi(w.w)};
            *(f32x4*)(Y + (size_t)r * D + col) = (x0 * rstd) * *(const f32x4*)(g + col); *(f32x4*)(Y + (size_t)r * D + col + 4) = (x1 * rstd) * *(const f32x4*)(g + col + 4); }
    }
}

__global__ void __launch_bounds__(NTHREADS, 2) mega_fwd(Args a) {
    extern __shared__ __attribute__((aligned(16))) unsigned char lds_raw[];
    Ctx c;
    c.lds = (LAS unsigned char*)lds_raw;
    c.tid = threadIdx.x; c.lane = c.tid & 63; c.wave = __builtin_amdgcn_readfirstlane(c.tid >> 6);
    c.G = gridDim.x; c.gw = blockIdx.x * NWAVES + c.wave; c.NGW = c.G * NWAVES;
    unsigned* ctl = (unsigned*)(a.ws + WS_CTL);
    for (int u = c.tid; u < (LDS_BYTES - LDSCTL_OFF) / 4; u += NTHREADS) ((LAS unsigned*)(c.lds + LDSCTL_OFF))[u] = 0u;
    __syncthreads();
    XcdBarrier bar = xcd_barrier_post(ctl + CW_BAR, (volatile LAS unsigned*)(c.lds + MISC_OFF) + 8);
    cg::grid_group grid = cg::this_grid();
    const unsigned G = (unsigned)c.G;
    TS_BEGIN(0);
    p0_prologue(a, c.lds, c.gw, c.NGW, c.wave, c.lane, true);
    if (a.ph_hi > 100000) grid.sync(); else xcd_barrier(bar);
    TS_END(0); TS_BEGIN(1);
    prep_phase(a.in[I_XP], a.in[I_XS], a.in[I_GF1], (const float*)(a.ws + WS_MOD), 1, (bf16*)a.out, (unsigned long long*)(a.ws + WS_SS), 0, M, c.gw, c.NGW, c.lane);
    bias_phase(a, 0, 2 * 832, c.gw, c.NGW, c.lane);
    gct_phase(a, c.gw, c.NGW, c.lane);
    xcd_barrier(bar);
    TS_END(1); TS_BEGIN(2);
    { stage_G<0, 0, 0>(a, c, 0); sb_arrive(ctl, 0); }
    { stage_G<0, 0, 1>(a, c, 32); sb_arrive(ctl, 1); }
    { sb_wait(ctl, 0, G); stage_D<0, 0, 0>(a, c, 64); sb_arrive(ctl, 2); }
    { sb_wait(ctl, 1, G); stage_D<0, 0, 1>(a, c, 0); sb_arrive(ctl, 3); }
    { const int b = (int)blockIdx.x;
      if (b < 64 || b >= 192) hyena_filter_phase(a, c.lds, (b < 64 ? b : b - 128) * NWAVES + c.wave, 128 * NWAVES, c.wave, c.lane); }
    sb_wait(ctl, 2, G); sb_wait(ctl, 3, G);
    stage_IN<0, 0>(a, c, 0);
    stage_IN<0, 1>(a, c, 128);
    xcd_barrier(bar);
    TS_END(2); TS_BEGIN(3);
    mix_stage<0>(a, c);
    xcd_barrier(bar);
    TS_END(3); TS_BEGIN(4);
    { stage_OUT<0, 0>(a, c, 128); sb_arrive(ctl, 4); }
    { stage_OUT<0, 1>(a, c, 64); sb_arrive(ctl, 5); }
    { sb_wait(ctl, 4, G); stage_G<0, 1, 0>(a, c, 0); sb_arrive(ctl, 6); }
    { sb_wait(ctl, 5, G); stage_G<0, 1, 1>(a, c, 32); sb_arrive(ctl, 7); }
    { sb_wait(ctl, 6, G); stage_D<0, 1, 0>(a, c, 0); sb_arrive(ctl, 8); }
    { sb_wait(ctl, 7, G); stage_D<0, 1, 1>(a, c, 192); sb_arrive(ctl, 9); }
    { sb_wait(ctl, 8, G); stage_G<1, 0, 0>(a, c, 64); sb_arrive(ctl, 10); }
    { sb_wait(ctl, 9, G); stage_G<1, 0, 1>(a, c, 96); sb_arrive(ctl, 11); }
    { sb_wait(ctl, 10, G); stage_D<1, 0, 0>(a, c, 128); sb_arrive(ctl, 12); }
    { sb_wait(ctl, 11, G); stage_D<1, 0, 1>(a, c, 64); sb_arrive(ctl, 13); }
    sb_wait(ctl, 12, G); sb_wait(ctl, 13, G);
    stage_IN<1, 0>(a, c, 0);
    stage_IN<1, 1>(a, c, 128);
    xcd_barrier(bar);
    TS_END(4); TS_BEGIN(5);
    mix_stage<1>(a, c);
    xcd_barrier(bar);
    TS_END(5); TS_BEGIN(6);
    { stage_OUT<1, 0>(a, c, 128); sb_arrive(ctl, 14); }
    { stage_OUT<1, 1>(a, c, 64); sb_arrive(ctl, 15); }
    { sb_wait(ctl, 14, G); stage_G<1, 1, 0>(a, c, 128); sb_arrive(ctl, 16); }
    { sb_wait(ctl, 15, G); stage_G<1, 1, 1>(a, c, 160); sb_arrive(ctl, 17); }
    { sb_wait(ctl, 16, G); stage_D<1, 1, 0>(a, c, 0); sb_arrive(ctl, 18); }
    { sb_wait(ctl, 17, G); stage_D<1, 1, 1>(a, c, 192); sb_arrive(ctl, 19); }
    { sb_wait(ctl, 18, G); final_half(a, c, 0); }
    { sb_wait(ctl, 19, G); final_half(a, c, 1); }
    TS_END(6);
    if constexpr (PROBE_TS >= 0) { if (blockIdx.x == PROBE_BLK && threadIdx.x == 0) { const unsigned long long t0 = *((volatile LAS unsigned long long*)(c.lds + MISC_OFF + 64)), t1 = *((volatile LAS unsigned long long*)(c.lds + MISC_OFF + 72)); const unsigned long long now = __builtin_amdgcn_s_memrealtime(); while (__builtin_amdgcn_s_memrealtime() - now < 9ull * (t1 - t0)) __builtin_amdgcn_s_sleep(8); } __syncthreads(); }
}

extern "C" void kernel_launch(void* const* d_in, const int* in_sizes, int n_in, void* d_out, int out_size, void* d_ws, size_t ws_size, hipStream_t stream) {
    static int grid = 0;
    if (grid == 0) {
        if (n_in != N_IN || ws_size < WS_END || out_size != M * D + 2 * 32 * 2 * 256 * 128) { fprintf(stderr, "kernel_launch: unexpected shapes (n_in %d, ws %zu, out %d)\n", n_in, ws_size, out_size); grid = -1; return; }
        int dev = 0, cus = 0, per_cu = 0;
        if (hipGetDevice(&dev) != hipSuccess || hipDeviceGetAttribute(&cus, hipDeviceAttributeMultiprocessorCount, dev) != hipSuccess) { grid = -1; return; }
        if (hipFuncSetAttribute((const void*)mega_fwd, hipFuncAttributeMaxDynamicSharedMemorySize, LDS_BYTES) != hipSuccess) { fprintf(stderr, "kernel_launch: hipFuncSetAttribute failed\n"); grid = -1; return; }
        if (hipOccupancyMaxActiveBlocksPerMultiprocessor(&per_cu, (const void*)mega_fwd, NTHREADS, LDS_BYTES) != hipSuccess || per_cu < 1) { fprintf(stderr, "kernel_launch: occupancy query says %d\n", per_cu); per_cu = 1; }
        (void)hipGetLastError();
        if (cus < 256) { fprintf(stderr, "kernel_launch: built for a 256-CU device (got %d)\n", cus); grid = -1; return; }
        grid = 256;
    }
    if (grid < 0) return;
    (void)hipMemsetAsync((char*)d_ws + WS_CTL, 0, CTL_ZERO_BYTES, stream);
    Args a{};
    for (int i = 0; i < N_IN; ++i) a.in[i] = (const float*)d_in[i];
    a.out = (float*)d_out; a.ws = (unsigned char*)d_ws; a.ph_lo = 0; a.ph_hi = 1;
    void* args[] = {&a};
    hipError_t e = hipLaunchCooperativeKernel((const void*)mega_fwd, dim3(grid), dim3(NTHREADS), args, LDS_BYTES, stream);
    if (e != hipSuccess) fprintf(stderr, "cooperative launch failed: %s (grid %d)\n", hipGetErrorString(e), grid);
}
```

```cpp
#include <hip/hip_runtime.h>
#include <hip/hip_cooperative_groups.h>
#include <cstdio>
#include <cstdint>
namespace cg = cooperative_groups;

constexpr int D = 1024, DFF = 2816, INW = 2048;
constexpr int MCTX = 8192, MLAT = 16384, M = MCTX + MLAT;
constexpr int LCTX = 256, LLAT = 2048;
constexpr int NCOND = 9, MODW = 9 * 1024;
constexpr int ZW = 1280;
constexpr int HYC = 768;
constexpr float EPS = 1e-6f;
constexpr float SS_FIX = 16777216.0f, SS_UNFIX = 1.0f / 16777216.0f;
constexpr float FSQ_FIX = 68719476736.0f, FSQ_UNFIX = 1.0f / 68719476736.0f;
constexpr float LOG2E = 1.4426950408889634f;
constexpr float QSCALE = 0.125f * LOG2E;

enum { I_XP = 0, I_XS, I_C, I_CK, I_CV, I_CCTX, I_WMOD, I_BMOD, I_GF1, I_GMIX, I_GF2, I_GFIN, I_W1G, I_W1U, I_W1D, I_W2G, I_W2U, I_W2D, I_WIN, I_WOUT, I_SINK,
       I_CDW, I_CDWB, I_CLNG, I_CLNB, I_CPW, I_HSW, I_HSB, I_HW1, I_HB1, I_HF1, I_HW2, I_HB2, I_HF2, I_HW3, I_HLD, I_HBIAS, N_IN };

constexpr size_t MiB = 1u << 20;
constexpr size_t WS_CTL = 0, CTL_ZERO_BYTES = 3 * MiB;
constexpr size_t WS_SUMSQ = 64 * 1024;
constexpr size_t WS_MOD = 128 * 1024;
constexpr size_t WS_SS = 1 * MiB;
constexpr size_t WS_ROPE = 3 * MiB;
constexpr size_t WS_BIAS = 3 * MiB + 64 * 1024;
constexpr size_t WS_WGU = 4 * MiB;
constexpr size_t WS_WD = 48 * MiB;
constexpr size_t WS_WIN = 70 * MiB;
constexpr size_t WS_WOUT = 78 * MiB;
constexpr size_t WS_CKB = 82 * MiB;
constexpr size_t WS_CVT = 83 * MiB;
constexpr size_t WS_HYH = 84 * MiB;
constexpr size_t WS_HYRAW = 86 * MiB;
constexpr size_t WS_X = 96 * MiB;
constexpr size_t WS_BIG = 144 * MiB;
constexpr size_t WS_Z = WS_BIG;
constexpr size_t WS_ZT = 204 * MiB;
constexpr size_t WS_GCT = 276 * MiB;
constexpr size_t WS_END = 277 * MiB;
static_assert(WS_MOD + 2 * 9 * 9216 * 4 <= WS_SS && WS_SS + 7 * (size_t)M * 8 <= CTL_ZERO_BYTES && CTL_ZERO_BYTES <= WS_ROPE && WS_BIAS + 2 * 9 * 13312 * 4 <= WS_WGU, "ctl");
static_assert(WS_BIG + (size_t)M * DFF * 2 <= WS_GCT && WS_Z + (size_t)M * ZW * 2 <= WS_ZT && WS_ZT + (size_t)896 * M * 2 <= WS_GCT, "ws map");
constexpr int CW_BAR = 4096;

constexpr int RING_BYTES = 131072;
constexpr int LDSCTL_OFF = 135168, MISC_OFF = LDSCTL_OFF + 320;
constexpr int LDS_BYTES = 137216;
constexpr int NWAVES = 8, NTHREADS = 512;

namespace pg8 {
#define PG8_LAS __attribute__((address_space(3)))
typedef unsigned short bf16_t;
typedef short bf16x8 __attribute__((ext_vector_type(8)));
typedef float f32x4 __attribute__((ext_vector_type(4)));
typedef unsigned u32x4 __attribute__((ext_vector_type(4)));
constexpr int BM = 256, BK = 64, HALF = 128, HTB = HALF * BK * 2  , STAGE_BYTES = 8 * HTB, NXCD = 8, WGM = 8;

__host__ __device__ __forceinline__ int lds_byte(int r, int c) { const int st = (r >> 4) * 2 + (c >> 5), rr = r & 15, cc = c & 31, ob = rr * 64 + cc * 2; return st * 1024 + (ob ^ (((ob >> 9) & 1) << 5)); }
__host__ __device__ __forceinline__ void stage_rc(int b, int& R, int& C) { const int st = b / 1024, sb = b % 1024, swz = sb ^ (((sb >> 9) & 1) << 5); R = (st >> 1) * 16 + swz / 64; C = (st & 1) * 32 + (swz % 64) / 2; }
__host__ __device__ __forceinline__ int perm32(int rho) { const int n = rho >> 4, i = rho & 15; return 8 * (i >> 2) + 4 * n + (i & 3); }

struct Unit { int pm, pn; };
struct Gemm { const bf16_t* A; const bf16_t* Bt; int M, N, K; };

struct StaticOrder {
    int nM, nN, nwg, G, c;
    __host__ __device__ void init(int M, int N, int G_, int c_) { nM = M / BM; nN = N / BM; nwg = nM * nN; G = G_; c = c_; }
    __host__ __device__ bool next(int i, Unit& u) const {
        const long L = (long)i * G + c; if (L >= nwg) return false;
        int wgid = (int)L; { const int q = nwg / NXCD, r = nwg % NXCD, xcd = wgid % NXCD, off = wgid / NXCD; wgid = (xcd < r ? xcd * (q + 1) : r * (q + 1) + (xcd - r) * q) + off; }
        const int nig = WGM * nN, gid = wgid / nig, fm = gid * WGM, gsz = (nM - fm) < WGM ? (nM - fm) : WGM;
        u.pm = fm + ((wgid % nig) % gsz); u.pn = (wgid % nig) / gsz; return true;
    }
    __device__ __forceinline__ void a_ready(const Unit&) const {}
    __device__ __forceinline__ void done(const Unit&) const {}
};


__device__ __forceinline__ unsigned cvt_pk_bf16(float lo, float hi) { unsigned r; asm volatile("v_cvt_pk_bf16_f32 %0, %1, %2" : "=v"(r) : "v"(lo), "v"(hi)); return r; }
__device__ __forceinline__ float silu_f(float x) { return x * __builtin_amdgcn_rcpf(1.0f + __builtin_amdgcn_exp2f(-1.4426950408889634f * x)); }
__device__ __forceinline__ int cond_of_tile(int pm) { return pm < 32 ? 0 : 1 + ((pm - 32) >> 3); }

__device__ __forceinline__ void st16_wt(void* p, u32x4 v) { asm volatile("global_store_dwordx4 %0, %1, off sc1\n\ts_nop 1" :: "v"(p), "v"(v) : "memory"); }
__device__ __forceinline__ void st16_wt(void* p, f32x4 v) { asm volatile("global_store_dwordx4 %0, %1, off sc1\n\ts_nop 1" :: "v"(p), "v"(v) : "memory"); }
__device__ __forceinline__ void st8_wt(void* p, unsigned lo, unsigned hi) { __hip_atomic_store((unsigned long long*)p, ((unsigned long long)hi << 32) | lo, __ATOMIC_RELAXED, __HIP_MEMORY_SCOPE_AGENT); }
struct EpiGU {
    static constexpr bool PERM = true, AFTER_DRAIN = false;
    bf16_t* O;
    const unsigned long long* ss; const float* bias;
    __device__ __forceinline__ void operator()(const f32x4 (&acc)[2][2][4][2], const Unit& u, int wr, int wc, int fr, int fq) const {
        const int row0 = u.pm * BM + wr * 64 + fr, col0 = u.pn * HALF + wc * 32 + 8 * fq;
        const float* bp = bias + cond_of_tile(u.pm) * 5632 + u.pn * BM + wc * 32 + 8 * fq;
        const f32x4 bg0 = *(const f32x4*)bp, bg1 = *(const f32x4*)(bp + 4), bu0 = *(const f32x4*)(bp + HALF), bu1 = *(const f32x4*)(bp + HALF + 4);
        unsigned long long rsq[2][4]; float rsv[2][4];
#pragma unroll
        for (int ai = 0; ai < 2; ++ai)
#pragma unroll
            for (int m = 0; m < 4; ++m) rsq[ai][m] = ss[row0 + ai * HALF + m * 16];
#pragma unroll
        for (int ai = 0; ai < 2; ++ai)
#pragma unroll
            for (int m = 0; m < 4; ++m) rsv[ai][m] = (float)rsq[ai][m];
#pragma unroll
        for (int ai = 0; ai < 2; ++ai)
#pragma unroll
            for (int m = 0; m < 4; ++m) { const int row = row0 + ai * HALF + m * 16; bf16_t* rowp = O + (size_t)row * 2816 + col0;
                const float rs = __builtin_amdgcn_rsqf(rsv[ai][m] * (SS_UNFIX / 1024.0f) + 1e-6f);
                const f32x4 g0 = acc[ai][0][m][0] * rs + bg0, g1 = acc[ai][0][m][1] * rs + bg1, u0 = acc[ai][1][m][0] * rs + bu0, u1 = acc[ai][1][m][1] * rs + bu1;
                u32x4 w;
                w.x = cvt_pk_bf16(silu_f(g0[0]) * u0[0], silu_f(g0[1]) * u0[1]); w.y = cvt_pk_bf16(silu_f(g0[2]) * u0[2], silu_f(g0[3]) * u0[3]);
                w.z = cvt_pk_bf16(silu_f(g1[0]) * u1[0], silu_f(g1[1]) * u1[1]); w.w = cvt_pk_bf16(silu_f(g1[2]) * u1[2], silu_f(g1[3]) * u1[3]);
                st16_wt(rowp, w); }
    }
};
template <bool SRC32> struct EpiResT {
    static constexpr bool PERM = true, AFTER_DRAIN = false;
    const void* in0; const void* in1; bf16_t* X; const float* gate;
    bf16_t* Hn; const float* gct; unsigned long long* ssn; float scale;
    static __device__ __forceinline__ float lo16(unsigned w) { return __uint_as_float(w << 16); }
    static __device__ __forceinline__ float hi16(unsigned w) { return __uint_as_float(w & 0xffff0000u); }
    __device__ __forceinline__ void operator()(const f32x4 (&acc)[2][2][4][2], const Unit& u, int wr, int wc, int fr, int fq) const {
        asm volatile("" : "+v"(fr), "+v"(fq));
        const int cond = cond_of_tile(u.pm); const float* gp = gate + cond * 9216; const float* cp = gct + cond * 1024;
        const int col0 = u.pn * BM + wc * 32 + 8 * fq;
        const bool ctx = u.pm < 32; const void* src = ctx ? in0 : in1; const int rbase = u.pm * BM - (ctx ? 0 : 8192);
        f32x4 gv[2][2], gc[2][2], xo32[4][2][2]; u32x4 xo16[4][2];
#define EPIRES_LOAD(slot_, rg_) do { const size_t ro = (size_t)(rbase + ((rg_) >> 2) * HALF + wr * 64 + ((rg_) & 3) * 16 + fr) * 1024 + col0; \
            if constexpr (SRC32) { const float* sp = (const float*)src + ro; \
                _Pragma("unroll") for (int bj = 0; bj < 2; ++bj) _Pragma("unroll") for (int n = 0; n < 2; ++n) xo32[slot_][bj][n] = *(const f32x4*)(sp + bj * HALF + n * 4); } \
            else { const bf16_t* sp = (const bf16_t*)src + ro; \
                _Pragma("unroll") for (int bj = 0; bj < 2; ++bj) xo16[slot_][bj] = *(const u32x4*)(sp + bj * HALF); } } while (0)
#define EPIRES_DO(slot_, rg_) do { const int ai = (rg_) >> 2, m = (rg_) & 3, rl = ai * HALF + wr * 64 + m * 16 + fr; \
            const size_t oo = (size_t)(u.pm * BM + rl) * 1024 + col0; float sq = 0.f; \
            _Pragma("unroll") for (int bj = 0; bj < 2; ++bj) { f32x4 x0, x1; \
                if constexpr (SRC32) { x0 = xo32[slot_][bj][0]; x1 = xo32[slot_][bj][1]; } \
                else { const u32x4 w = xo16[slot_][bj]; x0 = (f32x4){lo16(w[0]), hi16(w[0]), lo16(w[1]), hi16(w[1])}; x1 = (f32x4){lo16(w[2]), hi16(w[2]), lo16(w[3]), hi16(w[3])}; } \
                const f32x4 xa = x0 + gv[bj][0] * acc[ai][bj][m][0], xb = x1 + gv[bj][1] * acc[ai][bj][m][1]; \
                st16_wt(X + oo + bj * HALF, (u32x4){cvt_pk_bf16(xa[0], xa[1]), cvt_pk_bf16(xa[2], xa[3]), cvt_pk_bf16(xb[0], xb[1]), cvt_pk_bf16(xb[2], xb[3])}); \
                sq += ((xa[0] * xa[0] + xa[1] * xa[1]) + (xa[2] * xa[2] + xa[3] * xa[3])) + ((xb[0] * xb[0] + xb[1] * xb[1]) + (xb[2] * xb[2] + xb[3] * xb[3])); \
                if (Hn) { const f32x4 ha = xa * gc[bj][0], hb = xb * gc[bj][1]; \
                    st16_wt(Hn + oo + bj * HALF, (u32x4){cvt_pk_bf16(ha[0], ha[1]), cvt_pk_bf16(ha[2], ha[3]), cvt_pk_bf16(hb[0], hb[1]), cvt_pk_bf16(hb[2], hb[3])}); } } \
            sq += __shfl_xor(sq, 16); sq += __shfl_xor(sq, 32); \
            if (fq == 0) atomicAdd(ssn + u.pm * BM + rl, (unsigned long long)(sq * SS_FIX)); } while (0)
#pragma unroll
        for (int bj = 0; bj < 2; ++bj)
#pragma unroll
            for (int n = 0; n < 2; ++n) { gv[bj][n] = *(const f32x4*)(gp + col0 + bj * HALF + n * 4); gc[bj][n] = Hn ? *(const f32x4*)(cp + col0 + bj * HALF + n * 4) : (f32x4){0.f, 0.f, 0.f, 0.f}; }
        EPIRES_LOAD(0, 0); EPIRES_LOAD(1, 1);
#pragma unroll
        for (int bj = 0; bj < 2; ++bj)
#pragma unroll
            for (int n = 0; n < 2; ++n) gv[bj][n] = gv[bj][n] * scale;
        EPIRES_DO(0, 0); EPIRES_DO(1, 1);
        EPIRES_LOAD(0, 2); EPIRES_LOAD(1, 3);
        EPIRES_DO(0, 2); EPIRES_DO(1, 3);
        EPIRES_LOAD(0, 4); EPIRES_LOAD(1, 5); EPIRES_LOAD(2, 6); EPIRES_LOAD(3, 7);
        EPIRES_DO(0, 4); EPIRES_DO(1, 5); EPIRES_DO(2, 6); EPIRES_DO(3, 7);
#undef EPIRES_LOAD
#undef EPIRES_DO
    }
};
struct EpiIN {
    static constexpr bool PERM = false, AFTER_DRAIN = false;
    bf16_t* Z; bf16_t* ZT; float* newk; float* newv; const float* rope; const unsigned long long* ss; const float* bias; int layer; float qscale;
    __device__ __forceinline__ void operator()(const f32x4 (&acc)[2][2][4][2], const Unit& u, int wr, int wc, int fr, int fq) const {
        const bool lat = u.pm >= 32;
        const int colb = u.pn * BM + wc * 32 + 4 * fq;
        const float* bp = bias + cond_of_tile(u.pm) * 2048 + colb;
        f32x4 bv[2][2];
#pragma unroll
        for (int bj = 0; bj < 2; ++bj)
#pragma unroll
            for (int n = 0; n < 2; ++n) bv[bj][n] = *(const f32x4*)(bp + bj * HALF + n * 16);
        const bool roped = lat && u.pn < 3;
        float rsl[2];
        { const unsigned long long q0 = ss[u.pm * BM + wr * 64 + 16 * fq + fr], q1 = ss[u.pm * BM + HALF + wr * 64 + 16 * fq + fr];
          rsl[0] = __builtin_amdgcn_rsqf((float)q0 * (SS_UNFIX / 1024.0f) + 1e-6f); rsl[1] = __builtin_amdgcn_rsqf((float)q1 * (SS_UNFIX / 1024.0f) + 1e-6f); }
#pragma unroll
        for (int ai = 0; ai < 2; ++ai) {
            f32x4 rc0[4], rc1[4];
#pragma unroll
            for (int m = 0; m < 4; ++m) { rc0[m] = (f32x4){1.f, 0.f, 1.f, 0.f}; rc1[m] = rc0[m];
                if (roped) { const int pos = (u.pm * BM + ai * HALF + wr * 64 + m * 16 + fr - 8192) & 2047; const int p = (wc & 1) ? (pos & 63) : (pos >> 6);
                    const f32x4* rp = (const f32x4*)(rope + (size_t)(p * 16 + 4 * fq) * 2); rc0[m] = rp[0]; rc1[m] = rp[1]; } }
#pragma unroll
            for (int m = 0; m < 4; ++m) { const int row = u.pm * BM + ai * HALF + wr * 64 + m * 16 + fr;
                const float rs = __shfl(rsl[ai], 16 * m + fr);
#pragma unroll
                for (int bj = 0; bj < 2; ++bj) { const int col = colb + bj * HALF;
                    f32x4 v0 = acc[ai][bj][m][0] * rs + bv[bj][0], v1 = acc[ai][bj][m][1] * rs + bv[bj][1];
                    if (u.pn < 5) {
                        const int cb = u.pn * BM + bj * HALF;
                        if (lat && cb < 640) {
                            const f32x4 cs0 = rc0[m], cs1 = rc1[m];
                            const float c0 = cs0[0], s0 = cs0[1], c1 = cs0[2], s1 = cs0[3], c2 = cs1[0], s2 = cs1[1], c3 = cs1[2], s3 = cs1[3];
                            const f32x4 a = v0, b = v1;
                            v0[0] = a[0] * c0 - b[0] * s0; v1[0] = b[0] * c0 + a[0] * s0;
                            v0[1] = a[1] * c1 - b[1] * s1; v1[1] = b[1] * c1 + a[1] * s1;
                            v0[2] = a[2] * c2 - b[2] * s2; v1[2] = b[2] * c2 + a[2] * s2;
                            v0[3] = a[3] * c3 - b[3] * s3; v1[3] = b[3] * c3 + a[3] * s3;
                        }
                        if (!lat && cb >= 512 && cb < 768) {
                            const int b = row >> 8, s = row & 255; float* dst = (cb < 640 ? newk : newv) + ((size_t)(b * 2 + layer) * 256 + s) * 128 + (col - cb);
                            *(f32x4*)dst = v0; *(f32x4*)(dst + 16) = v1;
                        }
                        if (cb < 512) { v0 = v0 * qscale; v1 = v1 * qscale; }
                        if (cb == 640) {
                            const int ch = 768 + col - 640;
#pragma unroll
                            for (int j = 0; j < 4; ++j) { ZT[(size_t)(ch + j) * 24576 + row] = (bf16_t)(cvt_pk_bf16(v0[j], 0.f) & 0xffffu); ZT[(size_t)(ch + 16 + j) * 24576 + row] = (bf16_t)(cvt_pk_bf16(v1[j], 0.f) & 0xffffu); }
                        } else {
                        bf16_t* zp = Z + (size_t)row * 1280 + col;
                        typedef unsigned u32x2 __attribute__((ext_vector_type(2)));
                        u32x2 w0, w1; w0.x = cvt_pk_bf16(v0[0], v0[1]); w0.y = cvt_pk_bf16(v0[2], v0[3]); w1.x = cvt_pk_bf16(v1[0], v1[1]); w1.y = cvt_pk_bf16(v1[2], v1[3]);
                        *(u32x2*)zp = w0; *(u32x2*)(zp + 16) = w1; }
                    } else {
                        const int ch = col - 1280;
#pragma unroll
                        for (int j = 0; j < 4; ++j) { ZT[(size_t)(ch + j) * 24576 + row] = (bf16_t)(cvt_pk_bf16(v0[j], 0.f) & 0xffffu); ZT[(size_t)(ch + 16 + j) * 24576 + row] = (bf16_t)(cvt_pk_bf16(v1[j], 0.f) & 0xffffu); }
                    }
                } }
        }
    }
};

template <class Epi, class Sched, bool ALIGN_EPI = false, bool SP2 = false>
__device__ __forceinline__ void gemm_phase(PG8_LAS unsigned char* lds, const Gemm g, const Sched S, const Epi E) {
    int tid_ = threadIdx.x; asm volatile("" : "+v"(tid_));
    const int tid = tid_, wid = __builtin_amdgcn_readfirstlane(tid >> 6), lane = tid & 63, wr = wid >> 2, wc = wid & 3, fr = lane & 15, fq = lane >> 4;
    const int K = g.K, nt = K / BK;
    unsigned voffA[2], voffB[2];
#pragma unroll
    for (int i = 0; i < 2; ++i) { int R, C; stage_rc(tid * 16 + i * 8192, R, C); const int Rb = Epi::PERM ? ((R & ~31) + perm32(R & 31)) : R;
        voffA[i] = (unsigned)(R * K + C) * 2u; voffB[i] = (unsigned)(Rb * K + C) * 2u; }
    const size_t kstep = (size_t)(BK * 2);
    const size_t hstep = (size_t)HALF * K * 2;
    const size_t tstep = 2 * hstep;
    const unsigned ldsw = (unsigned)wid * 1024u;
    const int aoff = lds_byte(wr * 64 + fr, fq * 8), boff = lds_byte(wc * 32 + fr, fq * 8);
#define PG8_SA(b, h) (((b) * 2 + (h)) * HTB)
#define PG8_SB(b, h) ((4 + (b) * 2 + (h)) * HTB)
#define PG8_STAGE(bufoff, gbase, voff) do { _Pragma("unroll") for (int _i = 0; _i < 2; ++_i) \
        __builtin_amdgcn_global_load_lds((const unsigned*)((const char*)(gbase) + (voff)[_i]), (PG8_LAS unsigned*)(lds + (bufoff) + ldsw + _i * 8192), 16, 0, 0); } while (0)
#define PG8_LDA(dst, b, h) do { _Pragma("unroll") for (int m = 0; m < 4; ++m) _Pragma("unroll") for (int k = 0; k < 2; ++k) dst[m][k] = *(const PG8_LAS bf16x8*)(lds + PG8_SA(b, h) + aoff + m * 2048 + k * 1024); } while (0)
#define PG8_LDB(dst, b, h) do { _Pragma("unroll") for (int n = 0; n < 2; ++n) _Pragma("unroll") for (int k = 0; k < 2; ++k) dst[n][k] = *(const PG8_LAS bf16x8*)(lds + PG8_SB(b, h) + boff + n * 2048 + k * 1024); } while (0)
#define PG8_MMA(ai, bj, At, Bt) do { __builtin_amdgcn_s_setprio(1); _Pragma("unroll") for (int m = 0; m < 4; ++m) _Pragma("unroll") for (int n = 0; n < 2; ++n) _Pragma("unroll") for (int k = 0; k < 2; ++k) \
        acc[ai][bj][m][n] = __builtin_amdgcn_mfma_f32_16x16x32_bf16(Bt[n][k], At[m][k], acc[ai][bj][m][n], 0, 0, 0); __builtin_amdgcn_s_setprio(0); } while (0)
#define PG8_WAIT_V(n) asm volatile("s_waitcnt vmcnt(" #n ")" ::: "memory")
#define PG8_WAIT_L(n) asm volatile("s_waitcnt lgkmcnt(" #n ")" ::: "memory")
#define PG8_BAR __builtin_amdgcn_s_barrier()
#define PG8_SCHED __builtin_amdgcn_sched_barrier(0)
    Unit cur, nxt; int ui = 0;
    if (!S.next(0, cur)) return;
    f32x4 acc[2][2][4][2];
#pragma unroll
    for (int a = 0; a < 2; ++a)
#pragma unroll
        for (int b = 0; b < 2; ++b)
#pragma unroll
            for (int m = 0; m < 4; ++m)
#pragma unroll
                for (int n = 0; n < 2; ++n) acc[a][b][m][n] = (f32x4){0.f, 0.f, 0.f, 0.f};
    bf16x8 At[4][2], B0[2][2], B1[2][2];
    const char* cA = (const char*)g.A + (size_t)cur.pm * tstep; const char* cB = (const char*)g.Bt + (size_t)cur.pn * tstep;
    S.a_ready(cur);
    if constexpr (SP2) {
        PG8_STAGE(PG8_SB(0, 0), cB, voffB); PG8_STAGE(PG8_SB(0, 1), cB + hstep, voffB); PG8_STAGE(PG8_SA(0, 0), cA, voffA); PG8_STAGE(PG8_SA(0, 1), cA + hstep, voffA);
        if (wr == 1) PG8_BAR;
        PG8_WAIT_V(2); PG8_BAR;
        PG8_STAGE(PG8_SB(1, 0), cB + kstep, voffB); PG8_STAGE(PG8_SA(1, 0), cA + kstep, voffA); PG8_STAGE(PG8_SB(1, 1), cB + hstep + kstep, voffB);
        PG8_WAIT_V(6); PG8_BAR;
    } else {
        PG8_STAGE(PG8_SB(0, 0), cB, voffB); PG8_STAGE(PG8_SA(0, 0), cA, voffA); PG8_STAGE(PG8_SB(0, 1), cB + hstep, voffB); PG8_STAGE(PG8_SA(0, 1), cA + hstep, voffA);
        if (wr == 1) PG8_BAR;
        PG8_WAIT_V(4); PG8_BAR;
        PG8_STAGE(PG8_SB(1, 0), cB + kstep, voffB); PG8_STAGE(PG8_SA(1, 0), cA + kstep, voffA); PG8_STAGE(PG8_SB(1, 1), cB + hstep + kstep, voffB);
        PG8_WAIT_V(6); PG8_BAR;
    }
    for (;;) {
        const bool has_next = S.next(ui + 1, nxt);
        const char* nA = has_next ? (const char*)g.A + (size_t)nxt.pm * tstep : cA; const char* nB = has_next ? (const char*)g.Bt + (size_t)nxt.pn * tstep : cB;
        for (int t = 0; t < nt; t += 2) {
            const bool last = (t == nt - 2);
            const char* a1 = cA + (size_t)(t + 1) * kstep;
            const char* a2 = last ? nA : cA + (size_t)(t + 2) * kstep; const char* b2 = last ? nB : cB + (size_t)(t + 2) * kstep;
            const char* a3 = a2 + kstep; const char* b3 = b2 + kstep;
            if (last && has_next) S.a_ready(nxt);
            if constexpr (SP2) {
            PG8_LDB(B0, 0, 0); PG8_LDB(B1, 0, 1); PG8_SCHED; PG8_LDA(At, 0, 0); PG8_STAGE(PG8_SA(1, 1), a1 + hstep, voffA);
            PG8_WAIT_V(8); PG8_WAIT_L(0); PG8_BAR; PG8_MMA(0, 0, At, B0); PG8_MMA(0, 1, At, B1); PG8_BAR; PG8_SCHED;
            PG8_LDA(At, 0, 1); PG8_STAGE(PG8_SB(0, 0), b2, voffB); PG8_STAGE(PG8_SB(0, 1), b2 + hstep, voffB); PG8_STAGE(PG8_SA(0, 0), a2, voffA);
            PG8_WAIT_V(8); PG8_WAIT_L(0); PG8_BAR; PG8_MMA(1, 0, At, B0); PG8_MMA(1, 1, At, B1); PG8_BAR; PG8_SCHED;
            PG8_LDB(B0, 1, 0); PG8_LDB(B1, 1, 1); PG8_SCHED; PG8_LDA(At, 1, 0); PG8_STAGE(PG8_SA(0, 1), a2 + hstep, voffA);
            PG8_WAIT_V(8); PG8_WAIT_L(0); PG8_BAR; PG8_MMA(0, 0, At, B0); PG8_MMA(0, 1, At, B1); PG8_BAR; PG8_SCHED;
            PG8_LDA(At, 1, 1); PG8_STAGE(PG8_SB(1, 0), b3, voffB); PG8_STAGE(PG8_SB(1, 1), b3 + hstep, voffB); PG8_STAGE(PG8_SA(1, 0), a3, voffA);
            PG8_WAIT_V(8); PG8_WAIT_L(0); PG8_BAR; PG8_MMA(1, 0, At, B0); PG8_MMA(1, 1, At, B1); PG8_BAR; PG8_SCHED;
            } else {
            PG8_LDB(B0, 0, 0); PG8_SCHED; PG8_LDA(At, 0, 0); PG8_STAGE(PG8_SA(1, 1), a1 + hstep, voffA);
            PG8_WAIT_L(8); PG8_BAR; PG8_WAIT_L(0); PG8_MMA(0, 0, At, B0); PG8_BAR; PG8_SCHED;
            PG8_LDB(B1, 0, 1); PG8_STAGE(PG8_SB(0, 0), b2, voffB);
            PG8_BAR; PG8_WAIT_L(0); PG8_MMA(0, 1, At, B1); PG8_BAR;
            PG8_LDA(At, 0, 1); PG8_STAGE(PG8_SA(0, 0), a2, voffA);
            PG8_BAR; PG8_WAIT_L(0); PG8_MMA(1, 0, At, B0); PG8_BAR; PG8_SCHED;
            PG8_STAGE(PG8_SB(0, 1), b2 + hstep, voffB);
            PG8_WAIT_V(6); PG8_BAR; PG8_MMA(1, 1, At, B1); PG8_BAR;
            PG8_LDB(B0, 1, 0); PG8_SCHED; PG8_LDA(At, 1, 0); PG8_STAGE(PG8_SA(0, 1), a2 + hstep, voffA);
            PG8_WAIT_L(8); PG8_BAR; PG8_WAIT_L(0); PG8_MMA(0, 0, At, B0); PG8_BAR; PG8_SCHED;
            PG8_LDB(B1, 1, 1); PG8_STAGE(PG8_SB(1, 0), b3, voffB);
            PG8_BAR; PG8_WAIT_L(0); PG8_MMA(0, 1, At, B1); PG8_BAR;
            PG8_LDA(At, 1, 1); PG8_STAGE(PG8_SA(1, 0), a3, voffA);
            PG8_BAR; PG8_WAIT_L(0); PG8_MMA(1, 0, At, B0); PG8_BAR; PG8_SCHED;
            PG8_STAGE(PG8_SB(1, 1), b3 + hstep, voffB);
            PG8_WAIT_V(6); PG8_BAR; PG8_MMA(1, 1, At, B1); PG8_BAR;
            }
        }
        if constexpr (ALIGN_EPI) { if (wr == 0) PG8_BAR; }
        if constexpr (!Epi::AFTER_DRAIN) { E(acc, cur, wr, wc, fr, fq); S.done(cur); }
        if (!has_next) break;
#pragma unroll
        for (int a = 0; a < 2; ++a)
#pragma unroll
            for (int b = 0; b < 2; ++b)
#pragma unroll
                for (int m = 0; m < 4; ++m)
#pragma unroll
                    for (int n = 0; n < 2; ++n) acc[a][b][m][n] = (f32x4){0.f, 0.f, 0.f, 0.f};
        cur = nxt; cA = nA; cB = nB; ++ui;
        if constexpr (ALIGN_EPI) { if (wr == 1) PG8_BAR; }
    }
    PG8_WAIT_V(0);
    if constexpr (!ALIGN_EPI) { if (wr == 0) PG8_BAR; }
    PG8_BAR;
    if constexpr (Epi::AFTER_DRAIN) { E.fused(acc, cur, wr, wc, fr, fq, lds, wid, lane); S.done(cur); }
#undef PG8_SA
#undef PG8_SB
#undef PG8_STAGE
#undef PG8_LDA
#undef PG8_LDB
#undef PG8_MMA
#undef PG8_WAIT_V
#undef PG8_WAIT_L
#undef PG8_BAR
#undef PG8_SCHED
}
}

#define GAS __attribute__((address_space(1)))
#define LAS __attribute__((address_space(3)))
typedef unsigned short bf16;
typedef unsigned v4u __attribute__((ext_vector_type(4)));
typedef unsigned v2u __attribute__((ext_vector_type(2)));
typedef float f32x4 __attribute__((ext_vector_type(4)));
typedef short bf16x8 __attribute__((ext_vector_type(8)));
typedef GAS unsigned gu32;
#define RLX_AGENT __ATOMIC_RELAXED, __HIP_MEMORY_SCOPE_AGENT
#define LDS_WAIT() asm volatile("s_waitcnt lgkmcnt(0)" ::: "memory")
#define VM_WAIT() asm volatile("s_waitcnt vmcnt(0)" ::: "memory")
__device__ __forceinline__ unsigned f2bf(float f) { unsigned u = __builtin_bit_cast(unsigned, f); return (u + 0x7fffu + ((u >> 16) & 1u)) >> 16; }
__device__ __forceinline__ unsigned pk2(float lo, float hi) { return f2bf(lo) | (f2bf(hi) << 16); }
__device__ __forceinline__ float bf2f(unsigned h) { return __builtin_bit_cast(float, h << 16); }
__device__ __forceinline__ float bflo(unsigned w) { return __builtin_bit_cast(float, w << 16); }
__device__ __forceinline__ float bfhi(unsigned w) { return __builtin_bit_cast(float, w & 0xffff0000u); }
__device__ __forceinline__ float wave_sum(float v) {
#define WS_DPP(ctrl, rmask) v += __builtin_bit_cast(float, __builtin_amdgcn_update_dpp(0, __builtin_bit_cast(int, v), ctrl, rmask, 0xf, false))
    WS_DPP(0xB1, 0xf); WS_DPP(0x4E, 0xf); WS_DPP(0x141, 0xf); WS_DPP(0x140, 0xf); WS_DPP(0x142, 0xa); WS_DPP(0x143, 0xc);
#undef WS_DPP
    return __builtin_bit_cast(float, __builtin_amdgcn_readlane(__builtin_bit_cast(int, v), 63));
}
__device__ __forceinline__ float silu_acc(float x) { return x / (1.0f + __expf(-x)); }

#define XB_TMO      128
#define XB_XCNT(j)  (256  + 64 * (j))
#define XB_XSUB(j)  (1280 + 64 * (j))
#define XB_XGEN(j)  (2304 + 64 * (j))
#define XB_TOP      3328
#define XB_TOPGEN   3392
#define XCD_BAR_WORDS 3456
#define XB_SPIN_CAP (1u << 18)
__device__ __forceinline__ unsigned xb_ld(unsigned* p)              { return __hip_atomic_load(p, __ATOMIC_RELAXED, __HIP_MEMORY_SCOPE_AGENT); }
__device__ __forceinline__ unsigned xb_add(unsigned* p, unsigned v) { return __hip_atomic_fetch_add(p, v, __ATOMIC_RELAXED, __HIP_MEMORY_SCOPE_AGENT); }
__device__ __forceinline__ unsigned xb_xcc_id() { return (unsigned)__builtin_amdgcn_s_getreg((3 << 11) | 20) & 0xFu; }
#define XB_SPIN(cond, bar) do { unsigned _sp = 0; while (cond) { __builtin_amdgcn_s_sleep(1); \
    if ((++_sp & 255u) == 0u) { if (xb_ld(&(bar)[XB_TMO])) break; if (_sp > XB_SPIN_CAP) { atomicAdd(&(bar)[XB_TMO], 1u); break; } } } } while (0)
struct XcdBarrier { unsigned* bar; unsigned x; volatile LAS unsigned* st; };
__device__ __forceinline__ XcdBarrier xcd_barrier_post(unsigned* bar, volatile LAS unsigned* st) {
    XcdBarrier b; b.bar = bar; b.x = xb_xcc_id(); b.st = st;
    if (threadIdx.x == 0) (void)xb_add(&bar[XB_XCNT(b.x)], 1u);
    return b;
}
__device__ __forceinline__ void xcd_barrier_complete(unsigned* bar, unsigned x, unsigned& nloc, unsigned& nx) {
    const unsigned G = gridDim.x * gridDim.y * gridDim.z;
    unsigned sum, cnt, mine, sp = 0u;
    for (;;) {
        sum = 0u; cnt = 0u; mine = 0u;
#pragma unroll
        for (unsigned j = 0; j < 16; ++j) { const unsigned c = xb_ld(&bar[XB_XCNT(j)]); sum += c; cnt += (c > 0u) ? 1u : 0u; mine = (j == x) ? c : mine; }
        if (sum == G) break;
        __builtin_amdgcn_s_sleep(1);
        if ((++sp & 255u) == 0u) { if (xb_ld(&bar[XB_TMO])) break; if (sp > XB_SPIN_CAP) { atomicAdd(&bar[XB_TMO], 1u); break; } }
    }
    nloc = mine > 0u ? mine : 1u; nx = cnt > 0u ? cnt : 1u;
}
__device__ __forceinline__ void xcd_barrier(const XcdBarrier& b) {
    asm volatile("s_waitcnt vmcnt(0)" ::: "memory");
    __syncthreads();
    if (threadIdx.x == 0) {
        unsigned* bar = b.bar;
        __builtin_amdgcn_s_waitcnt(0);
        unsigned nloc = b.st[0], nx = b.st[1];
        if (nloc == 0u) { xcd_barrier_complete(bar, b.x, nloc, nx); b.st[0] = nloc; b.st[1] = nx; }
        const unsigned old = xb_add(&bar[XB_XSUB(b.x)], 1u);
        const unsigned gen = old / nloc;
        if (old + 1u == (gen + 1u) * nloc) {
            __builtin_amdgcn_fence(__ATOMIC_RELEASE, "agent");
            asm volatile("s_waitcnt vmcnt(0)" ::: "memory");
            const unsigned og = xb_add(&bar[XB_TOP], 1u);
            const unsigned tg = og / nx;
            if (og + 1u == (tg + 1u) * nx) xb_add(&bar[XB_TOPGEN], 1u);
            else XB_SPIN(xb_ld(&bar[XB_TOPGEN]) == tg, bar);
            __builtin_amdgcn_fence(__ATOMIC_ACQUIRE, "agent");
            xb_add(&bar[XB_XGEN(b.x)], 1u);
            asm volatile("s_waitcnt vmcnt(0)" ::: "memory");
        } else {
            XB_SPIN(xb_ld(&bar[XB_XGEN(b.x)]) == gen, bar);
            __builtin_amdgcn_fence(__ATOMIC_ACQUIRE, "agent");
            asm volatile("s_waitcnt vmcnt(0)" ::: "memory");
        }
    }
    __syncthreads();
}

struct Args { const float* in[N_IN]; float* out; unsigned char* ws; int ph_lo, ph_hi; };

struct TrItem { const float* src; bf16* dst; int N, Kd; };
__device__ __forceinline__ TrItem tr_make(const float* W, int N, bf16* WT, int Kd, int kb, int nb, int mode) {
    const int k0 = 64 * kb, n0 = 32 * nb; const int drow0 = mode == 0 ? n0 : ((n0 >> 7) * 256 + (n0 & 127) + (mode == 2 ? 128 : 0));
    TrItem t; t.src = W + (size_t)k0 * N + n0; t.dst = WT + (size_t)drow0 * Kd + k0; t.N = N; t.Kd = Kd; return t;
}
__device__ __forceinline__ void tr_load(const TrItem& t, float (&tv)[32], int lane) {
#pragma unroll
    for (int i = 0; i < 32; ++i) tv[i] = t.src[(size_t)(2 * i + (lane >> 5)) * t.N + (lane & 31)];
}
__device__ __forceinline__ void tr_finish(const TrItem& t, const float (&tv)[32], LAS float* scr, int lane) {
#pragma unroll
    for (int i = 0; i < 32; ++i) scr[(2 * i + (lane >> 5)) * 33 + (lane & 31)] = tv[i];
    LDS_WAIT(); asm volatile("" ::: "memory");
    const int c = lane & 7;
#pragma unroll
    for (int j = 0; j < 4; ++j) { const int n = (lane >> 3) + 8 * j; const LAS float* s = scr + (8 * c) * 33 + n;
        v4u o; o.x = pk2(s[0 * 33], s[1 * 33]); o.y = pk2(s[2 * 33], s[3 * 33]); o.z = pk2(s[4 * 33], s[5 * 33]); o.w = pk2(s[6 * 33], s[7 * 33]);
        *(v4u*)(t.dst + (size_t)n * t.Kd + 8 * c) = o; }
    LDS_WAIT(); asm volatile("" ::: "memory");
}

__device__ __forceinline__ void p0_prologue(const Args& a, LAS unsigned char* lds, int gw, int NGW, int wave, int lane, const bool with_j3) {
    unsigned char* ws = a.ws;
    LAS float* scr = (LAS float*)(lds + wave * 16384);
    if (with_j3) {
        LAS float* sl = (LAS float*)lds;
        LAS float* red = (LAS float*)(lds + 40960);
        const int tid = threadIdx.x, sub = lane >> 4, q = lane & 15;
        for (int e = tid; e < 9 * 1024; e += NTHREADS) { const int cc = e >> 10, k = e & 1023; sl[e] = silu_acc(cc == 0 ? a.in[I_CCTX][k] : a.in[I_C][(cc - 1) * 1024 + k]); }
        __syncthreads();
        for (int it = blockIdx.x; it < 2 * 144 * 2; it += NGW / NWAVES) {
            const int l = it / 288, r = it % 288, nch = r >> 1, kh = r & 1;
            const int k0 = kh * 512 + wave * 64;
            const float* wm = a.in[I_WMOD] + (size_t)l * 1024 * 9216 + (size_t)(k0 + sub) * 9216 + nch * 64 + q * 4;
            f32x4 w[16];
#pragma unroll
            for (int i = 0; i < 16; ++i) w[i] = *(const f32x4*)(wm + (size_t)(4 * i) * 9216);
            f32x4 acc[9];
#pragma unroll
            for (int c = 0; c < 9; ++c) acc[c] = (f32x4){0.f, 0.f, 0.f, 0.f};
#pragma unroll
            for (int i = 0; i < 16; ++i)
#pragma unroll
                for (int c = 0; c < 9; ++c) acc[c] += sl[c * 1024 + k0 + 4 * i + sub] * w[i];
#pragma unroll
            for (int c = 0; c < 9; ++c)
#pragma unroll
                for (int j = 0; j < 4; ++j) { float v = acc[c][j]; v += __shfl_xor(v, 16); v += __shfl_xor(v, 32); acc[c][j] = v; }
            if (lane < 16) {
#pragma unroll
                for (int c = 0; c < 9; ++c) *(LAS f32x4*)(red + (wave * 9 + c) * 64 + q * 4) = acc[c];
            }
            __syncthreads();
            for (int e = tid; e < 9 * 64; e += NTHREADS) { const int c = e >> 6, col = e & 63, n = nch * 64 + col; float sm = 0.f;
#pragma unroll
                for (int w8 = 0; w8 < 8; ++w8) sm += red[(w8 * 9 + c) * 64 + col];
                if (kh == 0) sm += a.in[I_BMOD][l * 9216 + n];
                atomicAdd((float*)(ws + WS_MOD) + (size_t)(l * 9 + c) * 9216 + n, sm); }
            __syncthreads();
        }
    }
    constexpr int I_G = 16 * 88, I_D = 44 * 32, I_FF = 3 * I_G, I_IN = 16 * 64, I_OUT = 12 * 32, I_L = 2 * I_FF + I_IN + I_OUT;
    static_assert(I_G == I_D, "items");
    auto j1_item = [&](int it) __attribute__((always_inline)) -> TrItem {
        const int l = it / I_L; int r = it % I_L;
        if (r < 2 * I_FF) {
            const int f = r / I_FF; r %= I_FF; const int part = r / I_G; r %= I_G;
            const size_t lo = (size_t)l * 1024 * 2816;
            if (part == 0)      return tr_make(a.in[f ? I_W2G : I_W1G] + lo, 2816, (bf16*)(ws + WS_WGU) + (size_t)(l * 2 + f) * 5632 * 1024, 1024, r / 88, r % 88, 1);
            else if (part == 1) return tr_make(a.in[f ? I_W2U : I_W1U] + lo, 2816, (bf16*)(ws + WS_WGU) + (size_t)(l * 2 + f) * 5632 * 1024, 1024, r / 88, r % 88, 2);
            else                return tr_make(a.in[f ? I_W2D : I_W1D] + lo, 1024, (bf16*)(ws + WS_WD) + (size_t)(l * 2 + f) * 1024 * 2816, 2816, r / 32, r % 32, 0);
        }
        r -= 2 * I_FF;
        if (r < I_IN) return tr_make(a.in[I_WIN] + (size_t)l * 1024 * 2048, 2048, (bf16*)(ws + WS_WIN) + (size_t)l * 2048 * 1024, 1024, r / 64, r % 64, 0);
        r -= I_IN; int kb = r / 32; if (kb >= 8) kb += 4;
        return tr_make(a.in[I_WOUT] + (size_t)l * 1024 * 1024, 1024, (bf16*)(ws + WS_WOUT) + (size_t)l * 1024 * 1024, 1024, kb, r % 32, 0);
    };
    const int j_lo = 0, j_hi = 2 * I_L, j_gw = gw, j_st = NGW;
    if (j_lo + j_gw < j_hi) {
        TrItem cur = j1_item(j_lo + j_gw); float tv[32]; tr_load(cur, tv, lane);
        for (int it = j_lo + j_gw; it < j_hi; it += j_st) {
            const bool more = it + j_st < j_hi;
            TrItem nxt = cur; float tn[32];
            if (more) { nxt = j1_item(it + j_st); tr_load(nxt, tn, lane); }
            tr_finish(cur, tv, scr, lane);
            if (more) { cur = nxt;
#pragma unroll
                for (int i = 0; i < 32; ++i) tv[i] = tn[i]; }
        }
    }
    for (int it = gw; it < 2 * 256 * 4; it += NGW) {
        const int l = it >> 10, kp = (it >> 2) & 255, nc = it & 3;
        const float* pw = a.in[I_CPW] + (size_t)l * 65536 + kp * 256;
        const float* wo = a.in[I_WOUT] + (size_t)l * 1048576 + (size_t)512 * 1024 + nc * 256 + lane * 4;
        f32x4 acc = {0.f, 0.f, 0.f, 0.f};
#pragma unroll 8
        for (int j = 0; j < 256; ++j) acc += pw[j] * *(const f32x4*)(wo + (size_t)j * 1024);
        bf16* dst = (bf16*)(ws + WS_WOUT) + (size_t)l * 1048576 + (size_t)(nc * 256 + lane * 4) * 1024 + 512 + kp;
        dst[0] = (bf16)f2bf(acc[0]); dst[1024] = (bf16)f2bf(acc[1]); dst[2048] = (bf16)f2bf(acc[2]); dst[3072] = (bf16)f2bf(acc[3]);
    }
    {
        const int gt = gw * 64 + lane, NGT = NGW * 64;
        for (int e = gt; e < 2 * 8 * 256 * 128; e += NGT) {
            const int gd = e & 127, p = (e >> 7) & 255, b = (e >> 15) & 7, l = e >> 18;
            const size_t src = (((size_t)b * 2 + l) * 256 + p) * 128 + gd;
            const float kv = a.in[I_CK][src], vv = a.in[I_CV][src];
            ((bf16*)(ws + WS_CKB))[e] = (bf16)f2bf(kv);
            ((bf16*)(ws + WS_CVT))[(((size_t)l * 8 + b) * 128 + gd) * 256 + p] = (bf16)f2bf(vv);
        }
        for (int e = gt; e < 1024; e += NGT) { const int p = e >> 4, i = e & 15; const float inv = powf(10000.0f, -(float)i / 16.0f); const float ang = (float)p * inv;
            ((float*)(ws + WS_ROPE))[2 * e] = cosf(ang); ((float*)(ws + WS_ROPE))[2 * e + 1] = sinf(ang); }
    }
    for (int it = gw; it < 2 * 2304; it += NGW) {
        const int l = it / 2304, tt = it % 2304; const int L = tt < 2048 ? 2048 : 256, t = tt < 2048 ? tt : tt - 2048;
        const float tf = (float)t, tn = tf / (float)(L - 1);
        const float* w1 = a.in[I_HW1] + l * 33 * 64; const float* w2 = a.in[I_HW2] + l * 64 * 64;
        float s1 = tn * w1[lane];
#pragma unroll 4
        for (int i = 0; i < 16; ++i) { const float band = 1e-4f + (float)i * ((15.0f - 1e-4f) / 15.0f); const float ang = (6.283185307179586f * tf) * band / (float)L;
            s1 += cosf(ang) * w1[(1 + i) * 64 + lane] - sinf(ang) * w1[(17 + i) * 64 + lane]; }
        const float h1 = sinf(a.in[I_HF1][l * 64 + lane] * (s1 + a.in[I_HB1][l * 64 + lane]));
        float s2 = 0.f;
#pragma unroll 8
        for (int k = 0; k < 64; ++k) s2 += __shfl(h1, k) * w2[k * 64 + lane];
        const float h2 = sinf(a.in[I_HF2][l * 64 + lane] * (s2 + a.in[I_HB2][l * 64 + lane]));
        ((float*)(ws + WS_HYH))[(size_t)it * 64 + lane] = h2;
    }
}

__device__ __forceinline__ void prep_phase(const float* src0, const float* src1, const float* g, const float* mod, int sc_chunk, bf16* H, unsigned long long* ss, int r_lo, int r_hi, int gw, int NGW, int lane) {
    const int per = (r_hi - r_lo + NGW - 1) / NGW; int r = r_lo + gw * per; r_hi = (r + per < r_hi) ? r + per : r_hi; NGW = 1;
    if (r >= r_hi) return;
    f32x4 v[4], v1[4], v2[4];
#define PREP_LOAD(dst, row) do { const int rr_ = (row); if (rr_ < r_hi) { const float* xr_ = rr_ < MCTX ? src0 + (size_t)rr_ * D : src1 + (size_t)(rr_ - MCTX) * D; \
        _Pragma("unroll") for (int j = 0; j < 4; ++j) dst[j] = ((const f32x4*)xr_)[lane + 64 * j]; } } while (0)
    PREP_LOAD(v, r); PREP_LOAD(v1, r + NGW);
    for (; r < r_hi; r += NGW) {
        PREP_LOAD(v2, r + 2 * NGW);
        const int cond = r < MCTX ? 0 : 1 + ((r - MCTX) >> 11);
        const float* sc = mod + cond * 9216 + sc_chunk * 1024;
        float s = 0.f;
#pragma unroll
        for (int j = 0; j < 4; ++j) s += (v[j][0] * v[j][0] + v[j][1] * v[j][1]) + (v[j][2] * v[j][2] + v[j][3] * v[j][3]);
        s = wave_sum(s); if (lane == 0) ss[r] = (unsigned long long)(s * SS_FIX);
#pragma unroll
        for (int j = 0; j < 4; ++j) { const int col = 4 * (lane + 64 * j);
            const f32x4 o = v[j] * *(const f32x4*)(g + col) * (*(const f32x4*)(sc + col) + 1.0f);
            v2u w; w.x = pk2(o[0], o[1]); w.y = pk2(o[2], o[3]); *(v2u*)(H + (size_t)r * D + col) = w; }
#pragma unroll
        for (int j = 0; j < 4; ++j) { v[j] = v1[j]; v1[j] = v2[j]; }
    }
#undef PREP_LOAD
}
__device__ __forceinline__ void bias_phase(const Args& a, int it_lo, int it_hi, int gw, int NGW, int lane) {
    unsigned char* ws = a.ws;
    const int i = lane & 15, q = lane >> 4;
    for (int it = it_lo + gw; it < it_hi; it += NGW) {
        const int l = it / 832; int r = it % 832; int which, n0;
        if (r < 352) { which = 0; n0 = r * 16; } else if (r < 480) { which = 1; n0 = (r - 352) * 16; } else { which = 2; n0 = (r - 480) * 16; }
        const bf16* Wt = which == 1 ? (const bf16*)(ws + WS_WIN) + (size_t)l * 2048 * 1024 : (const bf16*)(ws + WS_WGU) + (size_t)(l * 2 + (which == 2 ? 1 : 0)) * 5632 * 1024;
        const int shc = which == 0 ? 0 : (which == 1 ? 3 : 6), off = which == 0 ? 0 : (which == 1 ? 50688 : 69120), bst = which == 1 ? 2048 : 5632;
        const float* shp = (const float*)(ws + WS_MOD) + (size_t)l * 9 * 9216 + (size_t)(i < 9 ? i : 0) * 9216 + shc * 1024 + 8 * q;
        const bf16* wp = Wt + (size_t)(n0 + i) * 1024 + 8 * q;
        f32x4 acc = {0.f, 0.f, 0.f, 0.f};
#pragma unroll 8
        for (int st = 0; st < 32; ++st) {
            const f32x4 s0 = *(const f32x4*)(shp + 32 * st), s1 = *(const f32x4*)(shp + 32 * st + 4);
            const v4u wv = *(const v4u*)(wp + 32 * st);
            v4u av; av.x = pk2(s0[0], s0[1]); av.y = pk2(s0[2], s0[3]); av.z = pk2(s1[0], s1[1]); av.w = pk2(s1[2], s1[3]);
            if (i >= 9) av = (v4u){0u, 0u, 0u, 0u};
            acc = __builtin_amdgcn_mfma_f32_16x16x32_bf16(__builtin_bit_cast(bf16x8, av), __builtin_bit_cast(bf16x8, wv), acc, 0, 0, 0);
        }
        float* bo = (float*)(ws + WS_BIAS) + (size_t)l * 119808 + off + n0 + i;
#pragma unroll
        for (int rg = 0; rg < 4; ++rg) { const int cond = 4 * q + rg; if (cond < 9) bo[(size_t)cond * bst] = acc[rg]; }
    }
}
__device__ __forceinline__ void gct_phase(const Args& a, int gw, int NGW, int lane) {
    const int gt = gw * 64 + lane, NGT = NGW * 64;
    for (int e = gt; e < 6 * 9 * 1024; e += NGT) {
        const int inst = e / 9216, r = e % 9216, cond = r >> 10, col = r & 1023;
        float v = 0.f;
        if (inst >= 1) { const int l = inst / 3, k = inst % 3;
            const float g = (k == 0 ? a.in[I_GF1] : (k == 1 ? a.in[I_GMIX] : a.in[I_GF2]))[l * 1024 + col];
            const float sc = ((const float*)(a.ws + WS_MOD))[(size_t)l * 9 * 9216 + cond * 9216 + (k == 0 ? 1 : (k == 1 ? 4 : 7)) * 1024 + col];
            v = g * (1.0f + sc); }
        ((float*)(a.ws + WS_GCT))[e] = v;
    }
}
__device__ __forceinline__ void final_norm_phase(float* X, const float* g, const float* ss, int gw, int NGW, int lane) {
    for (int r = gw; r < M; r += NGW) {
        float* xr = X + (size_t)r * D;
        const float rstd = 1.0f / sqrtf(ss[r] * (1.0f / D) + EPS);
#pragma unroll
        for (int j = 0; j < 4; ++j) { const int col = 4 * (lane + 64 * j); ((f32x4*)xr)[lane + 64 * j] = (((const f32x4*)xr)[lane + 64 * j] * rstd) * *(const f32x4*)(g + col); }
    }
}

__device__ __forceinline__ void hyena_filter_phase(const Args& a, LAS unsigned char* lds, int gw, int NGW, int wave, int lane) {
    unsigned char* ws = a.ws;
    LAS float* hs = (LAS float*)(lds + wave * 16384);
    for (int it = gw; it < 2 * 36 * 16; it += NGW) {
        const int l = it / 576, r = it % 576, tc = r >> 4, ng = r & 15;
        const int stream = tc < 32 ? 0 : 1; const int L = stream ? 256 : 2048; const int t0 = (stream ? tc - 32 : tc) * 64; const int soff = stream ? 4096 : 0;
        const int n = ng * 64 + lane, o = n >> 9, dir = (n >> 8) & 1, c = n & 255;
        const float* hrow = (const float*)(ws + WS_HYH) + ((size_t)l * 2304 + (stream ? 2048 : 0) + t0) * 64;
        f32x4 hv[16];
#pragma unroll
        for (int i = 0; i < 16; ++i) hv[i] = ((const f32x4*)hrow)[i * 64 + lane];
        const float* w3 = a.in[I_HW3] + (size_t)l * 64 * 1024 + n;
        float w[64];
#pragma unroll
        for (int k = 0; k < 64; ++k) w[k] = w3[k * 1024];
        const float ndecay = -__expf(a.in[I_HLD][l * 1024 + n]) / (float)(L - 1);
#pragma unroll
        for (int i = 0; i < 16; ++i) *(LAS f32x4*)(hs + (i * 64 + lane) * 4) = hv[i];
        LDS_WAIT(); asm volatile("" ::: "memory");
        bf16* dst = (bf16*)(ws + WS_HYRAW) + ((size_t)(l * 2 + o) * 256 + c) * 4608 + soff;
        float sq = 0.f;
        for (int tt = 0; tt < 64; ++tt) {
            const int t = t0 + tt; float dot = 0.f;
#pragma unroll
            for (int k4 = 0; k4 < 16; ++k4) { const f32x4 h = *(const LAS f32x4*)(hs + tt * 64 + k4 * 4); dot += (h[0] * w[4 * k4] + h[1] * w[4 * k4 + 1]) + (h[2] * w[4 * k4 + 2] + h[3] * w[4 * k4 + 3]); }
            const float val = dot * __expf((float)t * ndecay);
            sq += val * val;
            if (dir == 0) dst[L - 1 - t] = (bf16)f2bf(val);
            else if (t > 0) dst[L - 1 + t] = (bf16)f2bf(val);
            else dst[2 * L - 1] = 0;
        }
        atomicAdd((unsigned long long*)(ws + WS_SUMSQ) + ((l * 2 + stream) * 2 + o) * 256 + c, (unsigned long long)(sq * FSQ_FIX));
        LDS_WAIT(); asm volatile("" ::: "memory");
    }
}

__device__ __forceinline__ void conv_phase(const Args& a, int l, const bf16* Z, bf16* CAT, LAS unsigned char* lds, int tid) {
    LAS float* ybuf = (LAS float*)lds;
    LAS float* cbuf = (LAS float*)(lds + 65536);
    const float* dw = a.in[I_CDW] + l * 31 * 256; const float* dwb = a.in[I_CDWB] + l * 256; const float* lng = a.in[I_CLNG] + l * 256; const float* lnb = a.in[I_CLNB] + l * 256;
    const int lane = tid & 63, wave = tid >> 6;
    for (int u = blockIdx.x; u < M / 32; u += gridDim.x) {
        const int r0 = u * 32;
        const int seq0 = r0 < MCTX ? (r0 & ~255) : MCTX + ((r0 - MCTX) & ~2047); const int seq1 = seq0 + (r0 < MCTX ? 256 : 2048);
        for (int e = tid; e < 62 * 32; e += NTHREADS) {
            const int rr = e >> 5, ch = e & 31; const int row = r0 - 15 + rr;
            float y[8];
            if (row >= seq0 && row < seq1) {
                const v4u av = *(const v4u*)(Z + (size_t)row * ZW + 768 + ch * 8), gv = *(const v4u*)(Z + (size_t)row * ZW + 1024 + ch * 8);
                const float af[8] = {bflo(av.x), bfhi(av.x), bflo(av.y), bfhi(av.y), bflo(av.z), bfhi(av.z), bflo(av.w), bfhi(av.w)};
                const float gf[8] = {bflo(gv.x), bfhi(gv.x), bflo(gv.y), bfhi(gv.y), bflo(gv.z), bfhi(gv.z), bflo(gv.w), bfhi(gv.w)};
#pragma unroll
                for (int j = 0; j < 8; ++j) y[j] = af[j] / (1.0f + __expf(-gf[j]));
            } else {
#pragma unroll
                for (int j = 0; j < 8; ++j) y[j] = 0.f;
            }
            *(LAS f32x4*)(ybuf + rr * 256 + ch * 8) = (f32x4){y[0], y[1], y[2], y[3]}; *(LAS f32x4*)(ybuf + rr * 256 + ch * 8 + 4) = (f32x4){y[4], y[5], y[6], y[7]};
        }
        __syncthreads();
        { const int c = tid & 255, half = tid >> 8;
          float w[31];
#pragma unroll
          for (int k = 0; k < 31; ++k) w[k] = dw[k * 256 + c];
          const float bias = dwb[c];
          float yv[46];
#pragma unroll
          for (int i = 0; i < 46; ++i) yv[i] = ybuf[(half * 16 + i) * 256 + c];
#pragma unroll
          for (int t = 0; t < 16; ++t) { float s = bias;
#pragma unroll
              for (int k = 0; k < 31; ++k) s += w[k] * yv[t + k];
              cbuf[(half * 16 + t) * 256 + c] = s; } }
        __syncthreads();
        for (int rr = wave * 4; rr < wave * 4 + 4; ++rr) {
            const f32x4 x = *(const LAS f32x4*)(cbuf + rr * 256 + lane * 4);
            const float mu = wave_sum((x[0] + x[1]) + (x[2] + x[3])) * (1.0f / 256.0f);
            const f32x4 dx = x - mu;
            const float var = wave_sum((dx[0] * dx[0] + dx[1] * dx[1]) + (dx[2] * dx[2] + dx[3] * dx[3])) * (1.0f / 256.0f);
            const float rstd = 1.0f / sqrtf(var + EPS);
            const f32x4 yv = dx * rstd * *(const f32x4*)(lng + lane * 4) + *(const f32x4*)(lnb + lane * 4);
            v2u wv; wv.x = pk2(silu_acc(yv[0]), silu_acc(yv[1])); wv.y = pk2(silu_acc(yv[2]), silu_acc(yv[3]));
            *(v2u*)(CAT + (size_t)(r0 + rr) * 1024 + 512 + lane * 4) = wv;
        }
        __syncthreads();
    }
}


typedef unsigned long long u64;
typedef u64 u64x2 __attribute__((ext_vector_type(2)));
template <int L> struct HyGeo {
    static constexpr int R = L / 128, NSTEP = L / 32, CS = 4 * L + 64, US = 2 * L + 32, OFF_U = 8 * CS;
    static constexpr int USP = 2 * L + 176, PRE = 32;
};
template <int L>
__device__ __forceinline__ void hy_build_copies(LAS unsigned char* lds, const bf16* raw, int tid) {
    constexpr int CS = HyGeo<L>::CS;
    for (int p = tid; p < L / 4; p += NTHREADS) {
        const v4u a = *(const v4u*)(raw + 8 * p), b = *(const v4u*)(raw + 8 * p + 8);
        const unsigned w[8] = {a.x, a.y, a.z, a.w, b.x, b.y, b.z, b.w};
#pragma unroll
        for (int sg = 0; sg < 8; ++sg) { v4u o;
            if ((sg & 1) == 0) { o.x = w[sg / 2]; o.y = w[sg / 2 + 1]; o.z = w[sg / 2 + 2]; o.w = w[sg / 2 + 3]; }
            else { const int h = sg / 2; o.x = (w[h] >> 16) | (w[h + 1] << 16); o.y = (w[h + 1] >> 16) | (w[h + 2] << 16); o.z = (w[h + 2] >> 16) | (w[h + 3] << 16); o.w = (w[h + 3] >> 16) | (w[h + 4] << 16); }
            *(LAS v4u*)(lds + sg * CS + 16 * p) = o; }
    }
}
template <int L, int NB>
__device__ __forceinline__ void hy_toeplitz(LAS unsigned char* lds, int boff, f32x4 (&acc)[HyGeo<L>::R][NB > 8 ? 2 : 1], int wave, int lane) {
    constexpr int R = HyGeo<L>::R, NT = NB > 8 ? 2 : 1, NSTEP = HyGeo<L>::NSTEP, CS = HyGeo<L>::CS, US = HyGeo<L>::US;
    const int i = lane & 15, q = lane >> 4;
    const int abase = (7 - (i & 7)) * CS + 16 * ((L / 8 - 1) - (i >> 3) + q - 2 * R * wave);
    int bb[NT];
#pragma unroll
    for (int nt = 0; nt < NT; ++nt) bb[nt] = boff + ((NB > 8 ? nt * 16 + i : (i & 7))) * US + 16 * q;
    bf16x8 F[R];
#pragma unroll
    for (int e = 0; e < R; ++e) F[e] = *(const LAS bf16x8*)(lds + abase - 32 * e);
#pragma unroll
    for (int r = 0; r < R; ++r)
#pragma unroll
        for (int nt = 0; nt < NT; ++nt) acc[r][nt] = (f32x4){0.f, 0.f, 0.f, 0.f};
    bf16x8 B[2][NT];
#pragma unroll
    for (int nt = 0; nt < NT; ++nt) B[0][nt] = *(const LAS bf16x8*)(lds + bb[nt]);
#pragma unroll 1
    for (int jo = 0; jo < NSTEP; jo += 8) {
#pragma unroll
        for (int ji = 0; ji < 8; ++ji) {
            const int j = jo + ji; constexpr int dummy = 0; (void)dummy;
#pragma unroll
            for (int r = R - 2; r < R; ++r) { const int slot = (((r - 2 * ji) % R) + R) % R;
#pragma unroll
                for (int nt = 0; nt < NT; ++nt) acc[r][nt] = __builtin_amdgcn_mfma_f32_16x16x32_bf16(F[slot], B[ji & 1][nt], acc[r][nt], 0, 0, 0); }
            __builtin_amdgcn_sched_barrier(0);
            if (j + 1 < NSTEP) {
#pragma unroll
                for (int nt = 0; nt < NT; ++nt) B[(ji + 1) & 1][nt] = *(const LAS bf16x8*)(lds + bb[nt] + 64 * (j + 1));
#pragma unroll
                for (int rr = 0; rr < 2; ++rr) { const int slot = (((rr - 2 * (ji + 1)) % R) + R) % R; F[slot] = *(const LAS bf16x8*)(lds + abase + 64 * (j + 1) - 32 * rr); }
            }
            __builtin_amdgcn_sched_barrier(0);
#pragma unroll
            for (int r = 0; r < R - 2; ++r) { const int slot = (((r - 2 * ji) % R) + R) % R;
#pragma unroll
                for (int nt = 0; nt < NT; ++nt) acc[r][nt] = __builtin_amdgcn_mfma_f32_16x16x32_bf16(F[slot], B[ji & 1][nt], acc[r][nt], 0, 0, 0); }
            __builtin_amdgcn_sched_barrier(0);
        }
    }
}
template <int L>
__device__ __forceinline__ void hy_toeplitz_pk(LAS unsigned char* lds, int boff, f32x4 (&acc)[HyGeo<L>::R / 2], int wave, int lane) {
    constexpr int R = HyGeo<L>::R, RP = R / 2, NSTEP = HyGeo<L>::NSTEP, CS = HyGeo<L>::CS, USP = HyGeo<L>::USP;
    static_assert(RP == 8, "slot arithmetic assumes 8 tile pairs per wave and an 8-step unroll");
    const int i = lane & 15, q = lane >> 4;
    const int abase = (7 - (i & 7)) * CS + 16 * ((L / 8 - 1) - (i >> 3) + q - 2 * R * wave);
    const int bb = boff + (i & 7) * USP + 16 * q + (i < 8 ? HyGeo<L>::PRE : 0);
    bf16x8 F[RP];
#pragma unroll
    for (int rp = 0; rp < RP; ++rp) F[rp] = *(const LAS bf16x8*)(lds + abase - 32 * (2 * rp + 1));
#pragma unroll
    for (int rp = 0; rp < RP; ++rp) acc[rp] = (f32x4){0.f, 0.f, 0.f, 0.f};
    bf16x8 B[2];
    B[0] = *(const LAS bf16x8*)(lds + bb);
#pragma unroll 1
    for (int jo = 0; jo < NSTEP; jo += 8) {
#pragma unroll
        for (int ji = 0; ji < 8; ++ji) {
            const int j = jo + ji;
            { const int slot = (((RP - 1 - ji) % RP) + RP) % RP; acc[RP - 1] = __builtin_amdgcn_mfma_f32_16x16x32_bf16(F[slot], B[ji & 1], acc[RP - 1], 0, 0, 0); }
            __builtin_amdgcn_sched_barrier(0);
            B[(ji + 1) & 1] = *(const LAS bf16x8*)(lds + bb + 64 * (j + 1));
            { const int slot = (((0 - (ji + 1)) % RP) + RP) % RP; F[slot] = *(const LAS bf16x8*)(lds + abase + 64 * (j + 1) - 32); }
            __builtin_amdgcn_sched_barrier(0);
#pragma unroll
            for (int rp = 0; rp < RP - 1; ++rp) { const int slot = (((rp - ji) % RP) + RP) % RP; acc[rp] = __builtin_amdgcn_mfma_f32_16x16x32_bf16(F[slot], B[ji & 1], acc[rp], 0, 0, 0); }
            __builtin_amdgcn_sched_barrier(0);
        }
    }
#pragma unroll
    for (int rp = 0; rp < RP; ++rp) acc[rp] = __builtin_amdgcn_mfma_f32_16x16x32_bf16(F[rp], B[0], acc[rp], 0, 0, 0);
}
struct XRaw { v2u z; unsigned zl, zr; };
__device__ __forceinline__ XRaw xraw_load(const bf16* zrow, int t, int L) { XRaw x; x.z = *(const v2u*)zrow; x.zl = t > 0 ? (unsigned)zrow[-1] : 0u; x.zr = t + 4 < L ? (unsigned)zrow[4] : 0u; return x; }
__device__ __forceinline__ void sconv4x(const XRaw& x, float w0, float w1, float w2, float sb, float (&out)[4]) {
    const float zl = bf2f(x.zl), zr = bf2f(x.zr), z0 = bflo(x.z.x), z1 = bfhi(x.z.x), z2 = bflo(x.z.y), z3 = bfhi(x.z.y);
    out[0] = sb + w0 * zl + w1 * z0 + w2 * z1; out[1] = sb + w0 * z0 + w1 * z1 + w2 * z2; out[2] = sb + w0 * z1 + w1 * z2 + w2 * z3; out[3] = sb + w0 * z2 + w1 * z3 + w2 * zr;
}
__device__ __forceinline__ void sconv4(const bf16* zrow, int t, int L, float w0, float w1, float w2, float sb, float (&out)[4]) { const XRaw x = xraw_load(zrow, t, L); sconv4x(x, w0, w1, w2, sb, out); }
template <int L>
__device__ __forceinline__ void hy_store_copies(LAS unsigned char* lds, const v4u a, const v4u b, int p) {
    constexpr int CS = HyGeo<L>::CS;
    const unsigned w[8] = {a.x, a.y, a.z, a.w, b.x, b.y, b.z, b.w};
#pragma unroll
    for (int sg = 0; sg < 8; ++sg) { v4u o;
        if ((sg & 1) == 0) { o.x = w[sg / 2]; o.y = w[sg / 2 + 1]; o.z = w[sg / 2 + 2]; o.w = w[sg / 2 + 3]; }
        else { const int h = sg / 2; o.x = (w[h] >> 16) | (w[h + 1] << 16); o.y = (w[h + 1] >> 16) | (w[h + 2] << 16); o.z = (w[h + 2] >> 16) | (w[h + 3] << 16); o.w = (w[h + 3] >> 16) | (w[h + 4] << 16); }
        *(LAS v4u*)(lds + sg * CS + 16 * p) = o; }
}
template <int L, int NB, bool DUP = false>
__device__ __forceinline__ void hyena_channel(const Args& a, int l, int c, const bf16* ZT, bf16* CAT, LAS unsigned char* lds, int tid, int wave, int lane) {
    constexpr bool PK = (NB == 8);
    constexpr int R = HyGeo<L>::R, RA = PK ? R / 2 : R, NT = NB > 8 ? 2 : 1, US = PK ? HyGeo<L>::USP : HyGeo<L>::US, PRE = PK ? HyGeo<L>::PRE : 0, OFF_U = HyGeo<L>::OFF_U, OFF_Y = OFF_U + NB * US;
    constexpr bool LAT = (L == 2048); constexpr int stream = LAT ? 0 : 1; constexpr int rowbase = LAT ? MCTX : 0;
    static_assert(L / 4 <= NTHREADS, "one copy slot per thread");
    static_assert(OFF_Y + NB * US <= LDSCTL_OFF && !DUP, "LDS");
    unsigned char* ws = a.ws;
    const float* sw = a.in[I_HSW] + l * 3 * 768; const float* sb = a.in[I_HSB] + l * 768;
    const bf16* raw0 = (const bf16*)(ws + WS_HYRAW) + ((size_t)(l * 2 + 0) * 256 + c) * 4608 + (LAT ? 0 : 4096);
    const bf16* raw1 = (const bf16*)(ws + WS_HYRAW) + ((size_t)(l * 2 + 1) * 256 + c) * 4608 + (LAT ? 0 : 4096);
    const int i = lane & 15;
    const bool cp = tid < L / 4;
    v4u f0a = {0u, 0u, 0u, 0u}, f0b = f0a, f1a = f0a, f1b = f0a;
    if (cp) { f0a = *(const v4u*)(raw0 + 8 * tid); f0b = *(const v4u*)(raw0 + 8 * tid + 8); f1a = *(const v4u*)(raw1 + 8 * tid); f1b = *(const v4u*)(raw1 + 8 * tid + 8); }
    __syncthreads();
    if (cp) hy_store_copies<L>(lds, f0a, f0b, tid);
    if constexpr (PK) {
        const v4u z = {0u, 0u, 0u, 0u};
        if (tid < 32) *(LAS v4u*)(lds + (tid >> 2) * HyGeo<L>::CS + 4 * L + 16 * (tid & 3)) = z;
        else if (tid < 128) { const int e = tid - 32, row = e / 6, k = e % 6;
            *(LAS v4u*)(lds + OFF_U + row * US + (k < 2 ? 16 * k : PRE + 2 * L + 16 * (k - 2))) = z; }
    }
    { const float w0 = sw[c], w1 = sw[768 + c], w2 = sw[1536 + c], b0 = sb[c];
      for (int idx = tid; idx < NB * (L / 8); idx += NTHREADS) {
          const int b = idx / (L / 8), s0 = (idx % (L / 8)) * 8; const bf16* zrow = ZT + (size_t)c * M + rowbase + b * L + s0;
          float o0[4], o1[4]; sconv4(zrow, s0, L, w0, w1, w2, b0, o0); sconv4(zrow + 4, s0 + 4, L, w0, w1, w2, b0, o1);
          v4u w; w.x = pk2(o0[0], o0[1]); w.y = pk2(o0[2], o0[3]); w.z = pk2(o1[0], o1[1]); w.w = pk2(o1[2], o1[3]);
          *(LAS v4u*)(lds + OFF_U + b * US + PRE + 2 * s0) = w; } }
    __syncthreads();
    f32x4 acc[RA][NT];
#define HY_T(r_, q_) (PK ? 16 * (R * wave + 2 * (r_) + (i < 8 ? 1 : 0)) + 4 * (q_) : 16 * (R * wave + (r_)) + 4 * (q_))
    if constexpr (PK) { f32x4 (&ap)[RA] = *reinterpret_cast<f32x4 (*)[RA]>(&acc[0][0]); hy_toeplitz_pk<L>(lds, OFF_U, ap, wave, lane); }
    else hy_toeplitz<L, NB>(lds, OFF_U, acc, wave, lane);
    { const float scale = 1.0f / sqrtf((float)((const unsigned long long*)(ws + WS_SUMSQ))[((l * 2 + stream) * 2 + 0) * 256 + c] * FSQ_UNFIX + EPS), bias = a.in[I_HBIAS][(l * 2 + 0) * 256 + c];
      const float w0 = sw[256 + c], w1 = sw[768 + 256 + c], w2 = sw[1536 + 256 + c], b0 = sb[256 + c];
      int q = lane >> 4; asm volatile("" : "+v"(q));
#pragma unroll
      for (int nt = 0; nt < NT; ++nt) { const int b = PK ? (i & 7) : nt * 16 + i;
          if (b < NB) {
#pragma unroll
              for (int r = 0; r < RA; ++r) { const int t = HY_T(r, q);
                  float x1[4]; sconv4(ZT + (size_t)(256 + c) * M + rowbase + b * L + t, t, L, w0, w1, w2, b0, x1);
                  const v2u uv = *(const LAS v2u*)(lds + OFF_U + b * US + PRE + 2 * t);
                  const float y0 = x1[0] * (scale * acc[r][nt][0] + bias * bflo(uv.x)), y1 = x1[1] * (scale * acc[r][nt][1] + bias * bfhi(uv.x));
                  const float y2 = x1[2] * (scale * acc[r][nt][2] + bias * bflo(uv.y)), y3 = x1[3] * (scale * acc[r][nt][3] + bias * bfhi(uv.y));
                  v2u w; w.x = pk2(y0, y1); w.y = pk2(y2, y3); *(LAS v2u*)(lds + OFF_Y + b * US + PRE + 2 * t) = w; } } } }
    __syncthreads();
    if (cp) hy_store_copies<L>(lds, f1a, f1b, tid);
    __syncthreads();
    if constexpr (PK) { f32x4 (&ap)[RA] = *reinterpret_cast<f32x4 (*)[RA]>(&acc[0][0]); hy_toeplitz_pk<L>(lds, OFF_Y, ap, wave, lane); }
    else hy_toeplitz<L, NB>(lds, OFF_Y, acc, wave, lane);
    { const float scale = 1.0f / sqrtf((float)((const unsigned long long*)(ws + WS_SUMSQ))[((l * 2 + stream) * 2 + 1) * 256 + c] * FSQ_UNFIX + EPS), bias = a.in[I_HBIAS][(l * 2 + 1) * 256 + c];
      const float w0 = sw[512 + c], w1 = sw[768 + 512 + c], w2 = sw[1536 + 512 + c], b0 = sb[512 + c];
      int q = lane >> 4; asm volatile("" : "+v"(q));
#pragma unroll
      for (int nt = 0; nt < NT; ++nt) { const int b = PK ? (i & 7) : nt * 16 + i;
          if (b < NB) {
#pragma unroll
              for (int r = 0; r < RA; ++r) { const int t = HY_T(r, q);
                  float x2[4]; sconv4(ZT + (size_t)(512 + c) * M + rowbase + b * L + t, t, L, w0, w1, w2, b0, x2);
                  const v2u yv = *(const LAS v2u*)(lds + OFF_Y + b * US + PRE + 2 * t);
                  bf16* dst = CAT + (size_t)(rowbase + b * L + t) * 1024 + 768 + c;
                  dst[0]    = (bf16)f2bf(x2[0] * (scale * acc[r][nt][0] + bias * bflo(yv.x)));
                  dst[1024] = (bf16)f2bf(x2[1] * (scale * acc[r][nt][1] + bias * bfhi(yv.x)));
                  dst[2048] = (bf16)f2bf(x2[2] * (scale * acc[r][nt][2] + bias * bflo(yv.y)));
                  dst[3072] = (bf16)f2bf(x2[3] * (scale * acc[r][nt][3] + bias * bfhi(yv.y))); } } } }
#undef HY_T
    __syncthreads();
}

typedef float f32x16 __attribute__((ext_vector_type(16)));
constexpr int ATT_KP = 144, ATT_VP = 80, ATT_KB = 32 * ATT_KP, ATT_BUF = ATT_KB + 64 * ATT_VP;
__device__ __forceinline__ void attn_phase(const Args& a, int l, const bf16* Z, const bf16* ZT, bf16* CAT, LAS unsigned char* lds, int tid, int wave, int lane) {
    const bf16* CKB = (const bf16*)(a.ws + WS_CKB) + (size_t)l * 8 * 256 * 128; const bf16* CVT = (const bf16*)(a.ws + WS_CVT) + (size_t)l * 8 * 128 * 256;
    const int r = lane & 31, hh = lane >> 5;
    for (int it = blockIdx.x; it < 768; it += gridDim.x) {
        bool lat; int b, g, qb;
        if (it < 512) { lat = true; b = it >> 6; g = (it >> 5) & 1; qb = it & 31; }
        else { const int rr = it - 512; lat = false; b = rr >> 3; g = (rr >> 2) & 1; qb = rr & 3; }
        const int h = g * 4 + (wave & 3), q0 = qb * 64 + 32 * (wave >> 2);
        const int L = lat ? 2048 : 256, seq0 = lat ? MCTX + b * 2048 : b * 256;
        const int kt_lo = lat ? (qb * 64 - 128 < 0 ? 0 : qb * 64 - 128) : 0, kt_hi = lat ? (qb * 64 + 192 > L ? L : qb * 64 + 192) : 256;
        const int n_local = (kt_hi - kt_lo) >> 5, n_total = n_local + (lat ? 8 : 0);
        const bool isk = tid < 256; const int t2 = tid & 255;
        const bf16* src_loc = isk ? Z + (size_t)(seq0 + kt_lo + (t2 >> 3)) * ZW + 512 + g * 64 + (t2 & 7) * 8 : ZT + (size_t)(768 + g * 64 + (t2 >> 2)) * M + seq0 + kt_lo + (t2 & 3) * 8;
        const bf16* src_ctx = isk ? CKB + ((size_t)b * 256 + (t2 >> 3)) * 128 + g * 64 + (t2 & 7) * 8 : CVT + ((size_t)b * 128 + g * 64 + (t2 >> 2)) * 256 + (t2 & 3) * 8;
        const size_t step_loc = isk ? (size_t)32 * ZW : 32, step_ctx = isk ? (size_t)32 * 128 : 32;
        const int dst = isk ? (t2 >> 3) * ATT_KP + (t2 & 7) * 16 : ATT_KB + (t2 >> 2) * ATT_VP + ((t2 & 3) >> 1) * 32 + ((t2 & 3) & 1) * 8;
#define ATT_GLOAD(ti_) (*(const v4u*)((ti_) < n_local ? src_loc + (size_t)(ti_) * step_loc : src_ctx + (size_t)((ti_) - n_local) * step_ctx))
#define ATT_LSTORE(buf_, v_) do { LAS unsigned char* p_ = lds + (buf_) * ATT_BUF + dst; if (isk) *(LAS v4u*)p_ = (v_); else { v2u lo_, hi_; lo_.x = (v_).x; lo_.y = (v_).y; hi_.x = (v_).z; hi_.y = (v_).w; *(LAS v2u*)p_ = lo_; *(LAS v2u*)(p_ + 16) = hi_; } } while (0)
        bf16x8 qf[4];
        { const bf16* qp = Z + (size_t)(seq0 + q0 + r) * ZW + h * 64 + 8 * hh;
#pragma unroll
          for (int s = 0; s < 4; ++s) qf[s] = *(const bf16x8*)(qp + 16 * s); }
        f32x16 o0, o1;
#pragma unroll
        for (int e = 0; e < 16; ++e) { o0[e] = 0.f; o1[e] = 0.f; }
        float mrun = a.in[I_SINK][l * 8 + h] * LOG2E, lsum = 1.0f;
        __syncthreads();
        v4u g1 = {0u, 0u, 0u, 0u}, g2 = g1;
        { const v4u g0 = ATT_GLOAD(0); if (n_total > 1) g1 = ATT_GLOAD(1); if (n_total > 2) g2 = ATT_GLOAD(2); ATT_LSTORE(0, g0); }
        __syncthreads();
        for (int ti = 0; ti < n_total; ++ti) {
            v4u gn = {0u, 0u, 0u, 0u};
            if (ti + 3 < n_total) gn = ATT_GLOAD(ti + 3);
            const int kt = kt_lo + 32 * ti;
            const bool active = !lat || ti >= n_local || (kt >= q0 - 128 && kt <= q0 + 128);
            if (active) {
                const LAS unsigned char* kb = lds + (ti & 1) * ATT_BUF + r * ATT_KP + 16 * hh;
                const LAS unsigned char* vb = lds + (ti & 1) * ATT_BUF + ATT_KB + r * ATT_VP + 16 * hh;
                f32x16 st;
#pragma unroll
                for (int e = 0; e < 16; ++e) st[e] = 0.f;
#pragma unroll
                for (int s = 0; s < 4; ++s) st = __builtin_amdgcn_mfma_f32_32x32x16_bf16(*(const LAS bf16x8*)(kb + 32 * s), qf[s], st, 0, 0, 0);
                const bf16x8 v00 = *(const LAS bf16x8*)(vb), v01 = *(const LAS bf16x8*)(vb + 32), v10 = *(const LAS bf16x8*)(vb + 32 * ATT_VP), v11 = *(const LAS bf16x8*)(vb + 32 * ATT_VP + 32);
                if (lat && ti < n_local) {
                    if (kt == q0 - 128) {
#pragma unroll
                        for (int e = 0; e < 16; ++e) { const int jj = (e & 3) + 8 * (e >> 2) + 4 * hh; if (jj < r) st[e] = -1e30f; }
                    } else if (kt == q0 + 128) {
#pragma unroll
                        for (int e = 0; e < 16; ++e) { const int jj = (e & 3) + 8 * (e >> 2) + 4 * hh; if (jj > r) st[e] = -1e30f; }
                    }
                }
                float mx = fmaxf(fmaxf(st[0], st[1]), fmaxf(st[2], st[3]));
#pragma unroll
                for (int e = 4; e < 16; e += 4) mx = fmaxf(mx, fmaxf(fmaxf(st[e], st[e + 1]), fmaxf(st[e + 2], st[e + 3])));
                mx = fmaxf(mx, __shfl_xor(mx, 32));
                const float mn = fmaxf(mrun, mx); const bool grew = __any(mn > mrun);
                const float alpha = grew ? __builtin_amdgcn_exp2f(mrun - mn) : 1.0f; mrun = mn;
                float ps = 0.f;
#pragma unroll
                for (int e = 0; e < 16; ++e) { st[e] = __builtin_amdgcn_exp2f(st[e] - mn); ps += st[e]; }
                ps += __shfl_xor(ps, 32);
                lsum = lsum * alpha + ps;
                if (grew) {
#pragma unroll
                    for (int e = 0; e < 16; ++e) { o0[e] *= alpha; o1[e] *= alpha; } }
                v4u pa, pb;
                pa.x = pk2(st[0], st[1]); pa.y = pk2(st[2], st[3]); pa.z = pk2(st[4], st[5]); pa.w = pk2(st[6], st[7]);
                pb.x = pk2(st[8], st[9]); pb.y = pk2(st[10], st[11]); pb.z = pk2(st[12], st[13]); pb.w = pk2(st[14], st[15]);
                const bf16x8 p0 = __builtin_bit_cast(bf16x8, pa), p1 = __builtin_bit_cast(bf16x8, pb);
                o0 = __builtin_amdgcn_mfma_f32_32x32x16_bf16(v00, p0, o0, 0, 0, 0);
                o0 = __builtin_amdgcn_mfma_f32_32x32x16_bf16(v01, p1, o0, 0, 0, 0);
                o1 = __builtin_amdgcn_mfma_f32_32x32x16_bf16(v10, p0, o1, 0, 0, 0);
                o1 = __builtin_amdgcn_mfma_f32_32x32x16_bf16(v11, p1, o1, 0, 0, 0);
            }
            if (ti + 1 < n_total) ATT_LSTORE((ti + 1) & 1, g1);
            g1 = g2; g2 = gn;
            __syncthreads();
        }
#undef ATT_GLOAD
#undef ATT_LSTORE
        const float inv = 1.0f / lsum;
        bf16* op = CAT + (size_t)(seq0 + q0 + r) * 1024 + h * 64 + 4 * hh;
#pragma unroll
        for (int g4 = 0; g4 < 4; ++g4) {
            v2u w; w.x = pk2(o0[4 * g4] * inv, o0[4 * g4 + 1] * inv); w.y = pk2(o0[4 * g4 + 2] * inv, o0[4 * g4 + 3] * inv); *(v2u*)(op + 8 * g4) = w;
            v2u x; x.x = pk2(o1[4 * g4] * inv, o1[4 * g4 + 1] * inv); x.y = pk2(o1[4 * g4 + 2] * inv, o1[4 * g4 + 3] * inv); *(v2u*)(op + 32 + 8 * g4) = x; }
    }
}

#ifndef PROBE_PH
#define PROBE_PH -1
#endif
#ifndef PROBE_TS
#define PROBE_TS -1
#endif
#ifndef PROBE_BLK
#define PROBE_BLK 0
#endif
#define TS_BEGIN(k) do { if constexpr ((k) == PROBE_TS) { if (blockIdx.x == PROBE_BLK && threadIdx.x == 0) *((volatile LAS unsigned long long*)(c.lds + MISC_OFF + 64)) = __builtin_amdgcn_s_memrealtime(); } } while (0)
#define TS_END(k) do { if constexpr ((k) == PROBE_TS) { if (blockIdx.x == PROBE_BLK && threadIdx.x == 0) *((volatile LAS unsigned long long*)(c.lds + MISC_OFF + 72)) = __builtin_amdgcn_s_memrealtime(); } } while (0)
struct Ctx { LAS unsigned char* lds; int tid, lane, wave, G, gw, NGW; };
constexpr int CW_SPLIT = 8192;

__device__ __forceinline__ void sb_arrive(unsigned* ctl, int id) {
    asm volatile("s_waitcnt vmcnt(0)" ::: "memory");
    __syncthreads();
    if (threadIdx.x == 0) __hip_atomic_fetch_add(ctl + CW_SPLIT + 64 * id, 1u, __ATOMIC_RELAXED, __HIP_MEMORY_SCOPE_AGENT);
}
__device__ __forceinline__ void sb_wait(unsigned* ctl, int id, unsigned G) {
    if (threadIdx.x == 0) {
        unsigned sp = 0;
        while (__hip_atomic_load(ctl + CW_SPLIT + 64 * id, __ATOMIC_RELAXED, __HIP_MEMORY_SCOPE_AGENT) < G) {
            __builtin_amdgcn_s_sleep(2);
            if (++sp > (1u << 22)) { atomicAdd(ctl + CW_BAR + XB_TMO, 1u); break; }
        }
        __builtin_amdgcn_fence(__ATOMIC_ACQUIRE, "agent");
        asm volatile("s_waitcnt vmcnt(0)" ::: "memory");
    }
    __syncthreads();
}
struct HalfOrder {
    pg8::StaticOrder S; int pm0;
    __device__ __forceinline__ void init(int N, int G, int c, int pm0_, int off) { const int rot = (G == 256) ? off : 0; S.init(48 * 256, N, G, (c + G - rot) % G); pm0 = pm0_; }
    __device__ __forceinline__ bool next(int i, pg8::Unit& u) const { if (!S.next(i, u)) return false; u.pm += pm0; return true; }
    __device__ __forceinline__ void a_ready(const pg8::Unit&) const {}
    __device__ __forceinline__ void done(const pg8::Unit&) const {}
};

template <int L, int f, int h> __device__ __forceinline__ void stage_G(const Args& a, const Ctx& c, int off) {
    unsigned char* ws = a.ws;
    pg8::Gemm g{(const bf16*)a.out, (const bf16*)(ws + WS_WGU) + (size_t)(L * 2 + f) * 5632 * 1024, M, 5632, 1024};
    HalfOrder S; S.init(5632, c.G, (int)blockIdx.x, 48 * h, off);
    pg8::EpiGU E{(bf16*)(ws + WS_BIG), (const unsigned long long*)(ws + WS_SS) + (size_t)(3 * L + 2 * f) * M, (const float*)(ws + WS_BIAS) + (size_t)L * 119808 + (f ? 69120 : 0)};
    pg8::gemm_phase<pg8::EpiGU, HalfOrder, true, true>(c.lds, g, S, E);
}
template <int L, int f, int h> __device__ __forceinline__ void stage_D(const Args& a, const Ctx& c, int off) {
    unsigned char* ws = a.ws; bf16* X = (bf16*)(ws + WS_X); unsigned long long* SS = (unsigned long long*)(ws + WS_SS);
    const float* modl = (const float*)(ws + WS_MOD) + (size_t)L * 9 * 9216;
    pg8::Gemm g{(const bf16*)(ws + WS_BIG), (const bf16*)(ws + WS_WD) + (size_t)(L * 2 + f) * 1024 * 2816, M, 1024, 2816};
    HalfOrder S; S.init(1024, c.G, (int)blockIdx.x, 48 * h, off);
    constexpr bool first = (L == 0) && f == 0;
    bf16* Hn = (f == 1 && L == 1) ? (bf16*)nullptr : (bf16*)a.out;
    const float* gct = (const float*)(ws + WS_GCT) + (size_t)(f == 0 ? 3 * L + 1 : (L == 0 ? 3 : 0)) * 9216;
    typedef pg8::EpiResT<first> Epi;
    Epi E{first ? (const void*)a.in[I_XP] : (const void*)X, first ? (const void*)a.in[I_XS] : (const void*)(X + (size_t)MCTX * D), X, modl + (f ? 8 : 2) * 1024, Hn, gct, SS + (size_t)(3 * L + 1 + 2 * f) * M, 0.5f};
    pg8::gemm_phase<Epi, HalfOrder, true, true>(c.lds, g, S, E);
}
template <int L, int h> __device__ __forceinline__ void stage_IN(const Args& a, const Ctx& c, int off) {
    unsigned char* ws = a.ws; float* newk = a.out + (size_t)M * D; float* newv = newk + 32 * 2 * 256 * 128;
    pg8::Gemm g{(const bf16*)a.out, (const bf16*)(ws + WS_WIN) + (size_t)L * 2048 * 1024, M, 2048, 1024};
    HalfOrder S; S.init(2048, c.G, (int)blockIdx.x, 48 * h, off);
    pg8::EpiIN E{(bf16*)(ws + WS_Z), (bf16*)(ws + WS_ZT), newk, newv, (const float*)(ws + WS_ROPE), (const unsigned long long*)(ws + WS_SS) + (size_t)(3 * L + 1) * M, (const float*)(ws + WS_BIAS) + (size_t)L * 119808 + 50688, L, QSCALE};
    pg8::gemm_phase<pg8::EpiIN, HalfOrder, true, true>(c.lds, g, S, E);
}
template <int L, int h> __device__ __forceinline__ void stage_OUT(const Args& a, const Ctx& c, int off) {
    unsigned char* ws = a.ws; bf16* X = (bf16*)(ws + WS_X); const float* modl = (const float*)(ws + WS_MOD) + (size_t)L * 9 * 9216;
    pg8::Gemm g{(const bf16*)a.out + (size_t)M * D, (const bf16*)(ws + WS_WOUT) + (size_t)L * 1024 * 1024, M, 1024, 1024};
    HalfOrder S; S.init(1024, c.G, (int)blockIdx.x, 48 * h, off);
    typedef pg8::EpiResT<false> Epi;
    Epi E{X, X + (size_t)MCTX * D, X, modl + 5 * 1024, (bf16*)a.out, (const float*)(ws + WS_GCT) + (size_t)(3 * L + 2) * 9216, (unsigned long long*)(ws + WS_SS) + (size_t)(3 * L + 2) * M, 1.0f};
    pg8::gemm_phase<Epi, HalfOrder, true, true>(c.lds, g, S, E);
}
template <int L> __device__ __forceinline__ void mix_stage(const Args& a, const Ctx& c) {
    unsigned char* ws = a.ws; const bf16* Z = (const bf16*)(ws + WS_Z); const bf16* ZT = (const bf16*)(ws + WS_ZT); bf16* CAT = (bf16*)a.out + (size_t)M * D;
    int tid_ = c.tid; asm volatile("" : "+v"(tid_));
    const int G = c.G, tid = tid_, lane = tid_ & 63; LAS unsigned char* lds = c.lds;
#define HY_CH(w) ((((w) & 7) << 5) | (((w) >> 3) & 31))
    if constexpr (L == 0) TS_BEGIN(301);
    for (int w = blockIdx.x; w < 256; w += G) hyena_channel<2048, 8>(a, L, HY_CH(w), ZT, CAT, lds, tid, c.wave, lane);
    if constexpr (L == 0) { TS_END(301); TS_BEGIN(302); }
    for (int w = blockIdx.x; w < 256; w += G) hyena_channel<256, 32>(a, L, HY_CH(w), ZT, CAT, lds, tid, c.wave, lane);
#undef HY_CH
    if constexpr (L == 0) { TS_END(302); TS_BEGIN(303); }
    attn_phase(a, L, Z, ZT, CAT, lds, tid, c.wave, lane);
    __syncthreads();
    if constexpr (L == 0) { TS_END(303); TS_BEGIN(304); }
    conv_phase(a, L, Z, CAT, lds, tid);
    if constexpr (L == 0) TS_END(304);
}
__device__ __forceinline__ void final_half(const Args& a, const Ctx& c, int h) {
    const bf16* X = (const bf16*)(a.ws + WS_X); float* Y = a.out; const unsigned long long* ss = (const unsigned long long*)(a.ws + WS_SS) + (size_t)6 * M; const float* g = a.in[I_GFIN];
    for (int r = h * 12288 + c.gw; r < (h + 1) * 12288; r += c.NGW) {
        const float rstd = 1.0f / sqrtf((float)ss[r] * (SS_UNFIX / D) + EPS);
#pragma unroll
        for (int j = 0; j < 2; ++j) { const int col = 8 * (c.lane + 64 * j); const v4u w = *(const v4u*)(X + (size_t)r * D + col);
            const f32x4 x0 = {bflo(w.x), bfhi(w.x), bflo(w.y), bfhi(w.y)}, x1 = {bflo(w.z), bfhi(w.z), bflo(w.w), bfhi(w.w)};
            *(f32x4*)(Y + (size_t)r * D + col) = (x0 * rstd) * *(const f32x4*)(g + col); *(f32x4*)(Y + (size_t)r * D + col + 4) = (x1 * rstd) * *(const f32x4*)(g + col + 4); }
    }
}

__global__ void __launch_bounds__(NTHREADS, 2) mega_fwd(Args a) {
    extern __shared__ __attribute__((aligned(16))) unsigned char lds_raw[];
    Ctx c;
    c.lds = (LAS unsigned char*)lds_raw;
    c.tid = threadIdx.x; c.lane = c.tid & 63; c.wave = __builtin_amdgcn_readfirstlane(c.tid >> 6);
    c.G = gridDim.x; c.gw = blockIdx.x * NWAVES + c.wave; c.NGW = c.G * NWAVES;
    unsigned* ctl = (unsigned*)(a.ws + WS_CTL);
    for (int u = c.tid; u < (LDS_BYTES - LDSCTL_OFF) / 4; u += NTHREADS) ((LAS unsigned*)(c.lds + LDSCTL_OFF))[u] = 0u;
    __syncthreads();
    XcdBarrier bar = xcd_barrier_post(ctl + CW_BAR, (volatile LAS unsigned*)(c.lds + MISC_OFF) + 8);
    cg::grid_group grid = cg::this_grid();
    const unsigned G = (unsigned)c.G;
    TS_BEGIN(0);
    p0_prologue(a, c.lds, c.gw, c.NGW, c.wave, c.lane, true);
    if (a.ph_hi > 100000) grid.sync(); else xcd_barrier(bar);
    TS_END(0); TS_BEGIN(1);
    prep_phase(a.in[I_XP], a.in[I_XS], a.in[I_GF1], (const float*)(a.ws + WS_MOD), 1, (bf16*)a.out, (unsigned long long*)(a.ws + WS_SS), 0, M, c.gw, c.NGW, c.lane);
    bias_phase(a, 0, 2 * 832, c.gw, c.NGW, c.lane);
    gct_phase(a, c.gw, c.NGW, c.lane);
    xcd_barrier(bar);
    TS_END(1); TS_BEGIN(2);
    { stage_G<0, 0, 0>(a, c, 0); sb_arrive(ctl, 0); }
    { stage_G<0, 0, 1>(a, c, 32); sb_arrive(ctl, 1); }
    { sb_wait(ctl, 0, G); stage_D<0, 0, 0>(a, c, 64); sb_arrive(ctl, 2); }
    { sb_wait(ctl, 1, G); stage_D<0, 0, 1>(a, c, 0); sb_arrive(ctl, 3); }
    { const int b = (int)blockIdx.x;
      if (b < 64 || b >= 192) hyena_filter_phase(a, c.lds, (b < 64 ? b : b - 128) * NWAVES + c.wave, 128 * NWAVES, c.wave, c.lane); }
    sb_wait(ctl, 2, G); sb_wait(ctl, 3, G);
    stage_IN<0, 0>(a, c, 0);
    stage_IN<0, 1>(a, c, 128);
    xcd_barrier(bar);
    TS_END(2); TS_BEGIN(3);
    mix_stage<0>(a, c);
    xcd_barrier(bar);
    TS_END(3); TS_BEGIN(4);
    { stage_OUT<0, 0>(a, c, 128); sb_arrive(ctl, 4); }
    { stage_OUT<0, 1>(a, c, 64); sb_arrive(ctl, 5); }
    { sb_wait(ctl, 4, G); stage_G<0, 1, 0>(a, c, 0); sb_arrive(ctl, 6); }
    { sb_wait(ctl, 5, G); stage_G<0, 1, 1>(a, c, 32); sb_arrive(ctl, 7); }
    { sb_wait(ctl, 6, G); stage_D<0, 1, 0>(a, c, 0); sb_arrive(ctl, 8); }
    { sb_wait(ctl, 7, G); stage_D<0, 1, 1>(a, c, 192); sb_arrive(ctl, 9); }
    { sb_wait(ctl, 8, G); stage_G<1, 0, 0>(a, c, 64); sb_arrive(ctl, 10); }
    { sb_wait(ctl, 9, G); stage_G<1, 0, 1>(a, c, 96); sb_arrive(ctl, 11); }
    { sb_wait(ctl, 10, G); stage_D<1, 0, 0>(a, c, 128); sb_arrive(ctl, 12); }
    { sb_wait(ctl, 11, G); stage_D<1, 0, 1>(a, c, 64); sb_arrive(ctl, 13); }
    sb_wait(ctl, 12, G); sb_wait(ctl, 13, G);
    stage_IN<1, 0>(a, c, 0);
    stage_IN<1, 1>(a, c, 128);
    xcd_barrier(bar);
    TS_END(4); TS_BEGIN(5);
    mix_stage<1>(a, c);
    xcd_barrier(bar);
    TS_END(5); TS_BEGIN(6);
    { stage_OUT<1, 0>(a, c, 128); sb_arrive(ctl, 14); }
    { stage_OUT<1, 1>(a, c, 64); sb_arrive(ctl, 15); }
    { sb_wait(ctl, 14, G); stage_G<1, 1, 0>(a, c, 128); sb_arrive(ctl, 16); }
    { sb_wait(ctl, 15, G); stage_G<1, 1, 1>(a, c, 160); sb_arrive(ctl, 17); }
    { sb_wait(ctl, 16, G); stage_D<1, 1, 0>(a, c, 0); sb_arrive(ctl, 18); }
    { sb_wait(ctl, 17, G); stage_D<1, 1, 1>(a, c, 192); sb_arrive(ctl, 19); }
    { sb_wait(ctl, 18, G); final_half(a, c, 0); }
    { sb_wait(ctl, 19, G); final_half(a, c, 1); }
    TS_END(6);
    if constexpr (PROBE_TS >= 0) { if (blockIdx.x == PROBE_BLK && threadIdx.x == 0) { const unsigned long long t0 = *((volatile LAS unsigned long long*)(c.lds + MISC_OFF + 64)), t1 = *((volatile LAS unsigned long long*)(c.lds + MISC_OFF + 72)); const unsigned long long now = __builtin_amdgcn_s_memrealtime(); while (__builtin_amdgcn_s_memrealtime() - now < 9ull * (t1 - t0)) __builtin_amdgcn_s_sleep(8); } __syncthreads(); }
}

extern "C" void kernel_launch(void* const* d_in, const int* in_sizes, int n_in, void* d_out, int out_size, void* d_ws, size_t ws_size, hipStream_t stream) {
    static int grid = 0;
    if (grid == 0) {
        if (n_in != N_IN || ws_size < WS_END || out_size != M * D + 2 * 32 * 2 * 256 * 128) { fprintf(stderr, "kernel_launch: unexpected shapes (n_in %d, ws %zu, out %d)\n", n_in, ws_size, out_size); grid = -1; return; }
        int dev = 0, cus = 0, per_cu = 0;
        if (hipGetDevice(&dev) != hipSuccess || hipDeviceGetAttribute(&cus, hipDeviceAttributeMultiprocessorCount, dev) != hipSuccess) { grid = -1; return; }
        if (hipFuncSetAttribute((const void*)mega_fwd, hipFuncAttributeMaxDynamicSharedMemorySize, LDS_BYTES) != hipSuccess) { fprintf(stderr, "kernel_launch: hipFuncSetAttribute failed\n"); grid = -1; return; }
        if (hipOccupancyMaxActiveBlocksPerMultiprocessor(&per_cu, (const void*)mega_fwd, NTHREADS, LDS_BYTES) != hipSuccess || per_cu < 1) { fprintf(stderr, "kernel_launch: occupancy query says %d\n", per_cu); per_cu = 1; }
        (void)hipGetLastError();
        if (cus < 256) { fprintf(stderr, "kernel_launch: built for a 256-CU device (got %d)\n", cus); grid = -1; return; }
        grid = 256;
    }
    if (grid < 0) return;
    (void)hipMemsetAsync((char*)d_ws + WS_CTL, 0, CTL_ZERO_BYTES, stream);
    Args a{};
    for (int i = 0; i < N_IN; ++i) a.in[i] = (const float*)d_in[i];
    a.out = (float*)d_out; a.ws = (unsigned char*)d_ws; a.ph_lo = 0; a.ph_hi = 1;
    void* args[] = {&a};
    hipError_t e = hipLaunchCooperativeKernel((const void*)mega_fwd, dim3(grid), dim3(NTHREADS), args, LDS_BYTES, stream);
    if (e != hipSuccess) fprintf(stderr, "cooperative launch failed: %s (grid %d)\n", hipGetErrorString(e), grid);
}
```

```cpp
#include <hip/hip_runtime.h>
#include <hip/hip_cooperative_groups.h>
#include <cstdio>
#include <cstdint>
namespace cg = cooperative_groups;

constexpr int D = 1024, DFF = 2816, INW = 2048;
constexpr int MCTX = 8192, MLAT = 16384, M = MCTX + MLAT;
constexpr int LCTX = 256, LLAT = 2048;
constexpr int NCOND = 9, MODW = 9 * 1024;
constexpr int ZW = 1280;
constexpr int HYC = 768;
constexpr float EPS = 1e-6f;
constexpr float SS_FIX = 16777216.0f, SS_UNFIX = 1.0f / 16777216.0f;
constexpr float FSQ_FIX = 68719476736.0f, FSQ_UNFIX = 1.0f / 68719476736.0f;
constexpr float LOG2E = 1.4426950408889634f;
constexpr float QSCALE = 0.125f * LOG2E;

enum { I_XP = 0, I_XS, I_C, I_CK, I_CV, I_CCTX, I_WMOD, I_BMOD, I_GF1, I_GMIX, I_GF2, I_GFIN, I_W1G, I_W1U, I_W1D, I_W2G, I_W2U, I_W2D, I_WIN, I_WOUT, I_SINK,
       I_CDW, I_CDWB, I_CLNG, I_CLNB, I_CPW, I_HSW, I_HSB, I_HW1, I_HB1, I_HF1, I_HW2, I_HB2, I_HF2, I_HW3, I_HLD, I_HBIAS, N_IN };

constexpr size_t MiB = 1u << 20;
constexpr size_t WS_CTL = 0, CTL_ZERO_BYTES = 3 * MiB;
constexpr size_t WS_SUMSQ = 64 * 1024;
constexpr size_t WS_MOD = 128 * 1024;
constexpr size_t WS_SS = 1 * MiB;
constexpr size_t WS_ROPE = 3 * MiB;
constexpr size_t WS_BIAS = 3 * MiB + 64 * 1024;
constexpr size_t WS_WGU = 4 * MiB;
constexpr size_t WS_WD = 48 * MiB;
constexpr size_t WS_WIN = 70 * MiB;
constexpr size_t WS_WOUT = 78 * MiB;
constexpr size_t WS_CKB = 82 * MiB;
constexpr size_t WS_CVT = 83 * MiB;
constexpr size_t WS_HYH = 84 * MiB;
constexpr size_t WS_HYRAW = 86 * MiB;
constexpr size_t WS_X = 96 * MiB;
constexpr size_t WS_BIG = 144 * MiB;
constexpr size_t WS_Z = WS_BIG;
constexpr size_t WS_ZT = 204 * MiB;
constexpr size_t WS_GCT = 276 * MiB;
constexpr size_t WS_TMPW = 277 * MiB;
constexpr size_t WS_END = 278 * MiB;
static_assert(WS_MOD + 2 * 9 * 9216 * 4 <= WS_SS && WS_SS + 7 * (size_t)M * 8 <= CTL_ZERO_BYTES && CTL_ZERO_BYTES <= WS_ROPE && WS_BIAS + 2 * 9 * 13312 * 4 <= WS_WGU, "ctl");
static_assert(WS_BIG + (size_t)M * DFF * 2 <= WS_GCT && WS_Z + (size_t)M * ZW * 2 <= WS_ZT && WS_ZT + (size_t)896 * M * 2 <= WS_GCT, "ws map");
constexpr int CW_BAR = 4096;

constexpr int RING_BYTES = 131072;
constexpr int LDSCTL_OFF = 135168, MISC_OFF = LDSCTL_OFF + 320;
constexpr int LDS_BYTES = 137216;
constexpr int NWAVES = 8, NTHREADS = 512;

namespace pg8 {
#define PG8_LAS __attribute__((address_space(3)))
typedef unsigned short bf16_t;
typedef short bf16x8 __attribute__((ext_vector_type(8)));
typedef float f32x4 __attribute__((ext_vector_type(4)));
typedef unsigned u32x4 __attribute__((ext_vector_type(4)));
constexpr int BM = 256, BK = 64, HALF = 128, HTB = HALF * BK * 2  , STAGE_BYTES = 8 * HTB, NXCD = 8, WGM = 8;

__host__ __device__ __forceinline__ int lds_byte(int r, int c) { const int st = (r >> 4) * 2 + (c >> 5), rr = r & 15, cc = c & 31, ob = rr * 64 + cc * 2; return st * 1024 + (ob ^ (((ob >> 9) & 1) << 5)); }
__host__ __device__ __forceinline__ void stage_rc(int b, int& R, int& C) { const int st = b / 1024, sb = b % 1024, swz = sb ^ (((sb >> 9) & 1) << 5); R = (st >> 1) * 16 + swz / 64; C = (st & 1) * 32 + (swz % 64) / 2; }
__host__ __device__ __forceinline__ int perm32(int rho) { const int n = rho >> 4, i = rho & 15; return 8 * (i >> 2) + 4 * n + (i & 3); }

struct Unit { int pm, pn; };
struct Gemm { const bf16_t* A; const bf16_t* Bt; int M, N, K; };

struct StaticOrder {
    int nM, nN, nwg, G, c;
    __host__ __device__ void init(int M, int N, int G_, int c_) { nM = M / BM; nN = N / BM; nwg = nM * nN; G = G_; c = c_; }
    __host__ __device__ bool next(int i, Unit& u) const {
        const long L = (long)i * G + c; if (L >= nwg) return false;
        int wgid = (int)L; { const int q = nwg / NXCD, r = nwg % NXCD, xcd = wgid % NXCD, off = wgid / NXCD; wgid = (xcd < r ? xcd * (q + 1) : r * (q + 1) + (xcd - r) * q) + off; }
        const int nig = WGM * nN, gid = wgid / nig, fm = gid * WGM, gsz = (nM - fm) < WGM ? (nM - fm) : WGM;
        u.pm = fm + ((wgid % nig) % gsz); u.pn = (wgid % nig) / gsz; return true;
    }
    __device__ __forceinline__ void a_ready(const Unit&) const {}
    __device__ __forceinline__ void done(const Unit&) const {}
};


__device__ __forceinline__ unsigned cvt_pk_bf16(float lo, float hi) { unsigned r; asm volatile("v_cvt_pk_bf16_f32 %0, %1, %2" : "=v"(r) : "v"(lo), "v"(hi)); return r; }
__device__ __forceinline__ float silu_f(float x) { return x * __builtin_amdgcn_rcpf(1.0f + __builtin_amdgcn_exp2f(-1.4426950408889634f * x)); }
__device__ __forceinline__ int cond_of_tile(int pm) { return pm < 32 ? 0 : 1 + ((pm - 32) >> 3); }

__device__ __forceinline__ void st16_wt(void* p, u32x4 v) { asm volatile("global_store_dwordx4 %0, %1, off sc1\n\ts_nop 1" :: "v"(p), "v"(v) : "memory"); }
__device__ __forceinline__ void st16_wt(void* p, f32x4 v) { asm volatile("global_store_dwordx4 %0, %1, off sc1\n\ts_nop 1" :: "v"(p), "v"(v) : "memory"); }
__device__ __forceinline__ void st8_wt(void* p, unsigned lo, unsigned hi) { __hip_atomic_store((unsigned long long*)p, ((unsigned long long)hi << 32) | lo, __ATOMIC_RELAXED, __HIP_MEMORY_SCOPE_AGENT); }
struct EpiGU {
    static constexpr bool PERM = true, AFTER_DRAIN = false;
    bf16_t* O;
    const unsigned long long* ss; const float* bias;
    __device__ __forceinline__ void operator()(const f32x4 (&acc)[2][2][4][2], const Unit& u, int wr, int wc, int fr, int fq) const {
        const int row0 = u.pm * BM + wr * 64 + fr, col0 = u.pn * HALF + wc * 32 + 8 * fq;
        const float* bp = bias + cond_of_tile(u.pm) * 5632 + u.pn * BM + wc * 32 + 8 * fq;
        const f32x4 bg0 = *(const f32x4*)bp, bg1 = *(const f32x4*)(bp + 4), bu0 = *(const f32x4*)(bp + HALF), bu1 = *(const f32x4*)(bp + HALF + 4);
        unsigned long long rsq[2][4]; float rsv[2][4];
#pragma unroll
        for (int ai = 0; ai < 2; ++ai)
#pragma unroll
            for (int m = 0; m < 4; ++m) rsq[ai][m] = ss[row0 + ai * HALF + m * 16];
#pragma unroll
        for (int ai = 0; ai < 2; ++ai)
#pragma unroll
            for (int m = 0; m < 4; ++m) rsv[ai][m] = (float)rsq[ai][m];
#pragma unroll
        for (int ai = 0; ai < 2; ++ai)
#pragma unroll
            for (int m = 0; m < 4; ++m) { const int row = row0 + ai * HALF + m * 16; bf16_t* rowp = O + (size_t)row * 2816 + col0;
                const float rs = __builtin_amdgcn_rsqf(rsv[ai][m] * (SS_UNFIX / 1024.0f) + 1e-6f);
                const f32x4 g0 = acc[ai][0][m][0] * rs + bg0, g1 = acc[ai][0][m][1] * rs + bg1, u0 = acc[ai][1][m][0] * rs + bu0, u1 = acc[ai][1][m][1] * rs + bu1;
                u32x4 w;
                w.x = cvt_pk_bf16(silu_f(g0[0]) * u0[0], silu_f(g0[1]) * u0[1]); w.y = cvt_pk_bf16(silu_f(g0[2]) * u0[2], silu_f(g0[3]) * u0[3]);
                w.z = cvt_pk_bf16(silu_f(g1[0]) * u1[0], silu_f(g1[1]) * u1[1]); w.w = cvt_pk_bf16(silu_f(g1[2]) * u1[2], silu_f(g1[3]) * u1[3]);
                st16_wt(rowp, w); }
    }
};
template <bool SRC32> struct EpiResT {
    static constexpr bool PERM = true, AFTER_DRAIN = false;
    const void* in0; const void* in1; bf16_t* X; const float* gate;
    bf16_t* Hn; const float* gct; unsigned long long* ssn; float scale;
    static __device__ __forceinline__ float lo16(unsigned w) { return __uint_as_float(w << 16); }
    static __device__ __forceinline__ float hi16(unsigned w) { return __uint_as_float(w & 0xffff0000u); }
    __device__ __forceinline__ void operator()(const f32x4 (&acc)[2][2][4][2], const Unit& u, int wr, int wc, int fr, int fq) const {
        asm volatile("" : "+v"(fr), "+v"(fq));
        const int cond = cond_of_tile(u.pm); const float* gp = gate + cond * 9216; const float* cp = gct + cond * 1024;
        const int col0 = u.pn * BM + wc * 32 + 8 * fq;
        const bool ctx = u.pm < 32; const void* src = ctx ? in0 : in1; const int rbase = u.pm * BM - (ctx ? 0 : 8192);
        f32x4 gv[2][2], gc[2][2], xo32[4][2][2]; u32x4 xo16[4][2];
#define EPIRES_LOAD(slot_, rg_) do { const size_t ro = (size_t)(rbase + ((rg_) >> 2) * HALF + wr * 64 + ((rg_) & 3) * 16 + fr) * 1024 + col0; \
            if constexpr (SRC32) { const float* sp = (const float*)src + ro; \
                _Pragma("unroll") for (int bj = 0; bj < 2; ++bj) _Pragma("unroll") for (int n = 0; n < 2; ++n) xo32[slot_][bj][n] = *(const f32x4*)(sp + bj * HALF + n * 4); } \
            else { const bf16_t* sp = (const bf16_t*)src + ro; \
                _Pragma("unroll") for (int bj = 0; bj < 2; ++bj) xo16[slot_][bj] = *(const u32x4*)(sp + bj * HALF); } } while (0)
#define EPIRES_DO(slot_, rg_) do { const int ai = (rg_) >> 2, m = (rg_) & 3, rl = ai * HALF + wr * 64 + m * 16 + fr; \
            const size_t oo = (size_t)(u.pm * BM + rl) * 1024 + col0; float sq = 0.f; \
            _Pragma("unroll") for (int bj = 0; bj < 2; ++bj) { f32x4 x0, x1; \
                if constexpr (SRC32) { x0 = xo32[slot_][bj][0]; x1 = xo32[slot_][bj][1]; } \
                else { const u32x4 w = xo16[slot_][bj]; x0 = (f32x4){lo16(w[0]), hi16(w[0]), lo16(w[1]), hi16(w[1])}; x1 = (f32x4){lo16(w[2]), hi16(w[2]), lo16(w[3]), hi16(w[3])}; } \
                const f32x4 xa = x0 + gv[bj][0] * acc[ai][bj][m][0], xb = x1 + gv[bj][1] * acc[ai][bj][m][1]; \
                st16_wt(X + oo + bj * HALF, (u32x4){cvt_pk_bf16(xa[0], xa[1]), cvt_pk_bf16(xa[2], xa[3]), cvt_pk_bf16(xb[0], xb[1]), cvt_pk_bf16(xb[2], xb[3])}); \
                sq += ((xa[0] * xa[0] + xa[1] * xa[1]) + (xa[2] * xa[2] + xa[3] * xa[3])) + ((xb[0] * xb[0] + xb[1] * xb[1]) + (xb[2] * xb[2] + xb[3] * xb[3])); \
                if (Hn) { const f32x4 ha = xa * gc[bj][0], hb = xb * gc[bj][1]; \
                    st16_wt(Hn + oo + bj * HALF, (u32x4){cvt_pk_bf16(ha[0], ha[1]), cvt_pk_bf16(ha[2], ha[3]), cvt_pk_bf16(hb[0], hb[1]), cvt_pk_bf16(hb[2], hb[3])}); } } \
            sq += __shfl_xor(sq, 16); sq += __shfl_xor(sq, 32); \
            if (fq == 0) atomicAdd(ssn + u.pm * BM + rl, (unsigned long long)(sq * SS_FIX)); } while (0)
#pragma unroll
        for (int bj = 0; bj < 2; ++bj)
#pragma unroll
            for (int n = 0; n < 2; ++n) { gv[bj][n] = *(const f32x4*)(gp + col0 + bj * HALF + n * 4); gc[bj][n] = Hn ? *(const f32x4*)(cp + col0 + bj * HALF + n * 4) : (f32x4){0.f, 0.f, 0.f, 0.f}; }
        EPIRES_LOAD(0, 0); EPIRES_LOAD(1, 1);
#pragma unroll
        for (int bj = 0; bj < 2; ++bj)
#pragma unroll
            for (int n = 0; n < 2; ++n) gv[bj][n] = gv[bj][n] * scale;
        EPIRES_DO(0, 0); EPIRES_DO(1, 1);
        EPIRES_LOAD(0, 2); EPIRES_LOAD(1, 3);
        EPIRES_DO(0, 2); EPIRES_DO(1, 3);
        EPIRES_LOAD(0, 4); EPIRES_LOAD(1, 5); EPIRES_LOAD(2, 6); EPIRES_LOAD(3, 7);
        EPIRES_DO(0, 4); EPIRES_DO(1, 5); EPIRES_DO(2, 6); EPIRES_DO(3, 7);
#undef EPIRES_LOAD
#undef EPIRES_DO
    }
};
struct EpiIN {
    static constexpr bool PERM = false, AFTER_DRAIN = false;
    bf16_t* Z; bf16_t* ZT; float* newk; float* newv; const float* rope; const unsigned long long* ss; const float* bias; int layer; float qscale;
    __device__ __forceinline__ void operator()(const f32x4 (&acc)[2][2][4][2], const Unit& u, int wr, int wc, int fr, int fq) const {
        const bool lat = u.pm >= 32;
        const int colb = u.pn * BM + wc * 32 + 4 * fq;
        const float* bp = bias + cond_of_tile(u.pm) * 2048 + colb;
        f32x4 bv[2][2];
#pragma unroll
        for (int bj = 0; bj < 2; ++bj)
#pragma unroll
            for (int n = 0; n < 2; ++n) bv[bj][n] = *(const f32x4*)(bp + bj * HALF + n * 16);
        const bool roped = lat && u.pn < 3;
        float rsl[2];
        { const unsigned long long q0 = ss[u.pm * BM + wr * 64 + 16 * fq + fr], q1 = ss[u.pm * BM + HALF + wr * 64 + 16 * fq + fr];
          rsl[0] = __builtin_amdgcn_rsqf((float)q0 * (SS_UNFIX / 1024.0f) + 1e-6f); rsl[1] = __builtin_amdgcn_rsqf((float)q1 * (SS_UNFIX / 1024.0f) + 1e-6f); }
#pragma unroll
        for (int ai = 0; ai < 2; ++ai) {
            f32x4 rc0[4], rc1[4];
#pragma unroll
            for (int m = 0; m < 4; ++m) { rc0[m] = (f32x4){1.f, 0.f, 1.f, 0.f}; rc1[m] = rc0[m];
                if (roped) { const int pos = (u.pm * BM + ai * HALF + wr * 64 + m * 16 + fr - 8192) & 2047; const int p = (wc & 1) ? (pos & 63) : (pos >> 6);
                    const f32x4* rp = (const f32x4*)(rope + (size_t)(p * 16 + 4 * fq) * 2); rc0[m] = rp[0]; rc1[m] = rp[1]; } }
#pragma unroll
            for (int m = 0; m < 4; ++m) { const int row = u.pm * BM + ai * HALF + wr * 64 + m * 16 + fr;
                const float rs = __shfl(rsl[ai], 16 * m + fr);
#pragma unroll
                for (int bj = 0; bj < 2; ++bj) { const int col = colb + bj * HALF;
                    f32x4 v0 = acc[ai][bj][m][0] * rs + bv[bj][0], v1 = acc[ai][bj][m][1] * rs + bv[bj][1];
                    if (u.pn < 5) {
                        const int cb = u.pn * BM + bj * HALF;
                        if (lat && cb < 640) {
                            const f32x4 cs0 = rc0[m], cs1 = rc1[m];
                            const float c0 = cs0[0], s0 = cs0[1], c1 = cs0[2], s1 = cs0[3], c2 = cs1[0], s2 = cs1[1], c3 = cs1[2], s3 = cs1[3];
                            const f32x4 a = v0, b = v1;
                            v0[0] = a[0] * c0 - b[0] * s0; v1[0] = b[0] * c0 + a[0] * s0;
                            v0[1] = a[1] * c1 - b[1] * s1; v1[1] = b[1] * c1 + a[1] * s1;
                            v0[2] = a[2] * c2 - b[2] * s2; v1[2] = b[2] * c2 + a[2] * s2;
                            v0[3] = a[3] * c3 - b[3] * s3; v1[3] = b[3] * c3 + a[3] * s3;
                        }
                        if (!lat && cb >= 512 && cb < 768) {
                            const int b = row >> 8, s = row & 255; float* dst = (cb < 640 ? newk : newv) + ((size_t)(b * 2 + layer) * 256 + s) * 128 + (col - cb);
                            *(f32x4*)dst = v0; *(f32x4*)(dst + 16) = v1;
                        }
                        if (cb < 512) { v0 = v0 * qscale; v1 = v1 * qscale; }
                        if (cb == 640) {
                            const int ch = 768 + col - 640;
#pragma unroll
                            for (int j = 0; j < 4; ++j) { ZT[(size_t)(ch + j) * 24576 + row] = (bf16_t)(cvt_pk_bf16(v0[j], 0.f) & 0xffffu); ZT[(size_t)(ch + 16 + j) * 24576 + row] = (bf16_t)(cvt_pk_bf16(v1[j], 0.f) & 0xffffu); }
                        } else {
                        bf16_t* zp = Z + (size_t)row * 1280 + col;
                        typedef unsigned u32x2 __attribute__((ext_vector_type(2)));
                        u32x2 w0, w1; w0.x = cvt_pk_bf16(v0[0], v0[1]); w0.y = cvt_pk_bf16(v0[2], v0[3]); w1.x = cvt_pk_bf16(v1[0], v1[1]); w1.y = cvt_pk_bf16(v1[2], v1[3]);
                        *(u32x2*)zp = w0; *(u32x2*)(zp + 16) = w1; }
                    } else {
                        const int ch = col - 1280;
#pragma unroll
                        for (int j = 0; j < 4; ++j) { ZT[(size_t)(ch + j) * 24576 + row] = (bf16_t)(cvt_pk_bf16(v0[j], 0.f) & 0xffffu); ZT[(size_t)(ch + 16 + j) * 24576 + row] = (bf16_t)(cvt_pk_bf16(v1[j], 0.f) & 0xffffu); }
                    }
                } }
        }
    }
};

template <class Epi, class Sched, bool ALIGN_EPI = false, bool SP2 = false>
__device__ __forceinline__ void gemm_phase(PG8_LAS unsigned char* lds, const Gemm g, const Sched S, const Epi E) {
    int tid_ = threadIdx.x; asm volatile("" : "+v"(tid_));
    const int tid = tid_, wid = __builtin_amdgcn_readfirstlane(tid >> 6), lane = tid & 63, wr = wid >> 2, wc = wid & 3, fr = lane & 15, fq = lane >> 4;
    const int K = g.K, nt = K / BK;
    unsigned voffA[2], voffB[2];
#pragma unroll
    for (int i = 0; i < 2; ++i) { int R, C; stage_rc(tid * 16 + i * 8192, R, C); const int Rb = Epi::PERM ? ((R & ~31) + perm32(R & 31)) : R;
        voffA[i] = (unsigned)(R * K + C) * 2u; voffB[i] = (unsigned)(Rb * K + C) * 2u; }
    const size_t kstep = (size_t)(BK * 2);
    const size_t hstep = (size_t)HALF * K * 2;
    const size_t tstep = 2 * hstep;
    const unsigned ldsw = (unsigned)wid * 1024u;
    const int aoff = lds_byte(wr * 64 + fr, fq * 8), boff = lds_byte(wc * 32 + fr, fq * 8);
#define PG8_SA(b, h) (((b) * 2 + (h)) * HTB)
#define PG8_SB(b, h) ((4 + (b) * 2 + (h)) * HTB)
#define PG8_STAGE(bufoff, gbase, voff) do { _Pragma("unroll") for (int _i = 0; _i < 2; ++_i) \
        __builtin_amdgcn_global_load_lds((const unsigned*)((const char*)(gbase) + (voff)[_i]), (PG8_LAS unsigned*)(lds + (bufoff) + ldsw + _i * 8192), 16, 0, 0); } while (0)
#define PG8_LDA(dst, b, h) do { _Pragma("unroll") for (int m = 0; m < 4; ++m) _Pragma("unroll") for (int k = 0; k < 2; ++k) dst[m][k] = *(const PG8_LAS bf16x8*)(lds + PG8_SA(b, h) + aoff + m * 2048 + k * 1024); } while (0)
#define PG8_LDB(dst, b, h) do { _Pragma("unroll") for (int n = 0; n < 2; ++n) _Pragma("unroll") for (int k = 0; k < 2; ++k) dst[n][k] = *(const PG8_LAS bf16x8*)(lds + PG8_SB(b, h) + boff + n * 2048 + k * 1024); } while (0)
#define PG8_MMA(ai, bj, At, Bt) do { __builtin_amdgcn_s_setprio(1); _Pragma("unroll") for (int m = 0; m < 4; ++m) _Pragma("unroll") for (int n = 0; n < 2; ++n) _Pragma("unroll") for (int k = 0; k < 2; ++k) \
        acc[ai][bj][m][n] = __builtin_amdgcn_mfma_f32_16x16x32_bf16(Bt[n][k], At[m][k], acc[ai][bj][m][n], 0, 0, 0); __builtin_amdgcn_s_setprio(0); } while (0)
#define PG8_WAIT_V(n) asm volatile("s_waitcnt vmcnt(" #n ")" ::: "memory")
#define PG8_WAIT_L(n) asm volatile("s_waitcnt lgkmcnt(" #n ")" ::: "memory")
#define PG8_BAR __builtin_amdgcn_s_barrier()
#define PG8_SCHED __builtin_amdgcn_sched_barrier(0)
    Unit cur, nxt; int ui = 0;
    if (!S.next(0, cur)) return;
    f32x4 acc[2][2][4][2];
#pragma unroll
    for (int a = 0; a < 2; ++a)
#pragma unroll
        for (int b = 0; b < 2; ++b)
#pragma unroll
            for (int m = 0; m < 4; ++m)
#pragma unroll
                for (int n = 0; n < 2; ++n) acc[a][b][m][n] = (f32x4){0.f, 0.f, 0.f, 0.f};
    bf16x8 At[4][2], B0[2][2], B1[2][2];
    const char* cA = (const char*)g.A + (size_t)cur.pm * tstep; const char* cB = (const char*)g.Bt + (size_t)cur.pn * tstep;
    S.a_ready(cur);
    if constexpr (SP2) {
        PG8_STAGE(PG8_SB(0, 0), cB, voffB); PG8_STAGE(PG8_SB(0, 1), cB + hstep, voffB); PG8_STAGE(PG8_SA(0, 0), cA, voffA); PG8_STAGE(PG8_SA(0, 1), cA + hstep, voffA);
        if (wr == 1) PG8_BAR;
        PG8_WAIT_V(2); PG8_BAR;
        PG8_STAGE(PG8_SB(1, 0), cB + kstep, voffB); PG8_STAGE(PG8_SA(1, 0), cA + kstep, voffA); PG8_STAGE(PG8_SB(1, 1), cB + hstep + kstep, voffB);
        PG8_WAIT_V(6); PG8_BAR;
    } else {
        PG8_STAGE(PG8_SB(0, 0), cB, voffB); PG8_STAGE(PG8_SA(0, 0), cA, voffA); PG8_STAGE(PG8_SB(0, 1), cB + hstep, voffB); PG8_STAGE(PG8_SA(0, 1), cA + hstep, voffA);
        if (wr == 1) PG8_BAR;
        PG8_WAIT_V(4); PG8_BAR;
        PG8_STAGE(PG8_SB(1, 0), cB + kstep, voffB); PG8_STAGE(PG8_SA(1, 0), cA + kstep, voffA); PG8_STAGE(PG8_SB(1, 1), cB + hstep + kstep, voffB);
        PG8_WAIT_V(6); PG8_BAR;
    }
    for (;;) {
        const bool has_next = S.next(ui + 1, nxt);
        const char* nA = has_next ? (const char*)g.A + (size_t)nxt.pm * tstep : cA; const char* nB = has_next ? (const char*)g.Bt + (size_t)nxt.pn * tstep : cB;
        for (int t = 0; t < nt; t += 2) {
            const bool last = (t == nt - 2);
            const char* a1 = cA + (size_t)(t + 1) * kstep;
            const char* a2 = last ? nA : cA + (size_t)(t + 2) * kstep; const char* b2 = last ? nB : cB + (size_t)(t + 2) * kstep;
            const char* a3 = a2 + kstep; const char* b3 = b2 + kstep;
            if (last && has_next) S.a_ready(nxt);
            if constexpr (SP2) {
            PG8_LDB(B0, 0, 0); PG8_LDB(B1, 0, 1); PG8_SCHED; PG8_LDA(At, 0, 0); PG8_STAGE(PG8_SA(1, 1), a1 + hstep, voffA);
            PG8_WAIT_V(8); PG8_WAIT_L(0); PG8_BAR; PG8_MMA(0, 0, At, B0); PG8_MMA(0, 1, At, B1); PG8_BAR; PG8_SCHED;
            PG8_LDA(At, 0, 1); PG8_STAGE(PG8_SB(0, 0), b2, voffB); PG8_STAGE(PG8_SB(0, 1), b2 + hstep, voffB); PG8_STAGE(PG8_SA(0, 0), a2, voffA);
            PG8_WAIT_V(8); PG8_WAIT_L(0); PG8_BAR; PG8_MMA(1, 0, At, B0); PG8_MMA(1, 1, At, B1); PG8_BAR; PG8_SCHED;
            PG8_LDB(B0, 1, 0); PG8_LDB(B1, 1, 1); PG8_SCHED; PG8_LDA(At, 1, 0); PG8_STAGE(PG8_SA(0, 1), a2 + hstep, voffA);
            PG8_WAIT_V(8); PG8_WAIT_L(0); PG8_BAR; PG8_MMA(0, 0, At, B0); PG8_MMA(0, 1, At, B1); PG8_BAR; PG8_SCHED;
            PG8_LDA(At, 1, 1); PG8_STAGE(PG8_SB(1, 0), b3, voffB); PG8_STAGE(PG8_SB(1, 1), b3 + hstep, voffB); PG8_STAGE(PG8_SA(1, 0), a3, voffA);
            PG8_WAIT_V(8); PG8_WAIT_L(0); PG8_BAR; PG8_MMA(1, 0, At, B0); PG8_MMA(1, 1, At, B1); PG8_BAR; PG8_SCHED;
            } else {
            PG8_LDB(B0, 0, 0); PG8_SCHED; PG8_LDA(At, 0, 0); PG8_STAGE(PG8_SA(1, 1), a1 + hstep, voffA);
            PG8_WAIT_L(8); PG8_BAR; PG8_WAIT_L(0); PG8_MMA(0, 0, At, B0); PG8_BAR; PG8_SCHED;
            PG8_LDB(B1, 0, 1); PG8_STAGE(PG8_SB(0, 0), b2, voffB);
            PG8_BAR; PG8_WAIT_L(0); PG8_MMA(0, 1, At, B1); PG8_BAR;
            PG8_LDA(At, 0, 1); PG8_STAGE(PG8_SA(0, 0), a2, voffA);
            PG8_BAR; PG8_WAIT_L(0); PG8_MMA(1, 0, At, B0); PG8_BAR; PG8_SCHED;
            PG8_STAGE(PG8_SB(0, 1), b2 + hstep, voffB);
            PG8_WAIT_V(6); PG8_BAR; PG8_MMA(1, 1, At, B1); PG8_BAR;
            PG8_LDB(B0, 1, 0); PG8_SCHED; PG8_LDA(At, 1, 0); PG8_STAGE(PG8_SA(0, 1), a2 + hstep, voffA);
            PG8_WAIT_L(8); PG8_BAR; PG8_WAIT_L(0); PG8_MMA(0, 0, At, B0); PG8_BAR; PG8_SCHED;
            PG8_LDB(B1, 1, 1); PG8_STAGE(PG8_SB(1, 0), b3, voffB);
            PG8_BAR; PG8_WAIT_L(0); PG8_MMA(0, 1, At, B1); PG8_BAR;
            PG8_LDA(At, 1, 1); PG8_STAGE(PG8_SA(1, 0), a3, voffA);
            PG8_BAR; PG8_WAIT_L(0); PG8_MMA(1, 0, At, B0); PG8_BAR; PG8_SCHED;
            PG8_STAGE(PG8_SB(1, 1), b3 + hstep, voffB);
            PG8_WAIT_V(6); PG8_BAR; PG8_MMA(1, 1, At, B1); PG8_BAR;
            }
        }
        if constexpr (ALIGN_EPI) { if (wr == 0) PG8_BAR; }
        if constexpr (!Epi::AFTER_DRAIN) { E(acc, cur, wr, wc, fr, fq); S.done(cur); }
        if (!has_next) break;
#pragma unroll
        for (int a = 0; a < 2; ++a)
#pragma unroll
            for (int b = 0; b < 2; ++b)
#pragma unroll
                for (int m = 0; m < 4; ++m)
#pragma unroll
                    for (int n = 0; n < 2; ++n) acc[a][b][m][n] = (f32x4){0.f, 0.f, 0.f, 0.f};
        cur = nxt; cA = nA; cB = nB; ++ui;
        if constexpr (ALIGN_EPI) { if (wr == 1) PG8_BAR; }
    }
    PG8_WAIT_V(0);
    if constexpr (!ALIGN_EPI) { if (wr == 0) PG8_BAR; }
    PG8_BAR;
    if constexpr (Epi::AFTER_DRAIN) { E.fused(acc, cur, wr, wc, fr, fq, lds, wid, lane); S.done(cur); }
#undef PG8_SA
#undef PG8_SB
#undef PG8_STAGE
#undef PG8_LDA
#undef PG8_LDB
#undef PG8_MMA
#undef PG8_WAIT_V
#undef PG8_WAIT_L
#undef PG8_BAR
#undef PG8_SCHED
}
}

#define GAS __attribute__((address_space(1)))
#define LAS __attribute__((address_space(3)))
typedef unsigned short bf16;
typedef unsigned v4u __attribute__((ext_vector_type(4)));
typedef unsigned v2u __attribute__((ext_vector_type(2)));
typedef float f32x4 __attribute__((ext_vector_type(4)));
typedef short bf16x8 __attribute__((ext_vector_type(8)));
typedef GAS unsigned gu32;
#define RLX_AGENT __ATOMIC_RELAXED, __HIP_MEMORY_SCOPE_AGENT
#define LDS_WAIT() asm volatile("s_waitcnt lgkmcnt(0)" ::: "memory")
#define VM_WAIT() asm volatile("s_waitcnt vmcnt(0)" ::: "memory")
__device__ __forceinline__ unsigned f2bf(float f) { unsigned u = __builtin_bit_cast(unsigned, f); return (u + 0x7fffu + ((u >> 16) & 1u)) >> 16; }
__device__ __forceinline__ unsigned pk2(float lo, float hi) { return f2bf(lo) | (f2bf(hi) << 16); }
__device__ __forceinline__ float bf2f(unsigned h) { return __builtin_bit_cast(float, h << 16); }
__device__ __forceinline__ float bflo(unsigned w) { return __builtin_bit_cast(float, w << 16); }
__device__ __forceinline__ float bfhi(unsigned w) { return __builtin_bit_cast(float, w & 0xffff0000u); }
__device__ __forceinline__ float wave_sum(float v) {
#define WS_DPP(ctrl, rmask) v += __builtin_bit_cast(float, __builtin_amdgcn_update_dpp(0, __builtin_bit_cast(int, v), ctrl, rmask, 0xf, false))
    WS_DPP(0xB1, 0xf); WS_DPP(0x4E, 0xf); WS_DPP(0x141, 0xf); WS_DPP(0x140, 0xf); WS_DPP(0x142, 0xa); WS_DPP(0x143, 0xc);
#undef WS_DPP
    return __builtin_bit_cast(float, __builtin_amdgcn_readlane(__builtin_bit_cast(int, v), 63));
}
__device__ __forceinline__ float silu_acc(float x) { return x / (1.0f + __expf(-x)); }

#define XB_TMO      128
#define XB_XCNT(j)  (256  + 64 * (j))
#define XB_XSUB(j)  (1280 + 64 * (j))
#define XB_XGEN(j)  (2304 + 64 * (j))
#define XB_TOP      3328
#define XB_TOPGEN   3392
#define XCD_BAR_WORDS 3456
#define XB_SPIN_CAP (1u << 18)
__device__ __forceinline__ unsigned xb_ld(unsigned* p)              { return __hip_atomic_load(p, __ATOMIC_RELAXED, __HIP_MEMORY_SCOPE_AGENT); }
__device__ __forceinline__ unsigned xb_add(unsigned* p, unsigned v) { return __hip_atomic_fetch_add(p, v, __ATOMIC_RELAXED, __HIP_MEMORY_SCOPE_AGENT); }
__device__ __forceinline__ unsigned xb_xcc_id() { return (unsigned)__builtin_amdgcn_s_getreg((3 << 11) | 20) & 0xFu; }
#define XB_SPIN(cond, bar) do { unsigned _sp = 0; while (cond) { __builtin_amdgcn_s_sleep(1); \
    if ((++_sp & 255u) == 0u) { if (xb_ld(&(bar)[XB_TMO])) break; if (_sp > XB_SPIN_CAP) { atomicAdd(&(bar)[XB_TMO], 1u); break; } } } } while (0)
struct XcdBarrier { unsigned* bar; unsigned x; volatile LAS unsigned* st; };
__device__ __forceinline__ XcdBarrier xcd_barrier_post(unsigned* bar, volatile LAS unsigned* st) {
    XcdBarrier b; b.bar = bar; b.x = xb_xcc_id(); b.st = st;
    if (threadIdx.x == 0) (void)xb_add(&bar[XB_XCNT(b.x)], 1u);
    return b;
}
__device__ __forceinline__ void xcd_barrier_complete(unsigned* bar, unsigned x, unsigned& nloc, unsigned& nx) {
    const unsigned G = gridDim.x * gridDim.y * gridDim.z;
    unsigned sum, cnt, mine, sp = 0u;
    for (;;) {
        sum = 0u; cnt = 0u; mine = 0u;
#pragma unroll
        for (unsigned j = 0; j < 16; ++j) { const unsigned c = xb_ld(&bar[XB_XCNT(j)]); sum += c; cnt += (c > 0u) ? 1u : 0u; mine = (j == x) ? c : mine; }
        if (sum == G) break;
        __builtin_amdgcn_s_sleep(1);
        if ((++sp & 255u) == 0u) { if (xb_ld(&bar[XB_TMO])) break; if (sp > XB_SPIN_CAP) { atomicAdd(&bar[XB_TMO], 1u); break; } }
    }
    nloc = mine > 0u ? mine : 1u; nx = cnt > 0u ? cnt : 1u;
}
__device__ __forceinline__ void xcd_barrier(const XcdBarrier& b) {
    asm volatile("s_waitcnt vmcnt(0)" ::: "memory");
    __syncthreads();
    if (threadIdx.x == 0) {
        unsigned* bar = b.bar;
        __builtin_amdgcn_s_waitcnt(0);
        unsigned nloc = b.st[0], nx = b.st[1];
        if (nloc == 0u) { xcd_barrier_complete(bar, b.x, nloc, nx); b.st[0] = nloc; b.st[1] = nx; }
        const unsigned old = xb_add(&bar[XB_XSUB(b.x)], 1u);
        const unsigned gen = old / nloc;
        if (old + 1u == (gen + 1u) * nloc) {
            __builtin_amdgcn_fence(__ATOMIC_RELEASE, "agent");
            asm volatile("s_waitcnt vmcnt(0)" ::: "memory");
            const unsigned og = xb_add(&bar[XB_TOP], 1u);
            const unsigned tg = og / nx;
            if (og + 1u == (tg + 1u) * nx) xb_add(&bar[XB_TOPGEN], 1u);
            else XB_SPIN(xb_ld(&bar[XB_TOPGEN]) == tg, bar);
            __builtin_amdgcn_fence(__ATOMIC_ACQUIRE, "agent");
            xb_add(&bar[XB_XGEN(b.x)], 1u);
            asm volatile("s_waitcnt vmcnt(0)" ::: "memory");
        } else {
            XB_SPIN(xb_ld(&bar[XB_XGEN(b.x)]) == gen, bar);
            __builtin_amdgcn_fence(__ATOMIC_ACQUIRE, "agent");
            asm volatile("s_waitcnt vmcnt(0)" ::: "memory");
        }
    }
    __syncthreads();
}

struct Args { const float* in[N_IN]; float* out; unsigned char* ws; int ph_lo, ph_hi; };

struct TrItem { const float* src; bf16* dst; int N, Kd; };
__device__ __forceinline__ TrItem tr_make(const float* W, int N, bf16* WT, int Kd, int kb, int nb, int mode) {
    const int k0 = 64 * kb, n0 = 32 * nb; const int drow0 = mode == 0 ? n0 : ((n0 >> 7) * 256 + (n0 & 127) + (mode == 2 ? 128 : 0));
    TrItem t; t.src = W + (size_t)k0 * N + n0; t.dst = WT + (size_t)drow0 * Kd + k0; t.N = N; t.Kd = Kd; return t;
}
__device__ __forceinline__ void tr_load(const TrItem& t, float (&tv)[32], int lane) {
#pragma unroll
    for (int i = 0; i < 32; ++i) tv[i] = t.src[(size_t)(2 * i + (lane >> 5)) * t.N + (lane & 31)];
}
__device__ __forceinline__ void tr_finish(const TrItem& t, const float (&tv)[32], LAS float* scr, int lane) {
#pragma unroll
    for (int i = 0; i < 32; ++i) scr[(2 * i + (lane >> 5)) * 33 + (lane & 31)] = tv[i];
    LDS_WAIT(); asm volatile("" ::: "memory");
    const int c = lane & 7;
#pragma unroll
    for (int j = 0; j < 4; ++j) { const int n = (lane >> 3) + 8 * j; const LAS float* s = scr + (8 * c) * 33 + n;
        v4u o; o.x = pk2(s[0 * 33], s[1 * 33]); o.y = pk2(s[2 * 33], s[3 * 33]); o.z = pk2(s[4 * 33], s[5 * 33]); o.w = pk2(s[6 * 33], s[7 * 33]);
        *(v4u*)(t.dst + (size_t)n * t.Kd + 8 * c) = o; }
    LDS_WAIT(); asm volatile("" ::: "memory");
}

#ifndef PROBE_TS
#define PROBE_TS -1
#endif
#ifndef PROBE_BLK
#define PROBE_BLK 0
#endif
#define P0TS_BEGIN(k) do { if constexpr ((k) == PROBE_TS) { if (blockIdx.x == PROBE_BLK && threadIdx.x == 0) *((volatile LAS unsigned long long*)(lds + MISC_OFF + 64)) = __builtin_amdgcn_s_memrealtime(); } } while (0)
#define P0TS_END(k) do { if constexpr ((k) == PROBE_TS) { if (blockIdx.x == PROBE_BLK && threadIdx.x == 0) *((volatile LAS unsigned long long*)(lds + MISC_OFF + 72)) = __builtin_amdgcn_s_memrealtime(); } } while (0)
__device__ __forceinline__ void p0_prologue(const Args& a, LAS unsigned char* lds, int gw, int NGW, int wave, int lane, const bool with_j3) {
    unsigned char* ws = a.ws;
    LAS float* scr = (LAS float*)(lds + wave * 16384);
    P0TS_BEGIN(10);
    const bool j3blk = with_j3 && (int)blockIdx.x < 144 && NGW == 2048;
    if (j3blk) {
        LAS float* sl = (LAS float*)lds;
        LAS float* red = (LAS float*)(lds + 40960);
        const int tid = threadIdx.x;
        for (int e = tid; e < 9 * 1024; e += NTHREADS) { const int cc = e >> 10, k = e & 1023; sl[e] = silu_acc(cc == 0 ? a.in[I_CCTX][k] : a.in[I_C][(cc - 1) * 1024 + k]); }
        __syncthreads();
        const int it = blockIdx.x, l = it / 72, r = it % 72, nch = r >> 1, kh = r & 1;
        const int k0 = kh * 512 + wave * 64;
        const float* wm = a.in[I_WMOD] + (size_t)l * 1024 * 9216 + (size_t)k0 * 9216 + nch * 256;
        const unsigned lo16 = (unsigned)lane * 16u;
        f32x4 acc[9];
#pragma unroll
        for (int c = 0; c < 9; ++c) acc[c] = (f32x4){0.f, 0.f, 0.f, 0.f};
#pragma unroll 1
        for (int kb = 0; kb < 4; ++kb) {
            f32x4 w[16];
#pragma unroll
            for (int k = 0; k < 16; ++k) w[k] = *(const f32x4*)((const char*)(wm + (size_t)(kb * 16 + k) * 9216) + lo16);
#pragma unroll
            for (int k = 0; k < 16; ++k) {
#pragma unroll
                for (int c = 0; c < 9; ++c) acc[c] += sl[c * 1024 + k0 + kb * 16 + k] * w[k];
                if ((k & 3) == 3) __builtin_amdgcn_sched_barrier(0);
            }
        }
#pragma unroll
        for (int c = 0; c < 9; ++c) *(LAS f32x4*)(red + (wave * 9 + c) * 256 + lane * 4) = acc[c];
        __syncthreads();
        for (int e = tid; e < 9 * 256; e += NTHREADS) { const int c = e >> 8, col = e & 255, n = nch * 256 + col; float sm = 0.f;
#pragma unroll
            for (int w8 = 0; w8 < 8; ++w8) sm += red[(w8 * 9 + c) * 256 + col];
            if (kh == 0) sm += a.in[I_BMOD][l * 9216 + n];
            atomicAdd((float*)(ws + WS_MOD) + (size_t)(l * 9 + c) * 9216 + n, sm); }
        __syncthreads();
    }
    P0TS_END(10); P0TS_BEGIN(11);
    constexpr int I_G = 16 * 88, I_D = 44 * 32, I_FF = 3 * I_G, I_IN = 16 * 64, I_OUT = 16 * 32, I_L = 2 * I_FF + I_IN + I_OUT;
    static_assert(I_G == I_D, "items");
    auto j1_item = [&](int it) __attribute__((always_inline)) -> TrItem {
        const int l = it / I_L; int r = it % I_L;
        if (r < 2 * I_FF) {
            const int f = r / I_FF; r %= I_FF; const int part = r / I_G; r %= I_G;
            const size_t lo = (size_t)l * 1024 * 2816;
            if (part == 0)      return tr_make(a.in[f ? I_W2G : I_W1G] + lo, 2816, (bf16*)(ws + WS_WGU) + (size_t)(l * 2 + f) * 5632 * 1024, 1024, r / 88, r % 88, 1);
            else if (part == 1) return tr_make(a.in[f ? I_W2U : I_W1U] + lo, 2816, (bf16*)(ws + WS_WGU) + (size_t)(l * 2 + f) * 5632 * 1024, 1024, r / 88, r % 88, 2);
            else                return tr_make(a.in[f ? I_W2D : I_W1D] + lo, 1024, (bf16*)(ws + WS_WD) + (size_t)(l * 2 + f) * 1024 * 2816, 2816, r / 32, r % 32, 0);
        }
        r -= 2 * I_FF;
        if (r < I_IN) return tr_make(a.in[I_WIN] + (size_t)l * 1024 * 2048, 2048, (bf16*)(ws + WS_WIN) + (size_t)l * 2048 * 1024, 1024, r / 64, r % 64, 0);
        r -= I_IN; const int kb = r / 32;
        if (kb >= 8 && kb < 12) return tr_make(a.in[I_WOUT] + (size_t)l * 1024 * 1024, 1024, (bf16*)(ws + WS_TMPW) + (size_t)l * 1024 * 256 - 512, 256, kb, r % 32, 0);
        return tr_make(a.in[I_WOUT] + (size_t)l * 1024 * 1024, 1024, (bf16*)(ws + WS_WOUT) + (size_t)l * 1024 * 1024, 1024, kb, r % 32, 0);
    };
    static_assert(2 * I_L == 1152 * 8 + 896 * 12, "transpose split");
    const bool split = with_j3 && NGW == 2048, lowv = gw < 1152;
    const int j_lo = split ? (lowv ? 0 : 9216) : 0, j_hi = split ? (lowv ? 9216 : 2 * I_L) : 2 * I_L, j_gw = split ? (lowv ? gw : gw - 1152) : gw, j_st = split ? (lowv ? 1152 : 896) : NGW;
    if (j_lo + j_gw < j_hi) {
        TrItem cur = j1_item(j_lo + j_gw); float tv[32]; tr_load(cur, tv, lane);
        for (int it = j_lo + j_gw; it < j_hi; it += j_st) {
            const bool more = it + j_st < j_hi;
            TrItem nxt = cur; float tn[32];
            if (more) { nxt = j1_item(it + j_st); tr_load(nxt, tn, lane); }
            tr_finish(cur, tv, scr, lane);
            if (more) { cur = nxt;
#pragma unroll
                for (int i = 0; i < 32; ++i) tv[i] = tn[i]; }
        }
    }
    P0TS_END(11); P0TS_BEGIN(12);
    P0TS_END(12); P0TS_BEGIN(13);
    {
        const int gt = gw * 64 + lane, NGT = NGW * 64;
        for (int e = gt; e < 2 * 8 * 256 * 128; e += NGT) {
            const int gd = e & 127, p = (e >> 7) & 255, b = (e >> 15) & 7, l = e >> 18;
            const size_t src = (((size_t)b * 2 + l) * 256 + p) * 128 + gd;
            const float kv = a.in[I_CK][src], vv = a.in[I_CV][src];
            ((bf16*)(ws + WS_CKB))[e] = (bf16)f2bf(kv);
            ((bf16*)(ws + WS_CVT))[(((size_t)l * 8 + b) * 128 + gd) * 256 + p] = (bf16)f2bf(vv);
        }
        for (int e = gt; e < 1024; e += NGT) { const int p = e >> 4, i = e & 15; const float inv = powf(10000.0f, -(float)i / 16.0f); const float ang = (float)p * inv;
            ((float*)(ws + WS_ROPE))[2 * e] = cosf(ang); ((float*)(ws + WS_ROPE))[2 * e + 1] = sinf(ang); }
    }
    P0TS_END(13); P0TS_BEGIN(14);
    for (int it = gw; it < 2 * 2304; it += NGW) {
        const int l = it / 2304, tt = it % 2304; const int L = tt < 2048 ? 2048 : 256, t = tt < 2048 ? tt : tt - 2048;
        const float tf = (float)t, tn = tf / (float)(L - 1);
        const float* w1 = a.in[I_HW1] + l * 33 * 64; const float* w2 = a.in[I_HW2] + l * 64 * 64;
        float s1 = tn * w1[lane];
        const float rev = tf * (1e-4f + (float)(lane & 15) * ((15.0f - 1e-4f) / 15.0f)) / (float)L; const float fr_ = rev - floorf(rev);
        const int cvi = __float_as_int(__builtin_amdgcn_cosf(fr_)), svi = __float_as_int(__builtin_amdgcn_sinf(fr_));
#pragma unroll
        for (int i = 0; i < 16; ++i) s1 += __int_as_float(__builtin_amdgcn_readlane(cvi, i)) * w1[(1 + i) * 64 + lane] - __int_as_float(__builtin_amdgcn_readlane(svi, i)) * w1[(17 + i) * 64 + lane];
        const float h1 = sinf(a.in[I_HF1][l * 64 + lane] * (s1 + a.in[I_HB1][l * 64 + lane]));
        const int h1i = __float_as_int(h1);
        float s2 = 0.f;
#pragma unroll 16
        for (int k = 0; k < 64; ++k) s2 += __int_as_float(__builtin_amdgcn_readlane(h1i, k)) * w2[k * 64 + lane];
        const float h2 = sinf(a.in[I_HF2][l * 64 + lane] * (s2 + a.in[I_HB2][l * 64 + lane]));
        ((float*)(ws + WS_HYH))[(size_t)it * 64 + lane] = h2;
    }
    P0TS_END(14);
}

__device__ __forceinline__ void fold_phase(const Args& a, int gw, int NGW, int lane) {
    unsigned char* ws = a.ws; const int i = lane & 15, q = lane >> 4;
    for (int it = gw; it < 2 * 64 * 4; it += NGW) {
        const int l = it >> 8, nt = (it >> 2) & 63, kq = it & 3;
        const bf16* ap = (const bf16*)(ws + WS_TMPW) + ((size_t)l * 1024 + nt * 16 + i) * 256 + 8 * q;
        const float* bp = a.in[I_CPW] + (size_t)l * 65536 + (size_t)(kq * 64 + i) * 256 + 8 * q;
        f32x4 acc[4];
#pragma unroll
        for (int ct = 0; ct < 4; ++ct) acc[ct] = (f32x4){0.f, 0.f, 0.f, 0.f};
#pragma unroll
        for (int ks = 0; ks < 8; ++ks) {
            const bf16x8 af = *(const bf16x8*)(ap + 32 * ks);
#pragma unroll
            for (int ct = 0; ct < 4; ++ct) { const f32x4 b0 = *(const f32x4*)(bp + (size_t)ct * 16 * 256 + 32 * ks), b1 = *(const f32x4*)(bp + (size_t)ct * 16 * 256 + 32 * ks + 4);
                v4u bw; bw.x = pk2(b0[0], b0[1]); bw.y = pk2(b0[2], b0[3]); bw.z = pk2(b1[0], b1[1]); bw.w = pk2(b1[2], b1[3]);
                acc[ct] = __builtin_amdgcn_mfma_f32_16x16x32_bf16(af, __builtin_bit_cast(bf16x8, bw), acc[ct], 0, 0, 0); }
        }
        bf16* dst = (bf16*)(ws + WS_WOUT) + (size_t)l * 1048576 + (size_t)(nt * 16 + 4 * q) * 1024 + 512 + kq * 64 + i;
#pragma unroll
        for (int ct = 0; ct < 4; ++ct)
#pragma unroll
            for (int j = 0; j < 4; ++j) dst[(size_t)j * 1024 + ct * 16] = (bf16)f2bf(acc[ct][j]);
    }
}
__device__ __forceinline__ void prep_phase(const float* src0, const float* src1, const float* g, const float* mod, int sc_chunk, bf16* H, unsigned long long* ss, int r_lo, int r_hi, int gw, int NGW, int lane) {
    const int per = (r_hi - r_lo + NGW - 1) / NGW; int r = r_lo + gw * per; r_hi = (r + per < r_hi) ? r + per : r_hi; NGW = 1;
    if (r >= r_hi) return;
    f32x4 v[4], v1[4], v2[4];
#define PREP_LOAD(dst, row) do { const int rr_ = (row); if (rr_ < r_hi) { const float* xr_ = rr_ < MCTX ? src0 + (size_t)rr_ * D : src1 + (size_t)(rr_ - MCTX) * D; \
        _Pragma("unroll") for (int j = 0; j < 4; ++j) dst[j] = ((const f32x4*)xr_)[lane + 64 * j]; } } while (0)
    PREP_LOAD(v, r); PREP_LOAD(v1, r + NGW);
    for (; r < r_hi; r += NGW) {
        PREP_LOAD(v2, r + 2 * NGW);
        const int cond = r < MCTX ? 0 : 1 + ((r - MCTX) >> 11);
        const float* sc = mod + cond * 9216 + sc_chunk * 1024;
        float s = 0.f;
#pragma unroll
        for (int j = 0; j < 4; ++j) s += (v[j][0] * v[j][0] + v[j][1] * v[j][1]) + (v[j][2] * v[j][2] + v[j][3] * v[j][3]);
        s = wave_sum(s); if (lane == 0) ss[r] = (unsigned long long)(s * SS_FIX);
#pragma unroll
        for (int j = 0; j < 4; ++j) { const int col = 4 * (lane + 64 * j);
            const f32x4 o = v[j] * *(const f32x4*)(g + col) * (*(const f32x4*)(sc + col) + 1.0f);
            v2u w; w.x = pk2(o[0], o[1]); w.y = pk2(o[2], o[3]); *(v2u*)(H + (size_t)r * D + col) = w; }
#pragma unroll
        for (int j = 0; j < 4; ++j) { v[j] = v1[j]; v1[j] = v2[j]; }
    }
#undef PREP_LOAD
}
__device__ __forceinline__ void bias_phase(const Args& a, int it_lo, int it_hi, int gw, int NGW, int lane) {
    unsigned char* ws = a.ws;
    const int i = lane & 15, q = lane >> 4;
    for (int it = it_lo + gw; it < it_hi; it += NGW) {
        const int l = it / 832; int r = it % 832; int which, n0;
        if (r < 352) { which = 0; n0 = r * 16; } else if (r < 480) { which = 1; n0 = (r - 352) * 16; } else { which = 2; n0 = (r - 480) * 16; }
        const bf16* Wt = which == 1 ? (const bf16*)(ws + WS_WIN) + (size_t)l * 2048 * 1024 : (const bf16*)(ws + WS_WGU) + (size_t)(l * 2 + (which == 2 ? 1 : 0)) * 5632 * 1024;
        const int shc = which == 0 ? 0 : (which == 1 ? 3 : 6), off = which == 0 ? 0 : (which == 1 ? 50688 : 69120), bst = which == 1 ? 2048 : 5632;
        const float* shp = (const float*)(ws + WS_MOD) + (size_t)l * 9 * 9216 + (size_t)(i < 9 ? i : 0) * 9216 + shc * 1024 + 8 * q;
        const bf16* wp = Wt + (size_t)(n0 + i) * 1024 + 8 * q;
        f32x4 acc = {0.f, 0.f, 0.f, 0.f};
#pragma unroll 8
        for (int st = 0; st < 32; ++st) {
            const f32x4 s0 = *(const f32x4*)(shp + 32 * st), s1 = *(const f32x4*)(shp + 32 * st + 4);
            const v4u wv = *(const v4u*)(wp + 32 * st);
            v4u av; av.x = pk2(s0[0], s0[1]); av.y = pk2(s0[2], s0[3]); av.z = pk2(s1[0], s1[1]); av.w = pk2(s1[2], s1[3]);
            if (i >= 9) av = (v4u){0u, 0u, 0u, 0u};
            acc = __builtin_amdgcn_mfma_f32_16x16x32_bf16(__builtin_bit_cast(bf16x8, av), __builtin_bit_cast(bf16x8, wv), acc, 0, 0, 0);
        }
        float* bo = (float*)(ws + WS_BIAS) + (size_t)l * 119808 + off + n0 + i;
#pragma unroll
        for (int rg = 0; rg < 4; ++rg) { const int cond = 4 * q + rg; if (cond < 9) bo[(size_t)cond * bst] = acc[rg]; }
    }
}
__device__ __forceinline__ void gct_phase(const Args& a, int gw, int NGW, int lane) {
    const int gt = gw * 64 + lane, NGT = NGW * 64;
    for (int e = gt; e < 6 * 9 * 1024; e += NGT) {
        const int inst = e / 9216, r = e % 9216, cond = r >> 10, col = r & 1023;
        float v = 0.f;
        if (inst >= 1) { const int l = inst / 3, k = inst % 3;
            const float g = (k == 0 ? a.in[I_GF1] : (k == 1 ? a.in[I_GMIX] : a.in[I_GF2]))[l * 1024 + col];
            const float sc = ((const float*)(a.ws + WS_MOD))[(size_t)l * 9 * 9216 + cond * 9216 + (k == 0 ? 1 : (k == 1 ? 4 : 7)) * 1024 + col];
            v = g * (1.0f + sc); }
        ((float*)(a.ws + WS_GCT))[e] = v;
    }
}
__device__ __forceinline__ void final_norm_phase(float* X, const float* g, const float* ss, int gw, int NGW, int lane) {
    for (int r = gw; r < M; r += NGW) {
        float* xr = X + (size_t)r * D;
        const float rstd = 1.0f / sqrtf(ss[r] * (1.0f / D) + EPS);
#pragma unroll
        for (int j = 0; j < 4; ++j) { const int col = 4 * (lane + 64 * j); ((f32x4*)xr)[lane + 64 * j] = (((const f32x4*)xr)[lane + 64 * j] * rstd) * *(const f32x4*)(g + col); }
    }
}

__device__ __forceinline__ void hyena_filter_phase(const Args& a, LAS unsigned char* lds, int gw, int NGW, int wave, int lane) {
    unsigned char* ws = a.ws;
    LAS float* hs = (LAS float*)(lds + wave * 16384);
    for (int it = gw; it < 2 * 36 * 16; it += NGW) {
        const int l = it / 576, r = it % 576, tc = r >> 4, ng = r & 15;
        const int stream = tc < 32 ? 0 : 1; const int L = stream ? 256 : 2048; const int t0 = (stream ? tc - 32 : tc) * 64; const int soff = stream ? 4096 : 0;
        const int n = ng * 64 + lane, o = n >> 9, dir = (n >> 8) & 1, c = n & 255;
        const float* hrow = (const float*)(ws + WS_HYH) + ((size_t)l * 2304 + (stream ? 2048 : 0) + t0) * 64;
        f32x4 hv[16];
#pragma unroll
        for (int i = 0; i < 16; ++i) hv[i] = ((const f32x4*)hrow)[i * 64 + lane];
        const float* w3 = a.in[I_HW3] + (size_t)l * 64 * 1024 + n;
        float w[64];
#pragma unroll
        for (int k = 0; k < 64; ++k) w[k] = w3[k * 1024];
        const float ndecay = -__expf(a.in[I_HLD][l * 1024 + n]) / (float)(L - 1);
#pragma unroll
        for (int i = 0; i < 16; ++i) *(LAS f32x4*)(hs + (i * 64 + lane) * 4) = hv[i];
        LDS_WAIT(); asm volatile("" ::: "memory");
        bf16* dst = (bf16*)(ws + WS_HYRAW) + ((size_t)(l * 2 + o) * 256 + c) * 4608 + soff;
        float sq = 0.f;
        for (int tt = 0; tt < 64; ++tt) {
            const int t = t0 + tt; float dot = 0.f;
#pragma unroll
            for (int k4 = 0; k4 < 16; ++k4) { const f32x4 h = *(const LAS f32x4*)(hs + tt * 64 + k4 * 4); dot += (h[0] * w[4 * k4] + h[1] * w[4 * k4 + 1]) + (h[2] * w[4 * k4 + 2] + h[3] * w[4 * k4 + 3]); }
            const float val = dot * __expf((float)t * ndecay);
            sq += val * val;
            if (dir == 0) dst[L - 1 - t] = (bf16)f2bf(val);
            else if (t > 0) dst[L - 1 + t] = (bf16)f2bf(val);
            else dst[2 * L - 1] = 0;
        }
        atomicAdd((unsigned long long*)(ws + WS_SUMSQ) + ((l * 2 + stream) * 2 + o) * 256 + c, (unsigned long long)(sq * FSQ_FIX));
        LDS_WAIT(); asm volatile("" ::: "memory");
    }
}

__device__ __forceinline__ void conv_phase(const Args& a, int l, const bf16* Z, bf16* CAT, LAS unsigned char* lds, int tid) {
    LAS float* ybuf = (LAS float*)lds;
    LAS float* cbuf = (LAS float*)(lds + 65536);
    const float* dw = a.in[I_CDW] + l * 31 * 256; const float* dwb = a.in[I_CDWB] + l * 256; const float* lng = a.in[I_CLNG] + l * 256; const float* lnb = a.in[I_CLNB] + l * 256;
    const int lane = tid & 63, wave = tid >> 6;
    for (int u = blockIdx.x; u < M / 32; u += gridDim.x) {
        const int r0 = u * 32;
        const int seq0 = r0 < MCTX ? (r0 & ~255) : MCTX + ((r0 - MCTX) & ~2047); const int seq1 = seq0 + (r0 < MCTX ? 256 : 2048);
        for (int e = tid; e < 62 * 32; e += NTHREADS) {
            const int rr = e >> 5, ch = e & 31; const int row = r0 - 15 + rr;
            float y[8];
            if (row >= seq0 && row < seq1) {
                const v4u av = *(const v4u*)(Z + (size_t)row * ZW + 768 + ch * 8), gv = *(const v4u*)(Z + (size_t)row * ZW + 1024 + ch * 8);
                const float af[8] = {bflo(av.x), bfhi(av.x), bflo(av.y), bfhi(av.y), bflo(av.z), bfhi(av.z), bflo(av.w), bfhi(av.w)};
                const float gf[8] = {bflo(gv.x), bfhi(gv.x), bflo(gv.y), bfhi(gv.y), bflo(gv.z), bfhi(gv.z), bflo(gv.w), bfhi(gv.w)};
#pragma unroll
                for (int j = 0; j < 8; ++j) y[j] = af[j] / (1.0f + __expf(-gf[j]));
            } else {
#pragma unroll
                for (int j = 0; j < 8; ++j) y[j] = 0.f;
            }
            *(LAS f32x4*)(ybuf + rr * 256 + ch * 8) = (f32x4){y[0], y[1], y[2], y[3]}; *(LAS f32x4*)(ybuf + rr * 256 + ch * 8 + 4) = (f32x4){y[4], y[5], y[6], y[7]};
        }
        __syncthreads();
        { const int c = tid & 255, half = tid >> 8;
          float w[31];
#pragma unroll
          for (int k = 0; k < 31; ++k) w[k] = dw[k * 256 + c];
          const float bias = dwb[c];
          float yv[46];
#pragma unroll
          for (int i = 0; i < 46; ++i) yv[i] = ybuf[(half * 16 + i) * 256 + c];
#pragma unroll
          for (int t = 0; t < 16; ++t) { float s = bias;
#pragma unroll
              for (int k = 0; k < 31; ++k) s += w[k] * yv[t + k];
              cbuf[(half * 16 + t) * 256 + c] = s; } }
        __syncthreads();
        for (int rr = wave * 4; rr < wave * 4 + 4; ++rr) {
            const f32x4 x = *(const LAS f32x4*)(cbuf + rr * 256 + lane * 4);
            const float mu = wave_sum((x[0] + x[1]) + (x[2] + x[3])) * (1.0f / 256.0f);
            const f32x4 dx = x - mu;
            const float var = wave_sum((dx[0] * dx[0] + dx[1] * dx[1]) + (dx[2] * dx[2] + dx[3] * dx[3])) * (1.0f / 256.0f);
            const float rstd = 1.0f / sqrtf(var + EPS);
            const f32x4 yv = dx * rstd * *(const f32x4*)(lng + lane * 4) + *(const f32x4*)(lnb + lane * 4);
            v2u wv; wv.x = pk2(silu_acc(yv[0]), silu_acc(yv[1])); wv.y = pk2(silu_acc(yv[2]), silu_acc(yv[3]));
            *(v2u*)(CAT + (size_t)(r0 + rr) * 1024 + 512 + lane * 4) = wv;
        }
        __syncthreads();
    }
}


typedef unsigned long long u64;
typedef u64 u64x2 __attribute__((ext_vector_type(2)));
template <int L> struct HyGeo {
    static constexpr int R = L / 128, NSTEP = L / 32, CS = 4 * L + 64, US = 2 * L + 32, OFF_U = 8 * CS;
    static constexpr int USP = 2 * L + 176, PRE = 32;
};
template <int L>
__device__ __forceinline__ void hy_build_copies(LAS unsigned char* lds, const bf16* raw, int tid) {
    constexpr int CS = HyGeo<L>::CS;
    for (int p = tid; p < L / 4; p += NTHREADS) {
        const v4u a = *(const v4u*)(raw + 8 * p), b = *(const v4u*)(raw + 8 * p + 8);
        const unsigned w[8] = {a.x, a.y, a.z, a.w, b.x, b.y, b.z, b.w};
#pragma unroll
        for (int sg = 0; sg < 8; ++sg) { v4u o;
            if ((sg & 1) == 0) { o.x = w[sg / 2]; o.y = w[sg / 2 + 1]; o.z = w[sg / 2 + 2]; o.w = w[sg / 2 + 3]; }
            else { const int h = sg / 2; o.x = (w[h] >> 16) | (w[h + 1] << 16); o.y = (w[h + 1] >> 16) | (w[h + 2] << 16); o.z = (w[h + 2] >> 16) | (w[h + 3] << 16); o.w = (w[h + 3] >> 16) | (w[h + 4] << 16); }
            *(LAS v4u*)(lds + sg * CS + 16 * p) = o; }
    }
}
template <int L, int NB>
__device__ __forceinline__ void hy_toeplitz(LAS unsigned char* lds, int boff, f32x4 (&acc)[HyGeo<L>::R][NB > 8 ? 2 : 1], int wave, int lane) {
    constexpr int R = HyGeo<L>::R, NT = NB > 8 ? 2 : 1, NSTEP = HyGeo<L>::NSTEP, CS = HyGeo<L>::CS, US = HyGeo<L>::US;
    const int i = lane & 15, q = lane >> 4;
    const int abase = (7 - (i & 7)) * CS + 16 * ((L / 8 - 1) - (i >> 3) + q - 2 * R * wave);
    int bb[NT];
#pragma unroll
    for (int nt = 0; nt < NT; ++nt) bb[nt] = boff + ((NB > 8 ? nt * 16 + i : (i & 7))) * US + 16 * q;
    bf16x8 F[R];
#pragma unroll
    for (int e = 0; e < R; ++e) F[e] = *(const LAS bf16x8*)(lds + abase - 32 * e);
#pragma unroll
    for (int r = 0; r < R; ++r)
#pragma unroll
        for (int nt = 0; nt < NT; ++nt) acc[r][nt] = (f32x4){0.f, 0.f, 0.f, 0.f};
    bf16x8 B[2][NT];
#pragma unroll
    for (int nt = 0; nt < NT; ++nt) B[0][nt] = *(const LAS bf16x8*)(lds + bb[nt]);
#pragma unroll 1
    for (int jo = 0; jo < NSTEP; jo += 8) {
#pragma unroll
        for (int ji = 0; ji < 8; ++ji) {
            const int j = jo + ji; constexpr int dummy = 0; (void)dummy;
#pragma unroll
            for (int r = R - 2; r < R; ++r) { const int slot = (((r - 2 * ji) % R) + R) % R;
#pragma unroll
                for (int nt = 0; nt < NT; ++nt) acc[r][nt] = __builtin_amdgcn_mfma_f32_16x16x32_bf16(F[slot], B[ji & 1][nt], acc[r][nt], 0, 0, 0); }
            __builtin_amdgcn_sched_barrier(0);
            if (j + 1 < NSTEP) {
#pragma unroll
                for (int nt = 0; nt < NT; ++nt) B[(ji + 1) & 1][nt] = *(const LAS bf16x8*)(lds + bb[nt] + 64 * (j + 1));
#pragma unroll
                for (int rr = 0; rr < 2; ++rr) { const int slot = (((rr - 2 * (ji + 1)) % R) + R) % R; F[slot] = *(const LAS bf16x8*)(lds + abase + 64 * (j + 1) - 32 * rr); }
            }
            __builtin_amdgcn_sched_barrier(0);
#pragma unroll
            for (int r = 0; r < R - 2; ++r) { const int slot = (((r - 2 * ji) % R) + R) % R;
#pragma unroll
                for (int nt = 0; nt < NT; ++nt) acc[r][nt] = __builtin_amdgcn_mfma_f32_16x16x32_bf16(F[slot], B[ji & 1][nt], acc[r][nt], 0, 0, 0); }
            __builtin_amdgcn_sched_barrier(0);
        }
    }
}
template <int L>
__device__ __forceinline__ void hy_toeplitz_pk(LAS unsigned char* lds, int boff, f32x4 (&acc)[HyGeo<L>::R / 2], int wave, int lane) {
    constexpr int R = HyGeo<L>::R, RP = R / 2, NSTEP = HyGeo<L>::NSTEP, CS = HyGeo<L>::CS, USP = HyGeo<L>::USP;
    static_assert(RP == 8, "slot arithmetic assumes 8 tile pairs per wave and an 8-step unroll");
    const int i = lane & 15, q = lane >> 4;
    const int abase = (7 - (i & 7)) * CS + 16 * ((L / 8 - 1) - (i >> 3) + q - 2 * R * wave);
    const int bb = boff + (i & 7) * USP + 16 * q + (i < 8 ? HyGeo<L>::PRE : 0);
    bf16x8 F[RP];
#pragma unroll
    for (int rp = 0; rp < RP; ++rp) F[rp] = *(const LAS bf16x8*)(lds + abase - 32 * (2 * rp + 1));
#pragma unroll
    for (int rp = 0; rp < RP; ++rp) acc[rp] = (f32x4){0.f, 0.f, 0.f, 0.f};
    bf16x8 B[2];
    B[0] = *(const LAS bf16x8*)(lds + bb);
#pragma unroll 1
    for (int jo = 0; jo < NSTEP; jo += 8) {
#pragma unroll
        for (int ji = 0; ji < 8; ++ji) {
            const int j = jo + ji;
            { const int slot = (((RP - 1 - ji) % RP) + RP) % RP; acc[RP - 1] = __builtin_amdgcn_mfma_f32_16x16x32_bf16(F[slot], B[ji & 1], acc[RP - 1], 0, 0, 0); }
            __builtin_amdgcn_sched_barrier(0);
            B[(ji + 1) & 1] = *(const LAS bf16x8*)(lds + bb + 64 * (j + 1));
            { const int slot = (((0 - (ji + 1)) % RP) + RP) % RP; F[slot] = *(const LAS bf16x8*)(lds + abase + 64 * (j + 1) - 32); }
            __builtin_amdgcn_sched_barrier(0);
#pragma unroll
            for (int rp = 0; rp < RP - 1; ++rp) { const int slot = (((rp - ji) % RP) + RP) % RP; acc[rp] = __builtin_amdgcn_mfma_f32_16x16x32_bf16(F[slot], B[ji & 1], acc[rp], 0, 0, 0); }
            __builtin_amdgcn_sched_barrier(0);
        }
    }
#pragma unroll
    for (int rp = 0; rp < RP; ++rp) acc[rp] = __builtin_amdgcn_mfma_f32_16x16x32_bf16(F[rp], B[0], acc[rp], 0, 0, 0);
}
struct XRaw { v2u z; unsigned zl, zr; };
__device__ __forceinline__ XRaw xraw_load(const bf16* zrow, int t, int L) { XRaw x; x.z = *(const v2u*)zrow; x.zl = t > 0 ? (unsigned)zrow[-1] : 0u; x.zr = t + 4 < L ? (unsigned)zrow[4] : 0u; return x; }
__device__ __forceinline__ void sconv4x(const XRaw& x, float w0, float w1, float w2, float sb, float (&out)[4]) {
    const float zl = bf2f(x.zl), zr = bf2f(x.zr), z0 = bflo(x.z.x), z1 = bfhi(x.z.x), z2 = bflo(x.z.y), z3 = bfhi(x.z.y);
    out[0] = sb + w0 * zl + w1 * z0 + w2 * z1; out[1] = sb + w0 * z0 + w1 * z1 + w2 * z2; out[2] = sb + w0 * z1 + w1 * z2 + w2 * z3; out[3] = sb + w0 * z2 + w1 * z3 + w2 * zr;
}
__device__ __forceinline__ void sconv4(const bf16* zrow, int t, int L, float w0, float w1, float w2, float sb, float (&out)[4]) { const XRaw x = xraw_load(zrow, t, L); sconv4x(x, w0, w1, w2, sb, out); }
template <int L>
__device__ __forceinline__ void hy_store_copies(LAS unsigned char* lds, const v4u a, const v4u b, int p) {
    constexpr int CS = HyGeo<L>::CS;
    const unsigned w[8] = {a.x, a.y, a.z, a.w, b.x, b.y, b.z, b.w};
#pragma unroll
    for (int sg = 0; sg < 8; ++sg) { v4u o;
        if ((sg & 1) == 0) { o.x = w[sg / 2]; o.y = w[sg / 2 + 1]; o.z = w[sg / 2 + 2]; o.w = w[sg / 2 + 3]; }
        else { const int h = sg / 2; o.x = (w[h] >> 16) | (w[h + 1] << 16); o.y = (w[h + 1] >> 16) | (w[h + 2] << 16); o.z = (w[h + 2] >> 16) | (w[h + 3] << 16); o.w = (w[h + 3] >> 16) | (w[h + 4] << 16); }
        *(LAS v4u*)(lds + sg * CS + 16 * p) = o; }
}
template <int L, int NB, bool DUP = false>
__device__ __forceinline__ void hyena_channel(const Args& a, int l, int c, const bf16* ZT, bf16* CAT, LAS unsigned char* lds, int tid, int wave, int lane) {
    constexpr bool PK = (NB == 8);
    constexpr int R = HyGeo<L>::R, RA = PK ? R / 2 : R, NT = NB > 8 ? 2 : 1, US = PK ? HyGeo<L>::USP : HyGeo<L>::US, PRE = PK ? HyGeo<L>::PRE : 0, OFF_U = HyGeo<L>::OFF_U, OFF_Y = OFF_U + NB * US;
    constexpr bool LAT = (L == 2048); constexpr int stream = LAT ? 0 : 1; constexpr int rowbase = LAT ? MCTX : 0;
    static_assert(L / 4 <= NTHREADS, "one copy slot per thread");
    static_assert(OFF_Y + NB * US <= LDSCTL_OFF && !DUP, "LDS");
    unsigned char* ws = a.ws;
    const float* sw = a.in[I_HSW] + l * 3 * 768; const float* sb = a.in[I_HSB] + l * 768;
    const bf16* raw0 = (const bf16*)(ws + WS_HYRAW) + ((size_t)(l * 2 + 0) * 256 + c) * 4608 + (LAT ? 0 : 4096);
    const bf16* raw1 = (const bf16*)(ws + WS_HYRAW) + ((size_t)(l * 2 + 1) * 256 + c) * 4608 + (LAT ? 0 : 4096);
    const int i = lane & 15;
    const bool cp = tid < L / 4;
    v4u f0a = {0u, 0u, 0u, 0u}, f0b = f0a, f1a = f0a, f1b = f0a;
    if (cp) { f0a = *(const v4u*)(raw0 + 8 * tid); f0b = *(const v4u*)(raw0 + 8 * tid + 8); f1a = *(const v4u*)(raw1 + 8 * tid); f1b = *(const v4u*)(raw1 + 8 * tid + 8); }
    __syncthreads();
    if (cp) hy_store_copies<L>(lds, f0a, f0b, tid);
    if constexpr (PK) {
        const v4u z = {0u, 0u, 0u, 0u};
        if (tid < 32) *(LAS v4u*)(lds + (tid >> 2) * HyGeo<L>::CS + 4 * L + 16 * (tid & 3)) = z;
        else if (tid < 128) { const int e = tid - 32, row = e / 6, k = e % 6;
            *(LAS v4u*)(lds + OFF_U + row * US + (k < 2 ? 16 * k : PRE + 2 * L + 16 * (k - 2))) = z; }
    }
    { const float w0 = sw[c], w1 = sw[768 + c], w2 = sw[1536 + c], b0 = sb[c];
      for (int idx = tid; idx < NB * (L / 8); idx += NTHREADS) {
          const int b = idx / (L / 8), s0 = (idx % (L / 8)) * 8; const bf16* zrow = ZT + (size_t)c * M + rowbase + b * L + s0;
          float o0[4], o1[4]; sconv4(zrow, s0, L, w0, w1, w2, b0, o0); sconv4(zrow + 4, s0 + 4, L, w0, w1, w2, b0, o1);
          v4u w; w.x = pk2(o0[0], o0[1]); w.y = pk2(o0[2], o0[3]); w.z = pk2(o1[0], o1[1]); w.w = pk2(o1[2], o1[3]);
          *(LAS v4u*)(lds + OFF_U + b * US + PRE + 2 * s0) = w; } }
    __syncthreads();
    f32x4 acc[RA][NT];
#define HY_T(r_, q_) (PK ? 16 * (R * wave + 2 * (r_) + (i < 8 ? 1 : 0)) + 4 * (q_) : 16 * (R * wave + (r_)) + 4 * (q_))
    if constexpr (PK) { f32x4 (&ap)[RA] = *reinterpret_cast<f32x4 (*)[RA]>(&acc[0][0]); hy_toeplitz_pk<L>(lds, OFF_U, ap, wave, lane); }
    else hy_toeplitz<L, NB>(lds, OFF_U, acc, wave, lane);
    { const float scale = 1.0f / sqrtf((float)((const unsigned long long*)(ws + WS_SUMSQ))[((l * 2 + stream) * 2 + 0) * 256 + c] * FSQ_UNFIX + EPS), bias = a.in[I_HBIAS][(l * 2 + 0) * 256 + c];
      const float w0 = sw[256 + c], w1 = sw[768 + 256 + c], w2 = sw[1536 + 256 + c], b0 = sb[256 + c];
      int q = lane >> 4; asm volatile("" : "+v"(q));
#pragma unroll
      for (int nt = 0; nt < NT; ++nt) { const int b = PK ? (i & 7) : nt * 16 + i;
          if (b < NB) {
#pragma unroll
              for (int r = 0; r < RA; ++r) { const int t = HY_T(r, q);
                  float x1[4]; sconv4(ZT + (size_t)(256 + c) * M + rowbase + b * L + t, t, L, w0, w1, w2, b0, x1);
                  const v2u uv = *(const LAS v2u*)(lds + OFF_U + b * US + PRE + 2 * t);
                  const float y0 = x1[0] * (scale * acc[r][nt][0] + bias * bflo(uv.x)), y1 = x1[1] * (scale * acc[r][nt][1] + bias * bfhi(uv.x));
                  const float y2 = x1[2] * (scale * acc[r][nt][2] + bias * bflo(uv.y)), y3 = x1[3] * (scale * acc[r][nt][3] + bias * bfhi(uv.y));
                  v2u w; w.x = pk2(y0, y1); w.y = pk2(y2, y3); *(LAS v2u*)(lds + OFF_Y + b * US + PRE + 2 * t) = w; } } } }
    __syncthreads();
    if (cp) hy_store_copies<L>(lds, f1a, f1b, tid);
    __syncthreads();
    if constexpr (PK) { f32x4 (&ap)[RA] = *reinterpret_cast<f32x4 (*)[RA]>(&acc[0][0]); hy_toeplitz_pk<L>(lds, OFF_Y, ap, wave, lane); }
    else hy_toeplitz<L, NB>(lds, OFF_Y, acc, wave, lane);
    { const float scale = 1.0f / sqrtf((float)((const unsigned long long*)(ws + WS_SUMSQ))[((l * 2 + stream) * 2 + 1) * 256 + c] * FSQ_UNFIX + EPS), bias = a.in[I_HBIAS][(l * 2 + 1) * 256 + c];
      const float w0 = sw[512 + c], w1 = sw[768 + 512 + c], w2 = sw[1536 + 512 + c], b0 = sb[512 + c];
      int q = lane >> 4; asm volatile("" : "+v"(q));
#pragma unroll
      for (int nt = 0; nt < NT; ++nt) { const int b = PK ? (i & 7) : nt * 16 + i;
          if (b < NB) {
#pragma unroll
              for (int r = 0; r < RA; ++r) { const int t = HY_T(r, q);
                  float x2[4]; sconv4(ZT + (size_t)(512 + c) * M + rowbase + b * L + t, t, L, w0, w1, w2, b0, x2);
                  const v2u yv = *(const LAS v2u*)(lds + OFF_Y + b * US + PRE + 2 * t);
                  bf16* dst = CAT + (size_t)(rowbase + b * L + t) * 1024 + 768 + c;
                  dst[0]    = (bf16)f2bf(x2[0] * (scale * acc[r][nt][0] + bias * bflo(yv.x)));
                  dst[1024] = (bf16)f2bf(x2[1] * (scale * acc[r][nt][1] + bias * bfhi(yv.x)));
                  dst[2048] = (bf16)f2bf(x2[2] * (scale * acc[r][nt][2] + bias * bflo(yv.y)));
                  dst[3072] = (bf16)f2bf(x2[3] * (scale * acc[r][nt][3] + bias * bfhi(yv.y))); } } } }
#undef HY_T
    __syncthreads();
}

typedef float f32x16 __attribute__((ext_vector_type(16)));
constexpr int ATT_KP = 144, ATT_VP = 80, ATT_KB = 32 * ATT_KP, ATT_BUF = ATT_KB + 64 * ATT_VP;
__device__ __forceinline__ void attn_phase(const Args& a, int l, const bf16* Z, const bf16* ZT, bf16* CAT, LAS unsigned char* lds, int tid, int wave, int lane) {
    const bf16* CKB = (const bf16*)(a.ws + WS_CKB) + (size_t)l * 8 * 256 * 128; const bf16* CVT = (const bf16*)(a.ws + WS_CVT) + (size_t)l * 8 * 128 * 256;
    const int r = lane & 31, hh = lane >> 5;
    for (int it = blockIdx.x; it < 768; it += gridDim.x) {
        bool lat; int b, g, qb;
        if (it < 512) { lat = true; b = it >> 6; g = (it >> 5) & 1; qb = it & 31; }
        else { const int rr = it - 512; lat = false; b = rr >> 3; g = (rr >> 2) & 1; qb = rr & 3; }
        const int h = g * 4 + (wave & 3), q0 = qb * 64 + 32 * (wave >> 2);
        const int L = lat ? 2048 : 256, seq0 = lat ? MCTX + b * 2048 : b * 256;
        const int kt_lo = lat ? (qb * 64 - 128 < 0 ? 0 : qb * 64 - 128) : 0, kt_hi = lat ? (qb * 64 + 192 > L ? L : qb * 64 + 192) : 256;
        const int n_local = (kt_hi - kt_lo) >> 5, n_total = n_local + (lat ? 8 : 0);
        const bool isk = tid < 256; const int t2 = tid & 255;
        const bf16* src_loc = isk ? Z + (size_t)(seq0 + kt_lo + (t2 >> 3)) * ZW + 512 + g * 64 + (t2 & 7) * 8 : ZT + (size_t)(768 + g * 64 + (t2 >> 2)) * M + seq0 + kt_lo + (t2 & 3) * 8;
        const bf16* src_ctx = isk ? CKB + ((size_t)b * 256 + (t2 >> 3)) * 128 + g * 64 + (t2 & 7) * 8 : CVT + ((size_t)b * 128 + g * 64 + (t2 >> 2)) * 256 + (t2 & 3) * 8;
        const size_t step_loc = isk ? (size_t)32 * ZW : 32, step_ctx = isk ? (size_t)32 * 128 : 32;
        const int dst = isk ? (t2 >> 3) * ATT_KP + (t2 & 7) * 16 : ATT_KB + (t2 >> 2) * ATT_VP + ((t2 & 3) >> 1) * 32 + ((t2 & 3) & 1) * 8;
#define ATT_GLOAD(ti_) (*(const v4u*)((ti_) < n_local ? src_loc + (size_t)(ti_) * step_loc : src_ctx + (size_t)((ti_) - n_local) * step_ctx))
#define ATT_LSTORE(buf_, v_) do { LAS unsigned char* p_ = lds + (buf_) * ATT_BUF + dst; if (isk) *(LAS v4u*)p_ = (v_); else { v2u lo_, hi_; lo_.x = (v_).x; lo_.y = (v_).y; hi_.x = (v_).z; hi_.y = (v_).w; *(LAS v2u*)p_ = lo_; *(LAS v2u*)(p_ + 16) = hi_; } } while (0)
        bf16x8 qf[4];
        { const bf16* qp = Z + (size_t)(seq0 + q0 + r) * ZW + h * 64 + 8 * hh;
#pragma unroll
          for (int s = 0; s < 4; ++s) qf[s] = *(const bf16x8*)(qp + 16 * s); }
        f32x16 o0, o1;
#pragma unroll
        for (int e = 0; e < 16; ++e) { o0[e] = 0.f; o1[e] = 0.f; }
        float mrun = a.in[I_SINK][l * 8 + h] * LOG2E, lsum = 1.0f;
        __syncthreads();
        v4u g1 = {0u, 0u, 0u, 0u}, g2 = g1;
        { const v4u g0 = ATT_GLOAD(0); if (n_total > 1) g1 = ATT_GLOAD(1); if (n_total > 2) g2 = ATT_GLOAD(2); ATT_LSTORE(0, g0); }
        __syncthreads();
        for (int ti = 0; ti < n_total; ++ti) {
            v4u gn = {0u, 0u, 0u, 0u};
            if (ti + 3 < n_total) gn = ATT_GLOAD(ti + 3);
            const int kt = kt_lo + 32 * ti;
            const bool active = !lat || ti >= n_local || (kt >= q0 - 128 && kt <= q0 + 128);
            if (active) {
                const LAS unsigned char* kb = lds + (ti & 1) * ATT_BUF + r * ATT_KP + 16 * hh;
                const LAS unsigned char* vb = lds + (ti & 1) * ATT_BUF + ATT_KB + r * ATT_VP + 16 * hh;
                f32x16 st;
#pragma unroll
                for (int e = 0; e < 16; ++e) st[e] = 0.f;
#pragma unroll
                for (int s = 0; s < 4; ++s) st = __builtin_amdgcn_mfma_f32_32x32x16_bf16(*(const LAS bf16x8*)(kb + 32 * s), qf[s], st, 0, 0, 0);
                const bf16x8 v00 = *(const LAS bf16x8*)(vb), v01 = *(const LAS bf16x8*)(vb + 32), v10 = *(const LAS bf16x8*)(vb + 32 * ATT_VP), v11 = *(const LAS bf16x8*)(vb + 32 * ATT_VP + 32);
                if (lat && ti < n_local) {
                    if (kt == q0 - 128) {
#pragma unroll
                        for (int e = 0; e < 16; ++e) { const int jj = (e & 3) + 8 * (e >> 2) + 4 * hh; if (jj < r) st[e] = -1e30f; }
                    } else if (kt == q0 + 128) {
#pragma unroll
                        for (int e = 0; e < 16; ++e) { const int jj = (e & 3) + 8 * (e >> 2) + 4 * hh; if (jj > r) st[e] = -1e30f; }
                    }
                }
                float mx = fmaxf(fmaxf(st[0], st[1]), fmaxf(st[2], st[3]));
#pragma unroll
                for (int e = 4; e < 16; e += 4) mx = fmaxf(mx, fmaxf(fmaxf(st[e], st[e + 1]), fmaxf(st[e + 2], st[e + 3])));
                mx = fmaxf(mx, __shfl_xor(mx, 32));
                const float mn = fmaxf(mrun, mx); const bool grew = __any(mn > mrun);
                const float alpha = grew ? __builtin_amdgcn_exp2f(mrun - mn) : 1.0f; mrun = mn;
                float ps = 0.f;
#pragma unroll
                for (int e = 0; e < 16; ++e) { st[e] = __builtin_amdgcn_exp2f(st[e] - mn); ps += st[e]; }
                ps += __shfl_xor(ps, 32);
                lsum = lsum * alpha + ps;
                if (grew) {
#pragma unroll
                    for (int e = 0; e < 16; ++e) { o0[e] *= alpha; o1[e] *= alpha; } }
                v4u pa, pb;
                pa.x = pk2(st[0], st[1]); pa.y = pk2(st[2], st[3]); pa.z = pk2(st[4], st[5]); pa.w = pk2(st[6], st[7]);
                pb.x = pk2(st[8], st[9]); pb.y = pk2(st[10], st[11]); pb.z = pk2(st[12], st[13]); pb.w = pk2(st[14], st[15]);
                const bf16x8 p0 = __builtin_bit_cast(bf16x8, pa), p1 = __builtin_bit_cast(bf16x8, pb);
                o0 = __builtin_amdgcn_mfma_f32_32x32x16_bf16(v00, p0, o0, 0, 0, 0);
                o0 = __builtin_amdgcn_mfma_f32_32x32x16_bf16(v01, p1, o0, 0, 0, 0);
                o1 = __builtin_amdgcn_mfma_f32_32x32x16_bf16(v10, p0, o1, 0, 0, 0);
                o1 = __builtin_amdgcn_mfma_f32_32x32x16_bf16(v11, p1, o1, 0, 0, 0);
            }
            if (ti + 1 < n_total) ATT_LSTORE((ti + 1) & 1, g1);
            g1 = g2; g2 = gn;
            __syncthreads();
        }
#undef ATT_GLOAD
#undef ATT_LSTORE
        const float inv = 1.0f / lsum;
        bf16* op = CAT + (size_t)(seq0 + q0 + r) * 1024 + h * 64 + 4 * hh;
#pragma unroll
        for (int g4 = 0; g4 < 4; ++g4) {
            v2u w; w.x = pk2(o0[4 * g4] * inv, o0[4 * g4 + 1] * inv); w.y = pk2(o0[4 * g4 + 2] * inv, o0[4 * g4 + 3] * inv); *(v2u*)(op + 8 * g4) = w;
            v2u x; x.x = pk2(o1[4 * g4] * inv, o1[4 * g4 + 1] * inv); x.y = pk2(o1[4 * g4 + 2] * inv, o1[4 * g4 + 3] * inv); *(v2u*)(op + 32 + 8 * g4) = x; }
    }
}

#ifndef PROBE_PH
#define PROBE_PH -1
#endif
#ifndef PROBE_TS
#define PROBE_TS -1
#endif
#ifndef PROBE_BLK
#define PROBE_BLK 0
#endif
#define TS_BEGIN(k) do { if constexpr ((k) == PROBE_TS) { if (blockIdx.x == PROBE_BLK && threadIdx.x == 0) *((volatile LAS unsigned long long*)(c.lds + MISC_OFF + 64)) = __builtin_amdgcn_s_memrealtime(); } } while (0)
#define TS_END(k) do { if constexpr ((k) == PROBE_TS) { if (blockIdx.x == PROBE_BLK && threadIdx.x == 0) *((volatile LAS unsigned long long*)(c.lds + MISC_OFF + 72)) = __builtin_amdgcn_s_memrealtime(); } } while (0)
struct Ctx { LAS unsigned char* lds; int tid, lane, wave, G, gw, NGW; };
constexpr int CW_SPLIT = 8192;

__device__ __forceinline__ void sb_arrive(unsigned* ctl, int id) {
    asm volatile("s_waitcnt vmcnt(0)" ::: "memory");
    __syncthreads();
    if (threadIdx.x == 0) __hip_atomic_fetch_add(ctl + CW_SPLIT + 64 * id, 1u, __ATOMIC_RELAXED, __HIP_MEMORY_SCOPE_AGENT);
}
__device__ __forceinline__ void sb_wait(unsigned* ctl, int id, unsigned G) {
    if (threadIdx.x == 0) {
        unsigned sp = 0;
        while (__hip_atomic_load(ctl + CW_SPLIT + 64 * id, __ATOMIC_RELAXED, __HIP_MEMORY_SCOPE_AGENT) < G) {
            __builtin_amdgcn_s_sleep(2);
            if (++sp > (1u << 22)) { atomicAdd(ctl + CW_BAR + XB_TMO, 1u); break; }
        }
        __builtin_amdgcn_fence(__ATOMIC_ACQUIRE, "agent");
        asm volatile("s_waitcnt vmcnt(0)" ::: "memory");
    }
    __syncthreads();
}
struct HalfOrder {
    pg8::StaticOrder S; int pm0;
    __device__ __forceinline__ void init(int N, int G, int c, int pm0_, int off) { const int rot = (G == 256) ? off : 0; S.init(48 * 256, N, G, (c + G - rot) % G); pm0 = pm0_; }
    __device__ __forceinline__ bool next(int i, pg8::Unit& u) const { if (!S.next(i, u)) return false; u.pm += pm0; return true; }
    __device__ __forceinline__ void a_ready(const pg8::Unit&) const {}
    __device__ __forceinline__ void done(const pg8::Unit&) const {}
};

template <int L, int f, int h> __device__ __forceinline__ void stage_G(const Args& a, const Ctx& c, int off) {
    unsigned char* ws = a.ws;
    pg8::Gemm g{(const bf16*)a.out, (const bf16*)(ws + WS_WGU) + (size_t)(L * 2 + f) * 5632 * 1024, M, 5632, 1024};
    HalfOrder S; S.init(5632, c.G, (int)blockIdx.x, 48 * h, off);
    pg8::EpiGU E{(bf16*)(ws + WS_BIG), (const unsigned long long*)(ws + WS_SS) + (size_t)(3 * L + 2 * f) * M, (const float*)(ws + WS_BIAS) + (size_t)L * 119808 + (f ? 69120 : 0)};
    pg8::gemm_phase<pg8::EpiGU, HalfOrder, true, true>(c.lds, g, S, E);
}
template <int L, int f, int h> __device__ __forceinline__ void stage_D(const Args& a, const Ctx& c, int off) {
    unsigned char* ws = a.ws; bf16* X = (bf16*)(ws + WS_X); unsigned long long* SS = (unsigned long long*)(ws + WS_SS);
    const float* modl = (const float*)(ws + WS_MOD) + (size_t)L * 9 * 9216;
    pg8::Gemm g{(const bf16*)(ws + WS_BIG), (const bf16*)(ws + WS_WD) + (size_t)(L * 2 + f) * 1024 * 2816, M, 1024, 2816};
    HalfOrder S; S.init(1024, c.G, (int)blockIdx.x, 48 * h, off);
    constexpr bool first = (L == 0) && f == 0;
    bf16* Hn = (f == 1 && L == 1) ? (bf16*)nullptr : (bf16*)a.out;
    const float* gct = (const float*)(ws + WS_GCT) + (size_t)(f == 0 ? 3 * L + 1 : (L == 0 ? 3 : 0)) * 9216;
    typedef pg8::EpiResT<first> Epi;
    Epi E{first ? (const void*)a.in[I_XP] : (const void*)X, first ? (const void*)a.in[I_XS] : (const void*)(X + (size_t)MCTX * D), X, modl + (f ? 8 : 2) * 1024, Hn, gct, SS + (size_t)(3 * L + 1 + 2 * f) * M, 0.5f};
    pg8::gemm_phase<Epi, HalfOrder, true, true>(c.lds, g, S, E);
}
template <int L, int h> __device__ __forceinline__ void stage_IN(const Args& a, const Ctx& c, int off) {
    unsigned char* ws = a.ws; float* newk = a.out + (size_t)M * D; float* newv = newk + 32 * 2 * 256 * 128;
    pg8::Gemm g{(const bf16*)a.out, (const bf16*)(ws + WS_WIN) + (size_t)L * 2048 * 1024, M, 2048, 1024};
    HalfOrder S; S.init(2048, c.G, (int)blockIdx.x, 48 * h, off);
    pg8::EpiIN E{(bf16*)(ws + WS_Z), (bf16*)(ws + WS_ZT), newk, newv, (const float*)(ws + WS_ROPE), (const unsigned long long*)(ws + WS_SS) + (size_t)(3 * L + 1) * M, (const float*)(ws + WS_BIAS) + (size_t)L * 119808 + 50688, L, QSCALE};
    pg8::gemm_phase<pg8::EpiIN, HalfOrder, true, true>(c.lds, g, S, E);
}
template <int L, int h> __device__ __forceinline__ void stage_OUT(const Args& a, const Ctx& c, int off) {
    unsigned char* ws = a.ws; bf16* X = (bf16*)(ws + WS_X); const float* modl = (const float*)(ws + WS_MOD) + (size_t)L * 9 * 9216;
    pg8::Gemm g{(const bf16*)a.out + (size_t)M * D, (const bf16*)(ws + WS_WOUT) + (size_t)L * 1024 * 1024, M, 1024, 1024};
    HalfOrder S; S.init(1024, c.G, (int)blockIdx.x, 48 * h, off);
    typedef pg8::EpiResT<false> Epi;
    Epi E{X, X + (size_t)MCTX * D, X, modl + 5 * 1024, (bf16*)a.out, (const float*)(ws + WS_GCT) + (size_t)(3 * L + 2) * 9216, (unsigned long long*)(ws + WS_SS) + (size_t)(3 * L + 2) * M, 1.0f};
    pg8::gemm_phase<Epi, HalfOrder, true, true>(c.lds, g, S, E);
}
template <int L> __device__ __forceinline__ void mix_stage(const Args& a, const Ctx& c) {
    unsigned char* ws = a.ws; const bf16* Z = (const bf16*)(ws + WS_Z); const bf16* ZT = (const bf16*)(ws + WS_ZT); bf16* CAT = (bf16*)a.out + (size_t)M * D;
    int tid_ = c.tid; asm volatile("" : "+v"(tid_));
    const int G = c.G, tid = tid_, lane = tid_ & 63; LAS unsigned char* lds = c.lds;
#define HY_CH(w) ((((w) & 7) << 5) | (((w) >> 3) & 31))
    if constexpr (L == 0) TS_BEGIN(301);
    for (int w = blockIdx.x; w < 256; w += G) hyena_channel<2048, 8>(a, L, HY_CH(w), ZT, CAT, lds, tid, c.wave, lane);
    if constexpr (L == 0) { TS_END(301); TS_BEGIN(302); }
    for (int w = blockIdx.x; w < 256; w += G) hyena_channel<256, 32>(a, L, HY_CH(w), ZT, CAT, lds, tid, c.wave, lane);
#undef HY_CH
    if constexpr (L == 0) { TS_END(302); TS_BEGIN(303); }
    attn_phase(a, L, Z, ZT, CAT, lds, tid, c.wave, lane);
    __syncthreads();
    if constexpr (L == 0) { TS_END(303); TS_BEGIN(304); }
    conv_phase(a, L, Z, CAT, lds, tid);
    if constexpr (L == 0) TS_END(304);
}
__device__ __forceinline__ void final_half(const Args& a, const Ctx& c, int h) {
    const bf16* X = (const bf16*)(a.ws + WS_X); float* Y = a.out; const unsigned long long* ss = (const unsigned long long*)(a.ws + WS_SS) + (size_t)6 * M; const float* g = a.in[I_GFIN];
    for (int r = h * 12288 + c.gw; r < (h + 1) * 12288; r += c.NGW) {
        const float rstd = 1.0f / sqrtf((float)ss[r] * (SS_UNFIX / D) + EPS);
#pragma unroll
        for (int j = 0; j < 2; ++j) { const int col = 8 * (c.lane + 64 * j); const v4u w = *(const v4u*)(X + (size_t)r * D + col);
            const f32x4 x0 = {bflo(w.x), bfhi(w.x), bflo(w.y), bfhi(w.y)}, x1 = {bflo(w.z), bfhi(w.z), bflo(w.w), bfhi(w.w)};
            *(f32x4*)(Y + (size_t)r * D + col) = (x0 * rstd) * *(const f32x4*)(g + col); *(f32x4*)(Y + (size_t)r * D + col + 4) = (x1 * rstd) * *(const f32x4*)(g + col + 4); }
    }
}

__global__ void __launch_bounds__(NTHREADS, 2) mega_fwd(Args a) {
    extern __shared__ __attribute__((aligned(16))) unsigned char lds_raw[];
    Ctx c;
    c.lds = (LAS unsigned char*)lds_raw;
    c.tid = threadIdx.x; c.lane = c.tid & 63; c.wave = __builtin_amdgcn_readfirstlane(c.tid >> 6);
    c.G = gridDim.x; c.gw = blockIdx.x * NWAVES + c.wave; c.NGW = c.G * NWAVES;
    unsigned* ctl = (unsigned*)(a.ws + WS_CTL);
    for (int u = c.tid; u < (LDS_BYTES - LDSCTL_OFF) / 4; u += NTHREADS) ((LAS unsigned*)(c.lds + LDSCTL_OFF))[u] = 0u;
    __syncthreads();
    XcdBarrier bar = xcd_barrier_post(ctl + CW_BAR, (volatile LAS unsigned*)(c.lds + MISC_OFF) + 8);
    cg::grid_group grid = cg::this_grid();
    const unsigned G = (unsigned)c.G;
    TS_BEGIN(0);
    p0_prologue(a, c.lds, c.gw, c.NGW, c.wave, c.lane, true);
    if (a.ph_hi > 100000) grid.sync(); else xcd_barrier(bar);
    TS_END(0); TS_BEGIN(1);
    prep_phase(a.in[I_XP], a.in[I_XS], a.in[I_GF1], (const float*)(a.ws + WS_MOD), 1, (bf16*)a.out, (unsigned long long*)(a.ws + WS_SS), 0, M, c.gw, c.NGW, c.lane);
    bias_phase(a, 0, 2 * 832, c.gw, c.NGW, c.lane);
    gct_phase(a, c.gw, c.NGW, c.lane);
    fold_phase(a, c.NGW - 1 - c.gw, c.NGW, c.lane);
    xcd_barrier(bar);
    TS_END(1); TS_BEGIN(2);
    { stage_G<0, 0, 0>(a, c, 0); sb_arrive(ctl, 0); }
    { stage_G<0, 0, 1>(a, c, 32); sb_arrive(ctl, 1); }
    { sb_wait(ctl, 0, G); stage_D<0, 0, 0>(a, c, 64); sb_arrive(ctl, 2); }
    { sb_wait(ctl, 1, G); stage_D<0, 0, 1>(a, c, 0); sb_arrive(ctl, 3); }
    { const int b = (int)blockIdx.x;
      if (b < 64 || b >= 192) hyena_filter_phase(a, c.lds, (b < 64 ? b : b - 128) * NWAVES + c.wave, 128 * NWAVES, c.wave, c.lane); }
    sb_wait(ctl, 2, G); sb_wait(ctl, 3, G);
    stage_IN<0, 0>(a, c, 0);
    stage_IN<0, 1>(a, c, 128);
    xcd_barrier(bar);
    TS_END(2); TS_BEGIN(3);
    mix_stage<0>(a, c);
    xcd_barrier(bar);
    TS_END(3); TS_BEGIN(4);
    { stage_OUT<0, 0>(a, c, 128); sb_arrive(ctl, 4); }
    { stage_OUT<0, 1>(a, c, 64); sb_arrive(ctl, 5); }
    { sb_wait(ctl, 4, G); stage_G<0, 1, 0>(a, c, 0); sb_arrive(ctl, 6); }
    { sb_wait(ctl, 5, G); stage_G<0, 1, 1>(a, c, 32); sb_arrive(ctl, 7); }
    { sb_wait(ctl, 6, G); stage_D<0, 1, 0>(a, c, 0); sb_arrive(ctl, 8); }
    { sb_wait(ctl, 7, G); stage_D<0, 1, 1>(a, c, 192); sb_arrive(ctl, 9); }
    { sb_wait(ctl, 8, G); stage_G<1, 0, 0>(a, c, 64); sb_arrive(ctl, 10); }
    { sb_wait(ctl, 9, G); stage_G<1, 0, 1>(a, c, 96); sb_arrive(ctl, 11); }
    { sb_wait(ctl, 10, G); stage_D<1, 0, 0>(a, c, 128); sb_arrive(ctl, 12); }
    { sb_wait(ctl, 11, G); stage_D<1, 0, 1>(a, c, 64); sb_arrive(ctl, 13); }
    sb_wait(ctl, 12, G); sb_wait(ctl, 13, G);
    stage_IN<1, 0>(a, c, 0);
    stage_IN<1, 1>(a, c, 128);
    xcd_barrier(bar);
    TS_END(4); TS_BEGIN(5);
    mix_stage<1>(a, c);
    xcd_barrier(bar);
    TS_END(5); TS_BEGIN(6);
    { stage_OUT<1, 0>(a, c, 128); sb_arrive(ctl, 14); }
    { stage_OUT<1, 1>(a, c, 64); sb_arrive(ctl, 15); }
    { sb_wait(ctl, 14, G); stage_G<1, 1, 0>(a, c, 128); sb_arrive(ctl, 16); }
    { sb_wait(ctl, 15, G); stage_G<1, 1, 1>(a, c, 160); sb_arrive(ctl, 17); }
    { sb_wait(ctl, 16, G); stage_D<1, 1, 0>(a, c, 0); sb_arrive(ctl, 18); }
    { sb_wait(ctl, 17, G); stage_D<1, 1, 1>(a, c, 192); sb_arrive(ctl, 19); }
    { sb_wait(ctl, 18, G); final_half(a, c, 0); }
    { sb_wait(ctl, 19, G); final_half(a, c, 1); }
    TS_END(6);
    if constexpr (PROBE_TS >= 0) { if (blockIdx.x == PROBE_BLK && threadIdx.x == 0) { const unsigned long long t0 = *((volatile LAS unsigned long long*)(c.lds + MISC_OFF + 64)), t1 = *((volatile LAS unsigned long long*)(c.lds + MISC_OFF + 72)); const unsigned long long now = __builtin_amdgcn_s_memrealtime(); while (__builtin_amdgcn_s_memrealtime() - now < 9ull * (t1 - t0)) __builtin_amdgcn_s_sleep(8); } __syncthreads(); }
}

extern "C" void kernel_launch(void* const* d_in, const int* in_sizes, int n_in, void* d_out, int out_size, void* d_ws, size_t ws_size, hipStream_t stream) {
    static int grid = 0;
    if (grid == 0) {
        if (n_in != N_IN || ws_size < WS_END || out_size != M * D + 2 * 32 * 2 * 256 * 128) { fprintf(stderr, "kernel_launch: unexpected shapes (n_in %d, ws %zu, out %d)\n", n_in, ws_size, out_size); grid = -1; return; }
        int dev = 0, cus = 0, per_cu = 0;
        if (hipGetDevice(&dev) != hipSuccess || hipDeviceGetAttribute(&cus, hipDeviceAttributeMultiprocessorCount, dev) != hipSuccess) { grid = -1; return; }
        if (hipFuncSetAttribute((const void*)mega_fwd, hipFuncAttributeMaxDynamicSharedMemorySize, LDS_BYTES) != hipSuccess) { fprintf(stderr, "kernel_launch: hipFuncSetAttribute failed\n"); grid = -1; return; }
        if (hipOccupancyMaxActiveBlocksPerMultiprocessor(&per_cu, (const void*)mega_fwd, NTHREADS, LDS_BYTES) != hipSuccess || per_cu < 1) { fprintf(stderr, "kernel_launch: occupancy query says %d\n", per_cu); per_cu = 1; }
        (void)hipGetLastError();
        if (cus < 256) { fprintf(stderr, "kernel_launch: built for a 256-CU device (got %d)\n", cus); grid = -1; return; }
        grid = 256;
    }
    if (grid < 0) return;
    (void)hipMemsetAsync((char*)d_ws + WS_CTL, 0, CTL_ZERO_BYTES, stream);
    Args a{};
    for (int i = 0; i < N_IN; ++i) a.in[i] = (const float*)d_in[i];
    a.out = (float*)d_out; a.ws = (unsigned char*)d_ws; a.ph_lo = 0; a.ph_hi = 1;
    void* args[] = {&a};
    hipError_t e = hipLaunchCooperativeKernel((const void*)mega_fwd, dim3(grid), dim3(NTHREADS), args, LDS_BYTES, stream);
    if (e != hipSuccess) fprintf(stderr, "cooperative launch failed: %s (grid %d)\n", hipGetErrorString(e), grid);
}
```

```cpp
#include <hip/hip_runtime.h>
#include <hip/hip_cooperative_groups.h>
#include <cstdio>
#include <cstdint>
namespace cg = cooperative_groups;

constexpr int D = 1024, DFF = 2816, INW = 2048;
constexpr int MCTX = 8192, MLAT = 16384, M = MCTX + MLAT;
constexpr int LCTX = 256, LLAT = 2048;
constexpr int NCOND = 9, MODW = 9 * 1024;
constexpr int ZW = 1280;
constexpr int HYC = 768;
constexpr float EPS = 1e-6f;
constexpr float SS_FIX = 16777216.0f, SS_UNFIX = 1.0f / 16777216.0f;
constexpr float FSQ_FIX = 68719476736.0f, FSQ_UNFIX = 1.0f / 68719476736.0f;
constexpr float LOG2E = 1.4426950408889634f;
constexpr float QSCALE = 0.125f * LOG2E;

enum { I_XP = 0, I_XS, I_C, I_CK, I_CV, I_CCTX, I_WMOD, I_BMOD, I_GF1, I_GMIX, I_GF2, I_GFIN, I_W1G, I_W1U, I_W1D, I_W2G, I_W2U, I_W2D, I_WIN, I_WOUT, I_SINK,
       I_CDW, I_CDWB, I_CLNG, I_CLNB, I_CPW, I_HSW, I_HSB, I_HW1, I_HB1, I_HF1, I_HW2, I_HB2, I_HF2, I_HW3, I_HLD, I_HBIAS, N_IN };

constexpr size_t MiB = 1u << 20;
constexpr size_t WS_CTL = 0, CTL_ZERO_BYTES = 3 * MiB;
constexpr size_t WS_SUMSQ = 64 * 1024;
constexpr size_t WS_MOD = 128 * 1024;
constexpr size_t WS_SS = 1 * MiB;
constexpr size_t WS_ROPE = 3 * MiB;
constexpr size_t WS_BIAS = 3 * MiB + 64 * 1024;
constexpr size_t WS_WGU = 4 * MiB;
constexpr size_t WS_WD = 48 * MiB;
constexpr size_t WS_WIN = 70 * MiB;
constexpr size_t WS_WOUT = 78 * MiB;
constexpr size_t WS_CKB = 82 * MiB;
constexpr size_t WS_CVT = 83 * MiB;
constexpr size_t WS_HYH = 84 * MiB;
constexpr size_t WS_HYRAW = 86 * MiB;
constexpr size_t WS_X = 96 * MiB;
constexpr size_t WS_BIG = 144 * MiB;
constexpr size_t WS_Z = WS_BIG;
constexpr size_t WS_ZT = 204 * MiB;
constexpr size_t WS_GCT = 276 * MiB;
constexpr size_t WS_TMPW = 277 * MiB;
constexpr size_t WS_END = 278 * MiB;
static_assert(WS_MOD + 2 * 9 * 9216 * 4 <= WS_SS && WS_SS + 7 * (size_t)M * 8 <= CTL_ZERO_BYTES && CTL_ZERO_BYTES <= WS_ROPE && WS_BIAS + 2 * 9 * 13312 * 4 <= WS_WGU, "ctl");
static_assert(WS_BIG + (size_t)M * DFF * 2 <= WS_GCT && WS_Z + (size_t)M * ZW * 2 <= WS_ZT && WS_ZT + (size_t)896 * M * 2 <= WS_GCT, "ws map");
constexpr int CW_BAR = 4096;

constexpr int RING_BYTES = 131072;
constexpr int LDSCTL_OFF = 135168, MISC_OFF = LDSCTL_OFF + 320;
constexpr int LDS_BYTES = 137216;
constexpr int NWAVES = 8, NTHREADS = 512;

namespace pg8 {
#define PG8_LAS __attribute__((address_space(3)))
typedef unsigned short bf16_t;
typedef short bf16x8 __attribute__((ext_vector_type(8)));
typedef float f32x4 __attribute__((ext_vector_type(4)));
typedef unsigned u32x4 __attribute__((ext_vector_type(4)));
constexpr int BM = 256, BK = 64, HALF = 128, HTB = HALF * BK * 2  , STAGE_BYTES = 8 * HTB, NXCD = 8, WGM = 8;

__host__ __device__ __forceinline__ int lds_byte(int r, int c) { const int st = (r >> 4) * 2 + (c >> 5), rr = r & 15, cc = c & 31, ob = rr * 64 + cc * 2; return st * 1024 + (ob ^ (((ob >> 9) & 1) << 5)); }
__host__ __device__ __forceinline__ void stage_rc(int b, int& R, int& C) { const int st = b / 1024, sb = b % 1024, swz = sb ^ (((sb >> 9) & 1) << 5); R = (st >> 1) * 16 + swz / 64; C = (st & 1) * 32 + (swz % 64) / 2; }
__host__ __device__ __forceinline__ int perm32(int rho) { const int n = rho >> 4, i = rho & 15; return 8 * (i >> 2) + 4 * n + (i & 3); }

struct Unit { int pm, pn; };
struct Gemm { const bf16_t* A; const bf16_t* Bt; int M, N, K; };

struct StaticOrder {
    int nM, nN, nwg, G, c;
    __host__ __device__ void init(int M, int N, int G_, int c_) { nM = M / BM; nN = N / BM; nwg = nM * nN; G = G_; c = c_; }
    __host__ __device__ bool next(int i, Unit& u) const {
        const long L = (long)i * G + c; if (L >= nwg) return false;
        int wgid = (int)L; { const int q = nwg / NXCD, r = nwg % NXCD, xcd = wgid % NXCD, off = wgid / NXCD; wgid = (xcd < r ? xcd * (q + 1) : r * (q + 1) + (xcd - r) * q) + off; }
        const int nig = WGM * nN, gid = wgid / nig, fm = gid * WGM, gsz = (nM - fm) < WGM ? (nM - fm) : WGM;
        u.pm = fm + ((wgid % nig) % gsz); u.pn = (wgid % nig) / gsz; return true;
    }
    __device__ __forceinline__ void a_ready(const Unit&) const {}
    __device__ __forceinline__ void done(const Unit&) const {}
};


__device__ __forceinline__ unsigned cvt_pk_bf16(float lo, float hi) { unsigned r; asm volatile("v_cvt_pk_bf16_f32 %0, %1, %2" : "=v"(r) : "v"(lo), "v"(hi)); return r; }
__device__ __forceinline__ float silu_f(float x) { return x * __builtin_amdgcn_rcpf(1.0f + __builtin_amdgcn_exp2f(-1.4426950408889634f * x)); }
__device__ __forceinline__ int cond_of_tile(int pm) { return pm < 32 ? 0 : 1 + ((pm - 32) >> 3); }

__device__ __forceinline__ void st16_wt(void* p, u32x4 v) { asm volatile("global_store_dwordx4 %0, %1, off sc1\n\ts_nop 1" :: "v"(p), "v"(v) : "memory"); }
__device__ __forceinline__ void st16_wt(void* p, f32x4 v) { asm volatile("global_store_dwordx4 %0, %1, off sc1\n\ts_nop 1" :: "v"(p), "v"(v) : "memory"); }
__device__ __forceinline__ void st8_wt(void* p, unsigned lo, unsigned hi) { __hip_atomic_store((unsigned long long*)p, ((unsigned long long)hi << 32) | lo, __ATOMIC_RELAXED, __HIP_MEMORY_SCOPE_AGENT); }
struct EpiGU {
    static constexpr bool PERM = true, AFTER_DRAIN = false;
    bf16_t* O;
    const unsigned long long* ss; const float* bias;
    __device__ __forceinline__ void operator()(const f32x4 (&acc)[2][2][4][2], const Unit& u, int wr, int wc, int fr, int fq) const {
        const int row0 = u.pm * BM + wr * 64 + fr, col0 = u.pn * HALF + wc * 32 + 8 * fq;
        const float* bp = bias + cond_of_tile(u.pm) * 5632 + u.pn * BM + wc * 32 + 8 * fq;
        const f32x4 bg0 = *(const f32x4*)bp, bg1 = *(const f32x4*)(bp + 4), bu0 = *(const f32x4*)(bp + HALF), bu1 = *(const f32x4*)(bp + HALF + 4);
        unsigned long long rsq[2][4]; float rsv[2][4];
#pragma unroll
        for (int ai = 0; ai < 2; ++ai)
#pragma unroll
            for (int m = 0; m < 4; ++m) rsq[ai][m] = ss[row0 + ai * HALF + m * 16];
#pragma unroll
        for (int ai = 0; ai < 2; ++ai)
#pragma unroll
            for (int m = 0; m < 4; ++m) rsv[ai][m] = (float)rsq[ai][m];
#pragma unroll
        for (int ai = 0; ai < 2; ++ai)
#pragma unroll
            for (int m = 0; m < 4; ++m) { const int row = row0 + ai * HALF + m * 16; bf16_t* rowp = O + (size_t)row * 2816 + col0;
                const float rs = __builtin_amdgcn_rsqf(rsv[ai][m] * (SS_UNFIX / 1024.0f) + 1e-6f);
                const f32x4 g0 = acc[ai][0][m][0] * rs + bg0, g1 = acc[ai][0][m][1] * rs + bg1, u0 = acc[ai][1][m][0] * rs + bu0, u1 = acc[ai][1][m][1] * rs + bu1;
                u32x4 w;
                w.x = cvt_pk_bf16(silu_f(g0[0]) * u0[0], silu_f(g0[1]) * u0[1]); w.y = cvt_pk_bf16(silu_f(g0[2]) * u0[2], silu_f(g0[3]) * u0[3]);
                w.z = cvt_pk_bf16(silu_f(g1[0]) * u1[0], silu_f(g1[1]) * u1[1]); w.w = cvt_pk_bf16(silu_f(g1[2]) * u1[2], silu_f(g1[3]) * u1[3]);
                st16_wt(rowp, w); }
    }
};
template <bool SRC32> struct EpiResT {
    static constexpr bool PERM = true, AFTER_DRAIN = false;
    const void* in0; const void* in1; bf16_t* X; const float* gate;
    bf16_t* Hn; const float* gct; unsigned long long* ssn; float scale;
    static __device__ __forceinline__ float lo16(unsigned w) { return __uint_as_float(w << 16); }
    static __device__ __forceinline__ float hi16(unsigned w) { return __uint_as_float(w & 0xffff0000u); }
    __device__ __forceinline__ void operator()(const f32x4 (&acc)[2][2][4][2], const Unit& u, int wr, int wc, int fr, int fq) const {
        asm volatile("" : "+v"(fr), "+v"(fq));
        const int cond = cond_of_tile(u.pm); const float* gp = gate + cond * 9216; const float* cp = gct + cond * 1024;
        const int col0 = u.pn * BM + wc * 32 + 8 * fq;
        const bool ctx = u.pm < 32; const void* src = ctx ? in0 : in1; const int rbase = u.pm * BM - (ctx ? 0 : 8192);
        f32x4 gv[2][2], gc[2][2], xo32[4][2][2]; u32x4 xo16[4][2];
#define EPIRES_LOAD(slot_, rg_) do { const size_t ro = (size_t)(rbase + ((rg_) >> 2) * HALF + wr * 64 + ((rg_) & 3) * 16 + fr) * 1024 + col0; \
            if constexpr (SRC32) { const float* sp = (const float*)src + ro; \
                _Pragma("unroll") for (int bj = 0; bj < 2; ++bj) _Pragma("unroll") for (int n = 0; n < 2; ++n) xo32[slot_][bj][n] = __builtin_nontemporal_load((const f32x4*)(sp + bj * HALF + n * 4)); } \
            else { const bf16_t* sp = (const bf16_t*)src + ro; \
                _Pragma("unroll") for (int bj = 0; bj < 2; ++bj) xo16[slot_][bj] = *(const u32x4*)(sp + bj * HALF); } } while (0)
#define EPIRES_DO(slot_, rg_) do { const int ai = (rg_) >> 2, m = (rg_) & 3, rl = ai * HALF + wr * 64 + m * 16 + fr; \
            const size_t oo = (size_t)(u.pm * BM + rl) * 1024 + col0; float sq = 0.f; \
            _Pragma("unroll") for (int bj = 0; bj < 2; ++bj) { f32x4 x0, x1; \
                if constexpr (SRC32) { x0 = xo32[slot_][bj][0]; x1 = xo32[slot_][bj][1]; } \
                else { const u32x4 w = xo16[slot_][bj]; x0 = (f32x4){lo16(w[0]), hi16(w[0]), lo16(w[1]), hi16(w[1])}; x1 = (f32x4){lo16(w[2]), hi16(w[2]), lo16(w[3]), hi16(w[3])}; } \
                const f32x4 xa = x0 + gv[bj][0] * acc[ai][bj][m][0], xb = x1 + gv[bj][1] * acc[ai][bj][m][1]; \
                st16_wt(X + oo + bj * HALF, (u32x4){cvt_pk_bf16(xa[0], xa[1]), cvt_pk_bf16(xa[2], xa[3]), cvt_pk_bf16(xb[0], xb[1]), cvt_pk_bf16(xb[2], xb[3])}); \
                sq += ((xa[0] * xa[0] + xa[1] * xa[1]) + (xa[2] * xa[2] + xa[3] * xa[3])) + ((xb[0] * xb[0] + xb[1] * xb[1]) + (xb[2] * xb[2] + xb[3] * xb[3])); \
                if (Hn) { const f32x4 ha = xa * gc[bj][0], hb = xb * gc[bj][1]; \
                    st16_wt(Hn + oo + bj * HALF, (u32x4){cvt_pk_bf16(ha[0], ha[1]), cvt_pk_bf16(ha[2], ha[3]), cvt_pk_bf16(hb[0], hb[1]), cvt_pk_bf16(hb[2], hb[3])}); } } \
            sq += __shfl_xor(sq, 16); sq += __shfl_xor(sq, 32); \
            if (fq == 0) atomicAdd(ssn + u.pm * BM + rl, (unsigned long long)(sq * SS_FIX)); } while (0)
#pragma unroll
        for (int bj = 0; bj < 2; ++bj)
#pragma unroll
            for (int n = 0; n < 2; ++n) { gv[bj][n] = *(const f32x4*)(gp + col0 + bj * HALF + n * 4); gc[bj][n] = Hn ? *(const f32x4*)(cp + col0 + bj * HALF + n * 4) : (f32x4){0.f, 0.f, 0.f, 0.f}; }
        EPIRES_LOAD(0, 0); EPIRES_LOAD(1, 1);
#pragma unroll
        for (int bj = 0; bj < 2; ++bj)
#pragma unroll
            for (int n = 0; n < 2; ++n) gv[bj][n] = gv[bj][n] * scale;
        EPIRES_DO(0, 0); EPIRES_DO(1, 1);
        EPIRES_LOAD(0, 2); EPIRES_LOAD(1, 3);
        EPIRES_DO(0, 2); EPIRES_DO(1, 3);
        EPIRES_LOAD(0, 4); EPIRES_LOAD(1, 5); EPIRES_LOAD(2, 6); EPIRES_LOAD(3, 7);
        EPIRES_DO(0, 4); EPIRES_DO(1, 5); EPIRES_DO(2, 6); EPIRES_DO(3, 7);
#undef EPIRES_LOAD
#undef EPIRES_DO
    }
};
struct EpiIN {
    static constexpr bool PERM = false, AFTER_DRAIN = false;
    bf16_t* Z; bf16_t* ZT; float* newk; float* newv; const float* rope; const unsigned long long* ss; const float* bias; int layer; float qscale;
    __device__ __forceinline__ void operator()(const f32x4 (&acc)[2][2][4][2], const Unit& u, int wr, int wc, int fr, int fq) const {
        const bool lat = u.pm >= 32;
        const int colb = u.pn * BM + wc * 32 + 4 * fq;
        const float* bp = bias + cond_of_tile(u.pm) * 2048 + colb;
        f32x4 bv[2][2];
#pragma unroll
        for (int bj = 0; bj < 2; ++bj)
#pragma unroll
            for (int n = 0; n < 2; ++n) bv[bj][n] = *(const f32x4*)(bp + bj * HALF + n * 16);
        const bool roped = lat && u.pn < 3;
        float rsl[2];
        { const unsigned long long q0 = ss[u.pm * BM + wr * 64 + 16 * fq + fr], q1 = ss[u.pm * BM + HALF + wr * 64 + 16 * fq + fr];
          rsl[0] = __builtin_amdgcn_rsqf((float)q0 * (SS_UNFIX / 1024.0f) + 1e-6f); rsl[1] = __builtin_amdgcn_rsqf((float)q1 * (SS_UNFIX / 1024.0f) + 1e-6f); }
#pragma unroll
        for (int ai = 0; ai < 2; ++ai) {
            f32x4 rc0[4], rc1[4];
#pragma unroll
            for (int m = 0; m < 4; ++m) { rc0[m] = (f32x4){1.f, 0.f, 1.f, 0.f}; rc1[m] = rc0[m];
                if (roped) { const int pos = (u.pm * BM + ai * HALF + wr * 64 + m * 16 + fr - 8192) & 2047; const int p = (wc & 1) ? (pos & 63) : (pos >> 6);
                    const f32x4* rp = (const f32x4*)(rope + (size_t)(p * 16 + 4 * fq) * 2); rc0[m] = rp[0]; rc1[m] = rp[1]; } }
#pragma unroll
            for (int m = 0; m < 4; ++m) { const int row = u.pm * BM + ai * HALF + wr * 64 + m * 16 + fr;
                const float rs = __shfl(rsl[ai], 16 * m + fr);
#pragma unroll
                for (int bj = 0; bj < 2; ++bj) { const int col = colb + bj * HALF;
                    f32x4 v0 = acc[ai][bj][m][0] * rs + bv[bj][0], v1 = acc[ai][bj][m][1] * rs + bv[bj][1];
                    if (u.pn < 5) {
                        const int cb = u.pn * BM + bj * HALF;
                        if (lat && cb < 640) {
                            const f32x4 cs0 = rc0[m], cs1 = rc1[m];
                            const float c0 = cs0[0], s0 = cs0[1], c1 = cs0[2], s1 = cs0[3], c2 = cs1[0], s2 = cs1[1], c3 = cs1[2], s3 = cs1[3];
                            const f32x4 a = v0, b = v1;
                            v0[0] = a[0] * c0 - b[0] * s0; v1[0] = b[0] * c0 + a[0] * s0;
                            v0[1] = a[1] * c1 - b[1] * s1; v1[1] = b[1] * c1 + a[1] * s1;
                            v0[2] = a[2] * c2 - b[2] * s2; v1[2] = b[2] * c2 + a[2] * s2;
                            v0[3] = a[3] * c3 - b[3] * s3; v1[3] = b[3] * c3 + a[3] * s3;
                        }
                        if (!lat && cb >= 512 && cb < 768) {
                            const int b = row >> 8, s = row & 255; float* dst = (cb < 640 ? newk : newv) + ((size_t)(b * 2 + layer) * 256 + s) * 128 + (col - cb);
                            __builtin_nontemporal_store(v0, (f32x4*)dst); __builtin_nontemporal_store(v1, (f32x4*)(dst + 16));
                        }
                        if (cb < 512) { v0 = v0 * qscale; v1 = v1 * qscale; }
                        if (cb == 640) {
                            const int ch = 768 + col - 640;
#pragma unroll
                            for (int j = 0; j < 4; ++j) { ZT[(size_t)(ch + j) * 24576 + row] = (bf16_t)(cvt_pk_bf16(v0[j], 0.f) & 0xffffu); ZT[(size_t)(ch + 16 + j) * 24576 + row] = (bf16_t)(cvt_pk_bf16(v1[j], 0.f) & 0xffffu); }
                        } else {
                        bf16_t* zp = Z + (size_t)row * 1280 + col;
                        typedef unsigned u32x2 __attribute__((ext_vector_type(2)));
                        u32x2 w0, w1; w0.x = cvt_pk_bf16(v0[0], v0[1]); w0.y = cvt_pk_bf16(v0[2], v0[3]); w1.x = cvt_pk_bf16(v1[0], v1[1]); w1.y = cvt_pk_bf16(v1[2], v1[3]);
                        *(u32x2*)zp = w0; *(u32x2*)(zp + 16) = w1; }
                    } else {
                        const int ch = col - 1280;
#pragma unroll
                        for (int j = 0; j < 4; ++j) { ZT[(size_t)(ch + j) * 24576 + row] = (bf16_t)(cvt_pk_bf16(v0[j], 0.f) & 0xffffu); ZT[(size_t)(ch + 16 + j) * 24576 + row] = (bf16_t)(cvt_pk_bf16(v1[j], 0.f) & 0xffffu); }
                    }
                } }
        }
    }
};

template <class Epi, class Sched, bool ALIGN_EPI = false, bool SP2 = false>
__device__ __forceinline__ void gemm_phase(PG8_LAS unsigned char* lds, const Gemm g, const Sched S, const Epi E) {
    int tid_ = threadIdx.x; asm volatile("" : "+v"(tid_));
    const int tid = tid_, wid = __builtin_amdgcn_readfirstlane(tid >> 6), lane = tid & 63, wr = wid >> 2, wc = wid & 3, fr = lane & 15, fq = lane >> 4;
    const int K = g.K, nt = K / BK;
    unsigned voffA[2], voffB[2];
#pragma unroll
    for (int i = 0; i < 2; ++i) { int R, C; stage_rc(tid * 16 + i * 8192, R, C); const int Rb = Epi::PERM ? ((R & ~31) + perm32(R & 31)) : R;
        voffA[i] = (unsigned)(R * K + C) * 2u; voffB[i] = (unsigned)(Rb * K + C) * 2u; }
    const size_t kstep = (size_t)(BK * 2);
    const size_t hstep = (size_t)HALF * K * 2;
    const size_t tstep = 2 * hstep;
    const unsigned ldsw = (unsigned)wid * 1024u;
    const int aoff = lds_byte(wr * 64 + fr, fq * 8), boff = lds_byte(wc * 32 + fr, fq * 8);
#define PG8_SA(b, h) (((b) * 2 + (h)) * HTB)
#define PG8_SB(b, h) ((4 + (b) * 2 + (h)) * HTB)
#define PG8_STAGE(bufoff, gbase, voff) do { _Pragma("unroll") for (int _i = 0; _i < 2; ++_i) \
        __builtin_amdgcn_global_load_lds((const unsigned*)((const char*)(gbase) + (voff)[_i]), (PG8_LAS unsigned*)(lds + (bufoff) + ldsw + _i * 8192), 16, 0, 0); } while (0)
#define PG8_LDA(dst, b, h) do { _Pragma("unroll") for (int m = 0; m < 4; ++m) _Pragma("unroll") for (int k = 0; k < 2; ++k) dst[m][k] = *(const PG8_LAS bf16x8*)(lds + PG8_SA(b, h) + aoff + m * 2048 + k * 1024); } while (0)
#define PG8_LDB(dst, b, h) do { _Pragma("unroll") for (int n = 0; n < 2; ++n) _Pragma("unroll") for (int k = 0; k < 2; ++k) dst[n][k] = *(const PG8_LAS bf16x8*)(lds + PG8_SB(b, h) + boff + n * 2048 + k * 1024); } while (0)
#define PG8_MMA(ai, bj, At, Bt) do { __builtin_amdgcn_s_setprio(1); _Pragma("unroll") for (int m = 0; m < 4; ++m) _Pragma("unroll") for (int n = 0; n < 2; ++n) _Pragma("unroll") for (int k = 0; k < 2; ++k) \
        acc[ai][bj][m][n] = __builtin_amdgcn_mfma_f32_16x16x32_bf16(Bt[n][k], At[m][k], acc[ai][bj][m][n], 0, 0, 0); __builtin_amdgcn_s_setprio(0); } while (0)
#define PG8_WAIT_V(n) asm volatile("s_waitcnt vmcnt(" #n ")" ::: "memory")
#define PG8_WAIT_L(n) asm volatile("s_waitcnt lgkmcnt(" #n ")" ::: "memory")
#define PG8_BAR __builtin_amdgcn_s_barrier()
#define PG8_SCHED __builtin_amdgcn_sched_barrier(0)
    Unit cur, nxt; int ui = 0;
    if (!S.next(0, cur)) return;
    f32x4 acc[2][2][4][2];
#pragma unroll
    for (int a = 0; a < 2; ++a)
#pragma unroll
        for (int b = 0; b < 2; ++b)
#pragma unroll
            for (int m = 0; m < 4; ++m)
#pragma unroll
                for (int n = 0; n < 2; ++n) acc[a][b][m][n] = (f32x4){0.f, 0.f, 0.f, 0.f};
    bf16x8 At[4][2], B0[2][2], B1[2][2];
    const char* cA = (const char*)g.A + (size_t)cur.pm * tstep; const char* cB = (const char*)g.Bt + (size_t)cur.pn * tstep;
    S.a_ready(cur);
    if constexpr (SP2) {
        PG8_STAGE(PG8_SB(0, 0), cB, voffB); PG8_STAGE(PG8_SB(0, 1), cB + hstep, voffB); PG8_STAGE(PG8_SA(0, 0), cA, voffA); PG8_STAGE(PG8_SA(0, 1), cA + hstep, voffA);
        if (wr == 1) PG8_BAR;
        PG8_WAIT_V(2); PG8_BAR;
        PG8_STAGE(PG8_SB(1, 0), cB + kstep, voffB); PG8_STAGE(PG8_SA(1, 0), cA + kstep, voffA); PG8_STAGE(PG8_SB(1, 1), cB + hstep + kstep, voffB);
        PG8_WAIT_V(6); PG8_BAR;
    } else {
        PG8_STAGE(PG8_SB(0, 0), cB, voffB); PG8_STAGE(PG8_SA(0, 0), cA, voffA); PG8_STAGE(PG8_SB(0, 1), cB + hstep, voffB); PG8_STAGE(PG8_SA(0, 1), cA + hstep, voffA);
        if (wr == 1) PG8_BAR;
        PG8_WAIT_V(4); PG8_BAR;
        PG8_STAGE(PG8_SB(1, 0), cB + kstep, voffB); PG8_STAGE(PG8_SA(1, 0), cA + kstep, voffA); PG8_STAGE(PG8_SB(1, 1), cB + hstep + kstep, voffB);
        PG8_WAIT_V(6); PG8_BAR;
    }
    for (;;) {
        const bool has_next = S.next(ui + 1, nxt);
        const char* nA = has_next ? (const char*)g.A + (size_t)nxt.pm * tstep : cA; const char* nB = has_next ? (const char*)g.Bt + (size_t)nxt.pn * tstep : cB;
        for (int t = 0; t < nt; t += 2) {
            const bool last = (t == nt - 2);
            const char* a1 = cA + (size_t)(t + 1) * kstep;
            const char* a2 = last ? nA : cA + (size_t)(t + 2) * kstep; const char* b2 = last ? nB : cB + (size_t)(t + 2) * kstep;
            const char* a3 = a2 + kstep; const char* b3 = b2 + kstep;
            if (last && has_next) S.a_ready(nxt);
            if constexpr (SP2) {
            PG8_LDB(B0, 0, 0); PG8_LDB(B1, 0, 1); PG8_SCHED; PG8_LDA(At, 0, 0); PG8_STAGE(PG8_SA(1, 1), a1 + hstep, voffA);
            PG8_WAIT_V(8); PG8_WAIT_L(0); PG8_BAR; PG8_MMA(0, 0, At, B0); PG8_MMA(0, 1, At, B1); PG8_BAR; PG8_SCHED;
            PG8_LDA(At, 0, 1); PG8_STAGE(PG8_SB(0, 0), b2, voffB); PG8_STAGE(PG8_SB(0, 1), b2 + hstep, voffB); PG8_STAGE(PG8_SA(0, 0), a2, voffA);
            PG8_WAIT_V(8); PG8_WAIT_L(0); PG8_BAR; PG8_MMA(1, 0, At, B0); PG8_MMA(1, 1, At, B1); PG8_BAR; PG8_SCHED;
            PG8_LDB(B0, 1, 0); PG8_LDB(B1, 1, 1); PG8_SCHED; PG8_LDA(At, 1, 0); PG8_STAGE(PG8_SA(0, 1), a2 + hstep, voffA);
            PG8_WAIT_V(8); PG8_WAIT_L(0); PG8_BAR; PG8_MMA(0, 0, At, B0); PG8_MMA(0, 1, At, B1); PG8_BAR; PG8_SCHED;
            PG8_LDA(At, 1, 1); PG8_STAGE(PG8_SB(1, 0), b3, voffB); PG8_STAGE(PG8_SB(1, 1), b3 + hstep, voffB); PG8_STAGE(PG8_SA(1, 0), a3, voffA);
            PG8_WAIT_V(8); PG8_WAIT_L(0); PG8_BAR; PG8_MMA(1, 0, At, B0); PG8_MMA(1, 1, At, B1); PG8_BAR; PG8_SCHED;
            } else {
            PG8_LDB(B0, 0, 0); PG8_SCHED; PG8_LDA(At, 0, 0); PG8_STAGE(PG8_SA(1, 1), a1 + hstep, voffA);
            PG8_WAIT_L(8); PG8_BAR; PG8_WAIT_L(0); PG8_MMA(0, 0, At, B0); PG8_BAR; PG8_SCHED;
            PG8_LDB(B1, 0, 1); PG8_STAGE(PG8_SB(0, 0), b2, voffB);
            PG8_BAR; PG8_WAIT_L(0); PG8_MMA(0, 1, At, B1); PG8_BAR;
            PG8_LDA(At, 0, 1); PG8_STAGE(PG8_SA(0, 0), a2, voffA);
            PG8_BAR; PG8_WAIT_L(0); PG8_MMA(1, 0, At, B0); PG8_BAR; PG8_SCHED;
            PG8_STAGE(PG8_SB(0, 1), b2 + hstep, voffB);
            PG8_WAIT_V(6); PG8_BAR; PG8_MMA(1, 1, At, B1); PG8_BAR;
            PG8_LDB(B0, 1, 0); PG8_SCHED; PG8_LDA(At, 1, 0); PG8_STAGE(PG8_SA(0, 1), a2 + hstep, voffA);
            PG8_WAIT_L(8); PG8_BAR; PG8_WAIT_L(0); PG8_MMA(0, 0, At, B0); PG8_BAR; PG8_SCHED;
            PG8_LDB(B1, 1, 1); PG8_STAGE(PG8_SB(1, 0), b3, voffB);
            PG8_BAR; PG8_WAIT_L(0); PG8_MMA(0, 1, At, B1); PG8_BAR;
            PG8_LDA(At, 1, 1); PG8_STAGE(PG8_SA(1, 0), a3, voffA);
            PG8_BAR; PG8_WAIT_L(0); PG8_MMA(1, 0, At, B0); PG8_BAR; PG8_SCHED;
            PG8_STAGE(PG8_SB(1, 1), b3 + hstep, voffB);
            PG8_WAIT_V(6); PG8_BAR; PG8_MMA(1, 1, At, B1); PG8_BAR;
            }
        }
        if constexpr (ALIGN_EPI) { if (wr == 0) PG8_BAR; }
        if constexpr (!Epi::AFTER_DRAIN) { E(acc, cur, wr, wc, fr, fq); S.done(cur); }
        if (!has_next) break;
#pragma unroll
        for (int a = 0; a < 2; ++a)
#pragma unroll
            for (int b = 0; b < 2; ++b)
#pragma unroll
                for (int m = 0; m < 4; ++m)
#pragma unroll
                    for (int n = 0; n < 2; ++n) acc[a][b][m][n] = (f32x4){0.f, 0.f, 0.f, 0.f};
        cur = nxt; cA = nA; cB = nB; ++ui;
        if constexpr (ALIGN_EPI) { if (wr == 1) PG8_BAR; }
    }
    PG8_WAIT_V(0);
    if constexpr (!ALIGN_EPI) { if (wr == 0) PG8_BAR; }
    PG8_BAR;
    if constexpr (Epi::AFTER_DRAIN) { E.fused(acc, cur, wr, wc, fr, fq, lds, wid, lane); S.done(cur); }
#undef PG8_SA
#undef PG8_SB
#undef PG8_STAGE
#undef PG8_LDA
#undef PG8_LDB
#undef PG8_MMA
#undef PG8_WAIT_V
#undef PG8_WAIT_L
#undef PG8_BAR
#undef PG8_SCHED
}
}

#define GAS __attribute__((address_space(1)))
#define LAS __attribute__((address_space(3)))
typedef unsigned short bf16;
typedef unsigned v4u __attribute__((ext_vector_type(4)));
typedef unsigned v2u __attribute__((ext_vector_type(2)));
typedef float f32x4 __attribute__((ext_vector_type(4)));
typedef short bf16x8 __attribute__((ext_vector_type(8)));
typedef GAS unsigned gu32;
#define RLX_AGENT __ATOMIC_RELAXED, __HIP_MEMORY_SCOPE_AGENT
#define LDS_WAIT() asm volatile("s_waitcnt lgkmcnt(0)" ::: "memory")
#define VM_WAIT() asm volatile("s_waitcnt vmcnt(0)" ::: "memory")
__device__ __forceinline__ unsigned f2bf(float f) { unsigned u = __builtin_bit_cast(unsigned, f); return (u + 0x7fffu + ((u >> 16) & 1u)) >> 16; }
__device__ __forceinline__ unsigned pk2(float lo, float hi) { return f2bf(lo) | (f2bf(hi) << 16); }
__device__ __forceinline__ float bf2f(unsigned h) { return __builtin_bit_cast(float, h << 16); }
__device__ __forceinline__ float bflo(unsigned w) { return __builtin_bit_cast(float, w << 16); }
__device__ __forceinline__ float bfhi(unsigned w) { return __builtin_bit_cast(float, w & 0xffff0000u); }
__device__ __forceinline__ float wave_sum(float v) {
#define WS_DPP(ctrl, rmask) v += __builtin_bit_cast(float, __builtin_amdgcn_update_dpp(0, __builtin_bit_cast(int, v), ctrl, rmask, 0xf, false))
    WS_DPP(0xB1, 0xf); WS_DPP(0x4E, 0xf); WS_DPP(0x141, 0xf); WS_DPP(0x140, 0xf); WS_DPP(0x142, 0xa); WS_DPP(0x143, 0xc);
#undef WS_DPP
    return __builtin_bit_cast(float, __builtin_amdgcn_readlane(__builtin_bit_cast(int, v), 63));
}
__device__ __forceinline__ float silu_acc(float x) { return x / (1.0f + __expf(-x)); }

#define XB_TMO      128
#define XB_XCNT(j)  (256  + 64 * (j))
#define XB_XSUB(j)  (1280 + 64 * (j))
#define XB_XGEN(j)  (2304 + 64 * (j))
#define XB_TOP      3328
#define XB_TOPGEN   3392
#define XCD_BAR_WORDS 3456
#define XB_SPIN_CAP (1u << 18)
__device__ __forceinline__ unsigned xb_ld(unsigned* p)              { return __hip_atomic_load(p, __ATOMIC_RELAXED, __HIP_MEMORY_SCOPE_AGENT); }
__device__ __forceinline__ unsigned xb_add(unsigned* p, unsigned v) { return __hip_atomic_fetch_add(p, v, __ATOMIC_RELAXED, __HIP_MEMORY_SCOPE_AGENT); }
__device__ __forceinline__ unsigned xb_xcc_id() { return (unsigned)__builtin_amdgcn_s_getreg((3 << 11) | 20) & 0xFu; }
#define XB_SPIN(cond, bar) do { unsigned _sp = 0; while (cond) { __builtin_amdgcn_s_sleep(1); \
    if ((++_sp & 255u) == 0u) { if (xb_ld(&(bar)[XB_TMO])) break; if (_sp > XB_SPIN_CAP) { atomicAdd(&(bar)[XB_TMO], 1u); break; } } } } while (0)
struct XcdBarrier { unsigned* bar; unsigned x; volatile LAS unsigned* st; };
__device__ __forceinline__ XcdBarrier xcd_barrier_post(unsigned* bar, volatile LAS unsigned* st) {
    XcdBarrier b; b.bar = bar; b.x = xb_xcc_id(); b.st = st;
    if (threadIdx.x == 0) (void)xb_add(&bar[XB_XCNT(b.x)], 1u);
    return b;
}
__device__ __forceinline__ void xcd_barrier_complete(unsigned* bar, unsigned x, unsigned& nloc, unsigned& nx) {
    const unsigned G = gridDim.x * gridDim.y * gridDim.z;
    unsigned sum, cnt, mine, sp = 0u;
    for (;;) {
        sum = 0u; cnt = 0u; mine = 0u;
#pragma unroll
        for (unsigned j = 0; j < 16; ++j) { const unsigned c = xb_ld(&bar[XB_XCNT(j)]); sum += c; cnt += (c > 0u) ? 1u : 0u; mine = (j == x) ? c : mine; }
        if (sum == G) break;
        __builtin_amdgcn_s_sleep(1);
        if ((++sp & 255u) == 0u) { if (xb_ld(&bar[XB_TMO])) break; if (sp > XB_SPIN_CAP) { atomicAdd(&bar[XB_TMO], 1u); break; } }
    }
    nloc = mine > 0u ? mine : 1u; nx = cnt > 0u ? cnt : 1u;
}
__device__ __forceinline__ void xcd_barrier(const XcdBarrier& b) {
    asm volatile("s_waitcnt vmcnt(0)" ::: "memory");
    __syncthreads();
    if (threadIdx.x == 0) {
        unsigned* bar = b.bar;
        __builtin_amdgcn_s_waitcnt(0);
        unsigned nloc = b.st[0], nx = b.st[1];
        if (nloc == 0u) { xcd_barrier_complete(bar, b.x, nloc, nx); b.st[0] = nloc; b.st[1] = nx; }
        const unsigned old = xb_add(&bar[XB_XSUB(b.x)], 1u);
        const unsigned gen = old / nloc;
        if (old + 1u == (gen + 1u) * nloc) {
            __builtin_amdgcn_fence(__ATOMIC_RELEASE, "agent");
            asm volatile("s_waitcnt vmcnt(0)" ::: "memory");
            const unsigned og = xb_add(&bar[XB_TOP], 1u);
            const unsigned tg = og / nx;
            if (og + 1u == (tg + 1u) * nx) xb_add(&bar[XB_TOPGEN], 1u);
            else XB_SPIN(xb_ld(&bar[XB_TOPGEN]) == tg, bar);
            __builtin_amdgcn_fence(__ATOMIC_ACQUIRE, "agent");
            xb_add(&bar[XB_XGEN(b.x)], 1u);
            asm volatile("s_waitcnt vmcnt(0)" ::: "memory");
        } else {
            XB_SPIN(xb_ld(&bar[XB_XGEN(b.x)]) == gen, bar);
            __builtin_amdgcn_fence(__ATOMIC_ACQUIRE, "agent");
            asm volatile("s_waitcnt vmcnt(0)" ::: "memory");
        }
    }
    __syncthreads();
}

struct Args { const float* in[N_IN]; float* out; unsigned char* ws; int ph_lo, ph_hi; };

struct TrItem { const float* src; bf16* dst; int N, Kd; };
__device__ __forceinline__ TrItem tr_make(const float* W, int N, bf16* WT, int Kd, int kb, int nb, int mode) {
    const int k0 = 64 * kb, n0 = 32 * nb; const int drow0 = mode == 0 ? n0 : ((n0 >> 7) * 256 + (n0 & 127) + (mode == 2 ? 128 : 0));
    TrItem t; t.src = W + (size_t)k0 * N + n0; t.dst = WT + (size_t)drow0 * Kd + k0; t.N = N; t.Kd = Kd; return t;
}
__device__ __forceinline__ void tr_load(const TrItem& t, float (&tv)[32], int lane) {
#pragma unroll
    for (int i = 0; i < 32; ++i) tv[i] = __builtin_nontemporal_load(t.src + (size_t)(2 * i + (lane >> 5)) * t.N + (lane & 31));
}
__device__ __forceinline__ void tr_finish(const TrItem& t, const float (&tv)[32], LAS float* scr, int lane) {
#pragma unroll
    for (int i = 0; i < 32; ++i) scr[(2 * i + (lane >> 5)) * 33 + (lane & 31)] = tv[i];
    LDS_WAIT(); asm volatile("" ::: "memory");
    const int c = lane & 7;
#pragma unroll
    for (int j = 0; j < 4; ++j) { const int n = (lane >> 3) + 8 * j; const LAS float* s = scr + (8 * c) * 33 + n;
        v4u o; o.x = pk2(s[0 * 33], s[1 * 33]); o.y = pk2(s[2 * 33], s[3 * 33]); o.z = pk2(s[4 * 33], s[5 * 33]); o.w = pk2(s[6 * 33], s[7 * 33]);
        *(v4u*)(t.dst + (size_t)n * t.Kd + 8 * c) = o; }
    LDS_WAIT(); asm volatile("" ::: "memory");
}

constexpr int J1_G = 16 * 88, J1_D = 44 * 32, J1_FF = 3 * J1_G, J1_IN = 16 * 64, J1_OUT = 16 * 32, J1_L = 2 * J1_FF + J1_IN + J1_OUT, J1_SLOT0 = J1_L + 2984;
static_assert(J1_G == J1_D, "items");
__device__ __forceinline__ TrItem j1_item(const Args& a, int it) {
    unsigned char* ws = a.ws;
    const int l = it / J1_L; int r = it % J1_L;
    if (r < 2 * J1_FF) {
        const int f = r / J1_FF; r %= J1_FF; const int part = r / J1_G; r %= J1_G;
        const size_t lo = (size_t)l * 1024 * 2816;
        if (part == 0)      return tr_make(a.in[f ? I_W2G : I_W1G] + lo, 2816, (bf16*)(ws + WS_WGU) + (size_t)(l * 2 + f) * 5632 * 1024, 1024, r / 88, r % 88, 1);
        else if (part == 1) return tr_make(a.in[f ? I_W2U : I_W1U] + lo, 2816, (bf16*)(ws + WS_WGU) + (size_t)(l * 2 + f) * 5632 * 1024, 1024, r / 88, r % 88, 2);
        else                return tr_make(a.in[f ? I_W2D : I_W1D] + lo, 1024, (bf16*)(ws + WS_WD) + (size_t)(l * 2 + f) * 1024 * 2816, 2816, r / 32, r % 32, 0);
    }
    r -= 2 * J1_FF;
    if (r < J1_IN) return tr_make(a.in[I_WIN] + (size_t)l * 1024 * 2048, 2048, (bf16*)(ws + WS_WIN) + (size_t)l * 2048 * 1024, 1024, r / 64, r % 64, 0);
    r -= J1_IN; const int kb = r / 32;
    if (kb >= 8 && kb < 12) return tr_make(a.in[I_WOUT] + (size_t)l * 1024 * 1024, 1024, (bf16*)(ws + WS_TMPW) + (size_t)l * 1024 * 256 - 512, 256, kb, r % 32, 0);
    return tr_make(a.in[I_WOUT] + (size_t)l * 1024 * 1024, 1024, (bf16*)(ws + WS_WOUT) + (size_t)l * 1024 * 1024, 1024, kb, r % 32, 0);
}
__device__ __forceinline__ void j1_run(const Args& a, LAS float* scr, int it0, int it_hi, int stride, int lane) {
    if (it0 < it_hi) {
        TrItem cur = j1_item(a, it0); float tv[32]; tr_load(cur, tv, lane);
        for (int it = it0; it < it_hi; it += stride) {
            const bool more = it + stride < it_hi;
            TrItem nxt = cur; float tn[32];
            if (more) { nxt = j1_item(a, it + stride); tr_load(nxt, tn, lane); }
            tr_finish(cur, tv, scr, lane);
            if (more) { cur = nxt;
#pragma unroll
                for (int i = 0; i < 32; ++i) tv[i] = tn[i]; }
        }
    }
}

#ifndef PROBE_TS
#define PROBE_TS -1
#endif
#ifndef PROBE_BLK
#define PROBE_BLK 0
#endif
#define P0TS_BEGIN(k) do { if constexpr ((k) == PROBE_TS) { if (blockIdx.x == PROBE_BLK && threadIdx.x == 0) *((volatile LAS unsigned long long*)(lds + MISC_OFF + 64)) = __builtin_amdgcn_s_memrealtime(); } } while (0)
#define P0TS_END(k) do { if constexpr ((k) == PROBE_TS) { if (blockIdx.x == PROBE_BLK && threadIdx.x == 0) *((volatile LAS unsigned long long*)(lds + MISC_OFF + 72)) = __builtin_amdgcn_s_memrealtime(); } } while (0)
__device__ __forceinline__ void p0_prologue(const Args& a, LAS unsigned char* lds, int gw, int NGW, int wave, int lane, const bool with_j3) {
    unsigned char* ws = a.ws;
    LAS float* scr = (LAS float*)(lds + wave * 16384);
    P0TS_BEGIN(10);
    const bool j3blk = with_j3 && (int)blockIdx.x < 144 && NGW == 2048;
    if (j3blk) {
        LAS float* sl = (LAS float*)lds;
        LAS float* red = (LAS float*)(lds + 40960);
        const int tid = threadIdx.x;
        for (int e = tid; e < 9 * 1024; e += NTHREADS) { const int cc = e >> 10, k = e & 1023; sl[e] = silu_acc(cc == 0 ? a.in[I_CCTX][k] : a.in[I_C][(cc - 1) * 1024 + k]); }
        __syncthreads();
        const int it = blockIdx.x, l = it / 72, r = it % 72, nch = r >> 1, kh = r & 1;
        const int k0 = kh * 512 + wave * 64;
        const float* wm = a.in[I_WMOD] + (size_t)l * 1024 * 9216 + (size_t)k0 * 9216 + nch * 256;
        const unsigned lo16 = (unsigned)lane * 16u;
        f32x4 acc[9];
#pragma unroll
        for (int c = 0; c < 9; ++c) acc[c] = (f32x4){0.f, 0.f, 0.f, 0.f};
#pragma unroll 1
        for (int kb = 0; kb < 4; ++kb) {
            f32x4 w[16];
#pragma unroll
            for (int k = 0; k < 16; ++k) w[k] = __builtin_nontemporal_load((const f32x4*)((const char*)(wm + (size_t)(kb * 16 + k) * 9216) + lo16));
#pragma unroll
            for (int k = 0; k < 16; ++k) {
#pragma unroll
                for (int c = 0; c < 9; ++c) acc[c] += sl[c * 1024 + k0 + kb * 16 + k] * w[k];
                if ((k & 3) == 3) __builtin_amdgcn_sched_barrier(0);
            }
        }
#pragma unroll
        for (int c = 0; c < 9; ++c) *(LAS f32x4*)(red + (wave * 9 + c) * 256 + lane * 4) = acc[c];
        __syncthreads();
        for (int e = tid; e < 9 * 256; e += NTHREADS) { const int c = e >> 8, col = e & 255, n = nch * 256 + col; float sm = 0.f;
#pragma unroll
            for (int w8 = 0; w8 < 8; ++w8) sm += red[(w8 * 9 + c) * 256 + col];
            if (kh == 0) sm += a.in[I_BMOD][l * 9216 + n];
            atomicAdd((float*)(ws + WS_MOD) + (size_t)(l * 9 + c) * 9216 + n, sm); }
        __syncthreads();
    }
    P0TS_END(10); P0TS_BEGIN(11);
    { const bool split = with_j3 && NGW == 2048, lowv = gw < 1152;
      static_assert(1152 * 4 <= J1_SLOT0, "transpose split");
      if (split) { if (lowv) j1_run(a, scr, gw, 4608, 1152, lane); else j1_run(a, scr, 4608 + (gw - 1152), J1_SLOT0, 896, lane); }
      else j1_run(a, scr, gw, J1_SLOT0, NGW, lane); }
    P0TS_END(11); P0TS_BEGIN(12);
    P0TS_END(12); P0TS_BEGIN(13);
    {
        const int gt = gw * 64 + lane, NGT = NGW * 64;
        for (int e = gt; e < 2 * 8 * 256 * 128; e += NGT) {
            const int gd = e & 127, p = (e >> 7) & 255, b = (e >> 15) & 7, l = e >> 18;
            const size_t src = (((size_t)b * 2 + l) * 256 + p) * 128 + gd;
            const float kv = a.in[I_CK][src], vv = a.in[I_CV][src];
            ((bf16*)(ws + WS_CKB))[e] = (bf16)f2bf(kv);
            ((bf16*)(ws + WS_CVT))[(((size_t)l * 8 + b) * 128 + gd) * 256 + p] = (bf16)f2bf(vv);
        }
        for (int e = gt; e < 1024; e += NGT) { const int p = e >> 4, i = e & 15; const float inv = powf(10000.0f, -(float)i / 16.0f); const float ang = (float)p * inv;
            ((float*)(ws + WS_ROPE))[2 * e] = cosf(ang); ((float*)(ws + WS_ROPE))[2 * e + 1] = sinf(ang); }
    }
    P0TS_END(13); P0TS_BEGIN(14);
    for (int it = gw; it < 2 * 2304; it += NGW) {
        const int l = it / 2304, tt = it % 2304; const int L = tt < 2048 ? 2048 : 256, t = tt < 2048 ? tt : tt - 2048;
        const float tf = (float)t, tn = tf / (float)(L - 1);
        const float* w1 = a.in[I_HW1] + l * 33 * 64; const float* w2 = a.in[I_HW2] + l * 64 * 64;
        float s1 = tn * w1[lane];
        const float rev = tf * (1e-4f + (float)(lane & 15) * ((15.0f - 1e-4f) / 15.0f)) / (float)L; const float fr_ = rev - floorf(rev);
        const int cvi = __float_as_int(__builtin_amdgcn_cosf(fr_)), svi = __float_as_int(__builtin_amdgcn_sinf(fr_));
#pragma unroll
        for (int i = 0; i < 16; ++i) s1 += __int_as_float(__builtin_amdgcn_readlane(cvi, i)) * w1[(1 + i) * 64 + lane] - __int_as_float(__builtin_amdgcn_readlane(svi, i)) * w1[(17 + i) * 64 + lane];
        const float h1 = sinf(a.in[I_HF1][l * 64 + lane] * (s1 + a.in[I_HB1][l * 64 + lane]));
        const int h1i = __float_as_int(h1);
        float s2 = 0.f;
#pragma unroll 16
        for (int k = 0; k < 64; ++k) s2 += __int_as_float(__builtin_amdgcn_readlane(h1i, k)) * w2[k * 64 + lane];
        const float h2 = sinf(a.in[I_HF2][l * 64 + lane] * (s2 + a.in[I_HB2][l * 64 + lane]));
        ((float*)(ws + WS_HYH))[(size_t)it * 64 + lane] = h2;
    }
    P0TS_END(14);
}

__device__ __forceinline__ void fold_phase(const Args& a, int it_lo, int it_hi, int gw, int NGW, int lane) {
    unsigned char* ws = a.ws; const int i = lane & 15, q = lane >> 4;
    for (int it = it_lo + gw; it < it_hi; it += NGW) {
        const int l = it >> 8, nt = (it >> 2) & 63, kq = it & 3;
        const bf16* ap = (const bf16*)(ws + WS_TMPW) + ((size_t)l * 1024 + nt * 16 + i) * 256 + 8 * q;
        const float* bp = a.in[I_CPW] + (size_t)l * 65536 + (size_t)(kq * 64 + i) * 256 + 8 * q;
        f32x4 acc[4];
#pragma unroll
        for (int ct = 0; ct < 4; ++ct) acc[ct] = (f32x4){0.f, 0.f, 0.f, 0.f};
#pragma unroll
        for (int ks = 0; ks < 8; ++ks) {
            const bf16x8 af = *(const bf16x8*)(ap + 32 * ks);
#pragma unroll
            for (int ct = 0; ct < 4; ++ct) { const f32x4 b0 = *(const f32x4*)(bp + (size_t)ct * 16 * 256 + 32 * ks), b1 = *(const f32x4*)(bp + (size_t)ct * 16 * 256 + 32 * ks + 4);
                v4u bw; bw.x = pk2(b0[0], b0[1]); bw.y = pk2(b0[2], b0[3]); bw.z = pk2(b1[0], b1[1]); bw.w = pk2(b1[2], b1[3]);
                acc[ct] = __builtin_amdgcn_mfma_f32_16x16x32_bf16(af, __builtin_bit_cast(bf16x8, bw), acc[ct], 0, 0, 0); }
        }
        bf16* dst = (bf16*)(ws + WS_WOUT) + (size_t)l * 1048576 + (size_t)(nt * 16 + 4 * q) * 1024 + 512 + kq * 64 + i;
#pragma unroll
        for (int ct = 0; ct < 4; ++ct)
#pragma unroll
            for (int j = 0; j < 4; ++j) dst[(size_t)j * 1024 + ct * 16] = (bf16)f2bf(acc[ct][j]);
    }
}
__device__ __forceinline__ void prep_phase(const float* src0, const float* src1, const float* g, const float* mod, int sc_chunk, bf16* H, unsigned long long* ss, int r_lo, int r_hi, int gw, int NGW, int lane) {
    const int per = (r_hi - r_lo + NGW - 1) / NGW; int r = r_lo + gw * per; r_hi = (r + per < r_hi) ? r + per : r_hi; NGW = 1;
    if (r >= r_hi) return;
    f32x4 v[4], v1[4], v2[4];
#define PREP_LOAD(dst, row) do { const int rr_ = (row); if (rr_ < r_hi) { const float* xr_ = rr_ < MCTX ? src0 + (size_t)rr_ * D : src1 + (size_t)(rr_ - MCTX) * D; \
        _Pragma("unroll") for (int j = 0; j < 4; ++j) dst[j] = __builtin_nontemporal_load((const f32x4*)xr_ + lane + 64 * j); } } while (0)
    PREP_LOAD(v, r); PREP_LOAD(v1, r + NGW);
    for (; r < r_hi; r += NGW) {
        PREP_LOAD(v2, r + 2 * NGW);
        const int cond = r < MCTX ? 0 : 1 + ((r - MCTX) >> 11);
        const float* sc = mod + cond * 9216 + sc_chunk * 1024;
        float s = 0.f;
#pragma unroll
        for (int j = 0; j < 4; ++j) s += (v[j][0] * v[j][0] + v[j][1] * v[j][1]) + (v[j][2] * v[j][2] + v[j][3] * v[j][3]);
        s = wave_sum(s); if (lane == 0) ss[r] = (unsigned long long)(s * SS_FIX);
#pragma unroll
        for (int j = 0; j < 4; ++j) { const int col = 4 * (lane + 64 * j);
            const f32x4 o = v[j] * *(const f32x4*)(g + col) * (*(const f32x4*)(sc + col) + 1.0f);
            v2u w; w.x = pk2(o[0], o[1]); w.y = pk2(o[2], o[3]); *(v2u*)(H + (size_t)r * D + col) = w; }
#pragma unroll
        for (int j = 0; j < 4; ++j) { v[j] = v1[j]; v1[j] = v2[j]; }
    }
#undef PREP_LOAD
}
__device__ __forceinline__ void bias_phase(const Args& a, int it_lo, int it_hi, int gw, int NGW, int lane) {
    unsigned char* ws = a.ws;
    const int i = lane & 15, q = lane >> 4;
    for (int it = it_lo + gw; it < it_hi; it += NGW) {
        const int l = it / 832; int r = it % 832; int which, n0;
        if (r < 352) { which = 0; n0 = r * 16; } else if (r < 480) { which = 1; n0 = (r - 352) * 16; } else { which = 2; n0 = (r - 480) * 16; }
        const bf16* Wt = which == 1 ? (const bf16*)(ws + WS_WIN) + (size_t)l * 2048 * 1024 : (const bf16*)(ws + WS_WGU) + (size_t)(l * 2 + (which == 2 ? 1 : 0)) * 5632 * 1024;
        const int shc = which == 0 ? 0 : (which == 1 ? 3 : 6), off = which == 0 ? 0 : (which == 1 ? 50688 : 69120), bst = which == 1 ? 2048 : 5632;
        const float* shp = (const float*)(ws + WS_MOD) + (size_t)l * 9 * 9216 + (size_t)(i < 9 ? i : 0) * 9216 + shc * 1024 + 8 * q;
        const bf16* wp = Wt + (size_t)(n0 + i) * 1024 + 8 * q;
        f32x4 acc = {0.f, 0.f, 0.f, 0.f};
#pragma unroll 8
        for (int st = 0; st < 32; ++st) {
            const f32x4 s0 = *(const f32x4*)(shp + 32 * st), s1 = *(const f32x4*)(shp + 32 * st + 4);
            const v4u wv = *(const v4u*)(wp + 32 * st);
            v4u av; av.x = pk2(s0[0], s0[1]); av.y = pk2(s0[2], s0[3]); av.z = pk2(s1[0], s1[1]); av.w = pk2(s1[2], s1[3]);
            if (i >= 9) av = (v4u){0u, 0u, 0u, 0u};
            acc = __builtin_amdgcn_mfma_f32_16x16x32_bf16(__builtin_bit_cast(bf16x8, av), __builtin_bit_cast(bf16x8, wv), acc, 0, 0, 0);
        }
        float* bo = (float*)(ws + WS_BIAS) + (size_t)l * 119808 + off + n0 + i;
#pragma unroll
        for (int rg = 0; rg < 4; ++rg) { const int cond = 4 * q + rg; if (cond < 9) bo[(size_t)cond * bst] = acc[rg]; }
    }
}
__device__ __forceinline__ void gct_phase(const Args& a, int gw, int NGW, int lane) {
    const int gt = gw * 64 + lane, NGT = NGW * 64;
    for (int e = gt; e < 6 * 9 * 1024; e += NGT) {
        const int inst = e / 9216, r = e % 9216, cond = r >> 10, col = r & 1023;
        float v = 0.f;
        if (inst >= 1) { const int l = inst / 3, k = inst % 3;
            const float g = (k == 0 ? a.in[I_GF1] : (k == 1 ? a.in[I_GMIX] : a.in[I_GF2]))[l * 1024 + col];
            const float sc = ((const float*)(a.ws + WS_MOD))[(size_t)l * 9 * 9216 + cond * 9216 + (k == 0 ? 1 : (k == 1 ? 4 : 7)) * 1024 + col];
            v = g * (1.0f + sc); }
        ((float*)(a.ws + WS_GCT))[e] = v;
    }
}
__device__ __forceinline__ void final_norm_phase(float* X, const float* g, const float* ss, int gw, int NGW, int lane) {
    for (int r = gw; r < M; r += NGW) {
        float* xr = X + (size_t)r * D;
        const float rstd = 1.0f / sqrtf(ss[r] * (1.0f / D) + EPS);
#pragma unroll
        for (int j = 0; j < 4; ++j) { const int col = 4 * (lane + 64 * j); ((f32x4*)xr)[lane + 64 * j] = (((const f32x4*)xr)[lane + 64 * j] * rstd) * *(const f32x4*)(g + col); }
    }
}

__device__ __forceinline__ void hyena_filter_phase(const Args& a, LAS unsigned char* lds, int gw, int NGW, int wave, int lane) {
    unsigned char* ws = a.ws; const int i = lane & 15, q = lane >> 4;
    for (int it = gw; it < 2 * 36 * 16; it += NGW) {
        const int l = it / 576, r = it % 576, tc = r >> 4, ng = r & 15;
        const int stream = tc < 32 ? 0 : 1; const int L = stream ? 256 : 2048; const int t0 = (stream ? tc - 32 : tc) * 64; const int soff = stream ? 4096 : 0;
        const int n0 = ng * 64, o = n0 >> 9, dir = (n0 >> 8) & 1;
        const float* hrow = (const float*)(ws + WS_HYH) + ((size_t)l * 2304 + (stream ? 2048 : 0) + t0) * 64;
        const float* w3 = a.in[I_HW3] + (size_t)l * 64 * 1024 + n0 + i;
        bf16x8 A[4][2], B[4][2];
#pragma unroll
        for (int tt = 0; tt < 4; ++tt)
#pragma unroll
            for (int ks = 0; ks < 2; ++ks) { const float* p = hrow + (16 * tt + i) * 64 + 32 * ks + 8 * q; const f32x4 x0 = *(const f32x4*)p, x1 = *(const f32x4*)(p + 4);
                v4u w; w.x = pk2(x0[0], x0[1]); w.y = pk2(x0[2], x0[3]); w.z = pk2(x1[0], x1[1]); w.w = pk2(x1[2], x1[3]); A[tt][ks] = __builtin_bit_cast(bf16x8, w); }
#pragma unroll
        for (int nt = 0; nt < 4; ++nt)
#pragma unroll
            for (int ks = 0; ks < 2; ++ks) { const float* p = w3 + (size_t)(32 * ks + 8 * q) * 1024 + 16 * nt;
                v4u w; w.x = pk2(p[0], p[1024]); w.y = pk2(p[2048], p[3072]); w.z = pk2(p[4096], p[5120]); w.w = pk2(p[6144], p[7168]); B[nt][ks] = __builtin_bit_cast(bf16x8, w); }
        f32x4 acc[4][4];
#pragma unroll
        for (int tt = 0; tt < 4; ++tt)
#pragma unroll
            for (int nt = 0; nt < 4; ++nt) { acc[tt][nt] = (f32x4){0.f, 0.f, 0.f, 0.f};
#pragma unroll
                for (int ks = 0; ks < 2; ++ks) acc[tt][nt] = __builtin_amdgcn_mfma_f32_16x16x32_bf16(A[tt][ks], B[nt][ks], acc[tt][nt], 0, 0, 0); }
#pragma unroll
        for (int nt = 0; nt < 4; ++nt) {
            const int n = n0 + 16 * nt + i, c = n & 255;
            const float ndecay = -__expf(a.in[I_HLD][l * 1024 + n]) / (float)(L - 1);
            bf16* dst = (bf16*)(ws + WS_HYRAW) + ((size_t)(l * 2 + o) * 256 + c) * 4608 + soff;
            float sq = 0.f;
#pragma unroll
            for (int tt = 0; tt < 4; ++tt) { const int t = t0 + 16 * tt + 4 * q; float v[4];
#pragma unroll
                for (int j = 0; j < 4; ++j) { v[j] = acc[tt][nt][j] * __expf((float)(t + j) * ndecay); sq += v[j] * v[j]; }
                if (dir == 0) { v2u w; w.x = pk2(v[3], v[2]); w.y = pk2(v[1], v[0]); *(v2u*)(dst + (L - 4 - t)) = w; }
                else { if (t > 0) dst[L - 1 + t] = (bf16)f2bf(v[0]); else dst[2 * L - 1] = 0;
                       *(unsigned*)(dst + L + t) = pk2(v[1], v[2]); dst[L + t + 2] = (bf16)f2bf(v[3]); } }
            sq += __shfl_xor(sq, 16); sq += __shfl_xor(sq, 32);
            if (q == 0) atomicAdd((unsigned long long*)(ws + WS_SUMSQ) + ((l * 2 + stream) * 2 + o) * 256 + c, (unsigned long long)(sq * FSQ_FIX));
        }
    }
}

__device__ __forceinline__ void conv_phase(const Args& a, int l, const bf16* Z, bf16* CAT, LAS unsigned char* lds, int tid) {
    LAS float* ybuf = (LAS float*)lds;
    LAS float* cbuf = (LAS float*)(lds + 65536);
    const float* dw = a.in[I_CDW] + l * 31 * 256; const float* dwb = a.in[I_CDWB] + l * 256; const float* lng = a.in[I_CLNG] + l * 256; const float* lnb = a.in[I_CLNB] + l * 256;
    const int lane = tid & 63, wave = tid >> 6;
    for (int u = blockIdx.x; u < M / 32; u += gridDim.x) {
        const int r0 = u * 32;
        const int seq0 = r0 < MCTX ? (r0 & ~255) : MCTX + ((r0 - MCTX) & ~2047); const int seq1 = seq0 + (r0 < MCTX ? 256 : 2048);
        for (int e = tid; e < 62 * 32; e += NTHREADS) {
            const int rr = e >> 5, ch = e & 31; const int row = r0 - 15 + rr;
            float y[8];
            if (row >= seq0 && row < seq1) {
                const v4u av = *(const v4u*)(Z + (size_t)row * ZW + 768 + ch * 8), gv = *(const v4u*)(Z + (size_t)row * ZW + 1024 + ch * 8);
                const float af[8] = {bflo(av.x), bfhi(av.x), bflo(av.y), bfhi(av.y), bflo(av.z), bfhi(av.z), bflo(av.w), bfhi(av.w)};
                const float gf[8] = {bflo(gv.x), bfhi(gv.x), bflo(gv.y), bfhi(gv.y), bflo(gv.z), bfhi(gv.z), bflo(gv.w), bfhi(gv.w)};
#pragma unroll
                for (int j = 0; j < 8; ++j) y[j] = af[j] / (1.0f + __expf(-gf[j]));
            } else {
#pragma unroll
                for (int j = 0; j < 8; ++j) y[j] = 0.f;
            }
            *(LAS f32x4*)(ybuf + rr * 256 + ch * 8) = (f32x4){y[0], y[1], y[2], y[3]}; *(LAS f32x4*)(ybuf + rr * 256 + ch * 8 + 4) = (f32x4){y[4], y[5], y[6], y[7]};
        }
        __syncthreads();
        { const int c = tid & 255, half = tid >> 8;
          float w[31];
#pragma unroll
          for (int k = 0; k < 31; ++k) w[k] = dw[k * 256 + c];
          const float bias = dwb[c];
          float yv[46];
#pragma unroll
          for (int i = 0; i < 46; ++i) yv[i] = ybuf[(half * 16 + i) * 256 + c];
#pragma unroll
          for (int t = 0; t < 16; ++t) { float s = bias;
#pragma unroll
              for (int k = 0; k < 31; ++k) s += w[k] * yv[t + k];
              cbuf[(half * 16 + t) * 256 + c] = s; } }
        __syncthreads();
        for (int rr = wave * 4; rr < wave * 4 + 4; ++rr) {
            const f32x4 x = *(const LAS f32x4*)(cbuf + rr * 256 + lane * 4);
            const float mu = wave_sum((x[0] + x[1]) + (x[2] + x[3])) * (1.0f / 256.0f);
            const f32x4 dx = x - mu;
            const float var = wave_sum((dx[0] * dx[0] + dx[1] * dx[1]) + (dx[2] * dx[2] + dx[3] * dx[3])) * (1.0f / 256.0f);
            const float rstd = 1.0f / sqrtf(var + EPS);
            const f32x4 yv = dx * rstd * *(const f32x4*)(lng + lane * 4) + *(const f32x4*)(lnb + lane * 4);
            v2u wv; wv.x = pk2(silu_acc(yv[0]), silu_acc(yv[1])); wv.y = pk2(silu_acc(yv[2]), silu_acc(yv[3]));
            *(v2u*)(CAT + (size_t)(r0 + rr) * 1024 + 512 + lane * 4) = wv;
        }
        __syncthreads();
    }
}


typedef unsigned long long u64;
typedef u64 u64x2 __attribute__((ext_vector_type(2)));
template <int L> struct HyGeo {
    static constexpr int R = L / 128, NSTEP = L / 32, CS = 4 * L + 64, US = 2 * L + 32, OFF_U = 8 * CS;
    static constexpr int USP = 2 * L + 176, PRE = 32;
};
template <int L>
__device__ __forceinline__ void hy_build_copies(LAS unsigned char* lds, const bf16* raw, int tid) {
    constexpr int CS = HyGeo<L>::CS;
    for (int p = tid; p < L / 4; p += NTHREADS) {
        const v4u a = *(const v4u*)(raw + 8 * p), b = *(const v4u*)(raw + 8 * p + 8);
        const unsigned w[8] = {a.x, a.y, a.z, a.w, b.x, b.y, b.z, b.w};
#pragma unroll
        for (int sg = 0; sg < 8; ++sg) { v4u o;
            if ((sg & 1) == 0) { o.x = w[sg / 2]; o.y = w[sg / 2 + 1]; o.z = w[sg / 2 + 2]; o.w = w[sg / 2 + 3]; }
            else { const int h = sg / 2; o.x = (w[h] >> 16) | (w[h + 1] << 16); o.y = (w[h + 1] >> 16) | (w[h + 2] << 16); o.z = (w[h + 2] >> 16) | (w[h + 3] << 16); o.w = (w[h + 3] >> 16) | (w[h + 4] << 16); }
            *(LAS v4u*)(lds + sg * CS + 16 * p) = o; }
    }
}
template <int L, int NB>
__device__ __forceinline__ void hy_toeplitz(LAS unsigned char* lds, int boff, f32x4 (&acc)[HyGeo<L>::R][NB > 8 ? 2 : 1], int wave, int lane) {
    constexpr int R = HyGeo<L>::R, NT = NB > 8 ? 2 : 1, NSTEP = HyGeo<L>::NSTEP, CS = HyGeo<L>::CS, US = HyGeo<L>::US;
    const int i = lane & 15, q = lane >> 4;
    const int abase = (7 - (i & 7)) * CS + 16 * ((L / 8 - 1) - (i >> 3) + q - 2 * R * wave);
    int bb[NT];
#pragma unroll
    for (int nt = 0; nt < NT; ++nt) bb[nt] = boff + ((NB > 8 ? nt * 16 + i : (i & 7))) * US + 16 * q;
    bf16x8 F[R];
#pragma unroll
    for (int e = 0; e < R; ++e) F[e] = *(const LAS bf16x8*)(lds + abase - 32 * e);
#pragma unroll
    for (int r = 0; r < R; ++r)
#pragma unroll
        for (int nt = 0; nt < NT; ++nt) acc[r][nt] = (f32x4){0.f, 0.f, 0.f, 0.f};
    bf16x8 B[2][NT];
#pragma unroll
    for (int nt = 0; nt < NT; ++nt) B[0][nt] = *(const LAS bf16x8*)(lds + bb[nt]);
#pragma unroll 1
    for (int jo = 0; jo < NSTEP; jo += 8) {
#pragma unroll
        for (int ji = 0; ji < 8; ++ji) {
            const int j = jo + ji; constexpr int dummy = 0; (void)dummy;
#pragma unroll
            for (int r = R - 2; r < R; ++r) { const int slot = (((r - 2 * ji) % R) + R) % R;
#pragma unroll
                for (int nt = 0; nt < NT; ++nt) acc[r][nt] = __builtin_amdgcn_mfma_f32_16x16x32_bf16(F[slot], B[ji & 1][nt], acc[r][nt], 0, 0, 0); }
            __builtin_amdgcn_sched_barrier(0);
            if (j + 1 < NSTEP) {
#pragma unroll
                for (int nt = 0; nt < NT; ++nt) B[(ji + 1) & 1][nt] = *(const LAS bf16x8*)(lds + bb[nt] + 64 * (j + 1));
#pragma unroll
                for (int rr = 0; rr < 2; ++rr) { const int slot = (((rr - 2 * (ji + 1)) % R) + R) % R; F[slot] = *(const LAS bf16x8*)(lds + abase + 64 * (j + 1) - 32 * rr); }
            }
            __builtin_amdgcn_sched_barrier(0);
#pragma unroll
            for (int r = 0; r < R - 2; ++r) { const int slot = (((r - 2 * ji) % R) + R) % R;
#pragma unroll
                for (int nt = 0; nt < NT; ++nt) acc[r][nt] = __builtin_amdgcn_mfma_f32_16x16x32_bf16(F[slot], B[ji & 1][nt], acc[r][nt], 0, 0, 0); }
            __builtin_amdgcn_sched_barrier(0);
        }
    }
}
template <int L>
__device__ __forceinline__ void hy_toeplitz_pk(LAS unsigned char* lds, int boff, f32x4 (&acc)[HyGeo<L>::R / 2], int wave, int lane) {
    constexpr int R = HyGeo<L>::R, RP = R / 2, NSTEP = HyGeo<L>::NSTEP, CS = HyGeo<L>::CS, USP = HyGeo<L>::USP;
    static_assert(RP == 8, "slot arithmetic assumes 8 tile pairs per wave and an 8-step unroll");
    const int i = lane & 15, q = lane >> 4;
    const int abase = (7 - (i & 7)) * CS + 16 * ((L / 8 - 1) - (i >> 3) + q - 2 * R * wave);
    const int bb = boff + (i & 7) * USP + 16 * q + (i < 8 ? HyGeo<L>::PRE : 0);
    bf16x8 F[RP];
#pragma unroll
    for (int rp = 0; rp < RP; ++rp) F[rp] = *(const LAS bf16x8*)(lds + abase - 32 * (2 * rp + 1));
#pragma unroll
    for (int rp = 0; rp < RP; ++rp) acc[rp] = (f32x4){0.f, 0.f, 0.f, 0.f};
    bf16x8 B[2];
    B[0] = *(const LAS bf16x8*)(lds + bb);
#pragma unroll 1
    for (int jo = 0; jo < NSTEP; jo += 8) {
#pragma unroll
        for (int ji = 0; ji < 8; ++ji) {
            const int j = jo + ji;
            { const int slot = (((RP - 1 - ji) % RP) + RP) % RP; acc[RP - 1] = __builtin_amdgcn_mfma_f32_16x16x32_bf16(F[slot], B[ji & 1], acc[RP - 1], 0, 0, 0); }
            __builtin_amdgcn_sched_barrier(0);
            B[(ji + 1) & 1] = *(const LAS bf16x8*)(lds + bb + 64 * (j + 1));
            { const int slot = (((0 - (ji + 1)) % RP) + RP) % RP; F[slot] = *(const LAS bf16x8*)(lds + abase + 64 * (j + 1) - 32); }
            __builtin_amdgcn_sched_barrier(0);
#pragma unroll
            for (int rp = 0; rp < RP - 1; ++rp) { const int slot = (((rp - ji) % RP) + RP) % RP; acc[rp] = __builtin_amdgcn_mfma_f32_16x16x32_bf16(F[slot], B[ji & 1], acc[rp], 0, 0, 0); }
            __builtin_amdgcn_sched_barrier(0);
        }
    }
#pragma unroll
    for (int rp = 0; rp < RP; ++rp) acc[rp] = __builtin_amdgcn_mfma_f32_16x16x32_bf16(F[rp], B[0], acc[rp], 0, 0, 0);
}
struct XRaw { v2u z; unsigned zl, zr; };
__device__ __forceinline__ XRaw xraw_load(const bf16* zrow, int t, int L) { XRaw x; x.z = *(const v2u*)zrow; x.zl = t > 0 ? (unsigned)zrow[-1] : 0u; x.zr = t + 4 < L ? (unsigned)zrow[4] : 0u; return x; }
__device__ __forceinline__ void sconv4x(const XRaw& x, float w0, float w1, float w2, float sb, float (&out)[4]) {
    const float zl = bf2f(x.zl), zr = bf2f(x.zr), z0 = bflo(x.z.x), z1 = bfhi(x.z.x), z2 = bflo(x.z.y), z3 = bfhi(x.z.y);
    out[0] = sb + w0 * zl + w1 * z0 + w2 * z1; out[1] = sb + w0 * z0 + w1 * z1 + w2 * z2; out[2] = sb + w0 * z1 + w1 * z2 + w2 * z3; out[3] = sb + w0 * z2 + w1 * z3 + w2 * zr;
}
__device__ __forceinline__ void sconv4(const bf16* zrow, int t, int L, float w0, float w1, float w2, float sb, float (&out)[4]) { const XRaw x = xraw_load(zrow, t, L); sconv4x(x, w0, w1, w2, sb, out); }
template <int L>
__device__ __forceinline__ void hy_store_copies(LAS unsigned char* lds, const v4u a, const v4u b, int p) {
    constexpr int CS = HyGeo<L>::CS;
    const unsigned w[8] = {a.x, a.y, a.z, a.w, b.x, b.y, b.z, b.w};
#pragma unroll
    for (int sg = 0; sg < 8; ++sg) { v4u o;
        if ((sg & 1) == 0) { o.x = w[sg / 2]; o.y = w[sg / 2 + 1]; o.z = w[sg / 2 + 2]; o.w = w[sg / 2 + 3]; }
        else { const int h = sg / 2; o.x = (w[h] >> 16) | (w[h + 1] << 16); o.y = (w[h + 1] >> 16) | (w[h + 2] << 16); o.z = (w[h + 2] >> 16) | (w[h + 3] << 16); o.w = (w[h + 3] >> 16) | (w[h + 4] << 16); }
        *(LAS v4u*)(lds + sg * CS + 16 * p) = o; }
}
template <int L, int NB, bool DUP = false>
__device__ __forceinline__ void hyena_channel(const Args& a, int l, int c, const bf16* ZT, bf16* CAT, LAS unsigned char* lds, int tid, int wave, int lane) {
    constexpr bool PK = (NB == 8);
    constexpr int R = HyGeo<L>::R, RA = PK ? R / 2 : R, NT = NB > 8 ? 2 : 1, US = PK ? HyGeo<L>::USP : HyGeo<L>::US, PRE = PK ? HyGeo<L>::PRE : 0, OFF_U = HyGeo<L>::OFF_U, OFF_Y = OFF_U + NB * US;
    constexpr bool LAT = (L == 2048); constexpr int stream = LAT ? 0 : 1; constexpr int rowbase = LAT ? MCTX : 0;
    static_assert(L / 4 <= NTHREADS, "one copy slot per thread");
    static_assert(OFF_Y + NB * US <= LDSCTL_OFF && !DUP, "LDS");
    unsigned char* ws = a.ws;
    const float* sw = a.in[I_HSW] + l * 3 * 768; const float* sb = a.in[I_HSB] + l * 768;
    const bf16* raw0 = (const bf16*)(ws + WS_HYRAW) + ((size_t)(l * 2 + 0) * 256 + c) * 4608 + (LAT ? 0 : 4096);
    const bf16* raw1 = (const bf16*)(ws + WS_HYRAW) + ((size_t)(l * 2 + 1) * 256 + c) * 4608 + (LAT ? 0 : 4096);
    const int i = lane & 15;
    const bool cp = tid < L / 4;
    v4u f0a = {0u, 0u, 0u, 0u}, f0b = f0a, f1a = f0a, f1b = f0a;
    if (cp) { f0a = *(const v4u*)(raw0 + 8 * tid); f0b = *(const v4u*)(raw0 + 8 * tid + 8); f1a = *(const v4u*)(raw1 + 8 * tid); f1b = *(const v4u*)(raw1 + 8 * tid + 8); }
    __syncthreads();
    if (cp) hy_store_copies<L>(lds, f0a, f0b, tid);
    if constexpr (PK) {
        const v4u z = {0u, 0u, 0u, 0u};
        if (tid < 32) *(LAS v4u*)(lds + (tid >> 2) * HyGeo<L>::CS + 4 * L + 16 * (tid & 3)) = z;
        else if (tid < 128) { const int e = tid - 32, row = e / 6, k = e % 6;
            *(LAS v4u*)(lds + OFF_U + row * US + (k < 2 ? 16 * k : PRE + 2 * L + 16 * (k - 2))) = z; }
    }
    { const float w0 = sw[c], w1 = sw[768 + c], w2 = sw[1536 + c], b0 = sb[c];
      for (int idx = tid; idx < NB * (L / 8); idx += NTHREADS) {
          const int b = idx / (L / 8), s0 = (idx % (L / 8)) * 8; const bf16* zrow = ZT + (size_t)c * M + rowbase + b * L + s0;
          float o0[4], o1[4]; sconv4(zrow, s0, L, w0, w1, w2, b0, o0); sconv4(zrow + 4, s0 + 4, L, w0, w1, w2, b0, o1);
          v4u w; w.x = pk2(o0[0], o0[1]); w.y = pk2(o0[2], o0[3]); w.z = pk2(o1[0], o1[1]); w.w = pk2(o1[2], o1[3]);
          *(LAS v4u*)(lds + OFF_U + b * US + PRE + 2 * s0) = w; } }
    __syncthreads();
    f32x4 acc[RA][NT];
#define HY_T(r_, q_) (PK ? 16 * (R * wave + 2 * (r_) + (i < 8 ? 1 : 0)) + 4 * (q_) : 16 * (R * wave + (r_)) + 4 * (q_))
    if constexpr (PK) { f32x4 (&ap)[RA] = *reinterpret_cast<f32x4 (*)[RA]>(&acc[0][0]); hy_toeplitz_pk<L>(lds, OFF_U, ap, wave, lane); }
    else hy_toeplitz<L, NB>(lds, OFF_U, acc, wave, lane);
    { const float scale = 1.0f / sqrtf((float)((const unsigned long long*)(ws + WS_SUMSQ))[((l * 2 + stream) * 2 + 0) * 256 + c] * FSQ_UNFIX + EPS), bias = a.in[I_HBIAS][(l * 2 + 0) * 256 + c];
      const float w0 = sw[256 + c], w1 = sw[768 + 256 + c], w2 = sw[1536 + 256 + c], b0 = sb[256 + c];
      int q = lane >> 4; asm volatile("" : "+v"(q));
#pragma unroll
      for (int nt = 0; nt < NT; ++nt) { const int b = PK ? (i & 7) : nt * 16 + i;
          if (b < NB) {
#pragma unroll
              for (int r = 0; r < RA; ++r) { const int t = HY_T(r, q);
                  float x1[4]; sconv4(ZT + (size_t)(256 + c) * M + rowbase + b * L + t, t, L, w0, w1, w2, b0, x1);
                  const v2u uv = *(const LAS v2u*)(lds + OFF_U + b * US + PRE + 2 * t);
                  const float y0 = x1[0] * (scale * acc[r][nt][0] + bias * bflo(uv.x)), y1 = x1[1] * (scale * acc[r][nt][1] + bias * bfhi(uv.x));
                  const float y2 = x1[2] * (scale * acc[r][nt][2] + bias * bflo(uv.y)), y3 = x1[3] * (scale * acc[r][nt][3] + bias * bfhi(uv.y));
                  v2u w; w.x = pk2(y0, y1); w.y = pk2(y2, y3); *(LAS v2u*)(lds + OFF_Y + b * US + PRE + 2 * t) = w; } } } }
    __syncthreads();
    if (cp) hy_store_copies<L>(lds, f1a, f1b, tid);
    __syncthreads();
    if constexpr (PK) { f32x4 (&ap)[RA] = *reinterpret_cast<f32x4 (*)[RA]>(&acc[0][0]); hy_toeplitz_pk<L>(lds, OFF_Y, ap, wave, lane); }
    else hy_toeplitz<L, NB>(lds, OFF_Y, acc, wave, lane);
    { const float scale = 1.0f / sqrtf((float)((const unsigned long long*)(ws + WS_SUMSQ))[((l * 2 + stream) * 2 + 1) * 256 + c] * FSQ_UNFIX + EPS), bias = a.in[I_HBIAS][(l * 2 + 1) * 256 + c];
      const float w0 = sw[512 + c], w1 = sw[768 + 512 + c], w2 = sw[1536 + 512 + c], b0 = sb[512 + c];
      int q = lane >> 4; asm volatile("" : "+v"(q));
#pragma unroll
      for (int nt = 0; nt < NT; ++nt) { const int b = PK ? (i & 7) : nt * 16 + i;
          if (b < NB) {
#pragma unroll
              for (int r = 0; r < RA; ++r) { const int t = HY_T(r, q);
                  float x2[4]; sconv4(ZT + (size_t)(512 + c) * M + rowbase + b * L + t, t, L, w0, w1, w2, b0, x2);
                  const v2u yv = *(const LAS v2u*)(lds + OFF_Y + b * US + PRE + 2 * t);
                  bf16* dst = CAT + (size_t)(rowbase + b * L + t) * 1024 + 768 + c;
                  dst[0]    = (bf16)f2bf(x2[0] * (scale * acc[r][nt][0] + bias * bflo(yv.x)));
                  dst[1024] = (bf16)f2bf(x2[1] * (scale * acc[r][nt][1] + bias * bfhi(yv.x)));
                  dst[2048] = (bf16)f2bf(x2[2] * (scale * acc[r][nt][2] + bias * bflo(yv.y)));
                  dst[3072] = (bf16)f2bf(x2[3] * (scale * acc[r][nt][3] + bias * bfhi(yv.y))); } } } }
#undef HY_T
    __syncthreads();
}

typedef float f32x16 __attribute__((ext_vector_type(16)));
constexpr int ATT_KP = 144, ATT_VP = 80, ATT_KB = 32 * ATT_KP, ATT_BUF = ATT_KB + 64 * ATT_VP;
__device__ __forceinline__ void attn_phase(const Args& a, int l, const bf16* Z, const bf16* ZT, bf16* CAT, LAS unsigned char* lds, int tid, int wave, int lane) {
    const bf16* CKB = (const bf16*)(a.ws + WS_CKB) + (size_t)l * 8 * 256 * 128; const bf16* CVT = (const bf16*)(a.ws + WS_CVT) + (size_t)l * 8 * 128 * 256;
    const int r = lane & 31, hh = lane >> 5;
    for (int it = blockIdx.x; it < 768; it += gridDim.x) {
        bool lat; int b, g, qb;
        if (it < 512) { lat = true; b = it >> 6; g = (it >> 5) & 1; qb = it & 31; }
        else { const int rr = it - 512; lat = false; b = rr >> 3; g = (rr >> 2) & 1; qb = rr & 3; }
        const int h = g * 4 + (wave & 3), q0 = qb * 64 + 32 * (wave >> 2);
        const int L = lat ? 2048 : 256, seq0 = lat ? MCTX + b * 2048 : b * 256;
        const int kt_lo = lat ? (qb * 64 - 128 < 0 ? 0 : qb * 64 - 128) : 0, kt_hi = lat ? (qb * 64 + 192 > L ? L : qb * 64 + 192) : 256;
        const int n_local = (kt_hi - kt_lo) >> 5, n_total = n_local + (lat ? 8 : 0);
        const bool isk = tid < 256; const int t2 = tid & 255;
        const bf16* src_loc = isk ? Z + (size_t)(seq0 + kt_lo + (t2 >> 3)) * ZW + 512 + g * 64 + (t2 & 7) * 8 : ZT + (size_t)(768 + g * 64 + (t2 >> 2)) * M + seq0 + kt_lo + (t2 & 3) * 8;
        const bf16* src_ctx = isk ? CKB + ((size_t)b * 256 + (t2 >> 3)) * 128 + g * 64 + (t2 & 7) * 8 : CVT + ((size_t)b * 128 + g * 64 + (t2 >> 2)) * 256 + (t2 & 3) * 8;
        const size_t step_loc = isk ? (size_t)32 * ZW : 32, step_ctx = isk ? (size_t)32 * 128 : 32;
        const int dst = isk ? (t2 >> 3) * ATT_KP + (t2 & 7) * 16 : ATT_KB + (t2 >> 2) * ATT_VP + ((t2 & 3) >> 1) * 32 + ((t2 & 3) & 1) * 8;
#define ATT_GLOAD(ti_) (*(const v4u*)((ti_) < n_local ? src_loc + (size_t)(ti_) * step_loc : src_ctx + (size_t)((ti_) - n_local) * step_ctx))
#define ATT_LSTORE(buf_, v_) do { LAS unsigned char* p_ = lds + (buf_) * ATT_BUF + dst; if (isk) *(LAS v4u*)p_ = (v_); else { v2u lo_, hi_; lo_.x = (v_).x; lo_.y = (v_).y; hi_.x = (v_).z; hi_.y = (v_).w; *(LAS v2u*)p_ = lo_; *(LAS v2u*)(p_ + 16) = hi_; } } while (0)
        bf16x8 qf[4];
        { const bf16* qp = Z + (size_t)(seq0 + q0 + r) * ZW + h * 64 + 8 * hh;
#pragma unroll
          for (int s = 0; s < 4; ++s) qf[s] = *(const bf16x8*)(qp + 16 * s); }
        f32x16 o0, o1;
#pragma unroll
        for (int e = 0; e < 16; ++e) { o0[e] = 0.f; o1[e] = 0.f; }
        float mrun = a.in[I_SINK][l * 8 + h] * LOG2E, lsum = 1.0f;
        __syncthreads();
        v4u g1 = {0u, 0u, 0u, 0u}, g2 = g1;
        { const v4u g0 = ATT_GLOAD(0); if (n_total > 1) g1 = ATT_GLOAD(1); if (n_total > 2) g2 = ATT_GLOAD(2); ATT_LSTORE(0, g0); }
        __syncthreads();
        for (int ti = 0; ti < n_total; ++ti) {
            v4u gn = {0u, 0u, 0u, 0u};
            if (ti + 3 < n_total) gn = ATT_GLOAD(ti + 3);
            const int kt = kt_lo + 32 * ti;
            const bool active = !lat || ti >= n_local || (kt >= q0 - 128 && kt <= q0 + 128);
            if (active) {
                const LAS unsigned char* kb = lds + (ti & 1) * ATT_BUF + r * ATT_KP + 16 * hh;
                const LAS unsigned char* vb = lds + (ti & 1) * ATT_BUF + ATT_KB + r * ATT_VP + 16 * hh;
                f32x16 st;
#pragma unroll
                for (int e = 0; e < 16; ++e) st[e] = 0.f;
#pragma unroll
                for (int s = 0; s < 4; ++s) st = __builtin_amdgcn_mfma_f32_32x32x16_bf16(*(const LAS bf16x8*)(kb + 32 * s), qf[s], st, 0, 0, 0);
                const bf16x8 v00 = *(const LAS bf16x8*)(vb), v01 = *(const LAS bf16x8*)(vb + 32), v10 = *(const LAS bf16x8*)(vb + 32 * ATT_VP), v11 = *(const LAS bf16x8*)(vb + 32 * ATT_VP + 32);
                if (lat && ti < n_local) {
                    if (kt == q0 - 128) {
#pragma unroll
                        for (int e = 0; e < 16; ++e) { const int jj = (e & 3) + 8 * (e >> 2) + 4 * hh; if (jj < r) st[e] = -1e30f; }
                    } else if (kt == q0 + 128) {
#pragma unroll
                        for (int e = 0; e < 16; ++e) { const int jj = (e & 3) + 8 * (e >> 2) + 4 * hh; if (jj > r) st[e] = -1e30f; }
                    }
                }
                float mx = fmaxf(fmaxf(st[0], st[1]), fmaxf(st[2], st[3]));
#pragma unroll
                for (int e = 4; e < 16; e += 4) mx = fmaxf(mx, fmaxf(fmaxf(st[e], st[e + 1]), fmaxf(st[e + 2], st[e + 3])));
                mx = fmaxf(mx, __shfl_xor(mx, 32));
                const float mn = fmaxf(mrun, mx); const bool grew = __any(mn > mrun);
                const float alpha = grew ? __builtin_amdgcn_exp2f(mrun - mn) : 1.0f; mrun = mn;
                float ps = 0.f;
#pragma unroll
                for (int e = 0; e < 16; ++e) { st[e] = __builtin_amdgcn_exp2f(st[e] - mn); ps += st[e]; }
                ps += __shfl_xor(ps, 32);
                lsum = lsum * alpha + ps;
                if (grew) {
#pragma unroll
                    for (int e = 0; e < 16; ++e) { o0[e] *= alpha; o1[e] *= alpha; } }
                v4u pa, pb;
                pa.x = pk2(st[0], st[1]); pa.y = pk2(st[2], st[3]); pa.z = pk2(st[4], st[5]); pa.w = pk2(st[6], st[7]);
                pb.x = pk2(st[8], st[9]); pb.y = pk2(st[10], st[11]); pb.z = pk2(st[12], st[13]); pb.w = pk2(st[14], st[15]);
                const bf16x8 p0 = __builtin_bit_cast(bf16x8, pa), p1 = __builtin_bit_cast(bf16x8, pb);
                o0 = __builtin_amdgcn_mfma_f32_32x32x16_bf16(v00, p0, o0, 0, 0, 0);
                o0 = __builtin_amdgcn_mfma_f32_32x32x16_bf16(v01, p1, o0, 0, 0, 0);
                o1 = __builtin_amdgcn_mfma_f32_32x32x16_bf16(v10, p0, o1, 0, 0, 0);
                o1 = __builtin_amdgcn_mfma_f32_32x32x16_bf16(v11, p1, o1, 0, 0, 0);
            }
            if (ti + 1 < n_total) ATT_LSTORE((ti + 1) & 1, g1);
            g1 = g2; g2 = gn;
            __syncthreads();
        }
#undef ATT_GLOAD
#undef ATT_LSTORE
        const float inv = 1.0f / lsum;
        bf16* op = CAT + (size_t)(seq0 + q0 + r) * 1024 + h * 64 + 4 * hh;
#pragma unroll
        for (int g4 = 0; g4 < 4; ++g4) {
            v2u w; w.x = pk2(o0[4 * g4] * inv, o0[4 * g4 + 1] * inv); w.y = pk2(o0[4 * g4 + 2] * inv, o0[4 * g4 + 3] * inv); *(v2u*)(op + 8 * g4) = w;
            v2u x; x.x = pk2(o1[4 * g4] * inv, o1[4 * g4 + 1] * inv); x.y = pk2(o1[4 * g4 + 2] * inv, o1[4 * g4 + 3] * inv); *(v2u*)(op + 32 + 8 * g4) = x; }
    }
}

#ifndef PROBE_PH
#define PROBE_PH -1
#endif
#ifndef PROBE_TS
#define PROBE_TS -1
#endif
#ifndef PROBE_BLK
#define PROBE_BLK 0
#endif
#define TS_BEGIN(k) do { if constexpr ((k) == PROBE_TS) { if (blockIdx.x == PROBE_BLK && threadIdx.x == 0) *((volatile LAS unsigned long long*)(c.lds + MISC_OFF + 64)) = __builtin_amdgcn_s_memrealtime(); } } while (0)
#define TS_END(k) do { if constexpr ((k) == PROBE_TS) { if (blockIdx.x == PROBE_BLK && threadIdx.x == 0) *((volatile LAS unsigned long long*)(c.lds + MISC_OFF + 72)) = __builtin_amdgcn_s_memrealtime(); } } while (0)
struct Ctx { LAS unsigned char* lds; int tid, lane, wave, G, gw, NGW; };
constexpr int CW_SPLIT = 8192;

__device__ __forceinline__ void sb_arrive(unsigned* ctl, int id) {
    asm volatile("s_waitcnt vmcnt(0)" ::: "memory");
    __syncthreads();
    if (threadIdx.x == 0) __hip_atomic_fetch_add(ctl + CW_SPLIT + 64 * id, 1u, __ATOMIC_RELAXED, __HIP_MEMORY_SCOPE_AGENT);
}
__device__ __forceinline__ void sb_wait(unsigned* ctl, int id, unsigned G) {
    if (threadIdx.x == 0) {
        unsigned sp = 0;
        while (__hip_atomic_load(ctl + CW_SPLIT + 64 * id, __ATOMIC_RELAXED, __HIP_MEMORY_SCOPE_AGENT) < G) {
            __builtin_amdgcn_s_sleep(2);
            if (++sp > (1u << 22)) { atomicAdd(ctl + CW_BAR + XB_TMO, 1u); break; }
        }
        __builtin_amdgcn_fence(__ATOMIC_ACQUIRE, "agent");
        asm volatile("s_waitcnt vmcnt(0)" ::: "memory");
    }
    __syncthreads();
}
struct HalfOrder {
    pg8::StaticOrder S; int pm0;
    __device__ __forceinline__ void init(int N, int G, int c, int pm0_, int off) { const int rot = (G == 256) ? off : 0; S.init(48 * 256, N, G, (c + G - rot) % G); pm0 = pm0_; }
    __device__ __forceinline__ bool next(int i, pg8::Unit& u) const { if (!S.next(i, u)) return false; u.pm += pm0; return true; }
    __device__ __forceinline__ void a_ready(const pg8::Unit&) const {}
    __device__ __forceinline__ void done(const pg8::Unit&) const {}
};

template <int L, int f, int h> __device__ __forceinline__ void stage_G(const Args& a, const Ctx& c, int off) {
    unsigned char* ws = a.ws;
    pg8::Gemm g{(const bf16*)a.out, (const bf16*)(ws + WS_WGU) + (size_t)(L * 2 + f) * 5632 * 1024, M, 5632, 1024};
    HalfOrder S; S.init(5632, c.G, (int)blockIdx.x, 48 * h, off);
    pg8::EpiGU E{(bf16*)(ws + WS_BIG), (const unsigned long long*)(ws + WS_SS) + (size_t)(3 * L + 2 * f) * M, (const float*)(ws + WS_BIAS) + (size_t)L * 119808 + (f ? 69120 : 0)};
    pg8::gemm_phase<pg8::EpiGU, HalfOrder, true, true>(c.lds, g, S, E);
}
template <int L, int f, int h> __device__ __forceinline__ void stage_D(const Args& a, const Ctx& c, int off) {
    unsigned char* ws = a.ws; bf16* X = (bf16*)(ws + WS_X); unsigned long long* SS = (unsigned long long*)(ws + WS_SS);
    const float* modl = (const float*)(ws + WS_MOD) + (size_t)L * 9 * 9216;
    pg8::Gemm g{(const bf16*)(ws + WS_BIG), (const bf16*)(ws + WS_WD) + (size_t)(L * 2 + f) * 1024 * 2816, M, 1024, 2816};
    HalfOrder S; S.init(1024, c.G, (int)blockIdx.x, 48 * h, off);
    constexpr bool first = (L == 0) && f == 0;
    bf16* Hn = (f == 1 && L == 1) ? (bf16*)nullptr : (bf16*)a.out;
    const float* gct = (const float*)(ws + WS_GCT) + (size_t)(f == 0 ? 3 * L + 1 : (L == 0 ? 3 : 0)) * 9216;
    typedef pg8::EpiResT<first> Epi;
    Epi E{first ? (const void*)a.in[I_XP] : (const void*)X, first ? (const void*)a.in[I_XS] : (const void*)(X + (size_t)MCTX * D), X, modl + (f ? 8 : 2) * 1024, Hn, gct, SS + (size_t)(3 * L + 1 + 2 * f) * M, 0.5f};
    pg8::gemm_phase<Epi, HalfOrder, true, true>(c.lds, g, S, E);
}
template <int L, int h> __device__ __forceinline__ void stage_IN(const Args& a, const Ctx& c, int off) {
    unsigned char* ws = a.ws; float* newk = a.out + (size_t)M * D; float* newv = newk + 32 * 2 * 256 * 128;
    pg8::Gemm g{(const bf16*)a.out, (const bf16*)(ws + WS_WIN) + (size_t)L * 2048 * 1024, M, 2048, 1024};
    HalfOrder S; S.init(2048, c.G, (int)blockIdx.x, 48 * h, off);
    pg8::EpiIN E{(bf16*)(ws + WS_Z), (bf16*)(ws + WS_ZT), newk, newv, (const float*)(ws + WS_ROPE), (const unsigned long long*)(ws + WS_SS) + (size_t)(3 * L + 1) * M, (const float*)(ws + WS_BIAS) + (size_t)L * 119808 + 50688, L, QSCALE};
    pg8::gemm_phase<pg8::EpiIN, HalfOrder, true, true>(c.lds, g, S, E);
}
template <int L, int h> __device__ __forceinline__ void stage_OUT(const Args& a, const Ctx& c, int off) {
    unsigned char* ws = a.ws; bf16* X = (bf16*)(ws + WS_X); const float* modl = (const float*)(ws + WS_MOD) + (size_t)L * 9 * 9216;
    pg8::Gemm g{(const bf16*)a.out + (size_t)M * D, (const bf16*)(ws + WS_WOUT) + (size_t)L * 1024 * 1024, M, 1024, 1024};
    HalfOrder S; S.init(1024, c.G, (int)blockIdx.x, 48 * h, off);
    typedef pg8::EpiResT<false> Epi;
    Epi E{X, X + (size_t)MCTX * D, X, modl + 5 * 1024, (bf16*)a.out, (const float*)(ws + WS_GCT) + (size_t)(3 * L + 2) * 9216, (unsigned long long*)(ws + WS_SS) + (size_t)(3 * L + 2) * M, 1.0f};
    pg8::gemm_phase<Epi, HalfOrder, true, true>(c.lds, g, S, E);
}
template <int L> __device__ __forceinline__ void mix_stage(const Args& a, const Ctx& c) {
    unsigned char* ws = a.ws; const bf16* Z = (const bf16*)(ws + WS_Z); const bf16* ZT = (const bf16*)(ws + WS_ZT); bf16* CAT = (bf16*)a.out + (size_t)M * D;
    int tid_ = c.tid; asm volatile("" : "+v"(tid_));
    const int G = c.G, tid = tid_, lane = tid_ & 63; LAS unsigned char* lds = c.lds;
#define HY_CH(w) ((((w) & 7) << 5) | (((w) >> 3) & 31))
    if constexpr (L == 0) { bias_phase(a, 832, 2 * 832, c.gw, c.NGW, lane); fold_phase(a, 256, 512, c.NGW - 1 - c.gw, c.NGW, lane); }
    if constexpr (L == 0) TS_BEGIN(301);
    for (int w = blockIdx.x; w < 256; w += G) hyena_channel<2048, 8>(a, L, HY_CH(w), ZT, CAT, lds, tid, c.wave, lane);
    if constexpr (L == 0) { TS_END(301); TS_BEGIN(302); }
    for (int w = blockIdx.x; w < 256; w += G) hyena_channel<256, 32>(a, L, HY_CH(w), ZT, CAT, lds, tid, c.wave, lane);
#undef HY_CH
    if constexpr (L == 0) { TS_END(302); TS_BEGIN(303); }
    attn_phase(a, L, Z, ZT, CAT, lds, tid, c.wave, lane);
    __syncthreads();
    if constexpr (L == 0) { TS_END(303); TS_BEGIN(304); }
    conv_phase(a, L, Z, CAT, lds, tid);
    if constexpr (L == 0) TS_END(304);
}
__device__ __forceinline__ void final_half(const Args& a, const Ctx& c, int h) {
    const bf16* X = (const bf16*)(a.ws + WS_X); float* Y = a.out; const unsigned long long* ss = (const unsigned long long*)(a.ws + WS_SS) + (size_t)6 * M; const float* g = a.in[I_GFIN];
    for (int r = h * 12288 + c.gw; r < (h + 1) * 12288; r += c.NGW) {
        const float rstd = 1.0f / sqrtf((float)ss[r] * (SS_UNFIX / D) + EPS);
#pragma unroll
        for (int j = 0; j < 2; ++j) { const int col = 8 * (c.lane + 64 * j); const v4u w = __builtin_nontemporal_load((const v4u*)(X + (size_t)r * D + col));
            const f32x4 x0 = {bflo(w.x), bfhi(w.x), bflo(w.y), bfhi(w.y)}, x1 = {bflo(w.z), bfhi(w.z), bflo(w.w), bfhi(w.w)};
            __builtin_nontemporal_store((x0 * rstd) * *(const f32x4*)(g + col), (f32x4*)(Y + (size_t)r * D + col)); __builtin_nontemporal_store((x1 * rstd) * *(const f32x4*)(g + col + 4), (f32x4*)(Y + (size_t)r * D + col + 4)); }
    }
}

__global__ void __launch_bounds__(NTHREADS, 2) mega_fwd(Args a) {
    extern __shared__ __attribute__((aligned(16))) unsigned char lds_raw[];
    Ctx c;
    c.lds = (LAS unsigned char*)lds_raw;
    c.tid = threadIdx.x; c.lane = c.tid & 63; c.wave = __builtin_amdgcn_readfirstlane(c.tid >> 6);
    c.G = gridDim.x; c.gw = blockIdx.x * NWAVES + c.wave; c.NGW = c.G * NWAVES;
    unsigned* ctl = (unsigned*)(a.ws + WS_CTL);
    for (int u = c.tid; u < (LDS_BYTES - LDSCTL_OFF) / 4; u += NTHREADS) ((LAS unsigned*)(c.lds + LDSCTL_OFF))[u] = 0u;
    __syncthreads();
    XcdBarrier bar = xcd_barrier_post(ctl + CW_BAR, (volatile LAS unsigned*)(c.lds + MISC_OFF) + 8);
    cg::grid_group grid = cg::this_grid();
    const unsigned G = (unsigned)c.G;
    TS_BEGIN(0);
    p0_prologue(a, c.lds, c.gw, c.NGW, c.wave, c.lane, true);
    if (a.ph_hi > 100000) grid.sync(); else xcd_barrier(bar);
    TS_END(0); TS_BEGIN(1);
    prep_phase(a.in[I_XP], a.in[I_XS], a.in[I_GF1], (const float*)(a.ws + WS_MOD), 1, (bf16*)a.out, (unsigned long long*)(a.ws + WS_SS), 0, M, c.gw, c.NGW, c.lane);
    bias_phase(a, 0, 832, c.gw, c.NGW, c.lane);
    gct_phase(a, c.gw, c.NGW, c.lane);
    fold_phase(a, 0, 256, c.NGW - 1 - c.gw, c.NGW, c.lane);
    xcd_barrier(bar);
    TS_END(1); TS_BEGIN(2);
    { stage_G<0, 0, 0>(a, c, 0); sb_arrive(ctl, 0); }
    { stage_G<0, 0, 1>(a, c, 32); sb_arrive(ctl, 1); }
    { sb_wait(ctl, 0, G); stage_D<0, 0, 0>(a, c, 64); sb_arrive(ctl, 2); }
    { sb_wait(ctl, 1, G); stage_D<0, 0, 1>(a, c, 0); sb_arrive(ctl, 3); }
    { const int b = (int)blockIdx.x;
      TS_BEGIN(24);
      if (b < 64 || b >= 192) { const int sw = (b < 64 ? b : b - 128) * NWAVES + c.wave;
          hyena_filter_phase(a, c.lds, sw, 128 * NWAVES, c.wave, c.lane);
          j1_run(a, (LAS float*)(c.lds + c.wave * 16384), J1_SLOT0 + sw, 2 * J1_L, 128 * NWAVES, c.lane); } }
    TS_END(24); TS_BEGIN(23);
    sb_wait(ctl, 2, G); sb_wait(ctl, 3, G);
    TS_END(23);
    stage_IN<0, 0>(a, c, 0);
    stage_IN<0, 1>(a, c, 128);
    xcd_barrier(bar);
    TS_END(2); TS_BEGIN(3);
    mix_stage<0>(a, c);
    xcd_barrier(bar);
    TS_END(3); TS_BEGIN(4);
    { stage_OUT<0, 0>(a, c, 128); sb_arrive(ctl, 4); }
    { stage_OUT<0, 1>(a, c, 64); sb_arrive(ctl, 5); }
    { sb_wait(ctl, 4, G); stage_G<0, 1, 0>(a, c, 0); sb_arrive(ctl, 6); }
    { sb_wait(ctl, 5, G); stage_G<0, 1, 1>(a, c, 32); sb_arrive(ctl, 7); }
    { sb_wait(ctl, 6, G); stage_D<0, 1, 0>(a, c, 0); sb_arrive(ctl, 8); }
    { sb_wait(ctl, 7, G); stage_D<0, 1, 1>(a, c, 192); sb_arrive(ctl, 9); }
    { sb_wait(ctl, 8, G); stage_G<1, 0, 0>(a, c, 64); sb_arrive(ctl, 10); }
    { sb_wait(ctl, 9, G); stage_G<1, 0, 1>(a, c, 96); sb_arrive(ctl, 11); }
    { sb_wait(ctl, 10, G); stage_D<1, 0, 0>(a, c, 128); sb_arrive(ctl, 12); }
    { sb_wait(ctl, 11, G); stage_D<1, 0, 1>(a, c, 64); sb_arrive(ctl, 13); }
    sb_wait(ctl, 12, G); sb_wait(ctl, 13, G);
    stage_IN<1, 0>(a, c, 0);
    stage_IN<1, 1>(a, c, 128);
    xcd_barrier(bar);
    TS_END(4); TS_BEGIN(5);
    mix_stage<1>(a, c);
    xcd_barrier(bar);
    TS_END(5); TS_BEGIN(6);
    { stage_OUT<1, 0>(a, c, 128); sb_arrive(ctl, 14); }
    { stage_OUT<1, 1>(a, c, 64); sb_arrive(ctl, 15); }
    { sb_wait(ctl, 14, G); stage_G<1, 1, 0>(a, c, 128); sb_arrive(ctl, 16); }
    { sb_wait(ctl, 15, G); stage_G<1, 1, 1>(a, c, 160); sb_arrive(ctl, 17); }
    { sb_wait(ctl, 16, G); stage_D<1, 1, 0>(a, c, 0); sb_arrive(ctl, 18); }
    { sb_wait(ctl, 17, G); stage_D<1, 1, 1>(a, c, 192); sb_arrive(ctl, 19); }
    { sb_wait(ctl, 18, G); final_half(a, c, 0); }
    { sb_wait(ctl, 19, G); final_half(a, c, 1); }
    TS_END(6);
    if constexpr (PROBE_TS >= 0) { if (blockIdx.x == PROBE_BLK && threadIdx.x == 0) { const unsigned long long t0 = *((volatile LAS unsigned long long*)(c.lds + MISC_OFF + 64)), t1 = *((volatile LAS unsigned long long*)(c.lds + MISC_OFF + 72)); const unsigned long long now = __builtin_amdgcn_s_memrealtime(); while (__builtin_amdgcn_s_memrealtime() - now < 9ull * (t1 - t0)) __builtin_amdgcn_s_sleep(8); } __syncthreads(); }
}

extern "C" void kernel_launch(void* const* d_in, const int* in_sizes, int n_in, void* d_out, int out_size, void* d_ws, size_t ws_size, hipStream_t stream) {
    static int grid = 0;
    if (grid == 0) {
        if (n_in != N_IN || ws_size < WS_END || out_size != M * D + 2 * 32 * 2 * 256 * 128) { fprintf(stderr, "kernel_launch: unexpected shapes (n_in %d, ws %zu, out %d)\n", n_in, ws_size, out_size); grid = -1; return; }
        int dev = 0, cus = 0, per_cu = 0;
        if (hipGetDevice(&dev) != hipSuccess || hipDeviceGetAttribute(&cus, hipDeviceAttributeMultiprocessorCount, dev) != hipSuccess) { grid = -1; return; }
        if (hipFuncSetAttribute((const void*)mega_fwd, hipFuncAttributeMaxDynamicSharedMemorySize, LDS_BYTES) != hipSuccess) { fprintf(stderr, "kernel_launch: hipFuncSetAttribute failed\n"); grid = -1; return; }
        if (hipOccupancyMaxActiveBlocksPerMultiprocessor(&per_cu, (const void*)mega_fwd, NTHREADS, LDS_BYTES) != hipSuccess || per_cu < 1) { fprintf(stderr, "kernel_launch: occupancy query says %d\n", per_cu); per_cu = 1; }
        (void)hipGetLastError();
        if (cus < 256) { fprintf(stderr, "kernel_launch: built for a 256-CU device (got %d)\n", cus); grid = -1; return; }
        grid = 256;
    }
    if (grid < 0) return;
    (void)hipMemsetAsync((char*)d_ws + WS_CTL, 0, CTL_ZERO_BYTES, stream);
    Args a{};
    for (int i = 0; i < N_IN; ++i) a.in[i] = (const float*)d_in[i];
    a.out = (float*)d_out; a.ws = (unsigned char*)d_ws; a.ph_lo = 0; a.ph_hi = 1;
    void* args[] = {&a};
    hipError_t e = hipLaunchCooperativeKernel((const void*)mega_fwd, dim3(grid), dim3(NTHREADS), args, LDS_BYTES, stream);
    if (e != hipSuccess) fprintf(stderr, "cooperative launch failed: %s (grid %d)\n", hipGetErrorString(e), grid);
}
```
